# Optimizing an MI355X kernel written in HIP

```python
import math
import jax, jax.numpy as jnp
from jax import lax
import numpy as np

D_MODEL = 1024
BATCH = 4
SEQ = 8192
DEPTH = 2

MEM_LEN = 256
D_FF = 2816
CONV_CH = 256
CONV_W = 31
SC_CH = 256
SC_W = 3
N_HEADS = 8
HEAD_DIM = 64
ATT_W = N_HEADS * HEAD_DIM
IDX_HEADS = 4
IDX_DIM = 64
TOPK_MAX = 256
Q_BLOCK = 128
ROPE_THETA = 10000.0
XA_HEADS = 4
XA_DIM = D_MODEL // XA_HEADS
MIX_W = CONV_CH + SC_CH + ATT_W
SPLIT_SIZES = (CONV_CH, CONV_CH,
               SC_CH, SC_CH, SC_CH,
               ATT_W, ATT_W, ATT_W,
               IDX_HEADS * IDX_DIM, IDX_DIM, IDX_HEADS)
N_IN = sum(SPLIT_SIZES)
SPLIT_POINTS = tuple(int(v) for v in np.cumsum(SPLIT_SIZES)[:-1])
IDX_SCALE = (IDX_HEADS ** -0.5) * (IDX_DIM ** -0.5)

kernel_name = "hymba_style_conformer_shortconv_dsa_hybrid"


def rms_norm(x, g, eps=1e-6):
    xf = x.astype(jnp.float32)
    y = xf * lax.rsqrt(jnp.mean(xf * xf, axis=-1, keepdims=True) + eps)
    return (y * g.astype(jnp.float32)).astype(x.dtype)


def layer_norm(x, g, b, eps=1e-5):
    xf = x.astype(jnp.float32)
    mu = jnp.mean(xf, axis=-1, keepdims=True)
    var = jnp.mean(jnp.square(xf - mu), axis=-1, keepdims=True)
    y = (xf - mu) * lax.rsqrt(var + eps)
    return (y * g.astype(jnp.float32) + b.astype(jnp.float32)).astype(x.dtype)


def swiglu(h, w_gate, w_up, w_down):
    return (jax.nn.silu(h @ w_gate) * (h @ w_up)) @ w_down


def causal_dwconv(x, w):
    width, ch = w.shape
    return lax.conv_general_dilated(
        x, w[:, None, :].astype(x.dtype), window_strides=(1,), padding=[(width - 1, 0)],
        dimension_numbers=('NWC', 'WIO', 'NWC'), feature_group_count=ch)


def rope_tables(positions, dim):
    inv_freq = ROPE_THETA ** (-jnp.arange(0, dim, 2, dtype=jnp.float32) / dim)
    ang = positions.astype(jnp.float32)[..., None] * inv_freq
    return jnp.cos(ang), jnp.sin(ang)


def apply_rope(t, cos, sin):
    tf = t.astype(jnp.float32)
    half = tf.shape[-1] // 2
    t1, t2 = tf[..., :half], tf[..., half:]
    c, s = cos[:, :, None, :], sin[:, :, None, :]
    return jnp.concatenate([t1 * c - t2 * s, t2 * c + t1 * s], axis=-1).astype(t.dtype)


def conformer_conv(a_val, a_gate, dw, dw_b, ln_g, ln_b):
    h = a_val * jax.nn.sigmoid(a_gate)
    h = causal_dwconv(h, dw) + dw_b
    return jax.nn.silu(layer_norm(h, ln_g, ln_b))


def short_gated_conv(b_gate, c_gate, h, w):
    return b_gate * causal_dwconv(c_gate * h, w)


def dsa_attention(q, k, v, q_idx, k_idx, w_idx):
    bsz, seq, nh, dh = q.shape
    topk = min(TOPK_MAX, seq // 4)
    nb = seq // Q_BLOCK
    key_pos = jnp.arange(seq)
    b_ar = jnp.arange(bsz)[:, None, None]

    def to_blocks(t):
        return jnp.moveaxis(t.reshape(bsz, nb, Q_BLOCK, *t.shape[2:]), 1, 0)

    q_pos = jnp.arange(seq).reshape(nb, Q_BLOCK)

    def one_block(args):
        qb, qib, wb, tb = args
        logits = jnp.einsum('bqhd,bsd->bqhs', qib, k_idx).astype(jnp.float32)
        score = jnp.einsum('bqh,bqhs->bqs', wb.astype(jnp.float32), jax.nn.relu(logits)) * IDX_SCALE
        causal = key_pos[None, :] <= tb[:, None]
        score = jnp.where(causal[None], score, -jnp.inf)
        top_val, top_idx = lax.top_k(score, topk)
        k_sel = k[b_ar, top_idx]
        v_sel = v[b_ar, top_idx]
        s = jnp.einsum('bqhd,bqkhd->bqhk', qb, k_sel).astype(jnp.float32) * (dh ** -0.5)
        s = jnp.where(jnp.isfinite(top_val)[:, :, None, :], s, -jnp.inf)
        p = jax.nn.softmax(s, axis=-1).astype(v.dtype)
        return jnp.einsum('bqhk,bqkhd->bqhd', p, v_sel)

    out = lax.map(one_block, (to_blocks(q), to_blocks(q_idx), to_blocks(w_idx), q_pos))
    return jnp.moveaxis(out, 0, 1).reshape(bsz, seq, nh * dh)


def memory_cross_attention(h, mem_n, wq, wkv, wo):
    bsz, seq, _ = h.shape
    m = mem_n.shape[1]
    q = (h @ wq).reshape(bsz, seq, XA_HEADS, XA_DIM)
    k, v = jnp.split(mem_n @ wkv, 2, axis=-1)
    k = k.reshape(bsz, m, XA_HEADS, XA_DIM)
    v = v.reshape(bsz, m, XA_HEADS, XA_DIM)
    s = jnp.einsum('bshd,bmhd->bhsm', q, k).astype(jnp.float32) * (XA_DIM ** -0.5)
    p = jax.nn.softmax(s, axis=-1).astype(v.dtype)
    o = jnp.einsum('bhsm,bmhd->bshd', p, v).reshape(bsz, seq, D_MODEL)
    return o @ wo


def setup_inputs(seed: int = 0) -> dict:
    key = jax.random.key(seed)
    ks = iter(jax.random.split(key, 32))
    L, D, F = DEPTH, D_MODEL, D_FF

    def w(shape, fan_in):
        return jax.random.normal(next(ks), shape, jnp.float32) * (fan_in ** -0.5)

    def gain(shape):
        return 1.0 + 0.01 * jax.random.normal(next(ks), shape, jnp.float32)

    def bias(shape):
        return 0.01 * jax.random.normal(next(ks), shape, jnp.float32)

    x = jax.random.normal(next(ks), (BATCH, SEQ, D), jnp.float32)
    mem = jax.random.normal(next(ks), (BATCH, MEM_LEN, D), jnp.float32)
    start = jax.random.randint(next(ks), (BATCH, 1), 0, 1024, dtype=jnp.int32)
    positions = (start + jnp.arange(SEQ, dtype=jnp.int32)[None, :]).astype(jnp.int32)
    return {
        "x": x, "mem": mem, "positions": positions,
        "ffn1_norm": gain((L, D)), "ffn1_w_gate": w((L, D, F), D), "ffn1_w_up": w((L, D, F), D),
        "ffn1_w_down": w((L, F, D), F),
        "mix_norm": gain((L, D)), "w_in": w((L, D, N_IN), D),
        "conf_dw": w((L, CONV_W, CONV_CH), CONV_W), "conf_dw_b": bias((L, CONV_CH)),
        "conf_ln_g": gain((L, CONV_CH)), "conf_ln_b": bias((L, CONV_CH)),
        "sc_dw": w((L, SC_W, SC_CH), SC_W),
        "w_out": w((L, MIX_W, D), MIX_W),
        "xa_norm": gain((L, D)), "mem_norm": gain((L, D)),
        "xa_wq": w((L, D, D), D), "xa_wkv": w((L, D, 2 * D), D), "xa_wo": w((L, D, D), D),
        "ffn2_norm": gain((L, D)), "ffn2_w_gate": w((L, D, F), D), "ffn2_w_up": w((L, D, F), D),
        "ffn2_w_down": w((L, F, D), F),
        "final_norm": gain((D,)),
    }


def reference(x, mem, positions, ffn1_norm, ffn1_w_gate, ffn1_w_up, ffn1_w_down, mix_norm, w_in,
              conf_dw, conf_dw_b, conf_ln_g, conf_ln_b, sc_dw, w_out, xa_norm, mem_norm,
              xa_wq, xa_wkv, xa_wo, ffn2_norm, ffn2_w_gate, ffn2_w_up, ffn2_w_down, final_norm):
    bsz, seq, _ = x.shape
    cos, sin = rope_tables(positions, HEAD_DIM)
    for l in range(DEPTH):
        x = x + 0.5 * swiglu(rms_norm(x, ffn1_norm[l]), ffn1_w_gate[l], ffn1_w_up[l], ffn1_w_down[l])
        h = rms_norm(x, mix_norm[l])
        (a_val, a_gate, b_gate, c_gate, b_h, q, k, v,
         q_idx, k_idx, w_idx) = jnp.split(h @ w_in[l], SPLIT_POINTS, axis=-1)
        y_a = conformer_conv(a_val, a_gate, conf_dw[l], conf_dw_b[l], conf_ln_g[l], conf_ln_b[l])
        y_b = short_gated_conv(b_gate, c_gate, b_h, sc_dw[l])
        q = apply_rope(q.reshape(bsz, seq, N_HEADS, HEAD_DIM), cos, sin)
        k = apply_rope(k.reshape(bsz, seq, N_HEADS, HEAD_DIM), cos, sin)
        v = v.reshape(bsz, seq, N_HEADS, HEAD_DIM)
        q_idx = apply_rope(q_idx.reshape(bsz, seq, IDX_HEADS, IDX_DIM), cos, sin)
        k_idx = apply_rope(k_idx[:, :, None, :], cos, sin)[:, :, 0, :]
        y_c = dsa_attention(q, k, v, q_idx, k_idx, w_idx)
        x = x + jnp.concatenate([y_a, y_b, y_c], axis=-1) @ w_out[l]
        x = x + memory_cross_attention(rms_norm(x, xa_norm[l]), rms_norm(mem, mem_norm[l]),
                                       xa_wq[l], xa_wkv[l], xa_wo[l])
        x = x + 0.5 * swiglu(rms_norm(x, ffn2_norm[l]), ffn2_w_gate[l], ffn2_w_up[l], ffn2_w_down[l])
    return rms_norm(x, final_norm)
```

```cpp
#include <hip/hip_runtime.h>
#include <cstdio>
#include <cstdint>
#include <cmath>
constexpr int NWAVES = 8;
constexpr int M = 32768, D = 1024, FF = 2816, SEQ = 8192, NBATCH = 4, DEPTH = 2, NGU = 2 * FF  , NINP = 3328  , NIN = 3140;
constexpr int NPH = 2 + 11 * DEPTH + 1;
constexpr float QSCALE = 0.125f * 1.4426950408889634f;
constexpr float XQSCALE = 0.0625f * 1.4426950408889634f;
constexpr float IDX_SCALE = 0.5f * 0.125f;
constexpr size_t MiB = 1u << 20;
constexpr size_t WS_CTL = 0, CTL_ZERO_BYTES = 1 * MiB;
constexpr size_t WS_SS = 448 * MiB, SS_STAGE = 2 * MiB;
constexpr size_t WS_MSS = 3 * MiB;
constexpr size_t WS_COS = 4 * MiB, WS_SIN = 8 * MiB;
constexpr size_t WS_MK = 12 * MiB;
constexpr size_t WS_MEMK = 22 * MiB, WS_MEMVT = 26 * MiB;
constexpr size_t WS_W = 30 * MiB, W_LAYER = 45 * MiB + MiB / 2;
constexpr size_t WO_GU1 = 0, WO_D1 = 11 * MiB, WO_IN = WO_D1 + 5 * MiB + MiB / 2, WO_OUT = WO_IN + 6 * MiB + MiB / 2, WO_Q = WO_OUT + 2 * MiB, WO_O = WO_Q + 2 * MiB, WO_GU2 = WO_O + 2 * MiB, WO_D2 = WO_GU2 + 11 * MiB;
static_assert(WO_D2 + 5 * MiB + MiB / 2 == W_LAYER, "weight map");
constexpr size_t WS_X = 122 * MiB;
constexpr size_t WS_R = 186 * MiB;
constexpr size_t WS_H = WS_R;
constexpr size_t WS_HG = WS_R, WS_U = WS_R + 16 * MiB, WS_BG = WS_R + 32 * MiB, WS_Q = WS_R + 48 * MiB, WS_K = WS_R + 80 * MiB, WS_V = WS_R + 112 * MiB, WS_QI = WS_R + 144 * MiB,
                 WS_KI = WS_R + 160 * MiB, WS_WI = WS_R + 164 * MiB, WS_MIX = WS_R + 165 * MiB, WS_MASK = WS_R + 229 * MiB, WS_MIXEND = WS_R + 261 * MiB;
constexpr size_t WS_XQ = WS_R;
constexpr size_t WS_END = 452 * MiB;
static_assert(WS_W + 2 * W_LAYER <= WS_X && WS_X + (size_t)M * D * 2 <= WS_R && WS_H + (size_t)M * FF * 2 <= WS_END && WS_MIXEND <= WS_END, "d_ws map");
constexpr int CW_TMO = 0, CW_BAR = 4096;
constexpr int RING_OFF = 0, RING_BYTES = 131072, LDSCTL_OFF = RING_BYTES, MISC_OFF = LDSCTL_OFF + 320, LDS_BYTES = 147456;

namespace pg8 {
#define PG8_LAS __attribute__((address_space(3)))
typedef unsigned short bf16_t;
typedef short bf16x8 __attribute__((ext_vector_type(8)));
typedef float f32x4 __attribute__((ext_vector_type(4)));
typedef unsigned u32x4 __attribute__((ext_vector_type(4)));
constexpr int BM = 256, BK = 64, HALF = 128, HTB = HALF * BK * 2  , STAGE_BYTES = 8 * HTB, NXCD = 8, WGM = 8;

__host__ __device__ __forceinline__ int lds_byte(int r, int c) { const int st = (r >> 4) * 2 + (c >> 5), rr = r & 15, cc = c & 31, ob = rr * 64 + cc * 2; return st * 1024 + (ob ^ (((ob >> 9) & 1) << 5)); }
__host__ __device__ __forceinline__ void stage_rc(int b, int& R, int& C) { const int st = b / 1024, sb = b % 1024, swz = sb ^ (((sb >> 9) & 1) << 5); R = (st >> 1) * 16 + swz / 64; C = (st & 1) * 32 + (swz % 64) / 2; }
__host__ __device__ __forceinline__ int perm32(int rho) { const int n = rho >> 4, i = rho & 15; return 8 * (i >> 2) + 4 * n + (i & 3); }

struct Unit { int pm, pn; };
struct Gemm { const bf16_t* A; const bf16_t* Bt; int M, N, K; };

struct StaticOrder {
    int nM, nN, nwg, G, c;
    __host__ __device__ void init(int M, int N, int G_, int c_) { nM = M / BM; nN = N / BM; nwg = nM * nN; G = G_; c = c_; }
    __host__ __device__ bool next(int i, Unit& u) const {
        const long L = (long)i * G + c; if (L >= nwg) return false;
        int wgid = (int)L; { const int q = nwg / NXCD, r = nwg % NXCD, xcd = wgid % NXCD, off = wgid / NXCD; wgid = (xcd < r ? xcd * (q + 1) : r * (q + 1) + (xcd - r) * q) + off; }
        const int nig = WGM * nN, gid = wgid / nig, fm = gid * WGM, gsz = (nM - fm) < WGM ? (nM - fm) : WGM;
        u.pm = fm + ((wgid % nig) % gsz); u.pn = (wgid % nig) / gsz; return true;
    }
    __device__ __forceinline__ void a_ready(const Unit&) const {}
    __device__ __forceinline__ void done(const Unit&) const {}
};
__device__ __forceinline__ unsigned cvt_pk_bf16(float lo, float hi) { unsigned r; asm volatile("v_cvt_pk_bf16_f32 %0, %1, %2" : "=v"(r) : "v"(lo), "v"(hi)); return r; }
typedef float f32x2 __attribute__((ext_vector_type(2)));
typedef unsigned u32x2 __attribute__((ext_vector_type(2)));
__device__ __forceinline__ float bflo(unsigned w) { return __uint_as_float(w << 16); }
__device__ __forceinline__ float bfhi(unsigned w) { return __uint_as_float(w & 0xffff0000u); }
__device__ __forceinline__ float sigm(float x) { return __builtin_amdgcn_rcpf(1.f + __builtin_amdgcn_exp2f(-1.4426950408889634f * x)); }
__device__ __forceinline__ u32x4 pack8(const f32x4 a, const f32x4 b) { u32x4 w; w.x = cvt_pk_bf16(a[0], a[1]); w.y = cvt_pk_bf16(a[2], a[3]); w.z = cvt_pk_bf16(b[0], b[1]); w.w = cvt_pk_bf16(b[2], b[3]); return w; }
__device__ __forceinline__ float sumsq_of(const float* ss, int row) { const f32x4* p = (const f32x4*)(ss + (size_t)row * 16); const f32x4 a = p[0], b = p[1], c = p[2], d = p[3];
    return (((a[0] + a[1]) + (a[2] + a[3])) + ((b[0] + b[1]) + (b[2] + b[3]))) + (((c[0] + c[1]) + (c[2] + c[3])) + ((d[0] + d[1]) + (d[2] + d[3]))); }
__device__ __forceinline__ float rstd_of(const float* ss, int row) { return __builtin_amdgcn_rsqf(sumsq_of(ss, row) * (1.f / 1024.f) + 1e-6f); }
__device__ __forceinline__ float rstd_of1(const float* ss, int row) { return __builtin_amdgcn_rsqf(ss[row] * (1.f / 1024.f) + 1e-6f); }
constexpr int FFH = 2816;

struct EpiSwiGLU {
    static constexpr bool PERM = true, AFTER_DRAIN = false;
    bf16_t* H; const float* ss;
    __device__ __forceinline__ void operator()(const f32x4 (&acc)[2][2][4][2], const Unit& u, int wr, int wc, int fr, int fq) const {
        asm volatile("" : "+v"(fr), "+v"(fq));
        const int row0 = u.pm * BM + wr * 64 + fr, col0 = u.pn * 128 + wc * 32 + fq * 8;
#pragma unroll
        for (int ai = 0; ai < 2; ++ai)
#pragma unroll
            for (int m = 0; m < 4; ++m) { const int row = row0 + ai * HALF + m * 16; const float rs = rstd_of(ss, row);
                f32x4 h0, h1;
#pragma unroll
                for (int j = 0; j < 4; ++j) { float g = acc[ai][0][m][0][j] * rs, uu = acc[ai][1][m][0][j] * rs; h0[j] = g * sigm(g) * uu;
                    g = acc[ai][0][m][1][j] * rs; uu = acc[ai][1][m][1][j] * rs; h1[j] = g * sigm(g) * uu; }
                *(u32x4*)(H + (size_t)row * FFH + col0) = pack8(h0, h1); asm volatile("" ::: "memory"); }
    }
};
struct EpiRes {
    static constexpr bool PERM = true, AFTER_DRAIN = false;
    bf16_t* X; float* ssn; float scale;
    __device__ __forceinline__ void operator()(const f32x4 (&acc)[2][2][4][2], const Unit& u, int wr, int wc, int fr, int fq) const {
        asm volatile("" : "+v"(fr), "+v"(fq));
        const int row0 = u.pm * BM + wr * 64 + fr, col0 = u.pn * BM + wc * 32 + fq * 8;
#pragma unroll
        for (int ai = 0; ai < 2; ++ai)
#pragma unroll
            for (int m = 0; m < 4; ++m) { const int row = row0 + ai * HALF + m * 16; float s = 0.f;
#pragma unroll
                for (int bj = 0; bj < 2; ++bj) { bf16_t* p = X + (size_t)row * 1024 + col0 + bj * HALF; const u32x4 xv = *(const u32x4*)p;
                    f32x4 a = acc[ai][bj][m][0] * scale, b = acc[ai][bj][m][1] * scale;
                    a[0] += bflo(xv.x); a[1] += bfhi(xv.x); a[2] += bflo(xv.y); a[3] += bfhi(xv.y); b[0] += bflo(xv.z); b[1] += bfhi(xv.z); b[2] += bflo(xv.w); b[3] += bfhi(xv.w);
                    const u32x4 w = pack8(a, b); *(u32x4*)p = w;
                    s += (bflo(w.x) * bflo(w.x) + bfhi(w.x) * bfhi(w.x)) + (bflo(w.y) * bflo(w.y) + bfhi(w.y) * bfhi(w.y)) + (bflo(w.z) * bflo(w.z) + bfhi(w.z) * bfhi(w.z)) + (bflo(w.w) * bflo(w.w) + bfhi(w.w) * bfhi(w.w)); }
                s += __shfl_xor(s, 16); s += __shfl_xor(s, 32);
                if (fq == 0) ssn[(size_t)row * 16 + u.pn * 4 + wc] = s; asm volatile("" ::: "memory"); }
    }
};
struct EpiRowScale {
    static constexpr bool PERM = true, AFTER_DRAIN = false;
    bf16_t* O; int ldc; const float* ss; float scale;
    __device__ __forceinline__ void operator()(const f32x4 (&acc)[2][2][4][2], const Unit& u, int wr, int wc, int fr, int fq) const {
        asm volatile("" : "+v"(fr), "+v"(fq));
        const int row0 = u.pm * BM + wr * 64 + fr, col0 = u.pn * BM + wc * 32 + fq * 8;
#pragma unroll
        for (int ai = 0; ai < 2; ++ai)
#pragma unroll
            for (int m = 0; m < 4; ++m) { const int row = row0 + ai * HALF + m * 16; const float rs = rstd_of(ss, row) * scale;
#pragma unroll
                for (int bj = 0; bj < 2; ++bj) *(u32x4*)(O + (size_t)row * ldc + col0 + bj * HALF) = pack8(acc[ai][bj][m][0] * rs, acc[ai][bj][m][1] * rs); asm volatile("" ::: "memory"); }
    }
};
struct EpiWin {
    static constexpr bool PERM = true, AFTER_DRAIN = false;
    unsigned char* ws; const float* ss; float qscale;
    __device__ __forceinline__ void operator()(const f32x4 (&acc)[2][2][4][2], const Unit& u, int wr, int wc, int fr, int fq) const {
        asm volatile("" : "+v"(fr), "+v"(fq));
        const int row0 = u.pm * BM + wr * 64 + fr, t = u.pn, c8 = wc * 32 + fq * 8;
        bf16_t* const HG = (bf16_t*)(ws + WS_HG); bf16_t* const U = (bf16_t*)(ws + WS_U); bf16_t* const BG = (bf16_t*)(ws + WS_BG); bf16_t* const Q = (bf16_t*)(ws + WS_Q); bf16_t* const K = (bf16_t*)(ws + WS_K);
        bf16_t* const V = (bf16_t*)(ws + WS_V); bf16_t* const QI = (bf16_t*)(ws + WS_QI); bf16_t* const KI = (bf16_t*)(ws + WS_KI); float* const WI = (float*)(ws + WS_WI); const float* const cs = (const float*)(ws + WS_COS); const float* const sn = (const float*)(ws + WS_SIN);
#pragma unroll
        for (int ai = 0; ai < 2; ++ai)
#pragma unroll
            for (int m = 0; m < 4; ++m) { const int row = row0 + ai * HALF + m * 16; const float rs = rstd_of(ss, row);
                const f32x4 a0 = acc[ai][0][m][0] * rs, a1 = acc[ai][0][m][1] * rs, b0 = acc[ai][1][m][0] * rs, b1 = acc[ai][1][m][1] * rs;
                if (t < 2) { f32x4 o0, o1;
#pragma unroll
                    for (int j = 0; j < 4; ++j) { o0[j] = a0[j] * sigm(b0[j]); o1[j] = a1[j] * sigm(b1[j]); }
                    *(u32x4*)(HG + (size_t)row * 256 + t * 128 + c8) = pack8(o0, o1); }
                else if (t < 4) { *(u32x4*)(U + (size_t)row * 256 + (t - 2) * 128 + c8) = pack8(a0 * b0, a1 * b1); }
                else if (t == 4) { *(u32x4*)(BG + (size_t)row * 256 + c8) = pack8(a0, a1); *(u32x4*)(BG + (size_t)row * 256 + 128 + c8) = pack8(b0, b1); }
                else if (t == 9 || t == 10) { *(u32x4*)(V + (size_t)row * 512 + (t - 9) * 256 + c8) = pack8(a0, a1); *(u32x4*)(V + (size_t)row * 512 + (t - 9) * 256 + 128 + c8) = pack8(b0, b1); }
                else { const f32x4 c0 = *(const f32x4*)(cs + (size_t)row * 32 + fq * 8), c1 = *(const f32x4*)(cs + (size_t)row * 32 + fq * 8 + 4);
                    const f32x4 s0 = *(const f32x4*)(sn + (size_t)row * 32 + fq * 8), s1 = *(const f32x4*)(sn + (size_t)row * 32 + fq * 8 + 4);
                    f32x4 p0 = a0 * c0 - b0 * s0, p1 = a1 * c1 - b1 * s1, r0 = b0 * c0 + a0 * s0, r1 = b1 * c1 + a1 * s1;
                    if (t < 7) { bf16_t* d = Q + (size_t)row * 512 + ((t - 5) * 4 + wc) * 64 + fq * 8; *(u32x4*)d = pack8(p0 * qscale, p1 * qscale); *(u32x4*)(d + 32) = pack8(r0 * qscale, r1 * qscale); }
                    else if (t < 9) { bf16_t* d = K + (size_t)row * 512 + ((t - 7) * 4 + wc) * 64 + fq * 8; *(u32x4*)d = pack8(p0, p1); *(u32x4*)(d + 32) = pack8(r0, r1); }
                    else if (t == 11) { bf16_t* d = QI + (size_t)row * 256 + wc * 64 + fq * 8; *(u32x4*)d = pack8(p0, p1); *(u32x4*)(d + 32) = pack8(r0, r1); }
                    else { if (wc == 0) { bf16_t* d = KI + (size_t)row * 64 + fq * 8; *(u32x4*)d = pack8(p0, p1); *(u32x4*)(d + 32) = pack8(r0, r1); }
                           if (wc == 1 && fq == 0) *(f32x4*)(WI + (size_t)row * 4) = b0; } }
                asm volatile("" ::: "memory");
            }
    }
};
struct EpiMemKV {
    static constexpr bool PERM = true, AFTER_DRAIN = false;
    bf16_t *MEMK, *MEMVT; const float* mss;
    __device__ __forceinline__ void operator()(const f32x4 (&acc)[2][2][4][2], const Unit& u, int wr, int wc, int fr, int fq) const {
        asm volatile("" : "+v"(fr), "+v"(fq));
        const bool isv = u.pm >= 4; const int l = isv ? ((u.pm - 8) >> 3) : ((u.pn - 4) >> 3);
        const int pr = isv ? ((u.pm - 8) & 7) : u.pm, pc = isv ? u.pn : ((u.pn - 4) & 7);
        bf16_t* O = (isv ? MEMVT : MEMK) + (size_t)l * 1024 * 1024;
        const int row0 = pr * BM + wr * 64 + fr, col0 = pc * BM + wc * 32 + fq * 8;
#pragma unroll
        for (int ai = 0; ai < 2; ++ai)
#pragma unroll
            for (int m = 0; m < 4; ++m) { const int row = row0 + ai * HALF + m * 16; const float rsr = isv ? 1.f : rstd_of1(mss, row);
#pragma unroll
                for (int bj = 0; bj < 2; ++bj) { f32x4 a = acc[ai][bj][m][0] * rsr, b = acc[ai][bj][m][1] * rsr;
                    if (isv) {
#pragma unroll
                        for (int j = 0; j < 4; ++j) { a[j] *= rstd_of1(mss, col0 + bj * HALF + j); b[j] *= rstd_of1(mss, col0 + bj * HALF + 4 + j); } }
                    *(u32x4*)(O + (size_t)row * 1024 + col0 + bj * HALF) = pack8(a, b); } asm volatile("" ::: "memory"); }
    }
};
struct MemKVOrder {
    int G, c;
    __device__ __forceinline__ bool next(int i, Unit& u) const {
        const int L = i * G + c; if (L >= 64) return false;
        const int ty = L >> 4, a = (L >> 2) & 3, b = L & 3, l = ty & 1;
        if (ty < 2) { u.pm = a; u.pn = 4 + 8 * l + b; } else { u.pm = 8 + 8 * l + a; u.pn = b; }
        return true;
    }
    __device__ __forceinline__ void a_ready(const Unit&) const {}
    __device__ __forceinline__ void done(const Unit&) const {}
};

template <class Epi, class Sched, bool ALIGN_EPI = false, bool SP2 = false>
__device__ __forceinline__ void gemm_phase(PG8_LAS unsigned char* lds, const Gemm g, const Sched& S, const Epi& E) {
    int tid_ = threadIdx.x; asm volatile("" : "+v"(tid_));
    const int tid = tid_, wid = __builtin_amdgcn_readfirstlane(tid >> 6), lane = tid & 63, wr = wid >> 2, wc = wid & 3, fr = lane & 15, fq = lane >> 4;
    const int K = g.K, nt = K / BK;
    unsigned voffA[2], voffB[2];
#pragma unroll
    for (int i = 0; i < 2; ++i) { int R, C; stage_rc(tid * 16 + i * 8192, R, C); const int Rb = Epi::PERM ? ((R & ~31) + perm32(R & 31)) : R;
        voffA[i] = (unsigned)(R * K + C) * 2u; voffB[i] = (unsigned)(Rb * K + C) * 2u; }
    const size_t kstep = (size_t)(BK * 2);
    const size_t hstep = (size_t)HALF * K * 2;
    const size_t tstep = 2 * hstep;
    const unsigned ldsw = (unsigned)wid * 1024u;
    const int aoff = lds_byte(wr * 64 + fr, fq * 8), boff = lds_byte(wc * 32 + fr, fq * 8);
#define PG8_SA(b, h) (((b) * 2 + (h)) * HTB)
#define PG8_SB(b, h) ((4 + (b) * 2 + (h)) * HTB)
#define PG8_STAGE(bufoff, gbase, voff) do { _Pragma("unroll") for (int _i = 0; _i < 2; ++_i) \
        __builtin_amdgcn_global_load_lds((const unsigned*)((const char*)(gbase) + (voff)[_i]), (PG8_LAS unsigned*)(lds + (bufoff) + ldsw + _i * 8192), 16, 0, 0); } while (0)
#define PG8_LDA(dst, b, h) do { _Pragma("unroll") for (int m = 0; m < 4; ++m) _Pragma("unroll") for (int k = 0; k < 2; ++k) dst[m][k] = *(const PG8_LAS bf16x8*)(lds + PG8_SA(b, h) + aoff + m * 2048 + k * 1024); } while (0)
#define PG8_LDB(dst, b, h) do { _Pragma("unroll") for (int n = 0; n < 2; ++n) _Pragma("unroll") for (int k = 0; k < 2; ++k) dst[n][k] = *(const PG8_LAS bf16x8*)(lds + PG8_SB(b, h) + boff + n * 2048 + k * 1024); } while (0)
#define PG8_MMA(ai, bj, At, Bt) do { __builtin_amdgcn_s_setprio(1); _Pragma("unroll") for (int m = 0; m < 4; ++m) _Pragma("unroll") for (int n = 0; n < 2; ++n) _Pragma("unroll") for (int k = 0; k < 2; ++k) \
        acc[ai][bj][m][n] = __builtin_amdgcn_mfma_f32_16x16x32_bf16(Bt[n][k], At[m][k], acc[ai][bj][m][n], 0, 0, 0); __builtin_amdgcn_s_setprio(0); } while (0)
#define PG8_WAIT_V(n) asm volatile("s_waitcnt vmcnt(" #n ")" ::: "memory")
#define PG8_WAIT_L(n) asm volatile("s_waitcnt lgkmcnt(" #n ")" ::: "memory")
#define PG8_BAR __builtin_amdgcn_s_barrier()
#define PG8_SCHED __builtin_amdgcn_sched_barrier(0)
    Unit cur, nxt; int ui = 0;
    if (!S.next(0, cur)) return;
    f32x4 acc[2][2][4][2];
#pragma unroll
    for (int a = 0; a < 2; ++a)
#pragma unroll
        for (int b = 0; b < 2; ++b)
#pragma unroll
            for (int m = 0; m < 4; ++m)
#pragma unroll
                for (int n = 0; n < 2; ++n) acc[a][b][m][n] = (f32x4){0.f, 0.f, 0.f, 0.f};
    bf16x8 At[4][2], B0[2][2], B1[2][2];
    const char* cA = (const char*)g.A + (size_t)cur.pm * tstep; const char* cB = (const char*)g.Bt + (size_t)cur.pn * tstep;
    S.a_ready(cur);
    if constexpr (SP2) {
        PG8_STAGE(PG8_SB(0, 0), cB, voffB); PG8_STAGE(PG8_SB(0, 1), cB + hstep, voffB); PG8_STAGE(PG8_SA(0, 0), cA, voffA); PG8_STAGE(PG8_SA(0, 1), cA + hstep, voffA);
        if (wr == 1) PG8_BAR;
        PG8_WAIT_V(2); PG8_BAR;
        PG8_STAGE(PG8_SB(1, 0), cB + kstep, voffB); PG8_STAGE(PG8_SA(1, 0), cA + kstep, voffA); PG8_STAGE(PG8_SB(1, 1), cB + hstep + kstep, voffB);
        PG8_WAIT_V(6); PG8_BAR;
    } else {
        PG8_STAGE(PG8_SB(0, 0), cB, voffB); PG8_STAGE(PG8_SA(0, 0), cA, voffA); PG8_STAGE(PG8_SB(0, 1), cB + hstep, voffB); PG8_STAGE(PG8_SA(0, 1), cA + hstep, voffA);
        if (wr == 1) PG8_BAR;
        PG8_WAIT_V(4); PG8_BAR;
        PG8_STAGE(PG8_SB(1, 0), cB + kstep, voffB); PG8_STAGE(PG8_SA(1, 0), cA + kstep, voffA); PG8_STAGE(PG8_SB(1, 1), cB + hstep + kstep, voffB);
        PG8_WAIT_V(6); PG8_BAR;
    }
    for (;;) {
        const bool has_next = S.next(ui + 1, nxt);
        const char* nA = has_next ? (const char*)g.A + (size_t)nxt.pm * tstep : cA; const char* nB = has_next ? (const char*)g.Bt + (size_t)nxt.pn * tstep : cB;
        for (int t = 0; t < nt; t += 2) {
            const bool last = (t == nt - 2);
            const char* a1 = cA + (size_t)(t + 1) * kstep;
            const char* a2 = last ? nA : cA + (size_t)(t + 2) * kstep; const char* b2 = last ? nB : cB + (size_t)(t + 2) * kstep;
            const char* a3 = a2 + kstep; const char* b3 = b2 + kstep;
            if (last && has_next) S.a_ready(nxt);
            if constexpr (SP2) {
            PG8_LDB(B0, 0, 0); PG8_LDB(B1, 0, 1); PG8_SCHED; PG8_LDA(At, 0, 0); PG8_STAGE(PG8_SA(1, 1), a1 + hstep, voffA);
            PG8_WAIT_V(8); PG8_WAIT_L(0); PG8_BAR; PG8_MMA(0, 0, At, B0); PG8_MMA(0, 1, At, B1); PG8_BAR; PG8_SCHED;
            PG8_LDA(At, 0, 1); PG8_STAGE(PG8_SB(0, 0), b2, voffB); PG8_STAGE(PG8_SB(0, 1), b2 + hstep, voffB); PG8_STAGE(PG8_SA(0, 0), a2, voffA);
            PG8_WAIT_V(8); PG8_WAIT_L(0); PG8_BAR; PG8_MMA(1, 0, At, B0); PG8_MMA(1, 1, At, B1); PG8_BAR; PG8_SCHED;
            PG8_LDB(B0, 1, 0); PG8_LDB(B1, 1, 1); PG8_SCHED; PG8_LDA(At, 1, 0); PG8_STAGE(PG8_SA(0, 1), a2 + hstep, voffA);
            PG8_WAIT_V(8); PG8_WAIT_L(0); PG8_BAR; PG8_MMA(0, 0, At, B0); PG8_MMA(0, 1, At, B1); PG8_BAR; PG8_SCHED;
            PG8_LDA(At, 1, 1); PG8_STAGE(PG8_SB(1, 0), b3, voffB); PG8_STAGE(PG8_SB(1, 1), b3 + hstep, voffB); PG8_STAGE(PG8_SA(1, 0), a3, voffA);
            PG8_WAIT_V(8); PG8_WAIT_L(0); PG8_BAR; PG8_MMA(1, 0, At, B0); PG8_MMA(1, 1, At, B1); PG8_BAR; PG8_SCHED;
            } else {
            PG8_LDB(B0, 0, 0); PG8_SCHED; PG8_LDA(At, 0, 0); PG8_STAGE(PG8_SA(1, 1), a1 + hstep, voffA);
            PG8_WAIT_L(8); PG8_BAR; PG8_WAIT_L(0); PG8_MMA(0, 0, At, B0); PG8_BAR; PG8_SCHED;
            PG8_LDB(B1, 0, 1); PG8_STAGE(PG8_SB(0, 0), b2, voffB);
            PG8_BAR; PG8_WAIT_L(0); PG8_MMA(0, 1, At, B1); PG8_BAR;
            PG8_LDA(At, 0, 1); PG8_STAGE(PG8_SA(0, 0), a2, voffA);
            PG8_BAR; PG8_WAIT_L(0); PG8_MMA(1, 0, At, B0); PG8_BAR; PG8_SCHED;
            PG8_STAGE(PG8_SB(0, 1), b2 + hstep, voffB);
            PG8_WAIT_V(6); PG8_BAR; PG8_MMA(1, 1, At, B1); PG8_BAR;
            PG8_LDB(B0, 1, 0); PG8_SCHED; PG8_LDA(At, 1, 0); PG8_STAGE(PG8_SA(0, 1), a2 + hstep, voffA);
            PG8_WAIT_L(8); PG8_BAR; PG8_WAIT_L(0); PG8_MMA(0, 0, At, B0); PG8_BAR; PG8_SCHED;
            PG8_LDB(B1, 1, 1); PG8_STAGE(PG8_SB(1, 0), b3, voffB);
            PG8_BAR; PG8_WAIT_L(0); PG8_MMA(0, 1, At, B1); PG8_BAR;
            PG8_LDA(At, 1, 1); PG8_STAGE(PG8_SA(1, 0), a3, voffA);
            PG8_BAR; PG8_WAIT_L(0); PG8_MMA(1, 0, At, B0); PG8_BAR; PG8_SCHED;
            PG8_STAGE(PG8_SB(1, 1), b3 + hstep, voffB);
            PG8_WAIT_V(6); PG8_BAR; PG8_MMA(1, 1, At, B1); PG8_BAR;
            }
        }
        if constexpr (ALIGN_EPI) { if (wr == 0) PG8_BAR; }
        if constexpr (!Epi::AFTER_DRAIN) { E(acc, cur, wr, wc, fr, fq); S.done(cur); }
        if (!has_next) break;
#pragma unroll
        for (int a = 0; a < 2; ++a)
#pragma unroll
            for (int b = 0; b < 2; ++b)
#pragma unroll
                for (int m = 0; m < 4; ++m)
#pragma unroll
                    for (int n = 0; n < 2; ++n) acc[a][b][m][n] = (f32x4){0.f, 0.f, 0.f, 0.f};
        cur = nxt; cA = nA; cB = nB; ++ui;
        if constexpr (ALIGN_EPI) { if (wr == 1) PG8_BAR; }
    }
    PG8_WAIT_V(0);
    if constexpr (!ALIGN_EPI) { if (wr == 0) PG8_BAR; }
    PG8_BAR;
    if constexpr (Epi::AFTER_DRAIN) { E.fused(acc, cur, wr, wc, fr, fq, lds, wid, lane); S.done(cur); }
#undef PG8_SA
#undef PG8_SB
#undef PG8_STAGE
#undef PG8_LDA
#undef PG8_LDB
#undef PG8_MMA
#undef PG8_WAIT_V
#undef PG8_WAIT_L
#undef PG8_BAR
#undef PG8_SCHED
}
}
#define GAS __attribute__((address_space(1)))
#define LAS __attribute__((address_space(3)))
typedef unsigned short bf16;
typedef unsigned v4u __attribute__((ext_vector_type(4)));
typedef float f32x4 __attribute__((ext_vector_type(4)));
typedef short bf16x8 __attribute__((ext_vector_type(8)));
typedef GAS unsigned gu32;
typedef GAS unsigned long long gu64;
#define RLX_AGENT __ATOMIC_RELAXED, __HIP_MEMORY_SCOPE_AGENT
#define LDS_WAIT() asm volatile("s_waitcnt lgkmcnt(0)" ::: "memory")
#define VM_WAIT() asm volatile("s_waitcnt vmcnt(0)" ::: "memory")
__device__ __forceinline__ unsigned long long rt() { return __builtin_amdgcn_s_memrealtime(); }
__device__ __forceinline__ unsigned f2bf(float f) { unsigned u = __builtin_bit_cast(unsigned, f); return (u + 0x7fffu + ((u >> 16) & 1u)) >> 16; }
__device__ __forceinline__ unsigned pk2(float lo, float hi) { return f2bf(lo) | (f2bf(hi) << 16); }

#define XB_TMO      128
#define XB_XCNT(j)  (256  + 64 * (j))
#define XB_XSUB(j)  (1280 + 64 * (j))
#define XB_XGEN(j)  (2304 + 64 * (j))
#define XB_TOP      3328
#define XB_TOPGEN   3392
#define XCD_BAR_WORDS 3456
#define XB_SPIN_CAP (1u << 18)

__device__ __forceinline__ unsigned xb_ld(unsigned* p)              { return __hip_atomic_load(p, __ATOMIC_RELAXED, __HIP_MEMORY_SCOPE_AGENT); }
__device__ __forceinline__ unsigned xb_add(unsigned* p, unsigned v) { return __hip_atomic_fetch_add(p, v, __ATOMIC_RELAXED, __HIP_MEMORY_SCOPE_AGENT); }
__device__ __forceinline__ unsigned xb_xcc_id() { return (unsigned)__builtin_amdgcn_s_getreg((3 << 11) | 20) & 0xFu; }
#define XB_SPIN(cond, bar) do { unsigned _sp = 0; while (cond) { __builtin_amdgcn_s_sleep(1); \
    if ((++_sp & 255u) == 0u) { if (xb_ld(&(bar)[XB_TMO])) break; if (_sp > XB_SPIN_CAP) { atomicAdd(&(bar)[XB_TMO], 1u); break; } } } } while (0)

struct XcdBarrier {
    unsigned* bar; unsigned x;
    volatile LAS unsigned* st;
};

__device__ __forceinline__ XcdBarrier xcd_barrier_post(unsigned* bar, volatile LAS unsigned* st) {
    XcdBarrier b; b.bar = bar; b.x = xb_xcc_id(); b.st = st;
    if (threadIdx.x == 0) (void)xb_add(&bar[XB_XCNT(b.x)], 1u);
    return b;
}
__device__ __forceinline__ void xcd_barrier_complete(unsigned* bar, unsigned x, unsigned& nloc, unsigned& nx) {
    const unsigned G = gridDim.x * gridDim.y * gridDim.z;
    unsigned sum, cnt, mine, sp = 0u;
    for (;;) {
        sum = 0u; cnt = 0u; mine = 0u;
#pragma unroll
        for (unsigned j = 0; j < 16; ++j) { const unsigned c = xb_ld(&bar[XB_XCNT(j)]); sum += c; cnt += (c > 0u) ? 1u : 0u; mine = (j == x) ? c : mine; }
        if (sum == G) break;
        __builtin_amdgcn_s_sleep(1);
        if ((++sp & 255u) == 0u) { if (xb_ld(&bar[XB_TMO])) break; if (sp > XB_SPIN_CAP) { atomicAdd(&bar[XB_TMO], 1u); break; } }
    }
    nloc = mine > 0u ? mine : 1u; nx = cnt > 0u ? cnt : 1u;
}

__device__ __forceinline__ void xcd_barrier(const XcdBarrier& b) {
    asm volatile("s_waitcnt vmcnt(0)" ::: "memory");
    __syncthreads();
    if (threadIdx.x == 0) {
        unsigned* bar = b.bar;
        __builtin_amdgcn_s_waitcnt(0);
        unsigned nloc = b.st[0], nx = b.st[1];
        if (nloc == 0u) { xcd_barrier_complete(bar, b.x, nloc, nx); b.st[0] = nloc; b.st[1] = nx; }
        const unsigned old = xb_add(&bar[XB_XSUB(b.x)], 1u);
        const unsigned gen = old / nloc;
        if (old + 1u == (gen + 1u) * nloc) {
            __builtin_amdgcn_fence(__ATOMIC_RELEASE, "agent");
            asm volatile("s_waitcnt vmcnt(0)" ::: "memory");
            const unsigned og = xb_add(&bar[XB_TOP], 1u);
            const unsigned tg = og / nx;
            if (og + 1u == (tg + 1u) * nx) xb_add(&bar[XB_TOPGEN], 1u);
            else XB_SPIN(xb_ld(&bar[XB_TOPGEN]) == tg, bar);
            __builtin_amdgcn_fence(__ATOMIC_ACQUIRE, "agent");
            xb_add(&bar[XB_XGEN(b.x)], 1u);
            asm volatile("s_waitcnt vmcnt(0)" ::: "memory");
        } else {
            XB_SPIN(xb_ld(&bar[XB_XGEN(b.x)]) == gen, bar);
            __builtin_amdgcn_fence(__ATOMIC_ACQUIRE, "agent");
            asm volatile("s_waitcnt vmcnt(0)" ::: "memory");
        }
    }
    __syncthreads();
}
struct Frame {
    LAS unsigned char* lds; volatile LAS unsigned* MISC; gu32* ctl;
    int tid, lane, wave, vcu, G;
    unsigned char* ws;
};
__device__ __forceinline__ float wave_sum(float v) {
#pragma unroll
    for (int o = 1; o < 64; o <<= 1) v += __shfl_xor(v, o);
    return v;
}
__device__ __forceinline__ float wave_max(float v) {
#pragma unroll
    for (int o = 1; o < 64; o <<= 1) v = fmaxf(v, __shfl_xor(v, o));
    return v;
}
__device__ __forceinline__ float bf2f_lo(unsigned w) { return __uint_as_float(w << 16); }
__device__ __forceinline__ float bf2f_hi(unsigned w) { return __uint_as_float(w & 0xffff0000u); }
__device__ __forceinline__ float bf2f(bf16 h) { return __uint_as_float((unsigned)h << 16); }

__device__ __forceinline__ void tr_item(const float* W, int Ns, const float* gain, bf16* WTrow, int K, int sc0, int nvalid, int k0, LAS float* scr, int lane) {
    const int col = lane & 31;
#pragma unroll 8
    for (int i = 0; i < 32; ++i) { const int kk = 2 * i + (lane >> 5); float v = 0.f; if (col < nvalid) v = W[(size_t)(k0 + kk) * Ns + sc0 + col]; if (gain) v *= gain[k0 + kk]; scr[kk * 33 + col] = v; }
    LDS_WAIT(); asm volatile("" ::: "memory");
    const int c = lane & 7;
#pragma unroll
    for (int j = 0; j < 4; ++j) { const int n = (lane >> 3) + 8 * j; const LAS float* s = scr + (8 * c) * 33 + n;
        v4u o; o.x = pk2(s[0 * 33], s[1 * 33]); o.y = pk2(s[2 * 33], s[3 * 33]); o.z = pk2(s[4 * 33], s[5 * 33]); o.w = pk2(s[6 * 33], s[7 * 33]);
        *(GAS v4u*)(WTrow + (size_t)n * K + 8 * c) = o; }
    LDS_WAIT(); asm volatile("" ::: "memory");
}
__device__ __forceinline__ int win_src_col(int j, int& nvalid) {
    const int tile = j >> 3, half = (j >> 2) & 1, q4 = j & 3; nvalid = 32;
    if (tile < 2) return (half ? 256 : 0) + 128 * tile + 32 * q4;
    if (tile < 4) return (half ? 1024 : 768) + 128 * (tile - 2) + 32 * q4;
    if (tile == 4) return 512 + 128 * half + 32 * q4;
    if (tile < 7) return 1280 + ((tile - 5) * 4 + q4) * 64 + 32 * half;
    if (tile < 9) return 1792 + ((tile - 7) * 4 + q4) * 64 + 32 * half;
    if (tile < 11) return 2304 + (tile - 9) * 256 + 128 * half + 32 * q4;
    if (tile == 11) return 2816 + q4 * 64 + 32 * half;
    if (q4 == 0) return 3072 + 32 * half;
    if (q4 == 1 && half == 1) { nvalid = 4; return 3136; }
    nvalid = 0; return 0;
}
__device__ __forceinline__ void gu_item(const float* wg, const float* wu, const float* gain, bf16* WT, int r, LAS float* scr, int lane) {
    const int group = r >> 4, kb = r & 15, tile = group >> 3, g8 = group & 7;
    tr_item(g8 < 4 ? wg : wu, FF, gain, WT + (size_t)(group * 32) * D + kb * 64, D, 128 * tile + 32 * (g8 & 3), 32, kb * 64, scr, lane);
}
__device__ __forceinline__ void plain_item(const float* W, int Ns, int K, const float* gain, bf16* WT, int r, LAS float* scr, int lane) {
    const int nkb = K / 64, group = r / nkb, kb = r % nkb;
    tr_item(W, Ns, gain, WT + (size_t)(group * 32) * K + kb * 64, K, group * 32, 32, kb * 64, scr, lane);
}
struct Args { const void* in[25]; float* out; unsigned char* ws; float invf[32]; int ph_lo, ph_hi; };
typedef const __attribute__((address_space(4))) Args* KArgs;
#define INF(A, k) ((const float*)(A)->in[k])
enum { I_X = 0, I_MEM, I_POS, I_FFN1_NORM, I_FFN1_WG, I_FFN1_WU, I_FFN1_WD, I_MIX_NORM, I_W_IN, I_CONF_DW, I_CONF_DW_B, I_CONF_LN_G, I_CONF_LN_B, I_SC_DW, I_W_OUT, I_XA_NORM, I_MEM_NORM, I_XA_WQ, I_XA_WKV, I_XA_WO,
       I_FFN2_NORM, I_FFN2_WG, I_FFN2_WU, I_FFN2_WD, I_FINAL_NORM };
constexpr int IT_GU = 2816, IT_D = 1408, IT_IN = 1664, IT_SQ = 512, IT_KV = 1024, IT_LAYER = 2 * IT_GU + 2 * IT_D + IT_IN + 3 * IT_SQ + IT_KV;
__device__ __forceinline__ void p0_prologue(Frame& F, KArgs A) {
    LAS float* scr = (LAS float*)(F.lds + RING_OFF + F.wave * 16384);
    const int gw = F.vcu * NWAVES + F.wave, NGW = F.G * NWAVES, lane = F.lane;
    unsigned char* ws = F.ws;
    for (int it = gw; it < DEPTH * IT_LAYER; it += NGW) {
        const int l = it / IT_LAYER; int r = it % IT_LAYER;
        unsigned char* wl = ws + WS_W + (size_t)l * W_LAYER;
        if (r < IT_GU) { gu_item(INF(A, I_FFN1_WG) + (size_t)l * D * FF, INF(A, I_FFN1_WU) + (size_t)l * D * FF, INF(A, I_FFN1_NORM) + l * D, (bf16*)(wl + WO_GU1), r, scr, lane); continue; } r -= IT_GU;
        if (r < IT_D) { plain_item(INF(A, I_FFN1_WD) + (size_t)l * FF * D, D, FF, nullptr, (bf16*)(wl + WO_D1), r, scr, lane); continue; } r -= IT_D;
        if (r < IT_IN) { const int group = r >> 4, kb = r & 15; int nv; const int sc = win_src_col(group, nv);
            tr_item(INF(A, I_W_IN) + (size_t)l * D * NIN, NIN, INF(A, I_MIX_NORM) + l * D, (bf16*)(wl + WO_IN) + (size_t)(group * 32) * D + kb * 64, D, sc, nv, kb * 64, scr, lane); continue; } r -= IT_IN;
        if (r < IT_SQ) { plain_item(INF(A, I_W_OUT) + (size_t)l * D * D, D, D, nullptr, (bf16*)(wl + WO_OUT), r, scr, lane); continue; } r -= IT_SQ;
        if (r < IT_SQ) { plain_item(INF(A, I_XA_WQ) + (size_t)l * D * D, D, D, INF(A, I_XA_NORM) + l * D, (bf16*)(wl + WO_Q), r, scr, lane); continue; } r -= IT_SQ;
        if (r < IT_SQ) { plain_item(INF(A, I_XA_WO) + (size_t)l * D * D, D, D, nullptr, (bf16*)(wl + WO_O), r, scr, lane); continue; } r -= IT_SQ;
        if (r < IT_KV) { plain_item(INF(A, I_XA_WKV) + (size_t)l * D * 2 * D, 2 * D, D, INF(A, I_MEM_NORM) + l * D, (bf16*)(ws + WS_MK) + (size_t)(1024 + 2048 * l) * D, r, scr, lane); continue; } r -= IT_KV;
        if (r < IT_GU) { gu_item(INF(A, I_FFN2_WG) + (size_t)l * D * FF, INF(A, I_FFN2_WU) + (size_t)l * D * FF, INF(A, I_FFN2_NORM) + l * D, (bf16*)(wl + WO_GU2), r, scr, lane); continue; } r -= IT_GU;
        plain_item(INF(A, I_FFN2_WD) + (size_t)l * FF * D, D, FF, nullptr, (bf16*)(wl + WO_D2), r, scr, lane);
    }
    for (int m = gw; m < M + 1024; m += NGW) {
        const bool ismem = m >= M; const int row = ismem ? m - M : m;
        const GAS f32x4* xr = (const GAS f32x4*)((ismem ? INF(A, I_MEM) : INF(A, I_X)) + (size_t)row * D) + lane;
        GAS unsigned long long* o8 = (GAS unsigned long long*)((bf16*)(ws + (ismem ? WS_MK : WS_X)) + (size_t)row * D) + lane;
        float s = 0.f;
#pragma unroll
        for (int j = 0; j < 4; ++j) { const f32x4 v = xr[64 * j]; const unsigned a = pk2(v.x, v.y), b = pk2(v.z, v.w); o8[64 * j] = (unsigned long long)a | ((unsigned long long)b << 32);
            s += (bf2f_lo(a) * bf2f_lo(a) + bf2f_hi(a) * bf2f_hi(a)) + (bf2f_lo(b) * bf2f_lo(b) + bf2f_hi(b) * bf2f_hi(b)); }
        s = wave_sum(s);
        if (ismem) { if (lane == 0) ((float*)(ws + WS_MSS))[row] = s; } else if (lane < 16) ((float*)(ws + WS_SS))[(size_t)row * 16 + lane] = lane == 0 ? s : 0.f;
    }
    for (int e = (F.vcu * NWAVES * 64 + F.tid); e < M * 32; e += F.G * NWAVES * 64) {
        const int row = e >> 5, i = e & 31;
        const float ang = __fmul_rn((float)((const int*)A->in[I_POS])[row], A->invf[i]);
        const double x = (double)ang, n = __builtin_rint(x * 0.15915494309189535), r = x - n * 6.283185307179586, r2 = r * r;
        double sp = -1.0 / 25852016738884976640000.0, cp = 1.0 / 620448401733239439360000.0;
        sp = sp * r2 + 1.0 / 51090942171709440000.0;  cp = cp * r2 - 1.0 / 1124000727777607680000.0;
        sp = sp * r2 - 1.0 / 121645100408832000.0;    cp = cp * r2 + 1.0 / 2432902008176640000.0;
        sp = sp * r2 + 1.0 / 355687428096000.0;       cp = cp * r2 - 1.0 / 6402373705728000.0;
        sp = sp * r2 - 1.0 / 1307674368000.0;         cp = cp * r2 + 1.0 / 20922789888000.0;
        sp = sp * r2 + 1.0 / 6227020800.0;            cp = cp * r2 - 1.0 / 87178291200.0;
        sp = sp * r2 - 1.0 / 39916800.0;              cp = cp * r2 + 1.0 / 479001600.0;
        sp = sp * r2 + 1.0 / 362880.0;                cp = cp * r2 - 1.0 / 3628800.0;
        sp = sp * r2 - 1.0 / 5040.0;                  cp = cp * r2 + 1.0 / 40320.0;
        sp = sp * r2 + 1.0 / 120.0;                   cp = cp * r2 - 1.0 / 720.0;
        sp = sp * r2 - 1.0 / 6.0;                     cp = cp * r2 + 1.0 / 24.0;
        sp = sp * r2 + 1.0;                           cp = cp * r2 - 0.5;
        cp = cp * r2 + 1.0;
        ((float*)(ws + WS_COS))[e] = (float)cp; ((float*)(ws + WS_SIN))[e] = (float)(sp * r);
    }
}

__device__ __forceinline__ void conv_a_unit(Frame& F, const bf16* HG, bf16* MIX, const float* dw, const float* dwb, const float* lng, const float* lnb, int unit) {
    const int tid = F.tid, lane = F.lane, wave = F.wave;
    const int row0 = unit * 64, t0 = row0 % SEQ;
    LAS unsigned short* hb = (LAS unsigned short*)(F.lds + RING_OFF); LAS float* yb = (LAS float*)(F.lds + RING_OFF + 49152);
    for (int ch = tid; ch < 94 * 32; ch += NWAVES * 64) { const int rr = ch >> 5, c16 = ch & 31; const int t = t0 - 30 + rr;
        v4u v = (v4u){0u, 0u, 0u, 0u}; if (t >= 0) v = *(const GAS v4u*)(HG + (size_t)(row0 - 30 + rr) * 256 + c16 * 8);
        *(LAS v4u*)(hb + rr * 256 + c16 * 8) = v; }
    __syncthreads();
    { const int c = tid & 255, half = tid >> 8;
      float w[31];
#pragma unroll
      for (int j = 0; j < 31; ++j) w[j] = dw[j * 256 + c];
      const float bias = dwb[c];
      float hv[62];
#pragma unroll
      for (int k = 0; k < 62; ++k) hv[k] = bf2f(hb[(32 * half + k) * 256 + c]);
#pragma unroll
      for (int i = 0; i < 32; ++i) { float y = bias;
#pragma unroll
          for (int j = 0; j < 31; ++j) y += w[j] * hv[i + j];
          yb[(32 * half + i) * 256 + c] = y; } }
    __syncthreads();
    { const f32x4 g = *(const GAS f32x4*)(lng + lane * 4), bb = *(const GAS f32x4*)(lnb + lane * 4);
      for (int tt = wave; tt < 64; tt += NWAVES) { const f32x4 y = *(LAS f32x4*)(yb + tt * 256 + lane * 4);
          const float mean = wave_sum((y.x + y.y) + (y.z + y.w)) * (1.f / 256.f); const f32x4 d = y - mean;
          const float var = wave_sum((d.x * d.x + d.y * d.y) + (d.z * d.z + d.w * d.w)) * (1.f / 256.f); const float rs = 1.0f / sqrtf(var + 1e-5f);
          f32x4 o = d * rs * g + bb;
#pragma unroll
          for (int j = 0; j < 4; ++j) o[j] = o[j] * pg8::sigm(o[j]);
          *(GAS unsigned long long*)(MIX + (size_t)(row0 + tt) * 1024 + lane * 4) = (unsigned long long)pk2(o.x, o.y) | ((unsigned long long)pk2(o.z, o.w) << 32); } }
    __syncthreads();
}
__device__ __forceinline__ void conv_b_all(Frame& F, const bf16* U, const bf16* BG, bf16* MIX, const float* sw) {
    for (int it = F.vcu * NWAVES * 64 + F.tid; it < M * 32; it += F.G * NWAVES * 64) { const int row = it >> 5, c8 = (it & 31) * 8, t = row % SEQ;
        const v4u z = (v4u){0u, 0u, 0u, 0u};
        const v4u u0 = *(const GAS v4u*)(U + (size_t)row * 256 + c8), u1 = t >= 1 ? *(const GAS v4u*)(U + (size_t)(row - 1) * 256 + c8) : z, u2 = t >= 2 ? *(const GAS v4u*)(U + (size_t)(row - 2) * 256 + c8) : z;
        const v4u g = *(const GAS v4u*)(BG + (size_t)row * 256 + c8);
        float o[8];
#pragma unroll
        for (int k = 0; k < 4; ++k) { const int c = c8 + 2 * k;
            o[2 * k]     = bf2f_lo(g[k]) * (sw[c] * bf2f_lo(u2[k]) + sw[256 + c] * bf2f_lo(u1[k]) + sw[512 + c] * bf2f_lo(u0[k]));
            o[2 * k + 1] = bf2f_hi(g[k]) * (sw[c + 1] * bf2f_hi(u2[k]) + sw[256 + c + 1] * bf2f_hi(u1[k]) + sw[512 + c + 1] * bf2f_hi(u0[k])); }
        v4u w; w.x = pk2(o[0], o[1]); w.y = pk2(o[2], o[3]); w.z = pk2(o[4], o[5]); w.w = pk2(o[6], o[7]);
        *(GAS v4u*)(MIX + (size_t)row * 1024 + 256 + c8) = w; }
}
__device__ __forceinline__ unsigned mono32(float f) { const unsigned u = __float_as_uint(f); return (u & 0x80000000u) ? ~u : (u | 0x80000000u); }
__device__ __forceinline__ void dsa_naive_query(Frame& F, const bf16* Q, const bf16* K, const bf16* V, const bf16* QI, const bf16* KI, const float* WI, bf16* MIX, int row) {
    const int tid = F.tid, lane = F.lane, wave = F.wave;
    const int b = row / SEQ, t = row % SEQ, n = t + 1;
    LAS unsigned long long* key64 = (LAS unsigned long long*)(F.lds + RING_OFF);
    LAS float* qi = (LAS float*)(F.lds + RING_OFF + 65536); LAS float* qh = (LAS float*)(F.lds + RING_OFF + 66560); LAS float* pl = (LAS float*)(F.lds + RING_OFF + 68608);
    LAS int* sel = (LAS int*)(F.lds + RING_OFF + 76800); LAS unsigned* cnt = (LAS unsigned*)(F.lds + RING_OFF + 77824);
    if (tid < 256) qi[tid] = bf2f(QI[(size_t)row * 256 + tid]);
    qh[tid] = bf2f(Q[(size_t)row * 512 + tid]);
    if (tid < 64) cnt[tid] = 0u;
    const f32x4 wv = *(const GAS f32x4*)(WI + (size_t)row * 4);
    __syncthreads();
    unsigned long long e[16];
#pragma unroll
    for (int j = 0; j < 16; ++j) { const int s = tid + 512 * j; e[j] = 0ull;
        if (s < n) { const GAS v4u* kr = (const GAS v4u*)(KI + (size_t)(b * SEQ + s) * 64); float kf[64];
#pragma unroll
            for (int c = 0; c < 8; ++c) { const v4u v = kr[c];
#pragma unroll
                for (int k = 0; k < 4; ++k) { kf[c * 8 + 2 * k] = bf2f_lo(v[k]); kf[c * 8 + 2 * k + 1] = bf2f_hi(v[k]); } }
            float sc = 0.f;
#pragma unroll
            for (int h = 0; h < 4; ++h) { float d0 = 0.f;
#pragma unroll
                for (int d = 0; d < 64; ++d) d0 += qi[h * 64 + d] * kf[d];
                sc += wv[h] * fmaxf(d0, 0.f); }
            sc = sc * IDX_SCALE + 0.0f;
            e[j] = ((unsigned long long)mono32(sc) << 13) | (unsigned long long)(8191 - s); } }
    unsigned long long T = 0ull;
    if (n > 256) {
        for (int bit = 44; bit >= 0; --bit) { const unsigned long long cand = T | (1ull << bit); unsigned c = 0;
#pragma unroll
            for (int j = 0; j < 16; ++j) c += (e[j] >= cand) ? 1u : 0u;
            c = (unsigned)wave_sum((float)c);
            if (lane == 0) atomicAdd((unsigned*)&cnt[bit], c);
            __syncthreads();
            if (cnt[bit] >= 256u) T = cand; }
    }
    if (T == 0ull) T = 1ull;
    { unsigned c = 0;
#pragma unroll
      for (int j = 0; j < 16; ++j) c += (e[j] >= T) ? 1u : 0u;
      unsigned inc = c;
#pragma unroll
      for (int o = 1; o < 64; o <<= 1) { const unsigned v = __shfl_up(inc, o); if (lane >= o) inc += v; }
      if (lane == 63) cnt[50 + wave] = inc;
      __syncthreads();
      unsigned base = inc - c;
#pragma unroll
      for (int w = 0; w < NWAVES; ++w) if (w < wave) base += cnt[50 + w];
#pragma unroll
      for (int j = 0; j < 16; ++j) if (e[j] >= T) { if (base < 256u) sel[base] = tid + 512 * j; ++base; }
      if (tid == NWAVES * 64 - 1) cnt[48] = base; }
    __syncthreads();
    const int nsel = min((int)cnt[48], 256);
    { const int h = wave; float sv[4]; float mx = -INFINITY;
#pragma unroll
      for (int kk = 0; kk < 4; ++kk) { const int k = lane + 64 * kk; sv[kk] = -INFINITY;
          if (k < nsel) { const GAS v4u* kr = (const GAS v4u*)(K + (size_t)(b * SEQ + sel[k]) * 512 + h * 64); float d0 = 0.f;
#pragma unroll
              for (int c = 0; c < 8; ++c) { const v4u v = kr[c];
#pragma unroll
                  for (int q = 0; q < 4; ++q) d0 += qh[h * 64 + c * 8 + 2 * q] * bf2f_lo(v[q]) + qh[h * 64 + c * 8 + 2 * q + 1] * bf2f_hi(v[q]); }
              sv[kk] = d0; }
          mx = fmaxf(mx, sv[kk]); }
      mx = wave_max(mx); float sum = 0.f;
#pragma unroll
      for (int kk = 0; kk < 4; ++kk) { const float p = (lane + 64 * kk < nsel) ? __builtin_amdgcn_exp2f(sv[kk] - mx) : 0.f; pl[h * 256 + lane + 64 * kk] = p; sum += p; }
      sum = wave_sum(sum);
      LDS_WAIT(); asm volatile("" ::: "memory");
      float o = 0.f;
#pragma unroll 8
      for (int k = 0; k < nsel; ++k) o += pl[h * 256 + k] * bf2f(V[(size_t)(b * SEQ + sel[k]) * 512 + h * 64 + lane]);
      MIX[(size_t)row * 1024 + 512 + h * 64 + lane] = (bf16)pk2(o / sum, 0.f); }
    __syncthreads();
}
typedef float f32x16 __attribute__((ext_vector_type(16)));
__device__ __forceinline__ int crow(int r, int hi) { return (r & 3) + 8 * (r >> 2) + 4 * hi; }
__device__ __forceinline__ void xattn_unit(Frame& F, bf16* XQ, const bf16* MEMK, const bf16* MEMVT, int pm, int h) {
    const int lane = F.lane, wave = F.wave, r32 = lane & 31, hi = lane >> 5, b = pm >> 5;
    const int R0 = pm * 256 + wave * 32;
    LAS float* wsf = (LAS float*)(F.lds + RING_OFF) + wave * 64;
    bf16x8 qf[16];
#pragma unroll
    for (int kk = 0; kk < 16; ++kk) qf[kk] = *(const GAS bf16x8*)(XQ + (size_t)(R0 + r32) * 1024 + h * 256 + kk * 16 + hi * 8);
    f32x16 st[8];
#pragma unroll
    for (int kb = 0; kb < 8; ++kb) { st[kb] = (f32x16){};
        const bf16* kr = MEMK + (size_t)(b * 256 + kb * 32 + r32) * 1024 + h * 256 + hi * 8;
#pragma unroll
        for (int kk = 0; kk < 16; ++kk) { const bf16x8 kf = *(const GAS bf16x8*)(kr + kk * 16); st[kb] = __builtin_amdgcn_mfma_f32_32x32x16_bf16(kf, qf[kk], st[kb], 0, 0, 0); } }
    float mx = -INFINITY;
#pragma unroll
    for (int kb = 0; kb < 8; ++kb)
#pragma unroll
        for (int r = 0; r < 16; ++r) mx = fmaxf(mx, st[kb][r]);
    mx = fmaxf(mx, __shfl_xor(mx, 32));
    float sum = 0.f; v4u pk[8][2];
#pragma unroll
    for (int kb = 0; kb < 8; ++kb) {
#pragma unroll
        for (int r = 0; r < 16; ++r) { st[kb][r] = __builtin_amdgcn_exp2f(st[kb][r] - mx); sum += st[kb][r]; }
#pragma unroll
        for (int hf = 0; hf < 2; ++hf)
#pragma unroll
            for (int q = 0; q < 4; ++q) pk[kb][hf][q] = pg8::cvt_pk_bf16(st[kb][8 * hf + 2 * q], st[kb][8 * hf + 2 * q + 1]); }
    sum += __shfl_xor(sum, 32);
    if (hi == 0) wsf[r32] = sum;
    f32x16 o[8];
#pragma unroll
    for (int db = 0; db < 8; ++db) { o[db] = (f32x16){};
        const bf16* vr = MEMVT + (size_t)(h * 256 + db * 32 + r32) * 1024 + b * 256 + 4 * hi;
#pragma unroll
        for (int ks = 0; ks < 16; ++ks) { const pg8::u32x2 lo = *(const GAS pg8::u32x2*)(vr + ks * 16), hh = *(const GAS pg8::u32x2*)(vr + ks * 16 + 8);
            const v4u vv = (v4u){lo.x, lo.y, hh.x, hh.y};
            o[db] = __builtin_amdgcn_mfma_f32_32x32x16_bf16(__builtin_bit_cast(bf16x8, pk[ks >> 1][ks & 1]), __builtin_bit_cast(bf16x8, vv), o[db], 0, 0, 0); } }
    LDS_WAIT(); asm volatile("" ::: "memory");
    float rl[16];
#pragma unroll
    for (int r = 0; r < 16; ++r) rl[r] = 1.0f / wsf[crow(r, hi)];
#pragma unroll
    for (int db = 0; db < 8; ++db)
#pragma unroll
        for (int r = 0; r < 16; ++r) XQ[(size_t)(R0 + crow(r, hi)) * 1024 + h * 256 + db * 32 + r32] = (bf16)pk2(o[db][r] * rl[r], 0.f);
    LDS_WAIT(); asm volatile("" ::: "memory");
}
__device__ __forceinline__ void final_norm_all(Frame& F, const bf16* X, const float* ss, const float* g, float* out) {
    const int gw = F.vcu * NWAVES + F.wave, NGW = F.G * NWAVES, lane = F.lane;
    for (int m = gw; m < M; m += NGW) { const float rs = pg8::rstd_of(ss, m);
#pragma unroll
        for (int j = 0; j < 4; ++j) { const unsigned long long v = ((const GAS unsigned long long*)(X + (size_t)m * D))[lane + 64 * j]; const f32x4 gg = *(const GAS f32x4*)(g + (lane + 64 * j) * 4);
            const unsigned a = (unsigned)v, bq = (unsigned)(v >> 32);
            *(GAS f32x4*)(out + (size_t)m * D + (lane + 64 * j) * 4) = (f32x4){bf2f_lo(a) * rs * gg.x, bf2f_hi(a) * rs * gg.y, bf2f_lo(bq) * rs * gg.z, bf2f_hi(bq) * rs * gg.w}; } }
}

#ifndef MK_EN
#define MK_EN 0x3ff
#endif
#define EN(n) (((MK_EN) >> (n)) & 1)
#ifndef MK_ONE_LAUNCH
#define MK_ONE_LAUNCH 0
#endif
__global__ void __launch_bounds__(NWAVES * 64, 2) mk_fwd(Args args) {
    extern __shared__ __attribute__((aligned(16))) unsigned char lds[];
    Frame F;
    F.lds = (LAS unsigned char*)lds; F.MISC = (volatile LAS unsigned*)(F.lds + MISC_OFF);
    F.tid = threadIdx.x; F.lane = F.tid & 63; F.wave = __builtin_amdgcn_readfirstlane(F.tid >> 6);
    F.G = gridDim.x; { const int bx = blockIdx.x; F.vcu = (F.G % 8 == 0) ? (bx % 8) * (F.G / 8) + bx / 8 : bx; }
    KArgs A = (KArgs)__builtin_amdgcn_kernarg_segment_ptr();
    unsigned char* ws = A->ws; F.ws = ws; F.ctl = (gu32*)(ws + WS_CTL);
#define PHASE_BEGIN() do { int t_ = threadIdx.x; asm volatile("" : "+v"(t_)); F.tid = t_; F.lane = t_ & 63; F.wave = __builtin_amdgcn_readfirstlane(t_ >> 6); \
        A = (KArgs)__builtin_amdgcn_kernarg_segment_ptr(); asm volatile("" : "+s"(A)); ws = A->ws; F.ws = ws; F.ctl = (gu32*)(ws + WS_CTL); } while (0)
    for (int u = F.tid; u < (LDS_BYTES - LDSCTL_OFF) / 4; u += NWAVES * 64) ((LAS unsigned*)(F.lds + LDSCTL_OFF))[u] = 0u;
    __syncthreads();
    const int lo = A->ph_lo, hi = A->ph_hi;
    XcdBarrier bar; bar.bar = (unsigned*)(F.ctl + CW_BAR); bar.x = 0; bar.st = nullptr;
    if (hi - lo > 1) bar = xcd_barrier_post((unsigned*)(F.ctl + CW_BAR), F.MISC + 8);
#define IN(k) (lo <= (k) && (k) < hi)
#define SEAM(k) do { if (IN(k) && IN((k) + 1)) xcd_barrier(bar); } while (0)
#define X ((bf16*)(ws + WS_X))
#define SSV(k) ((float*)(ws + WS_SS + (size_t)((k) & 1) * SS_STAGE))

    if (EN(0) && IN(0)) { PHASE_BEGIN(); p0_prologue(F, A); SEAM(0); }
    if (EN(1) && IN(1)) { PHASE_BEGIN();
        pg8::Gemm g{(const bf16*)(ws + WS_MK), (const bf16*)(ws + WS_MK), 5120, 5120, D}; pg8::MemKVOrder S{F.G, (int)blockIdx.x};
        pg8::EpiMemKV E{(bf16*)(ws + WS_MEMK), (bf16*)(ws + WS_MEMVT), (const float*)(ws + WS_MSS)};
        pg8::gemm_phase<pg8::EpiMemKV, pg8::MemKVOrder, true, true>(F.lds + RING_OFF, g, S, E);
        SEAM(1);
    }
    for (int l = 0; l < DEPTH; ++l) {
        const int pb = 2 + 11 * l;
#define FFN_UP(PH, WGU, SSIN) if (EN(2) && IN(PH)) { PHASE_BEGIN(); unsigned char* wl = ws + WS_W + (size_t)l * W_LAYER; \
            pg8::Gemm g{X, (const bf16*)(wl + (WGU)), M, NGU, D}; pg8::StaticOrder S; S.init(M, NGU, F.G, (int)blockIdx.x); \
            pg8::EpiSwiGLU E{(bf16*)(ws + WS_H), SSV(SSIN)}; \
            pg8::gemm_phase<pg8::EpiSwiGLU, pg8::StaticOrder, true, true>(F.lds + RING_OFF, g, S, E); SEAM(PH); }
#define GEMM_RES(PH, A, W, KK, SSOUT, SCALE) if (EN(3) && IN(PH)) { PHASE_BEGIN(); unsigned char* wl = ws + WS_W + (size_t)l * W_LAYER; \
            pg8::Gemm g{(const bf16*)(A), (const bf16*)(wl + (W)), M, D, (KK)}; pg8::StaticOrder S; S.init(M, D, F.G, (int)blockIdx.x); \
            pg8::EpiRes E{X, SSV(SSOUT), (SCALE)}; \
            pg8::gemm_phase<pg8::EpiRes, pg8::StaticOrder, true, true>(F.lds + RING_OFF, g, S, E); SEAM(PH); }
        FFN_UP(pb + 0, WO_GU1, 4 * l)
        GEMM_RES(pb + 1, ws + WS_H, WO_D1, FF, 4 * l + 1, 0.5f)
        if (EN(4) && IN(pb + 2)) { PHASE_BEGIN(); unsigned char* wl = ws + WS_W + (size_t)l * W_LAYER;
            pg8::Gemm g{X, (const bf16*)(wl + WO_IN), M, NINP, D}; pg8::StaticOrder S; S.init(M, NINP, F.G, (int)blockIdx.x);
            pg8::EpiWin E{ws, SSV(4 * l + 1), QSCALE};
            pg8::gemm_phase<pg8::EpiWin, pg8::StaticOrder, true, true>(F.lds + RING_OFF, g, S, E); SEAM(pb + 2);
        }
        if (EN(5) && IN(pb + 3)) { PHASE_BEGIN();
            for (int u = F.vcu; u < M / 64; u += F.G) conv_a_unit(F, (const bf16*)(ws + WS_HG), (bf16*)(ws + WS_MIX), INF(A, I_CONF_DW) + l * 31 * 256, INF(A, I_CONF_DW_B) + l * 256, INF(A, I_CONF_LN_G) + l * 256, INF(A, I_CONF_LN_B) + l * 256, u);
            conv_b_all(F, (const bf16*)(ws + WS_U), (const bf16*)(ws + WS_BG), (bf16*)(ws + WS_MIX), INF(A, I_SC_DW) + l * 3 * 256);
            SEAM(pb + 3);
        }
        if (EN(6) && IN(pb + 4)) { PHASE_BEGIN();
            for (int q = F.vcu; q < M; q += F.G) dsa_naive_query(F, (const bf16*)(ws + WS_Q), (const bf16*)(ws + WS_K), (const bf16*)(ws + WS_V), (const bf16*)(ws + WS_QI), (const bf16*)(ws + WS_KI), (const float*)(ws + WS_WI), (bf16*)(ws + WS_MIX), q);
            SEAM(pb + 4);
        }
        GEMM_RES(pb + 5, ws + WS_MIX, WO_OUT, D, 4 * l + 2, 1.0f)
        if (EN(7) && IN(pb + 6)) { PHASE_BEGIN(); unsigned char* wl = ws + WS_W + (size_t)l * W_LAYER;
            pg8::Gemm g{X, (const bf16*)(wl + WO_Q), M, D, D}; pg8::StaticOrder S; S.init(M, D, F.G, (int)blockIdx.x);
            pg8::EpiRowScale E{(bf16*)(ws + WS_XQ), D, SSV(4 * l + 2), XQSCALE};
            pg8::gemm_phase<pg8::EpiRowScale, pg8::StaticOrder, true, true>(F.lds + RING_OFF, g, S, E); SEAM(pb + 6);
        }
        if (EN(8) && IN(pb + 7)) { PHASE_BEGIN();
            for (int u = F.vcu; u < 512; u += F.G) xattn_unit(F, (bf16*)(ws + WS_XQ), (const bf16*)(ws + WS_MEMK) + (size_t)l * 1024 * 1024, (const bf16*)(ws + WS_MEMVT) + (size_t)l * 1024 * 1024, u >> 2, u & 3);
            SEAM(pb + 7);
        }
        GEMM_RES(pb + 8, ws + WS_XQ, WO_O, D, 4 * l + 3, 1.0f)
        FFN_UP(pb + 9, WO_GU2, 4 * l + 3)
        GEMM_RES(pb + 10, ws + WS_H, WO_D2, FF, 4 * l + 4, 0.5f)
    }
    if (EN(9) && IN(NPH - 1)) { PHASE_BEGIN(); final_norm_all(F, X, SSV(4 * DEPTH), INF(A, I_FINAL_NORM), A->out); }
#undef IN
#undef SEAM
#undef X
#undef SSV
}

extern "C" void kernel_launch(void* const* d_in, const int* in_sizes, int n_in, void* d_out, int out_size, void* d_ws, size_t ws_size, hipStream_t stream) {
    static int grid = 0;
    if (grid == 0) {
        if (n_in != 25 || in_sizes[0] != M * D || out_size != M * D || ws_size < WS_END) { fprintf(stderr, "kernel_launch: unexpected shapes (n_in %d, in0 %d, out %d, ws %zu); nothing launched\n", n_in, n_in > 0 ? in_sizes[0] : -1, out_size, ws_size); grid = -1; return; }
        int dev = 0, cus = 0, per_cu = 0;
        if (hipGetDevice(&dev) != hipSuccess || hipDeviceGetAttribute(&cus, hipDeviceAttributeMultiprocessorCount, dev) != hipSuccess) { grid = -1; return; }
        if (hipFuncSetAttribute((const void*)mk_fwd, hipFuncAttributeMaxDynamicSharedMemorySize, LDS_BYTES) != hipSuccess) { fprintf(stderr, "kernel_launch: hipFuncSetAttribute failed\n"); grid = -1; return; }
        if (hipOccupancyMaxActiveBlocksPerMultiprocessor(&per_cu, (const void*)mk_fwd, NWAVES * 64, LDS_BYTES) != hipSuccess || per_cu < 1) { fprintf(stderr, "kernel_launch: occupancy query reports %d\n", per_cu); }
        (void)hipGetLastError();
        grid = cus;
    }
    if (grid < 0) return;
    if (hipMemsetAsync((char*)d_ws + WS_CTL, 0, CTL_ZERO_BYTES, stream) != hipSuccess) return;
    Args a{};
    for (int i = 0; i < 25; ++i) a.in[i] = d_in[i];
    a.out = (float*)d_out; a.ws = (unsigned char*)d_ws;
    for (int i = 0; i < 32; ++i) a.invf[i] = powf(10000.0f, -(float)(2 * i) / 64.0f);
#if MK_ONE_LAUNCH
    a.ph_lo = 0; a.ph_hi = NPH;
    hipLaunchKernelGGL(mk_fwd, dim3(grid), dim3(NWAVES * 64), LDS_BYTES, stream, a);
#else
    for (int p = 0; p < NPH; ++p) { a.ph_lo = p; a.ph_hi = p + 1; hipLaunchKernelGGL(mk_fwd, dim3(grid), dim3(NWAVES * 64), LDS_BYTES, stream, a); }
#endif
}
```

```cpp
#include <hip/hip_runtime.h>
#include <cstdio>
#include <cstdint>
#include <cmath>
constexpr int NWAVES = 8;
constexpr int M = 32768, D = 1024, FF = 2816, SEQ = 8192, NBATCH = 4, DEPTH = 2, NGU = 2 * FF  , NINP = 3328  , NIN = 3140;
constexpr int NPH = 2 + 11 * DEPTH + 1;
constexpr float QSCALE = 0.125f * 1.4426950408889634f;
constexpr float XQSCALE = 0.0625f * 1.4426950408889634f;
constexpr float IDX_SCALE = 0.5f * 0.125f;
constexpr size_t MiB = 1u << 20;
constexpr size_t WS_CTL = 0, CTL_ZERO_BYTES = 1 * MiB;
constexpr size_t WS_SS = 448 * MiB, SS_STAGE = 2 * MiB;
constexpr size_t WS_MSS = 3 * MiB;
constexpr size_t WS_COS = 4 * MiB, WS_SIN = 8 * MiB;
constexpr size_t WS_MK = 12 * MiB;
constexpr size_t WS_MEMK = 22 * MiB, WS_MEMVT = 26 * MiB;
constexpr size_t WS_W = 30 * MiB, W_LAYER = 45 * MiB + MiB / 2;
constexpr size_t WO_GU1 = 0, WO_D1 = 11 * MiB, WO_IN = WO_D1 + 5 * MiB + MiB / 2, WO_OUT = WO_IN + 6 * MiB + MiB / 2, WO_Q = WO_OUT + 2 * MiB, WO_O = WO_Q + 2 * MiB, WO_GU2 = WO_O + 2 * MiB, WO_D2 = WO_GU2 + 11 * MiB;
static_assert(WO_D2 + 5 * MiB + MiB / 2 == W_LAYER, "weight map");
constexpr size_t WS_X = 122 * MiB;
constexpr size_t WS_R = 186 * MiB;
constexpr size_t WS_H = WS_R;
constexpr size_t WS_HG = WS_R, WS_U = WS_R + 16 * MiB, WS_BG = WS_R + 32 * MiB, WS_Q = WS_R + 48 * MiB, WS_K = WS_R + 80 * MiB, WS_V = WS_R + 112 * MiB, WS_QI = WS_R + 144 * MiB,
                 WS_KI = WS_R + 160 * MiB, WS_WI = WS_R + 164 * MiB, WS_MIX = WS_R + 165 * MiB, WS_MASK = WS_R + 229 * MiB, WS_MIXEND = WS_R + 261 * MiB;
constexpr size_t WS_XQ = WS_R;
constexpr size_t WS_X8 = WS_R + 96 * MiB;
constexpr size_t WS_XO8 = WS_R + 64 * MiB;
constexpr size_t WS_MASK1 = 452 * MiB;
constexpr size_t WS_END = 484 * MiB;
static_assert(WS_W + 2 * W_LAYER <= WS_X && WS_X + (size_t)M * D * 2 <= WS_R && WS_H + (size_t)M * FF * 2 <= WS_END && WS_MIXEND <= WS_END, "d_ws map");
constexpr int CW_TMO = 0, CW_BAR = 4096;
constexpr int RING_OFF = 0, RING_BYTES = 131072, LDSCTL_OFF = 143360, MISC_OFF = LDSCTL_OFF + 320, LDS_BYTES = 147456;

namespace pg8 {
#define PG8_LAS __attribute__((address_space(3)))
typedef unsigned short bf16_t;
typedef short bf16x8 __attribute__((ext_vector_type(8)));
typedef float f32x4 __attribute__((ext_vector_type(4)));
typedef unsigned u32x4 __attribute__((ext_vector_type(4)));
constexpr int BM = 256, BK = 64, HALF = 128, HTB = HALF * BK * 2  , STAGE_BYTES = 8 * HTB, NXCD = 8, WGM = 8;

__host__ __device__ __forceinline__ int lds_byte(int r, int c) { const int st = (r >> 4) * 2 + (c >> 5), rr = r & 15, cc = c & 31, ob = rr * 64 + cc * 2; return st * 1024 + (ob ^ (((ob >> 9) & 1) << 5)); }
__host__ __device__ __forceinline__ void stage_rc(int b, int& R, int& C) { const int st = b / 1024, sb = b % 1024, swz = sb ^ (((sb >> 9) & 1) << 5); R = (st >> 1) * 16 + swz / 64; C = (st & 1) * 32 + (swz % 64) / 2; }
__host__ __device__ __forceinline__ int perm32(int rho) { const int n = rho >> 4, i = rho & 15; return 8 * (i >> 2) + 4 * n + (i & 3); }

struct Unit { int pm, pn; };
struct Gemm { const bf16_t* A; const bf16_t* Bt; int M, N, K; };

struct StaticOrder {
    int nM, nN, nwg, G, c;
    __host__ __device__ void init(int M, int N, int G_, int c_) { nM = M / BM; nN = N / BM; nwg = nM * nN; G = G_; c = c_; }
    __host__ __device__ bool next(int i, Unit& u) const {
        const long L = (long)i * G + c; if (L >= nwg) return false;
        int wgid = (int)L; { const int q = nwg / NXCD, r = nwg % NXCD, xcd = wgid % NXCD, off = wgid / NXCD; wgid = (xcd < r ? xcd * (q + 1) : r * (q + 1) + (xcd - r) * q) + off; }
        const int nig = WGM * nN, gid = wgid / nig, fm = gid * WGM, gsz = (nM - fm) < WGM ? (nM - fm) : WGM;
        u.pm = fm + ((wgid % nig) % gsz); u.pn = (wgid % nig) / gsz; return true;
    }
    __device__ __forceinline__ void a_ready(const Unit&) const {}
    __device__ __forceinline__ void done(const Unit&) const {}
};
__device__ __forceinline__ unsigned cvt_pk_bf16(float lo, float hi) { unsigned r; asm volatile("v_cvt_pk_bf16_f32 %0, %1, %2" : "=v"(r) : "v"(lo), "v"(hi)); return r; }
typedef float f32x2 __attribute__((ext_vector_type(2)));
typedef unsigned u32x2 __attribute__((ext_vector_type(2)));
__device__ __forceinline__ float bflo(unsigned w) { return __uint_as_float(w << 16); }
__device__ __forceinline__ float bfhi(unsigned w) { return __uint_as_float(w & 0xffff0000u); }
__device__ __forceinline__ float sigm(float x) { return __builtin_amdgcn_rcpf(1.f + __builtin_amdgcn_exp2f(-1.4426950408889634f * x)); }
__device__ __forceinline__ u32x4 pack8(const f32x4 a, const f32x4 b) { u32x4 w; w.x = cvt_pk_bf16(a[0], a[1]); w.y = cvt_pk_bf16(a[2], a[3]); w.z = cvt_pk_bf16(b[0], b[1]); w.w = cvt_pk_bf16(b[2], b[3]); return w; }
__device__ __forceinline__ float sumsq_of(const float* ss, int row) { const f32x4* p = (const f32x4*)(ss + (size_t)row * 16); const f32x4 a = p[0], b = p[1], c = p[2], d = p[3];
    return (((a[0] + a[1]) + (a[2] + a[3])) + ((b[0] + b[1]) + (b[2] + b[3]))) + (((c[0] + c[1]) + (c[2] + c[3])) + ((d[0] + d[1]) + (d[2] + d[3]))); }
__device__ __forceinline__ float rstd_of(const float* ss, int row) { return __builtin_amdgcn_rsqf(sumsq_of(ss, row) * (1.f / 1024.f) + 1e-6f); }
__device__ __forceinline__ float rstd_of4(const float* ss, int row, int fq) { const f32x4 a = *(const f32x4*)(ss + (size_t)row * 16 + fq * 4); float s = (a[0] + a[1]) + (a[2] + a[3]);
    s += __shfl_xor(s, 16); s += __shfl_xor(s, 32); return __builtin_amdgcn_rsqf(s * (1.f / 1024.f) + 1e-6f); }
__device__ __forceinline__ f32x4 rstd_ld4(const float* ss, int row, int fq) { return *(const f32x4*)(ss + (size_t)row * 16 + fq * 4); }
__device__ __forceinline__ float rstd_fin4(const f32x4 a) { float s = (a[0] + a[1]) + (a[2] + a[3]); s += __shfl_xor(s, 16); s += __shfl_xor(s, 32); return __builtin_amdgcn_rsqf(s * (1.f / 1024.f) + 1e-6f); }
__device__ __forceinline__ float rstd_of1(const float* ss, int row) { return __builtin_amdgcn_rsqf(ss[row] * (1.f / 1024.f) + 1e-6f); }
constexpr int FFH = 2816;

struct EpiSwiGLU {
    static constexpr bool PERM = true, AFTER_DRAIN = false;
    bf16_t* H; const float* ss;
    __device__ __forceinline__ void operator()(const f32x4 (&acc)[2][2][4][2], const Unit& u, int wr, int wc, int fr, int fq) const {
        asm volatile("" : "+v"(fr), "+v"(fq));
        const int row0 = u.pm * BM + wr * 64 + fr;
        unsigned char* const hb = (unsigned char*)H + (size_t)(u.pm * (FFH / 128) + u.pn) * 32768 + ((((wr * 4 + wc) * 8 + (fq & 1)) * 32) + (fq >> 1) * 16 + fr) * 16;
        f32x4 pa[2][4];
#pragma unroll
        for (int ai = 0; ai < 2; ++ai)
#pragma unroll
            for (int m = 0; m < 4; ++m) pa[ai][m] = rstd_ld4(ss, row0 + ai * HALF + m * 16, fq);
        unsigned wa0 = 0u, wa1 = 0u;
#pragma unroll
        for (int ai = 0; ai < 2; ++ai)
#pragma unroll
            for (int m = 0; m < 4; ++m) { const float rs = rstd_fin4(pa[ai][m]);
                const float rsl = rs * 1.4426950408889634f, rsu = rs * 0.6931471805599453f;
                f32x4 h0, h1;
#pragma unroll
                for (int n = 0; n < 2; ++n) { const f32x4 G = acc[ai][0][m][n], U = acc[ai][1][m][n]; f32x4 hv;
#pragma unroll
                    for (int q = 0; q < 2; ++q) { const f32x2 g2 = (f32x2){G[2 * q], G[2 * q + 1]} * rsl, u2 = (f32x2){U[2 * q], U[2 * q + 1]} * rsu;
                        f32x2 r2; r2.x = __builtin_amdgcn_rcpf(1.f + __builtin_amdgcn_exp2f(-g2.x)); r2.y = __builtin_amdgcn_rcpf(1.f + __builtin_amdgcn_exp2f(-g2.y));
                        const f32x2 o2 = g2 * u2 * r2; hv[2 * q] = o2.x; hv[2 * q + 1] = o2.y; }
                    if (n == 0) h0 = hv; else h1 = hv; }
                unsigned w0 = 0u, w1 = 0u;
                w0 = __builtin_amdgcn_cvt_pk_fp8_f32(h0[0], h0[1], w0, false); w0 = __builtin_amdgcn_cvt_pk_fp8_f32(h0[2], h0[3], w0, true); w1 = __builtin_amdgcn_cvt_pk_fp8_f32(h1[0], h1[1], w1, false); w1 = __builtin_amdgcn_cvt_pk_fp8_f32(h1[2], h1[3], w1, true);
                if ((m & 1) == 0) { wa0 = w0; wa1 = w1; }
                else { const auto s0 = __builtin_amdgcn_permlane16_swap(wa0, w0, false, false), s1 = __builtin_amdgcn_permlane16_swap(wa1, w1, false, false);
                    *(u32x4*)(hb + (ai * 4 + m - 1) * 512) = (u32x4){s0[0], s1[0], s0[1], s1[1]}; asm volatile("" ::: "memory"); } }
    }
};
template <bool WX8> struct EpiRes {
    static constexpr bool PERM = true, AFTER_DRAIN = false;
    bf16_t* X; float* ssn; float scale;
    __device__ __forceinline__ void operator()(const f32x4 (&acc)[2][2][4][2], const Unit& u, int wr, int wc, int fr, int fq) const {
        asm volatile("" : "+v"(fr), "+v"(fq));
        const int row0 = u.pm * BM + wr * 64 + fr, col0 = u.pn * BM + wc * 32 + fq * 8;
        u32x4 xcur[2][2], xnxt[2][2];
#pragma unroll
        for (int h2 = 0; h2 < 2; ++h2)
#pragma unroll
            for (int bj = 0; bj < 2; ++bj) xcur[h2][bj] = *(const u32x4*)(X + (size_t)(row0 + h2 * 16) * 1024 + col0 + bj * HALF);
#pragma unroll
        for (int q = 0; q < 8; ++q) { const int ai = q >> 2, m = q & 3; const int row = row0 + ai * HALF + m * 16; float s = 0.f;
            if ((q & 1) == 0 && q + 2 < 8) {
#pragma unroll
                for (int h2 = 0; h2 < 2; ++h2)
#pragma unroll
                    for (int bj = 0; bj < 2; ++bj) { const int qn = q + 2 + h2; xnxt[h2][bj] = *(const u32x4*)(X + (size_t)(row0 + (qn >> 2) * HALF + (qn & 3) * 16) * 1024 + col0 + bj * HALF); } }
#pragma unroll
                for (int bj = 0; bj < 2; ++bj) { bf16_t* p = X + (size_t)row * 1024 + col0 + bj * HALF; const u32x4 xv = xcur[q & 1][bj];
                    f32x4 a = acc[ai][bj][m][0] * scale, b = acc[ai][bj][m][1] * scale;
                    a[0] += bflo(xv.x); a[1] += bfhi(xv.x); a[2] += bflo(xv.y); a[3] += bfhi(xv.y); b[0] += bflo(xv.z); b[1] += bfhi(xv.z); b[2] += bflo(xv.w); b[3] += bfhi(xv.w);
                    const u32x4 w = pack8(a, b); *(u32x4*)p = w;
                    if constexpr (WX8) { unsigned q0 = 0u, q1 = 0u; q0 = __builtin_amdgcn_cvt_pk_fp8_f32(bflo(w.x), bfhi(w.x), q0, false); q0 = __builtin_amdgcn_cvt_pk_fp8_f32(bflo(w.y), bfhi(w.y), q0, true); q1 = __builtin_amdgcn_cvt_pk_fp8_f32(bflo(w.z), bfhi(w.z), q1, false); q1 = __builtin_amdgcn_cvt_pk_fp8_f32(bflo(w.w), bfhi(w.w), q1, true);
                        *(u32x2*)((unsigned char*)X + (WS_X8 - WS_X) + (size_t)row * 1024 + col0 + bj * HALF) = (u32x2){q0, q1}; }
                    s += (bflo(w.x) * bflo(w.x) + bfhi(w.x) * bfhi(w.x)) + (bflo(w.y) * bflo(w.y) + bfhi(w.y) * bfhi(w.y)) + (bflo(w.z) * bflo(w.z) + bfhi(w.z) * bfhi(w.z)) + (bflo(w.w) * bflo(w.w) + bfhi(w.w) * bfhi(w.w)); }
                s += __shfl_xor(s, 16); s += __shfl_xor(s, 32);
                if (fq == 0) ssn[(size_t)row * 16 + u.pn * 4 + wc] = s;
            if (q & 1) { asm volatile("" ::: "memory");
#pragma unroll
                for (int h2 = 0; h2 < 2; ++h2)
#pragma unroll
                    for (int bj = 0; bj < 2; ++bj) xcur[h2][bj] = xnxt[h2][bj]; } }
    }
};
struct EpiRowScale {
    static constexpr bool PERM = true, AFTER_DRAIN = false;
    bf16_t* O; int ldc; const float* ss; float scale;
    __device__ __forceinline__ void operator()(const f32x4 (&acc)[2][2][4][2], const Unit& u, int wr, int wc, int fr, int fq) const {
        asm volatile("" : "+v"(fr), "+v"(fq));
        const int row0 = u.pm * BM + wr * 64 + fr, col0 = u.pn * BM + wc * 32 + fq * 8;
#pragma unroll
        for (int ai = 0; ai < 2; ++ai)
#pragma unroll
            for (int m = 0; m < 4; ++m) { const int row = row0 + ai * HALF + m * 16; const float rs = rstd_of4(ss, row, fq) * scale;
#pragma unroll
                for (int bj = 0; bj < 2; ++bj) *(u32x4*)(O + (size_t)row * ldc + col0 + bj * HALF) = pack8(acc[ai][bj][m][0] * rs, acc[ai][bj][m][1] * rs); asm volatile("" ::: "memory"); }
    }
};
struct EpiWin {
    static constexpr bool PERM = true, AFTER_DRAIN = false;
    unsigned char* ws; const float* ss; float qscale;
    __device__ __forceinline__ void operator()(const f32x4 (&acc)[2][2][4][2], const Unit& u, int wr, int wc, int fr, int fq) const {
        asm volatile("" : "+v"(fr), "+v"(fq));
        const int row0 = u.pm * BM + wr * 64 + fr, t = u.pn, c8 = wc * 32 + fq * 8;
        bf16_t* const HG = (bf16_t*)(ws + WS_HG); bf16_t* const U = (bf16_t*)(ws + WS_U); bf16_t* const BG = (bf16_t*)(ws + WS_BG); bf16_t* const Q = (bf16_t*)(ws + WS_Q); bf16_t* const K = (bf16_t*)(ws + WS_K);
        bf16_t* const V = (bf16_t*)(ws + WS_V); bf16_t* const QI = (bf16_t*)(ws + WS_QI); bf16_t* const KI = (bf16_t*)(ws + WS_KI); float* const WI = (float*)(ws + WS_WI); const float* const cs = (const float*)(ws + WS_COS); const float* const sn = (const float*)(ws + WS_SIN);
        float rsv[8];
        { f32x4 pa[8];
#pragma unroll
          for (int q = 0; q < 8; ++q) pa[q] = rstd_ld4(ss, row0 + (q >> 2) * HALF + (q & 3) * 16, fq);
#pragma unroll
          for (int q = 0; q < 8; ++q) rsv[q] = rstd_fin4(pa[q]); }
        asm volatile("" ::: "memory");
        if (t < 5 || t == 9 || t == 10) {
#pragma unroll
            for (int q = 0; q < 8; ++q) { const int ai = q >> 2, m = q & 3; const int row = row0 + ai * HALF + m * 16; const float rs = rsv[q];
                const f32x4 a0 = acc[ai][0][m][0] * rs, a1 = acc[ai][0][m][1] * rs, b0 = acc[ai][1][m][0] * rs, b1 = acc[ai][1][m][1] * rs;
                if (t < 2) { f32x4 o0, o1;
#pragma unroll
                    for (int j = 0; j < 4; ++j) { o0[j] = a0[j] * sigm(b0[j]); o1[j] = a1[j] * sigm(b1[j]); }
                    *(u32x4*)(HG + (size_t)row * 256 + t * 128 + c8) = pack8(o0, o1); }
                else if (t < 4) { *(u32x4*)(U + (size_t)row * 256 + (t - 2) * 128 + c8) = pack8(a0 * b0, a1 * b1); }
                else if (t == 4) { *(u32x4*)(BG + (size_t)row * 256 + c8) = pack8(a0, a1); *(u32x4*)(BG + (size_t)row * 256 + 128 + c8) = pack8(b0, b1); }
                else { *(u32x4*)(V + (size_t)row * 512 + (t - 9) * 256 + c8) = pack8(a0, a1); *(u32x4*)(V + (size_t)row * 512 + (t - 9) * 256 + 128 + c8) = pack8(b0, b1); }
                asm volatile("" ::: "memory"); }
        } else {
            f32x4 cc[4], cn[4];
            { const size_t o = (size_t)row0 * 32 + fq * 8; cc[0] = *(const f32x4*)(cs + o); cc[1] = *(const f32x4*)(cs + o + 4); cc[2] = *(const f32x4*)(sn + o); cc[3] = *(const f32x4*)(sn + o + 4); }
#pragma unroll
            for (int q = 0; q < 8; ++q) { const int ai = q >> 2, m = q & 3; const int row = row0 + ai * HALF + m * 16; const float rs = rsv[q];
                if (q + 1 < 8) { const size_t o = (size_t)(row0 + ((q + 1) >> 2) * HALF + ((q + 1) & 3) * 16) * 32 + fq * 8; cn[0] = *(const f32x4*)(cs + o); cn[1] = *(const f32x4*)(cs + o + 4); cn[2] = *(const f32x4*)(sn + o); cn[3] = *(const f32x4*)(sn + o + 4); }
                const f32x4 a0 = acc[ai][0][m][0] * rs, a1 = acc[ai][0][m][1] * rs, b0 = acc[ai][1][m][0] * rs, b1 = acc[ai][1][m][1] * rs;
                const f32x4 c0 = cc[0], c1 = cc[1], s0 = cc[2], s1 = cc[3];
                f32x4 p0 = a0 * c0 - b0 * s0, p1 = a1 * c1 - b1 * s1, r0 = b0 * c0 + a0 * s0, r1 = b1 * c1 + a1 * s1;
                if (t < 7) { bf16_t* d = Q + (size_t)row * 512 + ((t - 5) * 4 + wc) * 64 + fq * 8; *(u32x4*)d = pack8(p0 * qscale, p1 * qscale); *(u32x4*)(d + 32) = pack8(r0 * qscale, r1 * qscale); }
                else if (t < 9) { bf16_t* d = K + (size_t)row * 512 + ((t - 7) * 4 + wc) * 64 + fq * 8; *(u32x4*)d = pack8(p0, p1); *(u32x4*)(d + 32) = pack8(r0, r1); }
                else if (t == 11) { bf16_t* d = QI + (size_t)row * 256 + wc * 64 + fq * 8; *(u32x4*)d = pack8(p0, p1); *(u32x4*)(d + 32) = pack8(r0, r1); }
                else { if (wc == 0) { bf16_t* d = KI + ((((size_t)(row >> 5) * 4 + (fq >> 1)) * 64 + (fq & 1) * 32 + (row & 31)) << 3); *(u32x4*)d = pack8(p0, p1); *(u32x4*)(d + 1024) = pack8(r0, r1); }
                       if (wc == 1 && fq == 0) *(f32x4*)(WI + (size_t)row * 4) = b0; }
                asm volatile("" ::: "memory");
#pragma unroll
                for (int i = 0; i < 4; ++i) cc[i] = cn[i]; }
        }
    }
};
struct EpiMemKV {
    static constexpr bool PERM = true, AFTER_DRAIN = false;
    bf16_t *MEMK, *MEMVT; const float* mss;
    __device__ __forceinline__ void operator()(const f32x4 (&acc)[2][2][4][2], const Unit& u, int wr, int wc, int fr, int fq) const {
        asm volatile("" : "+v"(fr), "+v"(fq));
        const bool isv = u.pm >= 4; const int l = isv ? ((u.pm - 8) >> 3) : ((u.pn - 4) >> 3);
        const int pr = isv ? ((u.pm - 8) & 7) : u.pm, pc = isv ? u.pn : ((u.pn - 4) & 7);
        bf16_t* O = (isv ? MEMVT : MEMK) + (size_t)l * 1024 * 1024;
        const int row0 = pr * BM + wr * 64 + fr, col0 = pc * BM + wc * 32 + fq * 8;
#pragma unroll
        for (int ai = 0; ai < 2; ++ai)
#pragma unroll
            for (int m = 0; m < 4; ++m) { const int row = row0 + ai * HALF + m * 16; const float rsr = isv ? 1.f : rstd_of1(mss, row);
#pragma unroll
                for (int bj = 0; bj < 2; ++bj) { f32x4 a = acc[ai][bj][m][0] * rsr, b = acc[ai][bj][m][1] * rsr;
                    if (isv) {
#pragma unroll
                        for (int j = 0; j < 4; ++j) { a[j] *= rstd_of1(mss, col0 + bj * HALF + j); b[j] *= rstd_of1(mss, col0 + bj * HALF + 4 + j); } }
                    *(u32x4*)(O + (size_t)row * 1024 + col0 + bj * HALF) = pack8(a, b); } asm volatile("" ::: "memory"); }
    }
};
struct MemKVOrder {
    int G, c;
    __device__ __forceinline__ bool next(int i, Unit& u) const {
        const int L = i * G + c; if (L >= 64) return false;
        const int ty = L >> 4, a = (L >> 2) & 3, b = L & 3, l = ty & 1;
        if (ty < 2) { u.pm = a; u.pn = 4 + 8 * l + b; } else { u.pm = 8 + 8 * l + a; u.pn = b; }
        return true;
    }
    __device__ __forceinline__ void a_ready(const Unit&) const {}
    __device__ __forceinline__ void done(const Unit&) const {}
};

constexpr int TILE_X = (int)(WS_X >> 19), TILE_MK = (int)(WS_MK >> 19);
static_assert((WS_X & ((1u << 19) - 1)) == 0 && (WS_MK & ((1u << 19) - 1)) == 0 && ((WS_W + WO_IN) & ((1u << 19) - 1)) == 0 && (W_LAYER & ((1u << 19) - 1)) == 0, "tile-aligned operands");
struct WinKVOrder {
    int G, c, tin, nkv;
    __device__ __forceinline__ bool next(int i, Unit& u) const {
        const int nwin = 128 * 13; const long L0 = (long)i * G + c; if (L0 >= nwin + nkv) return false;
        int L = (int)L0;
        if (L < nwin) { int wgid = L; { const int q = nwin / 8, xcd = wgid % 8, off = wgid / 8; wgid = xcd * q + off; }
            const int nig = 8 * 13, gid = wgid / nig, fm = gid * 8; u.pm = TILE_X + fm + ((wgid % nig) % 8); u.pn = tin + (wgid % nig) / 8; return true; }
        L -= nwin; const int ty = L >> 4, a = (L >> 2) & 3, b = L & 3, l = ty & 1;
        if (ty < 2) { u.pm = TILE_MK + a; u.pn = TILE_MK + 4 + 8 * l + b; } else { u.pm = TILE_MK + 8 + 8 * l + a; u.pn = TILE_MK + b; }
        return true;
    }
    __device__ __forceinline__ void a_ready(const Unit&) const {}
    __device__ __forceinline__ void done(const Unit&) const {}
};
struct EpiWinKV {
    static constexpr bool PERM = true, AFTER_DRAIN = false;
    unsigned char* ws; const float* ss; float qscale; int tin;
    __device__ __forceinline__ void operator()(const f32x4 (&acc)[2][2][4][2], const Unit& u, int wr, int wc, int fr, int fq) const {
        if (u.pm >= TILE_X) { const EpiWin W{ws, ss, qscale}; const Unit v{u.pm - TILE_X, u.pn - tin}; W(acc, v, wr, wc, fr, fq); }
        else { const EpiMemKV KV{(bf16_t*)(ws + WS_MEMK), (bf16_t*)(ws + WS_MEMVT), (const float*)(ws + WS_MSS)}; const Unit v{u.pm - TILE_MK, u.pn - TILE_MK}; KV(acc, v, wr, wc, fr, fq); }
    }
};

template <class Epi, class Sched, bool ALIGN_EPI = false, bool SP2 = false, bool FP8 = false, bool ABLK = false>
__device__ __forceinline__ void gemm_phase(PG8_LAS unsigned char* lds, const Gemm g, const Sched& S, const Epi& E) {
    int tid_ = threadIdx.x; asm volatile("" : "+v"(tid_));
    const int tid = tid_, wid = __builtin_amdgcn_readfirstlane(tid >> 6), lane = tid & 63, wr = wid >> 2, wc = wid & 3, fr = lane & 15, fq = lane >> 4;
    const int K = g.K, nt = K / BK;
    unsigned voffA[2], voffB[2];
#pragma unroll
    for (int i = 0; i < 2; ++i) { int R, C; stage_rc(tid * 16 + i * 8192, R, C); const int Rb = Epi::PERM ? ((R & ~31) + perm32(R & 31)) : R;
        voffA[i] = ABLK ? (unsigned)(((((R >> 6) * 4 + (C >> 4)) * 8 + ((R >> 4) & 3)) * 64 + ((C >> 3) & 1) * 32 + (R & 15) * 2) * 8) : (unsigned)(R * K + C) * 2u; voffB[i] = (unsigned)(Rb * K + C) * 2u; }
    const size_t kstep = (size_t)(BK * 2);
    const size_t hstep = (size_t)HALF * K * 2;
    const size_t kstepA = ABLK ? (size_t)32768 : kstep, hstepA = ABLK ? (size_t)2048 : hstep;
    const size_t tstep = 2 * hstep;
    const unsigned ldsw = (unsigned)wid * 1024u;
    const int aoff = lds_byte(wr * 64 + fr, fq * 8), boff = lds_byte(wc * 32 + fr, fq * 8);
#define PG8_SA(b, h) (((b) * 2 + (h)) * HTB)
#define PG8_SB(b, h) ((4 + (b) * 2 + (h)) * HTB)
#define PG8_STAGE(bufoff, gbase, voff) do { _Pragma("unroll") for (int _i = 0; _i < 2; ++_i) \
        __builtin_amdgcn_global_load_lds((const unsigned*)((const char*)(gbase) + (voff)[_i]), (PG8_LAS unsigned*)(lds + (bufoff) + ldsw + _i * 8192), 16, 0, 0); } while (0)
#define PG8_LDA(dst, b, h) do { _Pragma("unroll") for (int m = 0; m < 4; ++m) _Pragma("unroll") for (int k = 0; k < 2; ++k) dst[m][k] = *(const PG8_LAS bf16x8*)(lds + PG8_SA(b, h) + aoff + m * 2048 + k * 1024); } while (0)
#define PG8_LDB(dst, b, h) do { _Pragma("unroll") for (int n = 0; n < 2; ++n) _Pragma("unroll") for (int k = 0; k < 2; ++k) dst[n][k] = *(const PG8_LAS bf16x8*)(lds + PG8_SB(b, h) + boff + n * 2048 + k * 1024); } while (0)
#define PG8_MMA(ai, bj, At, Bt) do { __builtin_amdgcn_s_setprio(1); _Pragma("unroll") for (int m = 0; m < 4; ++m) _Pragma("unroll") for (int n = 0; n < 2; ++n) { \
        if constexpr (FP8) { typedef int v4i_ __attribute__((ext_vector_type(4))); typedef int v8i_ __attribute__((ext_vector_type(8))); \
            const v8i_ b8 = __builtin_shufflevector(__builtin_bit_cast(v4i_, Bt[n][0]), __builtin_bit_cast(v4i_, Bt[n][1]), 0, 1, 2, 3, 4, 5, 6, 7), a8 = __builtin_shufflevector(__builtin_bit_cast(v4i_, At[m][0]), __builtin_bit_cast(v4i_, At[m][1]), 0, 1, 2, 3, 4, 5, 6, 7); \
            asm volatile("v_mfma_scale_f32_16x16x128_f8f6f4 %0, %1, %2, %0, %3, %3 op_sel_hi:[0,0,0]" : "+v"(acc[ai][bj][m][n]) : "v"(b8), "v"(a8), "v"(0x7f7f7f7f)); }   \
        else { _Pragma("unroll") for (int k = 0; k < 2; ++k) acc[ai][bj][m][n] = __builtin_amdgcn_mfma_f32_16x16x32_bf16(Bt[n][k], At[m][k], acc[ai][bj][m][n], 0, 0, 0); } } \
        __builtin_amdgcn_s_setprio(0); } while (0)
#define PG8_WAIT_V(n) asm volatile("s_waitcnt vmcnt(" #n ")" ::: "memory")
#define PG8_WAIT_V8_UNLESS_FIRST(t) asm volatile("s_cmp_eq_u32 %0, 0\n\ts_cbranch_scc1 .Lpg8skip%=\n\ts_waitcnt vmcnt(8)\n.Lpg8skip%=:" :: "s"(t) : "scc", "memory")
#define PG8_WAIT_L(n) asm volatile("s_waitcnt lgkmcnt(" #n ")" ::: "memory")
#define PG8_BAR __builtin_amdgcn_s_barrier()
#define PG8_SCHED __builtin_amdgcn_sched_barrier(0)
    Unit cur, nxt; int ui = 0;
    if (!S.next(0, cur)) return;
    f32x4 acc[2][2][4][2];
#pragma unroll
    for (int a = 0; a < 2; ++a)
#pragma unroll
        for (int b = 0; b < 2; ++b)
#pragma unroll
            for (int m = 0; m < 4; ++m)
#pragma unroll
                for (int n = 0; n < 2; ++n) acc[a][b][m][n] = (f32x4){0.f, 0.f, 0.f, 0.f};
    bf16x8 At[4][2], B0[2][2], B1[2][2];
    const char* cA = (const char*)g.A + (size_t)cur.pm * tstep; const char* cB = (const char*)g.Bt + (size_t)cur.pn * tstep;
    S.a_ready(cur);
    if constexpr (SP2) {
        PG8_STAGE(PG8_SB(0, 0), cB, voffB); PG8_STAGE(PG8_SB(0, 1), cB + hstep, voffB); PG8_STAGE(PG8_SA(0, 0), cA, voffA); PG8_STAGE(PG8_SA(0, 1), cA + hstepA, voffA);
        if (wr == 1) PG8_BAR;
        PG8_WAIT_V(2); PG8_BAR;
        PG8_STAGE(PG8_SB(1, 0), cB + kstep, voffB); PG8_STAGE(PG8_SA(1, 0), cA + kstepA, voffA); PG8_STAGE(PG8_SB(1, 1), cB + hstep + kstep, voffB);
        PG8_WAIT_V(0); PG8_BAR;
    } else {
        PG8_STAGE(PG8_SB(0, 0), cB, voffB); PG8_STAGE(PG8_SA(0, 0), cA, voffA); PG8_STAGE(PG8_SB(0, 1), cB + hstep, voffB); PG8_STAGE(PG8_SA(0, 1), cA + hstepA, voffA);
        if (wr == 1) PG8_BAR;
        PG8_WAIT_V(4); PG8_BAR;
        PG8_STAGE(PG8_SB(1, 0), cB + kstep, voffB); PG8_STAGE(PG8_SA(1, 0), cA + kstepA, voffA); PG8_STAGE(PG8_SB(1, 1), cB + hstep + kstep, voffB);
        PG8_WAIT_V(6); PG8_BAR;
    }
    for (;;) {
        const bool has_next = S.next(ui + 1, nxt);
        const char* nA = has_next ? (const char*)g.A + (size_t)nxt.pm * tstep : cA; const char* nB = has_next ? (const char*)g.Bt + (size_t)nxt.pn * tstep : cB;
        for (int t = 0; t < nt; t += 2) {
            const bool last = (t == nt - 2);
            const char* a1 = cA + (size_t)(t + 1) * kstepA;
            const char* a2 = last ? nA : cA + (size_t)(t + 2) * kstepA; const char* b2 = last ? nB : cB + (size_t)(t + 2) * kstep;
            const char* a3 = a2 + kstepA; const char* b3 = b2 + kstep;
            if (last && has_next) S.a_ready(nxt);
            if constexpr (SP2) {
            PG8_LDB(B0, 0, 0); PG8_LDB(B1, 0, 1); PG8_SCHED; PG8_LDA(At, 0, 0); PG8_STAGE(PG8_SA(1, 1), a1 + hstepA, voffA);
            PG8_WAIT_V8_UNLESS_FIRST(t); PG8_WAIT_L(0); PG8_BAR; PG8_MMA(0, 0, At, B0); PG8_MMA(0, 1, At, B1); PG8_BAR; PG8_SCHED;
            PG8_LDA(At, 0, 1); PG8_STAGE(PG8_SB(0, 0), b2, voffB); PG8_STAGE(PG8_SB(0, 1), b2 + hstep, voffB); PG8_STAGE(PG8_SA(0, 0), a2, voffA);
            PG8_WAIT_V8_UNLESS_FIRST(t); PG8_WAIT_L(0); PG8_BAR; PG8_MMA(1, 0, At, B0); PG8_MMA(1, 1, At, B1); PG8_BAR; PG8_SCHED;
            PG8_LDB(B0, 1, 0); PG8_LDB(B1, 1, 1); PG8_SCHED; PG8_LDA(At, 1, 0); PG8_STAGE(PG8_SA(0, 1), a2 + hstepA, voffA);
            PG8_WAIT_V(8); PG8_WAIT_L(0); PG8_BAR; PG8_MMA(0, 0, At, B0); PG8_MMA(0, 1, At, B1); PG8_BAR; PG8_SCHED;
            PG8_LDA(At, 1, 1); PG8_STAGE(PG8_SB(1, 0), b3, voffB); PG8_STAGE(PG8_SB(1, 1), b3 + hstep, voffB); PG8_STAGE(PG8_SA(1, 0), a3, voffA);
            PG8_WAIT_V(8); PG8_WAIT_L(0); PG8_BAR; PG8_MMA(1, 0, At, B0); PG8_MMA(1, 1, At, B1); PG8_BAR; PG8_SCHED;
            } else {
            PG8_LDB(B0, 0, 0); PG8_SCHED; PG8_LDA(At, 0, 0); PG8_STAGE(PG8_SA(1, 1), a1 + hstepA, voffA);
            PG8_WAIT_L(8); PG8_BAR; PG8_WAIT_L(0); PG8_MMA(0, 0, At, B0); PG8_BAR; PG8_SCHED;
            PG8_LDB(B1, 0, 1); PG8_STAGE(PG8_SB(0, 0), b2, voffB);
            PG8_BAR; PG8_WAIT_L(0); PG8_MMA(0, 1, At, B1); PG8_BAR;
            PG8_LDA(At, 0, 1); PG8_STAGE(PG8_SA(0, 0), a2, voffA);
            PG8_BAR; PG8_WAIT_L(0); PG8_MMA(1, 0, At, B0); PG8_BAR; PG8_SCHED;
            PG8_STAGE(PG8_SB(0, 1), b2 + hstep, voffB);
            PG8_WAIT_V(6); PG8_BAR; PG8_MMA(1, 1, At, B1); PG8_BAR;
            PG8_LDB(B0, 1, 0); PG8_SCHED; PG8_LDA(At, 1, 0); PG8_STAGE(PG8_SA(0, 1), a2 + hstepA, voffA);
            PG8_WAIT_L(8); PG8_BAR; PG8_WAIT_L(0); PG8_MMA(0, 0, At, B0); PG8_BAR; PG8_SCHED;
            PG8_LDB(B1, 1, 1); PG8_STAGE(PG8_SB(1, 0), b3, voffB);
            PG8_BAR; PG8_WAIT_L(0); PG8_MMA(0, 1, At, B1); PG8_BAR;
            PG8_LDA(At, 1, 1); PG8_STAGE(PG8_SA(1, 0), a3, voffA);
            PG8_BAR; PG8_WAIT_L(0); PG8_MMA(1, 0, At, B0); PG8_BAR; PG8_SCHED;
            PG8_STAGE(PG8_SB(1, 1), b3 + hstep, voffB);
            PG8_WAIT_V(6); PG8_BAR; PG8_MMA(1, 1, At, B1); PG8_BAR;
            }
        }
        if constexpr (SP2) PG8_WAIT_V(0);
        if constexpr (FP8) asm volatile("s_nop 15\n\ts_nop 15" ::: "memory");
        if constexpr (ALIGN_EPI) { if (wr == 0) PG8_BAR; }
        if constexpr (!Epi::AFTER_DRAIN) { E(acc, cur, wr, wc, fr, fq); S.done(cur); }
        if (!has_next) break;
#pragma unroll
        for (int a = 0; a < 2; ++a)
#pragma unroll
            for (int b = 0; b < 2; ++b)
#pragma unroll
                for (int m = 0; m < 4; ++m)
#pragma unroll
                    for (int n = 0; n < 2; ++n) acc[a][b][m][n] = (f32x4){0.f, 0.f, 0.f, 0.f};
        cur = nxt; cA = nA; cB = nB; ++ui;
        if constexpr (ALIGN_EPI) { if (wr == 1) PG8_BAR; }
    }
    PG8_WAIT_V(0);
    if constexpr (!ALIGN_EPI) { if (wr == 0) PG8_BAR; }
    PG8_BAR;
    if constexpr (Epi::AFTER_DRAIN) { E.fused(acc, cur, wr, wc, fr, fq, lds, wid, lane); S.done(cur); }
#undef PG8_SA
#undef PG8_SB
#undef PG8_STAGE
#undef PG8_LDA
#undef PG8_LDB
#undef PG8_MMA
#undef PG8_WAIT_V
#undef PG8_WAIT_L
#undef PG8_WAIT_V8_UNLESS_FIRST
#undef PG8_BAR
#undef PG8_SCHED
}
}
#define GAS __attribute__((address_space(1)))
#define LAS __attribute__((address_space(3)))
typedef unsigned short bf16;
typedef unsigned v4u __attribute__((ext_vector_type(4)));
typedef float f32x4 __attribute__((ext_vector_type(4)));
typedef short bf16x8 __attribute__((ext_vector_type(8)));
typedef GAS unsigned gu32;
typedef GAS unsigned long long gu64;
#define RLX_AGENT __ATOMIC_RELAXED, __HIP_MEMORY_SCOPE_AGENT
#define LDS_WAIT() asm volatile("s_waitcnt lgkmcnt(0)" ::: "memory")
#define VM_WAIT() asm volatile("s_waitcnt vmcnt(0)" ::: "memory")
__device__ __forceinline__ unsigned long long rt() { return __builtin_amdgcn_s_memrealtime(); }
__device__ __forceinline__ unsigned f2bf(float f) { unsigned u = __builtin_bit_cast(unsigned, f); return (u + 0x7fffu + ((u >> 16) & 1u)) >> 16; }
__device__ __forceinline__ unsigned pk2(float lo, float hi) { return f2bf(lo) | (f2bf(hi) << 16); }

#define XB_TMO      128
#define XB_XCNT(j)  (256  + 64 * (j))
#define XB_XSUB(j)  (1280 + 64 * (j))
#define XB_XGEN(j)  (2304 + 64 * (j))
#define XB_TOP      3328
#define XB_TOPGEN   3392
#define XCD_BAR_WORDS 3456
#define XB_SPIN_CAP (1u << 18)

__device__ __forceinline__ unsigned xb_ld(unsigned* p)              { return __hip_atomic_load(p, __ATOMIC_RELAXED, __HIP_MEMORY_SCOPE_AGENT); }
__device__ __forceinline__ unsigned xb_add(unsigned* p, unsigned v) { return __hip_atomic_fetch_add(p, v, __ATOMIC_RELAXED, __HIP_MEMORY_SCOPE_AGENT); }
__device__ __forceinline__ unsigned xb_xcc_id() { return (unsigned)__builtin_amdgcn_s_getreg((3 << 11) | 20) & 0xFu; }
#define XB_SPIN(cond, bar) do { unsigned _sp = 0; while (cond) { __builtin_amdgcn_s_sleep(1); \
    if ((++_sp & 255u) == 0u) { if (xb_ld(&(bar)[XB_TMO])) break; if (_sp > XB_SPIN_CAP) { atomicAdd(&(bar)[XB_TMO], 1u); break; } } } } while (0)

struct XcdBarrier {
    unsigned* bar; unsigned x;
    volatile LAS unsigned* st;
};

__device__ __forceinline__ XcdBarrier xcd_barrier_post(unsigned* bar, volatile LAS unsigned* st) {
    XcdBarrier b; b.bar = bar; b.x = xb_xcc_id(); b.st = st;
    if (threadIdx.x == 0) (void)xb_add(&bar[XB_XCNT(b.x)], 1u);
    return b;
}
__device__ __forceinline__ void xcd_barrier_complete(unsigned* bar, unsigned x, unsigned& nloc, unsigned& nx) {
    const unsigned G = gridDim.x * gridDim.y * gridDim.z;
    unsigned sum, cnt, mine, sp = 0u;
    for (;;) {
        sum = 0u; cnt = 0u; mine = 0u;
#pragma unroll
        for (unsigned j = 0; j < 16; ++j) { const unsigned c = xb_ld(&bar[XB_XCNT(j)]); sum += c; cnt += (c > 0u) ? 1u : 0u; mine = (j == x) ? c : mine; }
        if (sum == G) break;
        __builtin_amdgcn_s_sleep(1);
        if ((++sp & 255u) == 0u) { if (xb_ld(&bar[XB_TMO])) break; if (sp > XB_SPIN_CAP) { atomicAdd(&bar[XB_TMO], 1u); break; } }
    }
    nloc = mine > 0u ? mine : 1u; nx = cnt > 0u ? cnt : 1u;
}

__device__ __forceinline__ void xcd_barrier(const XcdBarrier& b) {
    asm volatile("s_waitcnt vmcnt(0)" ::: "memory");
    __syncthreads();
    if (threadIdx.x == 0) {
        unsigned* bar = b.bar;
        __builtin_amdgcn_s_waitcnt(0);
        unsigned nloc = b.st[0], nx = b.st[1];
        if (nloc == 0u) { xcd_barrier_complete(bar, b.x, nloc, nx); b.st[0] = nloc; b.st[1] = nx; }
        const unsigned old = xb_add(&bar[XB_XSUB(b.x)], 1u);
        const unsigned gen = old / nloc;
        if (old + 1u == (gen + 1u) * nloc) {
            __builtin_amdgcn_fence(__ATOMIC_RELEASE, "agent");
            asm volatile("s_waitcnt vmcnt(0)" ::: "memory");
            const unsigned og = xb_add(&bar[XB_TOP], 1u);
            const unsigned tg = og / nx;
            if (og + 1u == (tg + 1u) * nx) xb_add(&bar[XB_TOPGEN], 1u);
            else XB_SPIN(xb_ld(&bar[XB_TOPGEN]) == tg, bar);
            __builtin_amdgcn_fence(__ATOMIC_ACQUIRE, "agent");
            xb_add(&bar[XB_XGEN(b.x)], 1u);
            asm volatile("s_waitcnt vmcnt(0)" ::: "memory");
        } else {
            XB_SPIN(xb_ld(&bar[XB_XGEN(b.x)]) == gen, bar);
            __builtin_amdgcn_fence(__ATOMIC_ACQUIRE, "agent");
            asm volatile("s_waitcnt vmcnt(0)" ::: "memory");
        }
    }
    __syncthreads();
}
struct Frame {
    LAS unsigned char* lds; volatile LAS unsigned* MISC; gu32* ctl;
    int tid, lane, wave, vcu, G;
    unsigned char* ws;
};
__device__ __forceinline__ float wave_sum(float v) {
#pragma unroll
    for (int o = 1; o < 64; o <<= 1) v += __shfl_xor(v, o);
    return v;
}
__device__ __forceinline__ float wave_max(float v) {
#pragma unroll
    for (int o = 1; o < 64; o <<= 1) v = fmaxf(v, __shfl_xor(v, o));
    return v;
}
__device__ __forceinline__ float bf2f_lo(unsigned w) { return __uint_as_float(w << 16); }
__device__ __forceinline__ float bf2f_hi(unsigned w) { return __uint_as_float(w & 0xffff0000u); }
__device__ __forceinline__ float bf2f(bf16 h) { return __uint_as_float((unsigned)h << 16); }

__device__ __forceinline__ void tr_item(const float* W, int Ns, const float* gain, bf16* WTrow, int K, int sc0, int nvalid, int k0, LAS float* scr, int lane) {
    const int col = lane & 31;
    float wv_[32];
#pragma unroll
    for (int i = 0; i < 32; ++i) { const int kk = 2 * i + (lane >> 5); wv_[i] = (col < nvalid) ? W[(size_t)(k0 + kk) * Ns + sc0 + col] : 0.f; }
#pragma unroll
    for (int i = 0; i < 32; ++i) { const int kk = 2 * i + (lane >> 5); float v = wv_[i]; if (gain) v *= gain[k0 + kk]; scr[kk * 33 + col] = v; }
    LDS_WAIT(); asm volatile("" ::: "memory");
    const int c = lane & 7;
#pragma unroll
    for (int j = 0; j < 4; ++j) { const int n = (lane >> 3) + 8 * j; const LAS float* s = scr + (8 * c) * 33 + n;
        v4u o; o.x = pk2(s[0 * 33], s[1 * 33]); o.y = pk2(s[2 * 33], s[3 * 33]); o.z = pk2(s[4 * 33], s[5 * 33]); o.w = pk2(s[6 * 33], s[7 * 33]);
        *(GAS v4u*)(WTrow + (size_t)n * K + 8 * c) = o; }
    LDS_WAIT(); asm volatile("" ::: "memory");
}
__device__ __forceinline__ void tr_item8(const float* W, int Ns, unsigned char* WTrow, int K, int sc0, int k0, LAS float* scr, int lane, const float* gain = nullptr) {
    const int col = lane & 31;
    float wv_[32];
#pragma unroll
    for (int i = 0; i < 32; ++i) { const int kk = 2 * i + (lane >> 5); wv_[i] = W[(size_t)(k0 + kk) * Ns + sc0 + col]; }
#pragma unroll
    for (int i = 0; i < 32; ++i) { const int kk = 2 * i + (lane >> 5); float v = wv_[i] * 64.f; if (gain) v *= gain[k0 + kk]; scr[kk * 33 + col] = v; }
    LDS_WAIT(); asm volatile("" ::: "memory");
    const int n = lane >> 1, hf = lane & 1;
#pragma unroll
    for (int q = 0; q < 2; ++q) { const LAS float* sp = scr + (32 * hf + 16 * q) * 33 + n; v4u o;
#pragma unroll
        for (int d = 0; d < 4; ++d) { unsigned w = 0u; w = __builtin_amdgcn_cvt_pk_fp8_f32(sp[(4 * d) * 33], sp[(4 * d + 1) * 33], w, false); w = __builtin_amdgcn_cvt_pk_fp8_f32(sp[(4 * d + 2) * 33], sp[(4 * d + 3) * 33], w, true); o[d] = w; }
        *(GAS v4u*)(WTrow + (size_t)n * K + 32 * hf + 16 * q) = o; }
    LDS_WAIT(); asm volatile("" ::: "memory");
}
__device__ __forceinline__ void plain_item8(const float* W, int Ns, int K, unsigned char* WT, int r, LAS float* scr, int lane, const float* gain = nullptr) {
    const int nkb = K / 64, group = r / nkb, kb = r % nkb;
    tr_item8(W, Ns, WT + (size_t)(group * 32) * K + kb * 64, K, group * 32, kb * 64, scr, lane, gain);
}
__device__ __forceinline__ int win_src_col(int j, int& nvalid) {
    const int tile = j >> 3, half = (j >> 2) & 1, q4 = j & 3; nvalid = 32;
    if (tile < 2) return (half ? 256 : 0) + 128 * tile + 32 * q4;
    if (tile < 4) return (half ? 1024 : 768) + 128 * (tile - 2) + 32 * q4;
    if (tile == 4) return 512 + 128 * half + 32 * q4;
    if (tile < 7) return 1280 + ((tile - 5) * 4 + q4) * 64 + 32 * half;
    if (tile < 9) return 1792 + ((tile - 7) * 4 + q4) * 64 + 32 * half;
    if (tile < 11) return 2304 + (tile - 9) * 256 + 128 * half + 32 * q4;
    if (tile == 11) return 2816 + q4 * 64 + 32 * half;
    if (q4 == 0) return 3072 + 32 * half;
    if (q4 == 1 && half == 1) { nvalid = 4; return 3136; }
    nvalid = 0; return 0;
}
__device__ __forceinline__ void gu_item(const float* wg, const float* wu, const float* gain, bf16* WT, int r, LAS float* scr, int lane) {
    const int group = r >> 4, kb = r & 15, tile = group >> 3, g8 = group & 7;
    tr_item(g8 < 4 ? wg : wu, FF, gain, WT + (size_t)(group * 32) * D + kb * 64, D, 128 * tile + 32 * (g8 & 3), 32, kb * 64, scr, lane);
}
__device__ __forceinline__ void plain_item(const float* W, int Ns, int K, const float* gain, bf16* WT, int r, LAS float* scr, int lane) {
    const int nkb = K / 64, group = r / nkb, kb = r % nkb;
    tr_item(W, Ns, gain, WT + (size_t)(group * 32) * K + kb * 64, K, group * 32, 32, kb * 64, scr, lane);
}
struct Args { const void* in[25]; float* out; unsigned char* ws; float invf[32]; int ph_lo, ph_hi; };
typedef const __attribute__((address_space(4))) Args* KArgs;
#define INF(A, k) ((const float*)(A)->in[k])
enum { I_X = 0, I_MEM, I_POS, I_FFN1_NORM, I_FFN1_WG, I_FFN1_WU, I_FFN1_WD, I_MIX_NORM, I_W_IN, I_CONF_DW, I_CONF_DW_B, I_CONF_LN_G, I_CONF_LN_B, I_SC_DW, I_W_OUT, I_XA_NORM, I_MEM_NORM, I_XA_WQ, I_XA_WKV, I_XA_WO,
       I_FFN2_NORM, I_FFN2_WG, I_FFN2_WU, I_FFN2_WD, I_FINAL_NORM };
constexpr int IT_GU = 2816, IT_D = 1408, IT_IN = 1664, IT_SQ = 512, IT_KV = 1024, IT_LAYER = 2 * IT_GU + 2 * IT_D + IT_IN + 3 * IT_SQ + IT_KV;
__device__ __forceinline__ void p0_prologue(Frame& F, KArgs A) {
    LAS float* scr = (LAS float*)(F.lds + RING_OFF + F.wave * 16384);
    const int gw = F.vcu * NWAVES + F.wave, NGW = F.G * NWAVES, lane = F.lane;
    unsigned char* ws = F.ws;
    for (int it = gw; it < DEPTH * IT_LAYER; it += NGW) {
        const int l = it / IT_LAYER; int r = it % IT_LAYER;
        unsigned char* wl = ws + WS_W + (size_t)l * W_LAYER;
        if (r < IT_GU) { gu_item(INF(A, I_FFN1_WG) + (size_t)l * D * FF, INF(A, I_FFN1_WU) + (size_t)l * D * FF, INF(A, I_FFN1_NORM) + l * D, (bf16*)(wl + WO_GU1), r, scr, lane); continue; } r -= IT_GU;
        if (r < IT_D) { plain_item8(INF(A, I_FFN1_WD) + (size_t)l * FF * D, D, FF, wl + WO_D1, r, scr, lane); continue; } r -= IT_D;
        if (r < IT_IN) { const int group = r >> 4, kb = r & 15; int nv; const int sc = win_src_col(group, nv);
            tr_item(INF(A, I_W_IN) + (size_t)l * D * NIN, NIN, INF(A, I_MIX_NORM) + l * D, (bf16*)(wl + WO_IN) + (size_t)(group * 32) * D + kb * 64, D, sc, nv, kb * 64, scr, lane); continue; } r -= IT_IN;
        if (r < IT_SQ) { plain_item(INF(A, I_W_OUT) + (size_t)l * D * D, D, D, nullptr, (bf16*)(wl + WO_OUT), r, scr, lane); continue; } r -= IT_SQ;
        if (r < IT_SQ) { plain_item8(INF(A, I_XA_WQ) + (size_t)l * D * D, D, D, wl + WO_Q, r, scr, lane, INF(A, I_XA_NORM) + l * D); continue; } r -= IT_SQ;
        if (r < IT_SQ) { plain_item8(INF(A, I_XA_WO) + (size_t)l * D * D, D, D, wl + WO_O, r, scr, lane); continue; } r -= IT_SQ;
        if (r < IT_KV) { plain_item(INF(A, I_XA_WKV) + (size_t)l * D * 2 * D, 2 * D, D, INF(A, I_MEM_NORM) + l * D, (bf16*)(ws + WS_MK) + (size_t)(1024 + 2048 * l) * D, r, scr, lane); continue; } r -= IT_KV;
        if (r < IT_GU) { gu_item(INF(A, I_FFN2_WG) + (size_t)l * D * FF, INF(A, I_FFN2_WU) + (size_t)l * D * FF, INF(A, I_FFN2_NORM) + l * D, (bf16*)(wl + WO_GU2), r, scr, lane); continue; } r -= IT_GU;
        plain_item8(INF(A, I_FFN2_WD) + (size_t)l * FF * D, D, FF, wl + WO_D2, r, scr, lane);
    }
    for (int m = gw; m < M + 1024; m += NGW) {
        const bool ismem = m >= M; const int row = ismem ? m - M : m;
        const GAS f32x4* xr = (const GAS f32x4*)((ismem ? INF(A, I_MEM) : INF(A, I_X)) + (size_t)row * D) + lane;
        GAS unsigned long long* o8 = (GAS unsigned long long*)((bf16*)(ws + (ismem ? WS_MK : WS_X)) + (size_t)row * D) + lane;
        float s = 0.f;
#pragma unroll
        for (int j = 0; j < 4; ++j) { const f32x4 v = xr[64 * j]; const unsigned a = pk2(v.x, v.y), b = pk2(v.z, v.w); o8[64 * j] = (unsigned long long)a | ((unsigned long long)b << 32);
            s += (bf2f_lo(a) * bf2f_lo(a) + bf2f_hi(a) * bf2f_hi(a)) + (bf2f_lo(b) * bf2f_lo(b) + bf2f_hi(b) * bf2f_hi(b)); }
        s = wave_sum(s);
        if (ismem) { if (lane == 0) ((float*)(ws + WS_MSS))[row] = s; } else if (lane < 16) ((float*)(ws + WS_SS))[(size_t)row * 16 + lane] = lane == 0 ? s : 0.f;
    }
    for (int e = (F.vcu * NWAVES * 64 + F.tid); e < M * 32; e += F.G * NWAVES * 64) {
        const int row = e >> 5, i = e & 31;
        const float ang = __fmul_rn((float)((const int*)A->in[I_POS])[row], A->invf[i]);
        const double x = (double)ang, n = __builtin_rint(x * 0.15915494309189535), r = x - n * 6.283185307179586, r2 = r * r;
        double sp = -1.0 / 25852016738884976640000.0, cp = 1.0 / 620448401733239439360000.0;
        sp = sp * r2 + 1.0 / 51090942171709440000.0;  cp = cp * r2 - 1.0 / 1124000727777607680000.0;
        sp = sp * r2 - 1.0 / 121645100408832000.0;    cp = cp * r2 + 1.0 / 2432902008176640000.0;
        sp = sp * r2 + 1.0 / 355687428096000.0;       cp = cp * r2 - 1.0 / 6402373705728000.0;
        sp = sp * r2 - 1.0 / 1307674368000.0;         cp = cp * r2 + 1.0 / 20922789888000.0;
        sp = sp * r2 + 1.0 / 6227020800.0;            cp = cp * r2 - 1.0 / 87178291200.0;
        sp = sp * r2 - 1.0 / 39916800.0;              cp = cp * r2 + 1.0 / 479001600.0;
        sp = sp * r2 + 1.0 / 362880.0;                cp = cp * r2 - 1.0 / 3628800.0;
        sp = sp * r2 - 1.0 / 5040.0;                  cp = cp * r2 + 1.0 / 40320.0;
        sp = sp * r2 + 1.0 / 120.0;                   cp = cp * r2 - 1.0 / 720.0;
        sp = sp * r2 - 1.0 / 6.0;                     cp = cp * r2 + 1.0 / 24.0;
        sp = sp * r2 + 1.0;                           cp = cp * r2 - 0.5;
        cp = cp * r2 + 1.0;
        ((float*)(ws + WS_COS))[e] = (float)cp; ((float*)(ws + WS_SIN))[e] = (float)(sp * r);
    }
}

__device__ __forceinline__ void conv_a_unit(Frame& F, const bf16* HG, bf16* MIX, const float* dw, const float* dwb, const float* lng, const float* lnb, int unit) {
    const int tid = F.tid, lane = F.lane, wave = F.wave;
    const int row0 = unit * 64, t0 = row0 % SEQ;
    LAS unsigned short* hb = (LAS unsigned short*)(F.lds + RING_OFF); LAS float* yb = (LAS float*)(F.lds + RING_OFF + 49152);
    for (int ch = tid; ch < 94 * 32; ch += NWAVES * 64) { const int rr = ch >> 5, c16 = ch & 31; const int t = t0 - 30 + rr;
        v4u v = (v4u){0u, 0u, 0u, 0u}; if (t >= 0) v = *(const GAS v4u*)(HG + (size_t)(row0 - 30 + rr) * 256 + c16 * 8);
        *(LAS v4u*)(hb + rr * 256 + c16 * 8) = v; }
    __syncthreads();
    { const int c = tid & 255, half = tid >> 8;
      float w[31];
#pragma unroll
      for (int j = 0; j < 31; ++j) w[j] = dw[j * 256 + c];
      const float bias = dwb[c];
      float hv[62];
#pragma unroll
      for (int k = 0; k < 62; ++k) hv[k] = bf2f(hb[(32 * half + k) * 256 + c]);
#pragma unroll
      for (int i = 0; i < 32; ++i) { float y = bias;
#pragma unroll
          for (int j = 0; j < 31; ++j) y += w[j] * hv[i + j];
          yb[(32 * half + i) * 256 + c] = y; } }
    __syncthreads();
    { const f32x4 g = *(const GAS f32x4*)(lng + lane * 4), bb = *(const GAS f32x4*)(lnb + lane * 4);
      for (int tt = wave; tt < 64; tt += NWAVES) { const f32x4 y = *(LAS f32x4*)(yb + tt * 256 + lane * 4);
          const float mean = wave_sum((y.x + y.y) + (y.z + y.w)) * (1.f / 256.f); const f32x4 d = y - mean;
          const float var = wave_sum((d.x * d.x + d.y * d.y) + (d.z * d.z + d.w * d.w)) * (1.f / 256.f); const float rs = 1.0f / sqrtf(var + 1e-5f);
          f32x4 o = d * rs * g + bb;
#pragma unroll
          for (int j = 0; j < 4; ++j) o[j] = o[j] * pg8::sigm(o[j]);
          *(GAS unsigned long long*)(MIX + (size_t)(row0 + tt) * 1024 + lane * 4) = (unsigned long long)pk2(o.x, o.y) | ((unsigned long long)pk2(o.z, o.w) << 32); } }
    __syncthreads();
}
__device__ __forceinline__ void conv_b_all(Frame& F, const bf16* U, const bf16* BG, bf16* MIX, const float* sw) {
    for (int it = F.vcu * NWAVES * 64 + F.tid; it < M * 32; it += F.G * NWAVES * 64) { const int row = it >> 5, c8 = (it & 31) * 8, t = row % SEQ;
        const v4u z = (v4u){0u, 0u, 0u, 0u};
        const v4u u0 = *(const GAS v4u*)(U + (size_t)row * 256 + c8), u1 = t >= 1 ? *(const GAS v4u*)(U + (size_t)(row - 1) * 256 + c8) : z, u2 = t >= 2 ? *(const GAS v4u*)(U + (size_t)(row - 2) * 256 + c8) : z;
        const v4u g = *(const GAS v4u*)(BG + (size_t)row * 256 + c8);
        float o[8];
#pragma unroll
        for (int k = 0; k < 4; ++k) { const int c = c8 + 2 * k;
            o[2 * k]     = bf2f_lo(g[k]) * (sw[c] * bf2f_lo(u2[k]) + sw[256 + c] * bf2f_lo(u1[k]) + sw[512 + c] * bf2f_lo(u0[k]));
            o[2 * k + 1] = bf2f_hi(g[k]) * (sw[c + 1] * bf2f_hi(u2[k]) + sw[256 + c + 1] * bf2f_hi(u1[k]) + sw[512 + c + 1] * bf2f_hi(u0[k])); }
        v4u w; w.x = pk2(o[0], o[1]); w.y = pk2(o[2], o[3]); w.z = pk2(o[4], o[5]); w.w = pk2(o[6], o[7]);
        *(GAS v4u*)(MIX + (size_t)row * 1024 + 256 + c8) = w; }
}
__device__ __forceinline__ unsigned mono32(float f) { const unsigned u = __float_as_uint(f); return (u & 0x80000000u) ? ~u : (u | 0x80000000u); }
template <bool FROM_MASK> __device__ __forceinline__ void dsa_naive_query(Frame& F, const bf16* Q, const bf16* K, const bf16* V, const bf16* QI, const bf16* KI, const float* WI, const unsigned long long* MASK, bf16* MIX, int row) {
    const int tid = F.tid, lane = F.lane, wave = F.wave;
    const int b = row / SEQ, t = row % SEQ, n = t + 1;
    LAS unsigned long long* key64 = (LAS unsigned long long*)(F.lds + RING_OFF);
    LAS float* qi = (LAS float*)(F.lds + RING_OFF + 65536); LAS float* qh = (LAS float*)(F.lds + RING_OFF + 66560); LAS float* pl = (LAS float*)(F.lds + RING_OFF + 68608);
    LAS int* sel = (LAS int*)(F.lds + RING_OFF + 76800); LAS unsigned* cnt = (LAS unsigned*)(F.lds + RING_OFF + 77824);
    if (tid < 256) qi[tid] = bf2f(QI[(size_t)row * 256 + tid]);
    qh[tid] = bf2f(Q[(size_t)row * 512 + tid]);
    if (tid < 64) cnt[tid] = 0u;
    const f32x4 wv = *(const GAS f32x4*)(WI + (size_t)row * 4);
    __syncthreads();
    unsigned em = 0u;
    if constexpr (FROM_MASK) {
#pragma unroll
        for (int j = 0; j < 16; ++j) { const int s = tid + 512 * j;
            if (s < n) { const int kb = s >> 5, ko = s & 31, r = (ko & 3) + 4 * (ko >> 3), hh = (ko >> 2) & 1; const unsigned long long w = MASK[(((size_t)b * 256 + (t >> 5)) * 256 + kb) * 16 + r]; em |= (unsigned)((w >> (hh * 32 + (t & 31))) & 1ull) << j; } }
    } else {
    unsigned long long e[16]; unsigned long long T = 0ull;
#pragma unroll
    for (int j = 0; j < 16; ++j) { const int s = tid + 512 * j; e[j] = 0ull;
        if (s < n) { const GAS v4u* kr = (const GAS v4u*)(KI + (size_t)(b * SEQ + s) * 64); float kf[64];
#pragma unroll
            for (int c = 0; c < 8; ++c) { const v4u v = kr[c];
#pragma unroll
                for (int k = 0; k < 4; ++k) { kf[c * 8 + 2 * k] = bf2f_lo(v[k]); kf[c * 8 + 2 * k + 1] = bf2f_hi(v[k]); } }
            float sc = 0.f;
#pragma unroll
            for (int h = 0; h < 4; ++h) { float d0 = 0.f;
#pragma unroll
                for (int d = 0; d < 64; ++d) d0 += qi[h * 64 + d] * kf[d];
                sc += wv[h] * fmaxf(d0, 0.f); }
            sc = sc * IDX_SCALE + 0.0f;
            e[j] = ((unsigned long long)mono32(sc) << 13) | (unsigned long long)(8191 - s); } }
    if (n > 256) {
        for (int bit = 44; bit >= 0; --bit) { const unsigned long long cand = T | (1ull << bit); unsigned c = 0;
#pragma unroll
            for (int j = 0; j < 16; ++j) c += (e[j] >= cand) ? 1u : 0u;
            c = (unsigned)wave_sum((float)c);
            if (lane == 0) atomicAdd((unsigned*)&cnt[bit], c);
            __syncthreads();
            if (cnt[bit] >= 256u) T = cand; }
    }
    if (T == 0ull) T = 1ull;
#pragma unroll
    for (int j = 0; j < 16; ++j) em |= (e[j] >= T ? 1u : 0u) << j;
    }
    { unsigned c = 0;
      c = (unsigned)__builtin_popcount(em);
      unsigned inc = c;
#pragma unroll
      for (int o = 1; o < 64; o <<= 1) { const unsigned v = __shfl_up(inc, o); if (lane >= o) inc += v; }
      if (lane == 63) cnt[50 + wave] = inc;
      __syncthreads();
      unsigned base = inc - c;
#pragma unroll
      for (int w = 0; w < NWAVES; ++w) if (w < wave) base += cnt[50 + w];
#pragma unroll
      for (int j = 0; j < 16; ++j) if ((em >> j) & 1u) { if (base < 256u) sel[base] = tid + 512 * j; ++base; }
      if (tid == NWAVES * 64 - 1) cnt[48] = base; }
    __syncthreads();
    const int nsel = min((int)cnt[48], 256);
    { const int h = wave; float mx = -INFINITY;
#pragma unroll 1
      for (int kk = 0; kk < 4; ++kk) { const int k = lane + 64 * kk; float d0 = -INFINITY;
          if (k < nsel) { const GAS v4u* kr = (const GAS v4u*)(K + (size_t)(b * SEQ + sel[k]) * 512 + h * 64); d0 = 0.f;
#pragma unroll
              for (int c = 0; c < 8; ++c) { const v4u v = kr[c];
#pragma unroll
                  for (int q = 0; q < 4; ++q) d0 += qh[h * 64 + c * 8 + 2 * q] * bf2f_lo(v[q]) + qh[h * 64 + c * 8 + 2 * q + 1] * bf2f_hi(v[q]); } }
          pl[h * 256 + k] = d0; mx = fmaxf(mx, d0); }
      mx = wave_max(mx); float sum = 0.f;
#pragma unroll 1
      for (int kk = 0; kk < 4; ++kk) { const int k = lane + 64 * kk; const float p = (k < nsel) ? __builtin_amdgcn_exp2f(pl[h * 256 + k] - mx) : 0.f; pl[h * 256 + k] = p; sum += p; }
      sum = wave_sum(sum);
      LDS_WAIT(); asm volatile("" ::: "memory");
      float o = 0.f;
#pragma unroll 8
      for (int k = 0; k < nsel; ++k) o += pl[h * 256 + k] * bf2f(V[(size_t)(b * SEQ + sel[k]) * 512 + h * 64 + lane]);
      MIX[(size_t)row * 1024 + 512 + h * 64 + lane] = (bf16)pk2(o / sum, 0.f); }
    __syncthreads();
}
typedef float f32x16 __attribute__((ext_vector_type(16)));
__device__ __forceinline__ int crow(int r, int hi) { return (r & 3) + 8 * (r >> 2) + 4 * hi; }
constexpr int XA_ROWB = 528;
__device__ __forceinline__ void xattn_stage(Frame& F, const bf16* src  ) {
#pragma unroll 1
    for (int g = 0; g < 2; ++g) { v4u t[8];
#pragma unroll
        for (int i = 0; i < 8; ++i) { const int c = F.tid + 512 * (8 * g + i); t[i] = *(const GAS v4u*)(src + (size_t)(c >> 5) * 1024 + (c & 31) * 8); }
#pragma unroll
        for (int i = 0; i < 8; ++i) { const int c = F.tid + 512 * (8 * g + i); *(LAS v4u*)(F.lds + RING_OFF + (c >> 5) * XA_ROWB + (c & 31) * 16) = t[i]; } }
}
__device__ __forceinline__ void xattn_unit(Frame& F, const bf16* XQ, unsigned char* XO  , const bf16* MEMK, const bf16* MEMVT, int pm, int h) {
    const int lane = F.lane, wave = F.wave, r32 = lane & 31, hi = lane >> 5, b = pm >> 5;
    const int R0 = pm * 256 + wave * 32;
    LAS float* wsf = (LAS float*)(F.lds + RING_OFF + 256 * XA_ROWB) + wave * 64;
    xattn_stage(F, MEMK + (size_t)(b * 256) * 1024 + h * 256);
    bf16x8 qf[16];
#pragma unroll
    for (int kk = 0; kk < 16; ++kk) qf[kk] = *(const GAS bf16x8*)(XQ + (size_t)(R0 + r32) * 1024 + h * 256 + kk * 16 + hi * 8);
    __syncthreads();
    f32x16 st[8];
#pragma unroll
    for (int kb = 0; kb < 8; ++kb) { st[kb] = (f32x16){};
        const LAS unsigned char* kr = F.lds + RING_OFF + (kb * 32 + r32) * XA_ROWB + hi * 16;
#pragma unroll
        for (int kk = 0; kk < 16; ++kk) { const bf16x8 kf = *(const LAS bf16x8*)(kr + kk * 32); st[kb] = __builtin_amdgcn_mfma_f32_32x32x16_bf16(kf, qf[kk], st[kb], 0, 0, 0); if ((kk & 3) == 3) asm volatile("" ::: "memory"); } }
    float mx = -INFINITY;
#pragma unroll
    for (int kb = 0; kb < 8; ++kb)
#pragma unroll
        for (int r = 0; r < 16; ++r) mx = fmaxf(mx, st[kb][r]);
    { const auto rr = __builtin_amdgcn_permlane32_swap(__float_as_uint(mx), __float_as_uint(mx), false, false); mx = fmaxf(__uint_as_float(rr[0]), __uint_as_float(rr[1])); }
    float sum = 0.f; v4u pk[8][2];
#pragma unroll
    for (int kb = 0; kb < 8; ++kb) {
#pragma unroll
        for (int r = 0; r < 16; ++r) { st[kb][r] = __builtin_amdgcn_exp2f(st[kb][r] - mx); sum += st[kb][r]; }
#pragma unroll
        for (int hf = 0; hf < 2; ++hf)
#pragma unroll
            for (int q = 0; q < 4; ++q) pk[kb][hf][q] = pg8::cvt_pk_bf16(st[kb][8 * hf + 2 * q], st[kb][8 * hf + 2 * q + 1]); }
    { const auto rr = __builtin_amdgcn_permlane32_swap(__float_as_uint(sum), __float_as_uint(sum), false, false); sum = __uint_as_float(rr[0]) + __uint_as_float(rr[1]); }
    __syncthreads();
    xattn_stage(F, MEMVT + (size_t)(h * 256) * 1024 + b * 256);
    if (hi == 0) wsf[r32] = sum;
    __syncthreads();
    f32x16 o[8];
#pragma unroll
    for (int db = 0; db < 8; ++db) { o[db] = (f32x16){};
        const LAS unsigned char* vr = F.lds + RING_OFF + (db * 32 + r32) * XA_ROWB + hi * 8;
#pragma unroll
        for (int ks = 0; ks < 16; ++ks) { const pg8::u32x2 lo = *(const LAS pg8::u32x2*)(vr + ks * 32), hh = *(const LAS pg8::u32x2*)(vr + ks * 32 + 16);
            const v4u vv = (v4u){lo.x, lo.y, hh.x, hh.y};
            o[db] = __builtin_amdgcn_mfma_f32_32x32x16_bf16(__builtin_bit_cast(bf16x8, pk[ks >> 1][ks & 1]), __builtin_bit_cast(bf16x8, vv), o[db], 0, 0, 0); if ((ks & 3) == 3) asm volatile("" ::: "memory"); } }
    float rl[16];
#pragma unroll
    for (int r = 0; r < 16; ++r) rl[r] = 1.0f / wsf[crow(r, hi)];
#pragma unroll
    for (int db = 0; db < 8; ++db)
#pragma unroll
        for (int r = 0; r < 16; ++r) XO[(size_t)(R0 + crow(r, hi)) * 1024 + h * 256 + db * 32 + r32] = (unsigned char)__builtin_amdgcn_cvt_pk_fp8_f32(o[db][r] * rl[r], 0.f, 0u, false);
    __syncthreads();
}
__device__ __forceinline__ void final_norm_all(Frame& F, const bf16* X, const float* ss, const float* g, float* out) {
    const int gw = F.vcu * NWAVES + F.wave, NGW = F.G * NWAVES, lane = F.lane;
    f32x4 gg[4];
#pragma unroll
    for (int j = 0; j < 4; ++j) gg[j] = *(const GAS f32x4*)(g + (lane + 64 * j) * 4);
    for (int m0 = gw * 4; m0 < M; m0 += NGW * 4) {
        unsigned long long v[4][4]; float rs[4];
#pragma unroll
        for (int i = 0; i < 4; ++i) { rs[i] = pg8::rstd_of(ss, m0 + i);
#pragma unroll
            for (int j = 0; j < 4; ++j) v[i][j] = ((const GAS unsigned long long*)(X + (size_t)(m0 + i) * D))[lane + 64 * j]; }
#pragma unroll
        for (int i = 0; i < 4; ++i)
#pragma unroll
            for (int j = 0; j < 4; ++j) { const unsigned a = (unsigned)v[i][j], bq = (unsigned)(v[i][j] >> 32);
                *(GAS f32x4*)(out + (size_t)(m0 + i) * D + (lane + 64 * j) * 4) = (f32x4){bf2f_lo(a) * rs[i] * gg[j].x, bf2f_hi(a) * rs[i] * gg[j].y, bf2f_lo(bq) * rs[i] * gg[j].z, bf2f_hi(bq) * rs[i] * gg[j].w}; } }
}

constexpr int IX_HS = 1025;
constexpr int IX_ST = 32 * IX_HS * 4;
constexpr int IX_CAP = 1024;
#ifndef IX_DUP
#define IX_DUP 0
#endif
__device__ __forceinline__ void idx_load_a(bf16x8 (&a)[4], const bf16* kbase, int kb) {
#pragma unroll
    for (int kk = 0; kk < 4; ++kk) a[kk] = *(const GAS bf16x8*)(kbase + (size_t)kb * 2048 + kk * 512);
}
#define IX_RELU(x) __int_as_float(max(__float_as_int(x), 0))
#if IX_DUP & 8
#define IX_MF(ACC, H, KK) do { ACC = __builtin_amdgcn_mfma_f32_32x32x16_bf16(a[KK], bq[H][KK], ACC, 0, 0, 0); ACC = __builtin_amdgcn_mfma_f32_32x32x16_bf16(a[KK], bq[H][KK], ACC, 0, 0, 0); } while (0)
#else
#define IX_MF(ACC, H, KK) ACC = __builtin_amdgcn_mfma_f32_32x32x16_bf16(a[KK], bq[H][KK], ACC, 0, 0, 0)
#endif
#define IX_RS0(ACC, W, R) do { _Pragma("unroll") for (int r = (R); r < (R) + 4; ++r) { const float x = ACC[r]; sc[r] = __builtin_fmaf(W, IX_RELU(x), 0.0f); } } while (0)
#if IX_DUP & 16
#define IX_RS(ACC, W, R) do { _Pragma("unroll") for (int r = (R); r < (R) + 4; ++r) { const float x = ACC[r]; sc[r] = __builtin_fmaf(W, IX_RELU(x), sc[r]); float d_ = IX_RELU(x); asm volatile("v_max_i32 %0, 0, %0\n\tv_fma_f32 %0, %0, %0, %0" : "+v"(d_)); } } while (0)
#else
#define IX_RS(ACC, W, R) do { _Pragma("unroll") for (int r = (R); r < (R) + 4; ++r) { const float x = ACC[r]; sc[r] = __builtin_fmaf(W, IX_RELU(x), sc[r]); } } while (0)
#endif
#define IX_PIN(ACC, VACC, R) asm volatile("" : "+v"(ACC), "+v"(VACC), "+v"(sc[R]), "+v"(sc[(R) + 1]), "+v"(sc[(R) + 2]), "+v"(sc[(R) + 3]))
template <bool PREV> __device__ __forceinline__ void idx_half1(float (&sc)[16], f32x16& acc0, f32x16& acc1, f32x16& acc2, f32x16& acc3, const bf16x8 (&a)[4], const bf16x8 (&bq)[4][4], const f32x4 wv) {
    acc0 = (f32x16){};
#pragma unroll
    for (int kk = 0; kk < 4; ++kk) { IX_MF(acc0, 0, kk); if constexpr (PREV) { IX_RS(acc2, wv[2], 4 * kk); IX_PIN(acc0, acc2, 4 * kk); } }
    acc1 = (f32x16){};
#pragma unroll
    for (int kk = 0; kk < 4; ++kk) { IX_MF(acc1, 1, kk); if constexpr (PREV) { IX_RS(acc3, wv[3], 4 * kk); IX_PIN(acc1, acc3, 4 * kk); } }
}
__device__ __forceinline__ void idx_half2(float (&sc)[16], f32x16& acc0, f32x16& acc1, f32x16& acc2, f32x16& acc3, const bf16x8 (&a)[4], const bf16x8 (&bq)[4][4], const f32x4 wv) {
    acc2 = (f32x16){};
#pragma unroll
    for (int kk = 0; kk < 4; ++kk) { IX_MF(acc2, 2, kk); IX_RS0(acc0, wv[0], 4 * kk); IX_PIN(acc2, acc0, 4 * kk); }
    acc3 = (f32x16){};
#pragma unroll
    for (int kk = 0; kk < 4; ++kk) { IX_MF(acc3, 3, kk); IX_RS(acc1, wv[1], 4 * kk); IX_PIN(acc3, acc1, 4 * kk); }
}
__device__ __forceinline__ void idx_tail(float (&sc)[16], const f32x16& acc2, const f32x16& acc3, const f32x4 wv) {
    IX_RS(acc2, wv[2], 0); IX_RS(acc2, wv[2], 4); IX_RS(acc2, wv[2], 8); IX_RS(acc2, wv[2], 12);
    IX_RS(acc3, wv[3], 0); IX_RS(acc3, wv[3], 4); IX_RS(acc3, wv[3], 8); IX_RS(acc3, wv[3], 12);
}
#undef IX_PIN
#undef IX_RELU
#undef IX_MF
#undef IX_RS0
#undef IX_RS
template <bool L2> __device__ __forceinline__ void idx_scan(LAS unsigned* row, bool positive, unsigned need, int lane, unsigned& bin_out, unsigned& need_out) {
    asm volatile("" : "+v"(lane));
    unsigned c[16], sum = 0;
#pragma unroll
    for (int i = 0; i < 16; ++i) { const int p = 16 * lane + i; const int bin = L2 ? (positive ? 1023 - p : p) : (p < 512 ? 511 - p : p); c[i] = row[bin]; row[bin] = 0u; sum += c[i]; }
    unsigned incl = sum;
#pragma unroll
    for (int o = 1; o < 64; o <<= 1) { const unsigned v = __shfl_up(incl, o); if (lane >= o) incl += v; }
    const unsigned long long m = __ballot(incl >= need);
    const int Ls = m ? (int)__builtin_ctzll(m) : 63;
    unsigned cum = incl - sum, fb = 0u, fn = 1u; bool found = false;
#pragma unroll
    for (int i = 0; i < 16; ++i) { const int p = 16 * lane + i; const unsigned bin = (unsigned)(L2 ? (positive ? 1023 - p : p) : (p < 512 ? 511 - p : p));
        if (!found && cum + c[i] >= need) { found = true; fb = bin; fn = need - cum; } cum += c[i]; }
    bin_out = (unsigned)__shfl((int)fb, Ls); need_out = (unsigned)__shfl((int)fn, Ls);
}
template <int NS> __device__ __forceinline__ unsigned idx_select(LAS unsigned* row, unsigned n, unsigned need, int lane) {
    unsigned v[NS], vor = 0u, vand = 0xffffffffu;
#pragma unroll
    for (int s = 0; s < NS; ++s) { const unsigned idx = (unsigned)(s * 64 + lane); const bool ok = idx < n; v[s] = ok ? row[idx] : 0u; vor |= v[s]; vand &= ok ? v[s] : 0xffffffffu; }
#pragma unroll
    for (int o = 1; o < 64; o <<= 1) { vor |= (unsigned)__shfl_xor((int)vor, o); vand &= (unsigned)__shfl_xor((int)vand, o); }
    const unsigned diff = vor ^ vand;
    if (diff == 0u) return vand;
    const int top = 31 - __builtin_clz(diff);
    unsigned T = vand & ~((2u << top) - 1u);
    for (int bit = top; bit >= 0; --bit) { const unsigned cand = T | (1u << bit); unsigned c = 0;
#pragma unroll
        for (int s = 0; s < NS; ++s) c += (unsigned)__builtin_popcountll(__ballot(v[s] >= cand));
        if (c >= need) T = cand; }
    return T;
}
__device__ __forceinline__ unsigned ix_mono(unsigned raw) { return (raw & 0x80000000u) ? ~raw : (raw | 0x80000000u); }
__device__ __forceinline__ float ix_h2f(unsigned h) { return (float)__builtin_bit_cast(_Float16, (unsigned short)h); }
__device__ __forceinline__ unsigned ix_pick(const float (&sc)[16], unsigned r) {
    const unsigned m0 = (unsigned)((int)(r << 31) >> 31), m1 = (unsigned)((int)(r << 30) >> 31), m2 = (unsigned)((int)(r << 29) >> 31), m3 = (unsigned)((int)(r << 28) >> 31); unsigned t[8], u[4], w[2];
#pragma unroll
    for (int i = 0; i < 8; ++i) t[i] = (__float_as_uint(sc[2 * i + 1]) & m0) | (__float_as_uint(sc[2 * i]) & ~m0);
#pragma unroll
    for (int i = 0; i < 4; ++i) u[i] = (t[2 * i + 1] & m1) | (t[2 * i] & ~m1);
#pragma unroll
    for (int i = 0; i < 2; ++i) w[i] = (u[2 * i + 1] & m2) | (u[2 * i] & ~m2);
    return (w[1] & m3) | (w[0] & ~m3);
}
__device__ __forceinline__ void idx_unit(Frame& F, const bf16* QI, const bf16* KI, const float* WI, unsigned* MASK, int b, int j) {
    int lane = F.lane, r32 = lane & 31, hi = lane >> 5; const int wave = F.wave;
#define IX_LAUNDER() asm volatile("" : "+v"(lane), "+v"(r32), "+v"(hi))
    LAS unsigned* hist = (LAS unsigned*)(F.lds + RING_OFF);
    LAS unsigned* st = (LAS unsigned*)(F.lds + RING_OFF + IX_ST);
    const size_t qrow = (size_t)b * SEQ + 32 * j + r32;
    bf16x8 bq[4][4];
#pragma unroll
    for (int h = 0; h < 4; ++h)
#pragma unroll
        for (int kk = 0; kk < 4; ++kk) bq[h][kk] = *(const GAS bf16x8*)(QI + qrow * 256 + h * 64 + kk * 16 + hi * 8);
    f32x4 wv = *(const GAS f32x4*)(WI + qrow * 4); wv = wv * IDX_SCALE; if (IX_DUP & 8) wv = wv * 0.5f;
    const bf16* kbase = KI + (size_t)b * SEQ * 64 + (size_t)(hi * 32 + r32) * 8;
    LAS unsigned* myrow = hist + r32 * IX_HS;
    const unsigned myrow_b = (unsigned)(uintptr_t)myrow;
#define IX_BODY(KBP, ...) do { const int kb = (KBP); if (kb == j) { _Pragma("unroll") for (int r = 0; r < 16; ++r) sc[r] = (crow(r, hi) > r32) ? -INFINITY : sc[r]; } __VA_ARGS__ } while (0)
#define IX_STEP(A, KB, ...) do { idx_half1<true>(sc, acc0, acc1, acc2, acc3, A, bq, wv); IX_BODY(kbp, __VA_ARGS__); idx_half2(sc, acc0, acc1, acc2, acc3, A, bq, wv); idx_load_a(A, kbase, min((KB) + 3 * NWAVES, j)); kbp = (KB); } while (0)
#define IX_PASS(...) do { IX_LAUNDER(); bf16x8 a0[4], a1[4], a2[4]; idx_load_a(a0, kbase, min(wave, j)); idx_load_a(a1, kbase, min(wave + NWAVES, j)); idx_load_a(a2, kbase, min(wave + 2 * NWAVES, j)); \
        if (wave <= j) { float sc[16]; f32x16 acc0, acc1, acc2, acc3; int kbp = wave; \
            idx_half1<false>(sc, acc0, acc1, acc2, acc3, a0, bq, wv); idx_half2(sc, acc0, acc1, acc2, acc3, a0, bq, wv); idx_load_a(a0, kbase, min(wave + 3 * NWAVES, j)); \
            for (int kb_ = wave + NWAVES;;) { \
                if (kb_ > j) break; IX_STEP(a1, kb_, __VA_ARGS__); kb_ += NWAVES; \
                if (kb_ > j) break; IX_STEP(a2, kb_, __VA_ARGS__); kb_ += NWAVES; \
                if (kb_ > j) break; IX_STEP(a0, kb_, __VA_ARGS__); kb_ += NWAVES; } \
            idx_tail(sc, acc2, acc3, wv); IX_BODY(kbp, __VA_ARGS__); } } while (0)
    float ts = -3.402823466e38f, ti = -3.402823466e38f; unsigned mbase = 0u;
    if (j >= 8) for (int ra_ = 0; ra_ < 1 + (IX_DUP & 1); ++ra_) {
        IX_PASS({
            _Pragma("unroll") for (int r = 0; r < 16; r += 2) { unsigned u; asm("v_cvt_pkrtz_f16_f32 %0, %1, %2" : "=v"(u) : "v"(sc[r]), "v"(sc[r + 1]));
                unsigned a0, a1; asm("v_lshl_add_u32 %0, %1, 2, %2" : "=v"(a0) : "v"((u >> 6) & 1023u), "v"(myrow_b)); asm("v_lshl_add_u32 %0, %1, 2, %2" : "=v"(a1) : "v"(u >> 22), "v"(myrow_b));
                __hip_atomic_fetch_add((LAS unsigned*)a0, 1u, __ATOMIC_RELAXED, __HIP_MEMORY_SCOPE_WORKGROUP); __hip_atomic_fetch_add((LAS unsigned*)a1, 1u, __ATOMIC_RELAXED, __HIP_MEMORY_SCOPE_WORKGROUP); } });
        __syncthreads();
#pragma unroll 1
        for (int qq = wave * 4; qq < wave * 4 + 4; ++qq) { unsigned bn, nd; idx_scan<false>(hist + qq * IX_HS, true, 256u, lane, bn, nd);
            if (lane == 0) {
                float tsv, tiv;
                if (bn < 512u) { tiv = ix_h2f(bn << 6); tsv = ix_h2f((bn + 1u) << 6); }
                else { const unsigned mb = bn - 512u; const float mlo = ix_h2f(mb << 6), mhi = ix_h2f((mb + 1u) << 6);
                    tsv = (mlo == 0.f) ? 0.f : __uint_as_float(__float_as_uint(-mlo) - 1u); tiv = __uint_as_float(__float_as_uint(-mhi) - 1u); }
                st[qq] = bn; st[32 + qq] = nd; st[64 + qq] = __float_as_uint(tsv); st[96 + qq] = __float_as_uint(tiv); st[128 + qq] = ix_mono(__float_as_uint(tiv)); st[160 + qq] = 0u; } }
        __syncthreads();
        ts = __uint_as_float(st[64 + r32]); ti = __uint_as_float(st[96 + r32]); mbase = st[128 + r32];
    }
    unsigned short* mrow = (unsigned short*)(MASK + (((size_t)b * 256 + j) * 128) * 64);
    for (int rd_ = 0; rd_ < 1 + ((IX_DUP >> 1) & 1); ++rd_) { if (rd_) { __syncthreads(); if (F.tid < 32) st[160 + F.tid] = 0u; __syncthreads(); }
    IX_PASS({
            unsigned w16 = 0u, c16 = 0u;
            _Pragma("unroll") for (int r = 15; r >= 0; --r) asm("v_cmp_ge_f32_e32 vcc, %2, %3\n\tv_addc_co_u32_e32 %0, vcc, %0, %0, vcc\n\tv_cmp_ge_f32_e32 vcc, %2, %4\n\tv_addc_co_u32_e32 %1, vcc, %1, %1, vcc" : "+v"(w16), "+v"(c16) : "v"(sc[r]), "v"(ts), "v"(ti) : "vcc");
            mrow[(((size_t)(kb >> 1) * 64 + lane) << 1) + (kb & 1)] = (unsigned short)w16;
            const unsigned cm = c16 & ~w16;
            if (cm) { unsigned base = __hip_atomic_fetch_add(st + 160 + r32, (unsigned)__builtin_popcount(cm), __ATOMIC_RELAXED, __HIP_MEMORY_SCOPE_WORKGROUP);
                _Pragma("unroll 1") for (unsigned cmv = cm; cmv; cmv &= cmv - 1u) { const unsigned r = (unsigned)__builtin_ctz(cmv); const unsigned d = ix_mono(ix_pick(sc, r)) - mbase;
                        if (base < (unsigned)IX_CAP) myrow[base] = (min(d, 0x7ffffu) << 13) | (8191u - (32u * (unsigned)kb + (r & 3u) + 8u * (r >> 2) + 4u * (unsigned)hi)); ++base; } } });
    }
    for (int kb = j + 1 + wave; kb <= (j | 7); kb += NWAVES) mrow[(((size_t)(kb >> 1) * 64 + lane) << 1) + (kb & 1)] = (unsigned short)0;
    asm volatile("s_waitcnt vmcnt(0)" ::: "memory");
    __syncthreads();
    if (j >= 8) {
#pragma unroll 1
        for (int qq = wave * 4; qq < wave * 4 + 4; ++qq) { LAS unsigned* row = hist + qq * IX_HS; const unsigned n = min(st[160 + qq], (unsigned)IX_CAP), need = st[32 + qq];
            const int ns = (int)((n + 63u) >> 6); unsigned T = 0u;
            if (ns <= 2) T = idx_select<2>(row, n, need, lane); else if (ns <= 4) T = idx_select<4>(row, n, need, lane); else if (ns <= 8) T = idx_select<8>(row, n, need, lane); else T = idx_select<16>(row, n, need, lane);
            for (int s = 0; s < ns; ++s) { const unsigned idx = (unsigned)(s * 64 + lane);
                if (idx < n) { const unsigned v = row[idx]; row[idx] = 0u;
                    if (v >= T) { const unsigned key = 8191u - (v & 8191u), kbk = key >> 5, ko = key & 31u, rr = (ko & 3u) + 4u * (ko >> 3), hh = (ko >> 2) & 1u;
                        __hip_atomic_fetch_or((unsigned*)mrow + (size_t)(kbk >> 1) * 64 + hh * 32 + qq, 1u << (16u * (kbk & 1u) + rr), __ATOMIC_RELAXED, __HIP_MEMORY_SCOPE_AGENT); } } } }
        __syncthreads();
    }
#undef IX_PASS
#undef IX_STEP
#undef IX_BODY
#undef IX_LAUNDER
}
__device__ __forceinline__ void idx_unit_of(int u, int& b, int& j) { const int slot = u >> 8, v = u & 255, i = v & 63; b = v >> 6; j = slot == 0 ? 255 - i : slot == 1 ? 128 + i : slot == 2 ? 127 - i : i; }

#include <hip/hip_bf16.h>
namespace attn_body {
using bf16=__hip_bfloat16;
using bf16x8=__attribute__((ext_vector_type(8)))short;
using s16x4=__attribute__((ext_vector_type(4)))short;
using f32x16=__attribute__((ext_vector_type(16)))float;
using u32x4=__attribute__((ext_vector_type(4)))unsigned;
constexpr int BATCH=4,NHEAD=8,SEQ=8192,D=64,DM=NHEAD*D,OPITCH=1024;
constexpr int NW=8,QBLK=32,QB=QBLK*NW,KVBLK=64,NQB=SEQ/QB;
constexpr int ATTN_PITCH=DM, ATTN_UNIT_ROWS=QB;
__device__ __forceinline__ int crow(int r,int hi){return (r&3)+8*(r>>2)+4*hi;}
#define SBAR() __builtin_amdgcn_sched_barrier(0)
#define MASK1(p,w,e) ({ unsigned m_; asm("v_bfe_i32 %0, %1, %2, 1":"=v"(m_):"v"(w),"n"(e)); __uint_as_float(__float_as_uint(p)&m_); })

constexpr int NSLOT=3, SLOTB=8192;
constexpr int LDS_K=0, LDS_V=NSLOT*SLOTB, LDS_WS=2*NSLOT*SLOTB, LDS_OST=LDS_WS+NW*64*4, LDS_BYTES=LDS_OST+NW*4096;
constexpr float C2=0.125f*1.4426950408889634f;
__device__ __forceinline__ void glds16(const void*gsrc,unsigned lds_dst){unsigned keep;
  asm volatile("s_mov_b32 %0, m0\n\ts_mov_b32 m0, %2\n\ts_nop 0\n\tglobal_load_lds_dwordx4 %1, off\n\ts_mov_b32 m0, %0":"=&s"(keep):"v"(gsrc),"s"(lds_dst):"memory");}
__device__ __forceinline__ float max3f(float a,float b,float c){float r;asm("v_max3_f32 %0, %1, %2, %3":"=v"(r):"v"(a),"v"(b),"v"(c));return r;}
__device__ __forceinline__ float max2f(float a,float b){float r;asm("v_max_f32_e32 %0, %1, %2":"=v"(r):"v"(a),"v"(b));return r;}
__device__ __forceinline__ float fadd_s(float a,float b){float r;asm("v_add_f32_e32 %0, %1, %2":"=v"(r):"v"(a),"v"(b));return r;}
__device__ __forceinline__ float fsub_s(float a,float b){float r;asm("v_sub_f32_e32 %0, %1, %2":"=v"(r):"v"(a),"v"(b));return r;}
typedef float f32x2_t __attribute__((ext_vector_type(2))); typedef __bf16 bf16x2_t __attribute__((ext_vector_type(2)));
__device__ __forceinline__ unsigned cvtpk_s(float lo,float hi){f32x2_t v={lo,hi};bf16x2_t b=__builtin_convertvector(v,bf16x2_t);return __builtin_bit_cast(unsigned,b);}
#define WAIT_BAR(N) asm volatile("s_waitcnt vmcnt(" #N ") lgkmcnt(0)\n\ts_barrier":::"memory")

__device__ __forceinline__ void qkt(f32x16&p0,f32x16&p1,const char*Kslot,const bf16x8*qr,const f32x16&negm,int r32,int hi){
  const char*kb=Kslot+hi*1024+r32*16;
  #pragma unroll
  for(int d0=0;d0<4;++d0){
    const bf16x8 b0=*reinterpret_cast<const bf16x8*>(kb+d0*2048);
    const bf16x8 b1=*reinterpret_cast<const bf16x8*>(kb+d0*2048+512);
    if(d0==0){p0=__builtin_amdgcn_mfma_f32_32x32x16_bf16(b0,qr[0],negm,0,0,0);p1=__builtin_amdgcn_mfma_f32_32x32x16_bf16(b1,qr[0],negm,0,0,0);}
    else{p0=__builtin_amdgcn_mfma_f32_32x32x16_bf16(b0,qr[d0],p0,0,0,0);p1=__builtin_amdgcn_mfma_f32_32x32x16_bf16(b1,qr[d0],p1,0,0,0);}}
}
typedef __attribute__((address_space(3))) const char* lds_cptr;
typedef short v4i16_t __attribute__((ext_vector_type(4)));
__device__ __forceinline__ void kload8(bf16x8*kf,lds_cptr kp){
  kf[0]=*(const __attribute__((address_space(3))) bf16x8*)(kp);      kf[1]=*(const __attribute__((address_space(3))) bf16x8*)(kp+512);
  kf[2]=*(const __attribute__((address_space(3))) bf16x8*)(kp+2048); kf[3]=*(const __attribute__((address_space(3))) bf16x8*)(kp+2560);
  kf[4]=*(const __attribute__((address_space(3))) bf16x8*)(kp+4096); kf[5]=*(const __attribute__((address_space(3))) bf16x8*)(kp+4608);
  kf[6]=*(const __attribute__((address_space(3))) bf16x8*)(kp+6144); kf[7]=*(const __attribute__((address_space(3))) bf16x8*)(kp+6656);
}
__device__ __forceinline__ void kload2(bf16x8*kf,lds_cptr kp,int j){ kf[2*j]=*(const __attribute__((address_space(3))) bf16x8*)(kp+j*2048); kf[2*j+1]=*(const __attribute__((address_space(3))) bf16x8*)(kp+j*2048+512); }
__device__ __forceinline__ s16x4 vtr(lds_cptr p){ return __builtin_bit_cast(s16x4,__builtin_amdgcn_ds_read_tr16_b64_v4i16((__attribute__((address_space(3))) v4i16_t*)p)); }
__device__ __forceinline__ float rowmax(const f32x16&p0,const f32x16&p1){
  float a=max3f(p0[0],p0[1],p1[0]),b=max3f(p0[2],p0[3],p1[1]);a=max3f(a,p1[2],p1[3]);
  #pragma unroll
  for(int r=4;r<16;r+=4){a=max3f(a,p0[r],p0[r+1]);b=max3f(b,p0[r+2],p0[r+3]);a=max3f(a,p1[r],p1[r+1]);b=max3f(b,p1[r+2],p1[r+3]);}
  const float m=max2f(a,b);
  auto rr=__builtin_amdgcn_permlane32_swap(__float_as_uint(m),__float_as_uint(m),false,false);
  return max2f(__uint_as_float(rr[0]),__uint_as_float(rr[1]));
}
__device__ __forceinline__ void pv(f32x16*o,int vb,bf16x8 pa0,bf16x8 pa1,bf16x8 pa2,bf16x8 pa3){
  #pragma unroll
  for(int d0=0;d0<2;++d0){s16x4 lo[4],hi[4];
    #pragma unroll
    for(int ks=0;ks<4;++ks){
      asm volatile("ds_read_b64_tr_b16 %0,%1 offset:%c2":"=&v"(lo[ks]):"v"(vb),"i"(d0*4096+ks*1024):"memory");
      asm volatile("ds_read_b64_tr_b16 %0,%1 offset:%c2":"=&v"(hi[ks]):"v"(vb),"i"(d0*4096+ks*1024+512):"memory");}
    asm volatile("s_waitcnt lgkmcnt(0)":::"memory");SBAR();
    #define PK(k) (bf16x8){lo[k][0],lo[k][1],lo[k][2],lo[k][3],hi[k][0],hi[k][1],hi[k][2],hi[k][3]}
    o[d0]=__builtin_amdgcn_mfma_f32_32x32x16_bf16(pa0,PK(0),o[d0],0,0,0);
    o[d0]=__builtin_amdgcn_mfma_f32_32x32x16_bf16(pa1,PK(1),o[d0],0,0,0);
    o[d0]=__builtin_amdgcn_mfma_f32_32x32x16_bf16(pa2,PK(2),o[d0],0,0,0);
    o[d0]=__builtin_amdgcn_mfma_f32_32x32x16_bf16(pa3,PK(3),o[d0],0,0,0);
    #undef PK
  }
}

#ifndef ATTN_STORE16
#define ATTN_STORE16(p,v) (*(u32x4*)(p)=(v))
#endif
template<int THRL> __device__ __forceinline__ void attn_unit(int b,int h,int qb,const bf16*Q,const bf16*__restrict__ K,const bf16*__restrict__ V,bf16*O,const unsigned*MASK,char*shm){
  int tid_=threadIdx.x; asm volatile("":"+v"(tid_));
  const int tid=tid_,lane=tid&63,r32=lane&31,hi=lane>>5; const int wid=__builtin_amdgcn_readfirstlane(tid>>6);
  const long rowbase=(long)b*SEQ; const int q0=qb*QB;
  const bf16*Qw=Q+(rowbase+q0+wid*QBLK)*DM+h*D;
  const bf16*Kh=K+rowbase*DM+h*D,*Vh=V+rowbase*DM+h*D;
  const unsigned lds0=(unsigned)(uintptr_t)shm;
  float*wsf=(float*)(shm+LDS_WS)+wid*64;
  const bf16*ksrc=Kh+(long)lane*DM+wid*8;
  const bf16*vsrc=Vh+(long)(16*(wid&3)+(lane>>2))*DM+(wid>>2)*32+(lane&3)*8;
  const unsigned kdst=lds0+LDS_K+wid*1024, vdst=lds0+LDS_V+wid*1024;
  #define DMA_K(t,slot) glds16(ksrc+(long)(t)*KVBLK*DM,(unsigned)__builtin_amdgcn_readfirstlane(kdst+(slot)))
  #define DMA_V(t,slot) glds16(vsrc+(long)(t)*KVBLK*DM,(unsigned)__builtin_amdgcn_readfirstlane(vdst+(slot)))
  const int vb0=(int)(lds0+LDS_V)+((lane>>4)&1)*32+(lane&3)*8+(4*hi+((lane&15)>>2))*64;
  const char*Kbase=shm+LDS_K; bf16x8 kf[8];
  const lds_cptr shm3=(lds_cptr)shm; const lds_cptr kp0=shm3+LDS_K+hi*1024+r32*16; const lds_cptr vp0=shm3+LDS_V+((lane>>4)&1)*32+(lane&3)*8+(4*hi+((lane&15)>>2))*64;
  const int NT=(q0+QB)/KVBLK;
  const unsigned*mwl=MASK+((size_t)(b*256+qb*8+wid)*128)*64+lane;
  unsigned wA,wB;
  #define WLOAD(W,t) asm volatile("global_load_dword %0, %1, off":"=v"(W):"v"(mwl+(size_t)(t)*64):"memory")
  WLOAD(wA,0);WLOAD(wB,1);
  DMA_K(0,0);DMA_V(0,0);DMA_K(1,SLOTB);
  bf16x8 qr[4];
  #pragma unroll
  for(int d0=0;d0<4;++d0)qr[d0]=*reinterpret_cast<const bf16x8*>(&Qw[(long)r32*DM+d0*16+hi*8]);
  float mhat=0.f,l_reg=0.f;f32x16 o[2];o[0]=f32x16{};o[1]=f32x16{};f32x16 negm=f32x16{};asm volatile("":"+v"(negm));
  bool resc=false;
  #define START(P0,P1) do{ const float rm=rowmax(P0,P1); resc=false; \
    { const float dl=rm>-1e30f?rm:0.f; mhat=fadd_s(mhat,dl); \
      _Pragma("unroll") for(int r=0;r<16;++r){P0[r]=fsub_s(P0[r],dl);P1[r]=fsub_s(P1[r],dl);} \
      _Pragma("unroll") for(int r=0;r<16;++r)negm[r]=-mhat; asm volatile("":"+v"(negm)); } \
    _Pragma("unroll") for(int r=0;r<16;++r)P0[r]=__builtin_amdgcn_exp2f(P0[r]); }while(0)
  #define RESC() do{ if(resc){ asm volatile("s_waitcnt lgkmcnt(0)":::"memory"); \
      _Pragma("unroll") for(int d_=0;d_<2;++d_) _Pragma("unroll") for(int r=0;r<16;++r)o[d_][r]*=wsf[crow(r,hi)]; } }while(0)
  f32x16 pA0,pA1,pB0,pB1;
  int sl_prev=0,sl_cur=0,sl_next=SLOTB;
  #define ROT() do{sl_prev=sl_cur;sl_cur=sl_next;sl_next=(sl_next==(NSLOT-1)*SLOTB)?0:sl_next+SLOTB;}while(0)
  DMA_K(2,2*SLOTB);
  WAIT_BAR(3);
  qkt(pA0,pA1,Kbase,qr,negm,r32,hi);asm volatile("s_nop 15\n\ts_nop 7":"+v"(pA0),"+v"(pA1));
  START(pA0,pA1);
  _Pragma("unroll") for(int r=0;r<16;++r)pA1[r]=__builtin_amdgcn_exp2f(pA1[r]);
  _Pragma("unroll") for(int r=0;r<16;++r){pA0[r]=MASK1(pA0[r],wA,r);pA1[r]=MASK1(pA1[r],wA,16+r);}
  WAIT_BAR(0);
  DMA_K(3,0);DMA_V(1,SLOTB);
  ROT();
  kload8(kf,kp0+sl_cur);
  WAIT_BAR(2);
  s16x4 vlo[8],vhi[8]; u32x4 pw0,pw1,pw2,pw3;
  #define PKW(P,B) cvtpk_s(P[B],P[B+1])
  #define PAF(k) __builtin_bit_cast(bf16x8,pw##k)
  #define VFR(i) (bf16x8){vlo[i][0],vlo[i][1],vlo[i][2],vlo[i][3],vhi[i][0],vhi[i][1],vhi[i][2],vhi[i][3]}
  #define PIN(x) asm volatile("":"+v"(x))
  #define MX3(a,b,c) __builtin_fmaxf(__builtin_fmaxf((a),(b)),(c))
  #define GAPA(MF,A0,A1,A2,A3,W0,W1,PW) do{ MF; sacc+=A0; sacc+=A1; sacc+=A2; sacc+=A3; PIN(sacc); W0; W1; PIN(PW); SBAR(); }while(0)
  #define EX(v) __builtin_amdgcn_exp2f(v)
  #define GAPB(MF,X,B,W,E) do{ MF; X[B]=MASK1(EX(X[B]),W,(E)); X[B+1]=MASK1(EX(X[B+1]),W,(E)+1); X[B+2]=MASK1(EX(X[B+2]),W,(E)+2); X[B+3]=MASK1(EX(X[B+3]),W,(E)+3); PIN(X); SBAR(); }while(0)
  #define VRD(i) do{ vlo[i]=vtr(vp_+(((i)>>2)*4096+((i)&3)*1024)); vhi[i]=vtr(vp_+(((i)>>2)*4096+((i)&3)*1024+512)); }while(0)
  #define KRD(G,j) do{ if(G){ kload2(kf,kp0+sl_next,j); SBAR(); } }while(0)
  #define STEP(C0,C1,P0,P1,t,GK,GV,GL,WU,WL) do{ SBAR(); if((t)+1<NT){WLOAD(WL,(t)+1);} SBAR(); \
    const lds_cptr vp_=vp0+sl_prev; \
    VRD(0); SBAR(); float sacc=(P0[0]+P0[1]); \
    GAPA(C0=__builtin_amdgcn_mfma_f32_32x32x16_bf16(kf[0],qr[0],negm,0,0,0), P0[2],P0[3],P0[4],P0[5],     pw0[0]=PKW(P0,0), pw0[1]=PKW(P0,2), pw0); \
    VRD(4); SBAR(); GAPA(C1=__builtin_amdgcn_mfma_f32_32x32x16_bf16(kf[1],qr[0],negm,0,0,0), P0[6],P0[7],P0[8],P0[9],     pw0[2]=PKW(P0,4), pw0[3]=PKW(P0,6), pw0); \
    VRD(1); SBAR(); GAPA(C0=__builtin_amdgcn_mfma_f32_32x32x16_bf16(kf[2],qr[1],C0,0,0,0),   P0[10],P0[11],P0[12],P0[13], pw1[0]=PKW(P0,8), pw1[1]=PKW(P0,10), pw1); \
    VRD(5); SBAR(); GAPA(C1=__builtin_amdgcn_mfma_f32_32x32x16_bf16(kf[3],qr[1],C1,0,0,0),   P0[14],P0[15],P1[0],P1[1],   pw1[2]=PKW(P0,12),pw1[3]=PKW(P0,14), pw1); \
    VRD(2); SBAR(); GAPA(C0=__builtin_amdgcn_mfma_f32_32x32x16_bf16(kf[4],qr[2],C0,0,0,0),   P1[2],P1[3],P1[4],P1[5],     pw2[0]=PKW(P1,0), pw2[1]=PKW(P1,2), pw2); \
    VRD(6); SBAR(); GAPA(C1=__builtin_amdgcn_mfma_f32_32x32x16_bf16(kf[5],qr[2],C1,0,0,0),   P1[6],P1[7],P1[8],P1[9],     pw2[2]=PKW(P1,4), pw2[3]=PKW(P1,6), pw2); \
    VRD(3); SBAR(); GAPA(C0=__builtin_amdgcn_mfma_f32_32x32x16_bf16(kf[6],qr[3],C0,0,0,0),   P1[10],P1[11],P1[12],P1[13], pw3[0]=PKW(P1,8), pw3[1]=PKW(P1,10), pw3); \
    VRD(7); SBAR(); GAPA(C1=__builtin_amdgcn_mfma_f32_32x32x16_bf16(kf[7],qr[3],C1,0,0,0),   P1[14],P1[15],0.f,0.f,       pw3[2]=PKW(P1,12),pw3[3]=PKW(P1,14), pw3); \
    l_reg+=sacc; \
    if(GK){DMA_K((t)+3,sl_cur);} if(GV){DMA_V((t)+1,sl_next);} \
    { float a=MX3(C0[0],C0[1],C1[0]),b=MX3(C0[2],C0[3],C1[1]); a=MX3(a,C1[2],C1[3]); \
      _Pragma("unroll") for(int r=4;r<16;r+=4){a=MX3(a,C0[r],C0[r+1]);b=MX3(b,C0[r+2],C0[r+3]);a=MX3(a,C1[r],C1[r+1]);b=MX3(b,C1[r+2],C1[r+3]);} \
      float rm=__builtin_fmaxf(a,b); { auto rr=__builtin_amdgcn_permlane32_swap(__float_as_uint(rm),__float_as_uint(rm),false,false); rm=__builtin_fmaxf(__uint_as_float(rr[0]),__uint_as_float(rr[1])); } \
      resc=false; \
      if(__builtin_expect(__any(rm>(float)THRL),0)){ const float dl=__builtin_fmaxf(rm,0.f); mhat+=dl; \
        _Pragma("unroll") for(int r=0;r<16;++r){C0[r]-=dl;C1[r]-=dl;} \
        _Pragma("unroll") for(int r=0;r<16;++r)negm[r]=-mhat; asm volatile("":"+v"(negm)); \
        const float f=__builtin_amdgcn_exp2f(-dl); l_reg*=f; if(hi==0)wsf[r32]=f; resc=true; } } \
    SBAR(); \
    GAPB(o[0]=__builtin_amdgcn_mfma_f32_32x32x16_bf16(PAF(0),VFR(0),o[0],0,0,0), C0,0,WU,0); \
    GAPB(o[1]=__builtin_amdgcn_mfma_f32_32x32x16_bf16(PAF(0),VFR(4),o[1],0,0,0), C0,4,WU,4); \
    KRD(GL,0); GAPB(o[0]=__builtin_amdgcn_mfma_f32_32x32x16_bf16(PAF(1),VFR(1),o[0],0,0,0), C0,8,WU,8); \
    KRD(GL,1); GAPB(o[1]=__builtin_amdgcn_mfma_f32_32x32x16_bf16(PAF(1),VFR(5),o[1],0,0,0), C0,12,WU,12); \
    KRD(GL,2); GAPB(o[0]=__builtin_amdgcn_mfma_f32_32x32x16_bf16(PAF(2),VFR(2),o[0],0,0,0), C1,0,WU,16); \
    KRD(GL,3); GAPB(o[1]=__builtin_amdgcn_mfma_f32_32x32x16_bf16(PAF(2),VFR(6),o[1],0,0,0), C1,4,WU,20); \
    GAPB(o[0]=__builtin_amdgcn_mfma_f32_32x32x16_bf16(PAF(3),VFR(3),o[0],0,0,0), C1,8,WU,24); \
    GAPB(o[1]=__builtin_amdgcn_mfma_f32_32x32x16_bf16(PAF(3),VFR(7),o[1],0,0,0), C1,12,WU,28); \
    }while(0)
  int t=1;
  for(;t+5<NT;t+=2){
    STEP(pB0,pB1,pA0,pA1,t,true,true,true,wB,wA);     WAIT_BAR(2); RESC(); ROT();
    STEP(pA0,pA1,pB0,pB1,t+1,true,true,true,wA,wB);   WAIT_BAR(2); RESC(); ROT();
  }
  #define ENDW(tt) do{ if((tt)+3<NT){WAIT_BAR(2);} else if((tt)+2<NT){WAIT_BAR(1);} else {WAIT_BAR(0);} }while(0)
  for(;t+1<NT;t+=2){
    STEP(pB0,pB1,pA0,pA1,t,(t+3<NT),(t+1<NT),(t+1<NT),wB,wA);       ENDW(t);   RESC(); ROT();
    STEP(pA0,pA1,pB0,pB1,t+1,(t+4<NT),(t+2<NT),(t+2<NT),wA,wB);     ENDW(t+1); RESC(); ROT();
  }
  STEP(pB0,pB1,pA0,pA1,NT-1,false,false,false,wB,wA); RESC();
  { float sacc=pB0[0]+pB0[1]; _Pragma("unroll") for(int r=2;r<16;++r)sacc+=pB0[r]; _Pragma("unroll") for(int r=0;r<16;++r)sacc+=pB1[r]; l_reg+=sacc;
    pw0=(u32x4){PKW(pB0,0),PKW(pB0,2),PKW(pB0,4),PKW(pB0,6)};pw1=(u32x4){PKW(pB0,8),PKW(pB0,10),PKW(pB0,12),PKW(pB0,14)};pw2=(u32x4){PKW(pB1,0),PKW(pB1,2),PKW(pB1,4),PKW(pB1,6)};pw3=(u32x4){PKW(pB1,8),PKW(pB1,10),PKW(pB1,12),PKW(pB1,14)};
    SBAR(); pv(o,vb0+sl_cur,PAF(0),PAF(1),PAF(2),PAF(3)); }
  #undef PKW
  #undef PAF
  #undef VFR
  #undef PIN
  #undef MX3
  #undef GAPA
  #undef GAPB
  #undef EX
  #undef VRD
  #undef KRD
  #undef STEP
  #undef ENDW
  {auto rr=__builtin_amdgcn_permlane32_swap(__float_as_uint(l_reg),__float_as_uint(l_reg),false,false);l_reg=__uint_as_float(rr[0])+__uint_as_float(rr[1]);}
  if(hi==0)wsf[32+r32]=l_reg;asm volatile("s_waitcnt lgkmcnt(0)":::"memory");
  float rli[16];
  #pragma unroll
  for(int r=0;r<16;++r)rli[r]=__builtin_amdgcn_rcpf(wsf[32+crow(r,hi)]);
  bf16*Ow=O+(rowbase+q0+wid*QBLK)*OPITCH+h*D;
  { bf16*stg=(bf16*)(shm+LDS_OST)+wid*2048;
    #pragma unroll
    for(int r=0;r<16;++r){const int orow=crow(r,hi);
      #pragma unroll
      for(int d0=0;d0<2;++d0)stg[orow*64+d0*32+r32]=__float2bfloat16(o[d0][r]*rli[r]);}
    asm volatile("s_waitcnt lgkmcnt(0)":::"memory");
    #pragma unroll
    for(int i=0;i<4;++i){const int row=i*8+(lane>>3),ch=lane&7; const u32x4 v=*(const u32x4*)(stg+row*64+ch*8); ATTN_STORE16(Ow+(long)row*OPITCH+ch*8,v);} }
  asm volatile("s_waitcnt lgkmcnt(0)\n\ts_barrier":::"memory");
  #undef DMA_K
  #undef DMA_V
  #undef WLOAD
  #undef START
  #undef RESC
  #undef ROT
}
constexpr int ATTN_LDS_BYTES=LDS_BYTES;
struct AttnTensors { const bf16* Q; const bf16* K; const bf16* V; bf16* O; const unsigned* MASK; };
struct AttnUnit { int bh; int qb; };
struct StaticOrder {
  int vcu;
  int grid;
  __device__ __forceinline__ explicit StaticOrder(int grid_,int block):vcu((grid_%8==0)?(block%8)*(grid_/8)+block/8:block),grid(grid_){}
  __device__ __forceinline__ bool next(int i,AttnUnit&u)const{ const int v=vcu+(i>>2)*grid; if(v>=256)return false; const int k=i&3,s=v&7; u.bh=v>>3; u.qb=(k==0)?s:(k==1)?15-s:(k==2)?16+s:31-s; return true; }
  __device__ __forceinline__ void a_ready(const AttnUnit&)const{}
  __device__ __forceinline__ void done(const AttnUnit&)const{}
};
template<class Sched,int THRL=8> __device__ __forceinline__ void attn_phase(char*lds,const AttnTensors&T,const Sched&S){
  AttnUnit u;
  for(int i=0;S.next(i,u);++i){ S.a_ready(u); attn_unit<THRL>(u.bh/NHEAD,u.bh%NHEAD,u.qb,T.Q,T.K,T.V,T.O,T.MASK,lds); S.done(u); }
}
#undef SBAR
#undef WAIT_BAR
}

#ifndef MK_EN
#define MK_EN 0x3ff
#endif
#define EN(n) (((MK_EN) >> (n)) & 1)
#ifndef MK_NAIVE_SELECT
#define MK_NAIVE_SELECT 0
#endif
#ifndef MK_NAIVE_ATTN
#define MK_NAIVE_ATTN 0
#endif
#ifndef MK_DUP
#define MK_DUP 0
#endif
#ifndef MK_REPN
#define MK_REPN 1
#endif
#define REP(n) for (int rep_ = 0; rep_ < 1 + MK_REPN * (((MK_DUP) >> (n)) & 1); ++rep_)
#ifndef MK_ONE_LAUNCH
#define MK_ONE_LAUNCH 1
#endif
__device__ __forceinline__ bool static_unit(int nM, int nN, int G, int c, int i, int& pm, int& pn) {
    const int nwg = nM * nN; const long L = (long)i * G + c; if (L >= nwg) return false;
    int wgid = (int)L; { const int q = nwg / 8, r = nwg % 8, xcd = wgid % 8, off = wgid / 8; wgid = (xcd < r ? xcd * (q + 1) : r * (q + 1) + (xcd - r) * q) + off; }
    const int nig = 8 * nN, gid = wgid / nig, fm = gid * 8, gsz = (nM - fm) < 8 ? (nM - fm) : 8;
    pm = fm + ((wgid % nig) % gsz); pn = (wgid % nig) / gsz; return true;
}
__global__ void __launch_bounds__(NWAVES * 64, 2) mk_fwd(Args args) {
    extern __shared__ __attribute__((aligned(16))) unsigned char lds[];
    Frame F;
    F.lds = (LAS unsigned char*)lds; F.MISC = (volatile LAS unsigned*)(F.lds + MISC_OFF);
    F.tid = threadIdx.x; F.lane = F.tid & 63; F.wave = __builtin_amdgcn_readfirstlane(F.tid >> 6);
    F.G = gridDim.x; { const int bx = blockIdx.x; F.vcu = (F.G % 8 == 0) ? (bx % 8) * (F.G / 8) + bx / 8 : bx; }
    KArgs A = (KArgs)__builtin_amdgcn_kernarg_segment_ptr();
    unsigned char* ws = A->ws; F.ws = ws; F.ctl = (gu32*)(ws + WS_CTL);
#define PHASE_BEGIN() do { int t_ = threadIdx.x; asm volatile("" : "+v"(t_)); F.tid = t_; F.lane = t_ & 63; F.wave = __builtin_amdgcn_readfirstlane(t_ >> 6); \
        A = (KArgs)__builtin_amdgcn_kernarg_segment_ptr(); asm volatile("" : "+s"(A)); ws = A->ws; F.ws = ws; F.ctl = (gu32*)(ws + WS_CTL); } while (0)
    for (int u = F.tid; u < (LDS_BYTES - LDSCTL_OFF) / 4; u += NWAVES * 64) ((LAS unsigned*)(F.lds + LDSCTL_OFF))[u] = 0u;
    __syncthreads();
    const int lo = A->ph_lo, hi = A->ph_hi;
    XcdBarrier bar; bar.bar = (unsigned*)(F.ctl + CW_BAR); bar.x = 0; bar.st = nullptr;
    if (hi - lo > 1) bar = xcd_barrier_post((unsigned*)(F.ctl + CW_BAR), F.MISC + 8);
#define IN(k) (lo <= (k) && (k) < hi)
#define SEAM(k) do { if (IN(k) && IN((k) + 1)) xcd_barrier(bar); } while (0)
#define X ((bf16*)(ws + WS_X))
#define SSV(k) ((float*)(ws + WS_SS + (size_t)((k) & 1) * SS_STAGE))

    if (EN(0) && IN(0)) { PHASE_BEGIN(); REP(0) p0_prologue(F, A); SEAM(0); }
    for (int l = 0; l < DEPTH; ++l) {
        const int pb = 2 + 11 * l;
#define FFN_UP(PH, WGU, SSIN) if (EN(2) && IN(PH)) { PHASE_BEGIN(); unsigned char* wl = ws + WS_W + (size_t)l * W_LAYER; \
            pg8::Gemm g{X, (const bf16*)(wl + (WGU)), M, NGU, D}; pg8::StaticOrder S; S.init(M, NGU, F.G, (int)blockIdx.x); \
            pg8::EpiSwiGLU E{(bf16*)(ws + WS_H), SSV(SSIN)}; \
            REP(2) pg8::gemm_phase<pg8::EpiSwiGLU, pg8::StaticOrder, true, true>(F.lds + RING_OFF, g, S, E); SEAM(PH); }
#define GEMM_RES(PH, A, W, KK, SSOUT, SCALE, F8, WX8, AB) if (EN(3) && IN(PH)) { PHASE_BEGIN(); unsigned char* wl = ws + WS_W + (size_t)l * W_LAYER; \
            pg8::Gemm g{(const bf16*)(A), (const bf16*)(wl + (W)), M, D, (KK)}; pg8::StaticOrder S; S.init(M, D, F.G, (int)blockIdx.x); \
            REP(3) { const pg8::EpiRes<WX8> E{X, SSV(SSOUT), rep_ ? 0.f : (SCALE)}; pg8::gemm_phase<pg8::EpiRes<WX8>, pg8::StaticOrder, true, true, F8, AB>(F.lds + RING_OFF, g, S, E); } SEAM(PH); }
        FFN_UP(pb + 0, WO_GU1, 4 * l)
        GEMM_RES(pb + 1, ws + WS_H, WO_D1, FF / 2, 4 * l + 1, 0.5f / 64.f, true, false, true)
        if (EN(4) && IN(pb + 2)) { PHASE_BEGIN(); unsigned char* wl = ws + WS_W + (size_t)l * W_LAYER;
            pg8::Gemm g{(const bf16*)ws, (const bf16*)ws, M, NINP, D}; const pg8::WinKVOrder S{F.G, (int)blockIdx.x, (int)((WS_W + (size_t)l * W_LAYER + WO_IN) >> 19), l == 0 ? 64 : 0};
            const pg8::EpiWinKV E{ws, SSV(4 * l + 1), QSCALE, (int)((WS_W + (size_t)l * W_LAYER + WO_IN) >> 19)};
            REP(4) pg8::gemm_phase<pg8::EpiWinKV, pg8::WinKVOrder, true, true>(F.lds + RING_OFF, g, S, E); SEAM(pb + 2);
        }
        if (EN(5) && IN(pb + 3)) { PHASE_BEGIN(); REP(5) {
            REP(10) for (int u = F.vcu; u < M / 64; u += F.G) conv_a_unit(F, (const bf16*)(ws + WS_HG), (bf16*)(ws + WS_MIX), INF(A, I_CONF_DW) + l * 31 * 256, INF(A, I_CONF_DW_B) + l * 256, INF(A, I_CONF_LN_G) + l * 256, INF(A, I_CONF_LN_B) + l * 256, u);
            REP(11) conv_b_all(F, (const bf16*)(ws + WS_U), (const bf16*)(ws + WS_BG), (bf16*)(ws + WS_MIX), INF(A, I_SC_DW) + l * 3 * 256);
#if !MK_NAIVE_SELECT
            for (int u = F.tid; u < 32 * IX_HS + 192; u += NWAVES * 64) ((LAS unsigned*)(F.lds + RING_OFF))[u] = 0u;
            __syncthreads();
            for (int u = F.vcu; u < 1024; u += F.G) { int b, j; idx_unit_of(u, b, j); idx_unit(F, (const bf16*)(ws + WS_QI), (const bf16*)(ws + WS_KI), (const float*)(ws + WS_WI), (unsigned*)(ws + (l ? WS_MASK1 : WS_MASK)), b, j); }
#endif
            }
            SEAM(pb + 3);
        }
        if (EN(6) && IN(pb + 4)) { PHASE_BEGIN();
#if MK_NAIVE_SELECT
            for (int q = F.vcu; q < M; q += F.G) dsa_naive_query<false>(F, (const bf16*)(ws + WS_Q), (const bf16*)(ws + WS_K), (const bf16*)(ws + WS_V), (const bf16*)(ws + WS_QI), (const bf16*)(ws + WS_KI), (const float*)(ws + WS_WI), nullptr, (bf16*)(ws + WS_MIX), q);
#elif MK_NAIVE_ATTN
            for (int q = F.vcu; q < M; q += F.G) dsa_naive_query<true>(F, (const bf16*)(ws + WS_Q), (const bf16*)(ws + WS_K), (const bf16*)(ws + WS_V), (const bf16*)(ws + WS_QI), (const bf16*)(ws + WS_KI), (const float*)(ws + WS_WI), (const unsigned long long*)(ws + (l ? WS_MASK1 : WS_MASK)), (bf16*)(ws + WS_MIX), q);
#else
            { const attn_body::AttnTensors AT{(const attn_body::bf16*)(ws + WS_Q), (const attn_body::bf16*)(ws + WS_K), (const attn_body::bf16*)(ws + WS_V), (attn_body::bf16*)(ws + WS_MIX) + 512, (const unsigned*)(ws + (l ? WS_MASK1 : WS_MASK))};
              const attn_body::StaticOrder S((int)F.G, (int)blockIdx.x);
              REP(6) attn_body::attn_phase<attn_body::StaticOrder>((char*)lds + RING_OFF, AT, S); }
#endif
            SEAM(pb + 4);
        }
        GEMM_RES(pb + 5, ws + WS_MIX, WO_OUT, D, 4 * l + 2, 1.0f, false, true, false)
        if (EN(7) && IN(pb + 6)) { PHASE_BEGIN(); unsigned char* wl = ws + WS_W + (size_t)l * W_LAYER;
            pg8::Gemm g{(const bf16*)(ws + WS_X8), (const bf16*)(wl + WO_Q), M, D, D / 2}; pg8::StaticOrder S; S.init(M, D, F.G, (int)blockIdx.x);
            pg8::EpiRowScale E{(bf16*)(ws + WS_XQ), D, SSV(4 * l + 2), XQSCALE / 64.f};
            REP(7) pg8::gemm_phase<pg8::EpiRowScale, pg8::StaticOrder, true, true, true>(F.lds + RING_OFF, g, S, E);
            if (EN(8)) { PHASE_BEGIN(); for (int i = 0;; ++i) { int upm, upn; if (!static_unit(M / 256, D / 256, F.G, (int)blockIdx.x, i, upm, upn)) break; xattn_unit(F, (const bf16*)(ws + WS_XQ), ws + WS_XO8, (const bf16*)(ws + WS_MEMK) + (size_t)l * 1024 * 1024, (const bf16*)(ws + WS_MEMVT) + (size_t)l * 1024 * 1024, upm, upn); } }
            SEAM(pb + 6);
        }
        GEMM_RES(pb + 8, ws + WS_XO8, WO_O, D / 2, 4 * l + 3, 1.0f / 64.f, true, false, false)
        FFN_UP(pb + 9, WO_GU2, 4 * l + 3)
        GEMM_RES(pb + 10, ws + WS_H, WO_D2, FF / 2, 4 * l + 4, 0.5f / 64.f, true, false, true)
    }
    if (EN(9) && IN(NPH - 1)) { PHASE_BEGIN(); final_norm_all(F, X, SSV(4 * DEPTH), INF(A, I_FINAL_NORM), A->out); }
#undef IN
#undef SEAM
#undef X
#undef SSV
}

extern "C" void kernel_launch(void* const* d_in, const int* in_sizes, int n_in, void* d_out, int out_size, void* d_ws, size_t ws_size, hipStream_t stream) {
    static int grid = 0;
    if (grid == 0) {
        if (n_in != 25 || in_sizes[0] != M * D || out_size != M * D || ws_size < WS_END) { fprintf(stderr, "kernel_launch: unexpected shapes (n_in %d, in0 %d, out %d, ws %zu); nothing launched\n", n_in, n_in > 0 ? in_sizes[0] : -1, out_size, ws_size); grid = -1; return; }
        int dev = 0, cus = 0, per_cu = 0;
        if (hipGetDevice(&dev) != hipSuccess || hipDeviceGetAttribute(&cus, hipDeviceAttributeMultiprocessorCount, dev) != hipSuccess) { grid = -1; return; }
        if (hipFuncSetAttribute((const void*)mk_fwd, hipFuncAttributeMaxDynamicSharedMemorySize, LDS_BYTES) != hipSuccess) { fprintf(stderr, "kernel_launch: hipFuncSetAttribute failed\n"); grid = -1; return; }
        if (hipOccupancyMaxActiveBlocksPerMultiprocessor(&per_cu, (const void*)mk_fwd, NWAVES * 64, LDS_BYTES) != hipSuccess || per_cu < 1) { fprintf(stderr, "kernel_launch: occupancy query reports %d\n", per_cu); }
        (void)hipGetLastError();
        grid = cus;
    }
    if (grid < 0) return;
    if (hipMemsetAsync((char*)d_ws + WS_CTL, 0, CTL_ZERO_BYTES, stream) != hipSuccess) return;
    Args a{};
    for (int i = 0; i < 25; ++i) a.in[i] = d_in[i];
    a.out = (float*)d_out; a.ws = (unsigned char*)d_ws;
    for (int i = 0; i < 32; ++i) a.invf[i] = powf(10000.0f, -(float)(2 * i) / 64.0f);
#if MK_ONE_LAUNCH
    a.ph_lo = 0; a.ph_hi = NPH;
    hipLaunchKernelGGL(mk_fwd, dim3(grid), dim3(NWAVES * 64), LDS_BYTES, stream, a);
#else
    for (int p = 0; p < NPH; ++p) { a.ph_lo = p; a.ph_hi = p + 1; hipLaunchKernelGGL(mk_fwd, dim3(grid), dim3(NWAVES * 64), LDS_BYTES, stream, a); }
#endif
}
```

```cpp
#include <hip/hip_runtime.h>
#include <cstdio>
#include <cstdint>
#include <cmath>
constexpr int NWAVES = 8;
constexpr int M = 32768, D = 1024, FF = 2816, SEQ = 8192, NBATCH = 4, DEPTH = 2, NGU = 2 * FF  , NINP = 3328  , NIN = 3140;
constexpr int NPH = 2 + 11 * DEPTH + 1;
constexpr float QSCALE = 0.125f * 1.4426950408889634f;
constexpr float XQSCALE = 0.0625f * 1.4426950408889634f;
constexpr float IDX_SCALE = 0.5f * 0.125f;
constexpr size_t MiB = 1u << 20;
constexpr size_t WS_CTL = 0, CTL_ZERO_BYTES = 1 * MiB;
constexpr size_t WS_SS = 448 * MiB, SS_STAGE = 2 * MiB;
constexpr size_t WS_MSS = 3 * MiB;
constexpr size_t WS_COS = 4 * MiB, WS_SIN = 8 * MiB;
constexpr size_t WS_MK = 12 * MiB;
constexpr size_t WS_MEMK = 22 * MiB, WS_MEMVT = 26 * MiB;
constexpr size_t WS_W = 30 * MiB, W_LAYER = 45 * MiB + MiB / 2;
constexpr size_t WO_GU1 = 0, WO_D1 = 11 * MiB, WO_IN = WO_D1 + 5 * MiB + MiB / 2, WO_OUT = WO_IN + 6 * MiB + MiB / 2, WO_Q = WO_OUT + 2 * MiB, WO_O = WO_Q + 2 * MiB, WO_GU2 = WO_O + 2 * MiB, WO_D2 = WO_GU2 + 11 * MiB;
static_assert(WO_D2 + 5 * MiB + MiB / 2 == W_LAYER, "weight map");
constexpr size_t WS_X = 122 * MiB;
constexpr size_t WS_R = 186 * MiB;
constexpr size_t WS_H = WS_R;
constexpr size_t WS_HG = WS_R, WS_U = WS_R + 16 * MiB, WS_BG = WS_R + 32 * MiB, WS_Q = WS_R + 48 * MiB, WS_K = WS_R + 80 * MiB, WS_V = WS_R + 112 * MiB, WS_QI = WS_R + 144 * MiB,
                 WS_KI = WS_R + 160 * MiB, WS_WI = WS_R + 164 * MiB, WS_MIX = WS_R + 165 * MiB, WS_MASK = WS_R + 229 * MiB, WS_MIXEND = WS_R + 261 * MiB;
constexpr size_t WS_XQ = WS_R;
constexpr size_t WS_X8 = WS_R + 96 * MiB;
constexpr size_t WS_XO8 = WS_R + 64 * MiB;
constexpr size_t WS_MASK1 = 452 * MiB;
constexpr size_t WS_END = 484 * MiB;
static_assert(WS_W + 2 * W_LAYER <= WS_X && WS_X + (size_t)M * D * 2 <= WS_R && WS_H + (size_t)M * FF * 2 <= WS_END && WS_MIXEND <= WS_END, "d_ws map");
constexpr int CW_TMO = 0, CW_BAR = 4096;
constexpr int RING_OFF = 0, RING_BYTES = 131072, LDSCTL_OFF = 143360, MISC_OFF = LDSCTL_OFF + 320, LDS_BYTES = 147456;

namespace pg8 {
#define PG8_LAS __attribute__((address_space(3)))
typedef unsigned short bf16_t;
typedef short bf16x8 __attribute__((ext_vector_type(8)));
typedef float f32x4 __attribute__((ext_vector_type(4)));
typedef unsigned u32x4 __attribute__((ext_vector_type(4)));
constexpr int BM = 256, BK = 64, HALF = 128, HTB = HALF * BK * 2  , STAGE_BYTES = 8 * HTB, NXCD = 8, WGM = 8;

__host__ __device__ __forceinline__ int lds_byte(int r, int c) { const int st = (r >> 4) * 2 + (c >> 5), rr = r & 15, cc = c & 31, ob = rr * 64 + cc * 2; return st * 1024 + (ob ^ (((ob >> 9) & 1) << 5)); }
__host__ __device__ __forceinline__ void stage_rc(int b, int& R, int& C) { const int st = b / 1024, sb = b % 1024, swz = sb ^ (((sb >> 9) & 1) << 5); R = (st >> 1) * 16 + swz / 64; C = (st & 1) * 32 + (swz % 64) / 2; }
__host__ __device__ __forceinline__ int perm32(int rho) { const int n = rho >> 4, i = rho & 15; return 8 * (i >> 2) + 4 * n + (i & 3); }

struct Unit { int pm, pn; };
struct Gemm { const bf16_t* A; const bf16_t* Bt; int M, N, K; };

struct StaticOrder {
    int nM, nN, nwg, G, c;
    __host__ __device__ void init(int M, int N, int G_, int c_) { nM = M / BM; nN = N / BM; nwg = nM * nN; G = G_; c = c_; }
    __host__ __device__ bool next(int i, Unit& u) const {
        const long L = (long)i * G + c; if (L >= nwg) return false;
        int wgid = (int)L; { const int q = nwg / NXCD, r = nwg % NXCD, xcd = wgid % NXCD, off = wgid / NXCD; wgid = (xcd < r ? xcd * (q + 1) : r * (q + 1) + (xcd - r) * q) + off; }
        const int nig = WGM * nN, gid = wgid / nig, fm = gid * WGM, gsz = (nM - fm) < WGM ? (nM - fm) : WGM;
        u.pm = fm + ((wgid % nig) % gsz); u.pn = (wgid % nig) / gsz; return true;
    }
    __device__ __forceinline__ void a_ready(const Unit&) const {}
    __device__ __forceinline__ void done(const Unit&) const {}
};
__device__ __forceinline__ unsigned cvt_pk_bf16(float lo, float hi) { unsigned r; asm volatile("v_cvt_pk_bf16_f32 %0, %1, %2" : "=v"(r) : "v"(lo), "v"(hi)); return r; }
typedef float f32x2 __attribute__((ext_vector_type(2)));
typedef unsigned u32x2 __attribute__((ext_vector_type(2)));
__device__ __forceinline__ float bflo(unsigned w) { return __uint_as_float(w << 16); }
__device__ __forceinline__ float bfhi(unsigned w) { return __uint_as_float(w & 0xffff0000u); }
__device__ __forceinline__ float sigm(float x) { return __builtin_amdgcn_rcpf(1.f + __builtin_amdgcn_exp2f(-1.4426950408889634f * x)); }
__device__ __forceinline__ u32x4 pack8(const f32x4 a, const f32x4 b) { u32x4 w; w.x = cvt_pk_bf16(a[0], a[1]); w.y = cvt_pk_bf16(a[2], a[3]); w.z = cvt_pk_bf16(b[0], b[1]); w.w = cvt_pk_bf16(b[2], b[3]); return w; }
__device__ __forceinline__ float sumsq_of(const float* ss, int row) { const f32x4* p = (const f32x4*)(ss + (size_t)row * 16); const f32x4 a = p[0], b = p[1], c = p[2], d = p[3];
    return (((a[0] + a[1]) + (a[2] + a[3])) + ((b[0] + b[1]) + (b[2] + b[3]))) + (((c[0] + c[1]) + (c[2] + c[3])) + ((d[0] + d[1]) + (d[2] + d[3]))); }
__device__ __forceinline__ float rstd_of(const float* ss, int row) { return __builtin_amdgcn_rsqf(sumsq_of(ss, row) * (1.f / 1024.f) + 1e-6f); }
__device__ __forceinline__ float rstd_of4(const float* ss, int row, int fq) { const f32x4 a = *(const f32x4*)(ss + (size_t)row * 16 + fq * 4); float s = (a[0] + a[1]) + (a[2] + a[3]);
    s += __shfl_xor(s, 16); s += __shfl_xor(s, 32); return __builtin_amdgcn_rsqf(s * (1.f / 1024.f) + 1e-6f); }
__device__ __forceinline__ f32x4 rstd_ld4(const float* ss, int row, int fq) { return *(const f32x4*)(ss + (size_t)row * 16 + fq * 4); }
__device__ __forceinline__ float rstd_fin4(const f32x4 a) { float s = (a[0] + a[1]) + (a[2] + a[3]); s += __shfl_xor(s, 16); s += __shfl_xor(s, 32); return __builtin_amdgcn_rsqf(s * (1.f / 1024.f) + 1e-6f); }
__device__ __forceinline__ float rstd_of1(const float* ss, int row) { return __builtin_amdgcn_rsqf(ss[row] * (1.f / 1024.f) + 1e-6f); }
constexpr int FFH = 2816;

struct EpiSwiGLU {
    static constexpr bool PERM = true, AFTER_DRAIN = false;
    bf16_t* H; const float* ss;
    __device__ __forceinline__ void operator()(const f32x4 (&acc)[2][2][4][2], const Unit& u, int wr, int wc, int fr, int fq) const {
        asm volatile("" : "+v"(fr), "+v"(fq));
        const int row0 = u.pm * BM + wr * 64 + fr;
        unsigned char* const hb = (unsigned char*)H + (size_t)(u.pm * (FFH / 128) + u.pn) * 32768 + (((wr * 4 + wc) * 8) * 64 + (fq >> 1) * 32 + fr * 2 + (fq & 1)) * 8;
        f32x4 pa[2][4];
#pragma unroll
        for (int ai = 0; ai < 2; ++ai)
#pragma unroll
            for (int m = 0; m < 4; ++m) pa[ai][m] = rstd_ld4(ss, row0 + ai * HALF + m * 16, fq);
#pragma unroll
        for (int ai = 0; ai < 2; ++ai)
#pragma unroll
            for (int m = 0; m < 4; ++m) { const float rs = rstd_fin4(pa[ai][m]);
                const float rsl = rs * 1.4426950408889634f, rsu = rs * 0.6931471805599453f;
                f32x4 h0, h1;
#pragma unroll
                for (int n = 0; n < 2; ++n) { const f32x4 G = acc[ai][0][m][n], U = acc[ai][1][m][n]; f32x4 hv;
#pragma unroll
                    for (int q = 0; q < 2; ++q) { const f32x2 g2 = (f32x2){G[2 * q], G[2 * q + 1]} * rsl, u2 = (f32x2){U[2 * q], U[2 * q + 1]} * rsu;
                        f32x2 r2; r2.x = __builtin_amdgcn_rcpf(1.f + __builtin_amdgcn_exp2f(-g2.x)); r2.y = __builtin_amdgcn_rcpf(1.f + __builtin_amdgcn_exp2f(-g2.y));
                        const f32x2 o2 = g2 * u2 * r2; hv[2 * q] = o2.x; hv[2 * q + 1] = o2.y; }
                    if (n == 0) h0 = hv; else h1 = hv; }
                unsigned w0 = 0u, w1 = 0u;
                w0 = __builtin_amdgcn_cvt_pk_fp8_f32(h0[0], h0[1], w0, false); w0 = __builtin_amdgcn_cvt_pk_fp8_f32(h0[2], h0[3], w0, true); w1 = __builtin_amdgcn_cvt_pk_fp8_f32(h1[0], h1[1], w1, false); w1 = __builtin_amdgcn_cvt_pk_fp8_f32(h1[2], h1[3], w1, true);
                *(u32x2*)(hb + (ai * 4 + m) * 512) = (u32x2){w0, w1}; asm volatile("" ::: "memory"); }
    }
};
template <bool WX8> struct EpiRes {
    static constexpr bool PERM = true, AFTER_DRAIN = false;
    bf16_t* X; float* ssn; float scale;
    __device__ __forceinline__ void operator()(const f32x4 (&acc)[2][2][4][2], const Unit& u, int wr, int wc, int fr, int fq) const {
        asm volatile("" : "+v"(fr), "+v"(fq));
        const int row0 = u.pm * BM + wr * 64 + fr, col0 = u.pn * BM + wc * 32 + fq * 8;
        u32x4 xcur[2][2], xnxt[2][2];
#pragma unroll
        for (int h2 = 0; h2 < 2; ++h2)
#pragma unroll
            for (int bj = 0; bj < 2; ++bj) xcur[h2][bj] = *(const u32x4*)(X + (size_t)(row0 + h2 * 16) * 1024 + col0 + bj * HALF);
#pragma unroll
        for (int q = 0; q < 8; ++q) { const int ai = q >> 2, m = q & 3; const int row = row0 + ai * HALF + m * 16; float s = 0.f;
            if ((q & 1) == 0 && q + 2 < 8) {
#pragma unroll
                for (int h2 = 0; h2 < 2; ++h2)
#pragma unroll
                    for (int bj = 0; bj < 2; ++bj) { const int qn = q + 2 + h2; xnxt[h2][bj] = *(const u32x4*)(X + (size_t)(row0 + (qn >> 2) * HALF + (qn & 3) * 16) * 1024 + col0 + bj * HALF); } }
#pragma unroll
                for (int bj = 0; bj < 2; ++bj) { bf16_t* p = X + (size_t)row * 1024 + col0 + bj * HALF; const u32x4 xv = xcur[q & 1][bj];
                    f32x4 a = acc[ai][bj][m][0] * scale, b = acc[ai][bj][m][1] * scale;
                    a[0] += bflo(xv.x); a[1] += bfhi(xv.x); a[2] += bflo(xv.y); a[3] += bfhi(xv.y); b[0] += bflo(xv.z); b[1] += bfhi(xv.z); b[2] += bflo(xv.w); b[3] += bfhi(xv.w);
                    const u32x4 w = pack8(a, b); *(u32x4*)p = w;
                    if constexpr (WX8) { unsigned q0 = 0u, q1 = 0u; q0 = __builtin_amdgcn_cvt_pk_fp8_f32(bflo(w.x), bfhi(w.x), q0, false); q0 = __builtin_amdgcn_cvt_pk_fp8_f32(bflo(w.y), bfhi(w.y), q0, true); q1 = __builtin_amdgcn_cvt_pk_fp8_f32(bflo(w.z), bfhi(w.z), q1, false); q1 = __builtin_amdgcn_cvt_pk_fp8_f32(bflo(w.w), bfhi(w.w), q1, true);
                        *(u32x2*)((unsigned char*)X + (WS_X8 - WS_X) + (size_t)row * 1024 + col0 + bj * HALF) = (u32x2){q0, q1}; }
                    s += (bflo(w.x) * bflo(w.x) + bfhi(w.x) * bfhi(w.x)) + (bflo(w.y) * bflo(w.y) + bfhi(w.y) * bfhi(w.y)) + (bflo(w.z) * bflo(w.z) + bfhi(w.z) * bfhi(w.z)) + (bflo(w.w) * bflo(w.w) + bfhi(w.w) * bfhi(w.w)); }
                s += __shfl_xor(s, 16); s += __shfl_xor(s, 32);
                if (fq == 0) ssn[(size_t)row * 16 + u.pn * 4 + wc] = s;
            if (q & 1) { asm volatile("" ::: "memory");
#pragma unroll
                for (int h2 = 0; h2 < 2; ++h2)
#pragma unroll
                    for (int bj = 0; bj < 2; ++bj) xcur[h2][bj] = xnxt[h2][bj]; } }
    }
};
struct EpiRowScale {
    static constexpr bool PERM = true, AFTER_DRAIN = false;
    bf16_t* O; int ldc; const float* ss; float scale;
    __device__ __forceinline__ void operator()(const f32x4 (&acc)[2][2][4][2], const Unit& u, int wr, int wc, int fr, int fq) const {
        asm volatile("" : "+v"(fr), "+v"(fq));
        const int row0 = u.pm * BM + wr * 64 + fr, col0 = u.pn * BM + wc * 32 + fq * 8;
#pragma unroll
        for (int ai = 0; ai < 2; ++ai)
#pragma unroll
            for (int m = 0; m < 4; ++m) { const int row = row0 + ai * HALF + m * 16; const float rs = rstd_of4(ss, row, fq) * scale;
#pragma unroll
                for (int bj = 0; bj < 2; ++bj) *(u32x4*)(O + (size_t)row * ldc + col0 + bj * HALF) = pack8(acc[ai][bj][m][0] * rs, acc[ai][bj][m][1] * rs); asm volatile("" ::: "memory"); }
    }
};
struct EpiWin {
    static constexpr bool PERM = true, AFTER_DRAIN = false;
    unsigned char* ws; const float* ss; float qscale;
    __device__ __forceinline__ void operator()(const f32x4 (&acc)[2][2][4][2], const Unit& u, int wr, int wc, int fr, int fq) const {
        asm volatile("" : "+v"(fr), "+v"(fq));
        const int row0 = u.pm * BM + wr * 64 + fr, t = u.pn, c8 = wc * 32 + fq * 8;
        bf16_t* const HG = (bf16_t*)(ws + WS_HG); bf16_t* const U = (bf16_t*)(ws + WS_U); bf16_t* const BG = (bf16_t*)(ws + WS_BG); bf16_t* const Q = (bf16_t*)(ws + WS_Q); bf16_t* const K = (bf16_t*)(ws + WS_K);
        bf16_t* const V = (bf16_t*)(ws + WS_V); bf16_t* const QI = (bf16_t*)(ws + WS_QI); bf16_t* const KI = (bf16_t*)(ws + WS_KI); float* const WI = (float*)(ws + WS_WI); const float* const cs = (const float*)(ws + WS_COS); const float* const sn = (const float*)(ws + WS_SIN);
        float rsv[8];
        { f32x4 pa[8];
#pragma unroll
          for (int q = 0; q < 8; ++q) pa[q] = rstd_ld4(ss, row0 + (q >> 2) * HALF + (q & 3) * 16, fq);
#pragma unroll
          for (int q = 0; q < 8; ++q) rsv[q] = rstd_fin4(pa[q]); }
        asm volatile("" ::: "memory");
        if (t < 5 || t == 9 || t == 10) {
#pragma unroll
            for (int q = 0; q < 8; ++q) { const int ai = q >> 2, m = q & 3; const int row = row0 + ai * HALF + m * 16; const float rs = rsv[q];
                const f32x4 a0 = acc[ai][0][m][0] * rs, a1 = acc[ai][0][m][1] * rs, b0 = acc[ai][1][m][0] * rs, b1 = acc[ai][1][m][1] * rs;
                if (t < 2) { f32x4 o0, o1;
#pragma unroll
                    for (int j = 0; j < 4; ++j) { o0[j] = a0[j] * sigm(b0[j]); o1[j] = a1[j] * sigm(b1[j]); }
                    *(u32x4*)(HG + (size_t)row * 256 + t * 128 + c8) = pack8(o0, o1); }
                else if (t < 4) { *(u32x4*)(U + (size_t)row * 256 + (t - 2) * 128 + c8) = pack8(a0 * b0, a1 * b1); }
                else if (t == 4) { *(u32x4*)(BG + (size_t)row * 256 + c8) = pack8(a0, a1); *(u32x4*)(BG + (size_t)row * 256 + 128 + c8) = pack8(b0, b1); }
                else { *(u32x4*)(V + (size_t)row * 512 + (t - 9) * 256 + c8) = pack8(a0, a1); *(u32x4*)(V + (size_t)row * 512 + (t - 9) * 256 + 128 + c8) = pack8(b0, b1); }
                asm volatile("" ::: "memory"); }
        } else {
            f32x4 cc[4], cn[4];
            { const size_t o = (size_t)row0 * 32 + fq * 8; cc[0] = *(const f32x4*)(cs + o); cc[1] = *(const f32x4*)(cs + o + 4); cc[2] = *(const f32x4*)(sn + o); cc[3] = *(const f32x4*)(sn + o + 4); }
#pragma unroll
            for (int q = 0; q < 8; ++q) { const int ai = q >> 2, m = q & 3; const int row = row0 + ai * HALF + m * 16; const float rs = rsv[q];
                if (q + 1 < 8) { const size_t o = (size_t)(row0 + ((q + 1) >> 2) * HALF + ((q + 1) & 3) * 16) * 32 + fq * 8; cn[0] = *(const f32x4*)(cs + o); cn[1] = *(const f32x4*)(cs + o + 4); cn[2] = *(const f32x4*)(sn + o); cn[3] = *(const f32x4*)(sn + o + 4); }
                const f32x4 a0 = acc[ai][0][m][0] * rs, a1 = acc[ai][0][m][1] * rs, b0 = acc[ai][1][m][0] * rs, b1 = acc[ai][1][m][1] * rs;
                const f32x4 c0 = cc[0], c1 = cc[1], s0 = cc[2], s1 = cc[3];
                f32x4 p0 = a0 * c0 - b0 * s0, p1 = a1 * c1 - b1 * s1, r0 = b0 * c0 + a0 * s0, r1 = b1 * c1 + a1 * s1;
                if (t < 7) { bf16_t* d = Q + (size_t)row * 512 + ((t - 5) * 4 + wc) * 64 + fq * 8; *(u32x4*)d = pack8(p0 * qscale, p1 * qscale); *(u32x4*)(d + 32) = pack8(r0 * qscale, r1 * qscale); }
                else if (t < 9) { bf16_t* d = K + (size_t)row * 512 + ((t - 7) * 4 + wc) * 64 + fq * 8; *(u32x4*)d = pack8(p0, p1); *(u32x4*)(d + 32) = pack8(r0, r1); }
                else if (t == 11) { bf16_t* d = QI + (size_t)row * 256 + wc * 64 + fq * 8; *(u32x4*)d = pack8(p0, p1); *(u32x4*)(d + 32) = pack8(r0, r1); }
                else { if (wc == 0) { bf16_t* d = KI + ((((size_t)(row >> 5) * 4 + (fq >> 1)) * 64 + (fq & 1) * 32 + (row & 31)) << 3); *(u32x4*)d = pack8(p0, p1); *(u32x4*)(d + 1024) = pack8(r0, r1); }
                       if (wc == 1 && fq == 0) *(f32x4*)(WI + (size_t)row * 4) = b0; }
                asm volatile("" ::: "memory");
#pragma unroll
                for (int i = 0; i < 4; ++i) cc[i] = cn[i]; }
        }
    }
};
struct EpiMemKV {
    static constexpr bool PERM = true, AFTER_DRAIN = false;
    bf16_t *MEMK, *MEMVT; const float* mss;
    __device__ __forceinline__ void operator()(const f32x4 (&acc)[2][2][4][2], const Unit& u, int wr, int wc, int fr, int fq) const {
        asm volatile("" : "+v"(fr), "+v"(fq));
        const bool isv = u.pm >= 4; const int l = isv ? ((u.pm - 8) >> 3) : ((u.pn - 4) >> 3);
        const int pr = isv ? ((u.pm - 8) & 7) : u.pm, pc = isv ? u.pn : ((u.pn - 4) & 7);
        bf16_t* O = (isv ? MEMVT : MEMK) + (size_t)l * 1024 * 1024;
        const int row0 = pr * BM + wr * 64 + fr, col0 = pc * BM + wc * 32 + fq * 8;
#pragma unroll
        for (int ai = 0; ai < 2; ++ai)
#pragma unroll
            for (int m = 0; m < 4; ++m) { const int row = row0 + ai * HALF + m * 16; const float rsr = isv ? 1.f : rstd_of1(mss, row);
#pragma unroll
                for (int bj = 0; bj < 2; ++bj) { f32x4 a = acc[ai][bj][m][0] * rsr, b = acc[ai][bj][m][1] * rsr;
                    if (isv) {
#pragma unroll
                        for (int j = 0; j < 4; ++j) { a[j] *= rstd_of1(mss, col0 + bj * HALF + j); b[j] *= rstd_of1(mss, col0 + bj * HALF + 4 + j); } }
                    *(u32x4*)(O + (size_t)row * 1024 + col0 + bj * HALF) = pack8(a, b); } asm volatile("" ::: "memory"); }
    }
};
struct MemKVOrder {
    int G, c;
    __device__ __forceinline__ bool next(int i, Unit& u) const {
        const int L = i * G + c; if (L >= 64) return false;
        const int ty = L >> 4, a = (L >> 2) & 3, b = L & 3, l = ty & 1;
        if (ty < 2) { u.pm = a; u.pn = 4 + 8 * l + b; } else { u.pm = 8 + 8 * l + a; u.pn = b; }
        return true;
    }
    __device__ __forceinline__ void a_ready(const Unit&) const {}
    __device__ __forceinline__ void done(const Unit&) const {}
};

constexpr int TILE_X = (int)(WS_X >> 19), TILE_MK = (int)(WS_MK >> 19);
static_assert((WS_X & ((1u << 19) - 1)) == 0 && (WS_MK & ((1u << 19) - 1)) == 0 && ((WS_W + WO_IN) & ((1u << 19) - 1)) == 0 && (W_LAYER & ((1u << 19) - 1)) == 0, "tile-aligned operands");
struct WinKVOrder {
    int G, c, tin, nkv;
    __device__ __forceinline__ bool next(int i, Unit& u) const {
        const int nwin = 128 * 13; const long L0 = (long)i * G + c; if (L0 >= nwin + nkv) return false;
        int L = (int)L0;
        if (L < nwin) { int wgid = L; { const int q = nwin / 8, xcd = wgid % 8, off = wgid / 8; wgid = xcd * q + off; }
            const int nig = 8 * 13, gid = wgid / nig, fm = gid * 8; u.pm = TILE_X + fm + ((wgid % nig) % 8); u.pn = tin + (wgid % nig) / 8; return true; }
        L -= nwin; const int ty = L >> 4, a = (L >> 2) & 3, b = L & 3, l = ty & 1;
        if (ty < 2) { u.pm = TILE_MK + a; u.pn = TILE_MK + 4 + 8 * l + b; } else { u.pm = TILE_MK + 8 + 8 * l + a; u.pn = TILE_MK + b; }
        return true;
    }
    __device__ __forceinline__ void a_ready(const Unit&) const {}
    __device__ __forceinline__ void done(const Unit&) const {}
};
struct EpiWinKV {
    static constexpr bool PERM = true, AFTER_DRAIN = false;
    unsigned char* ws; const float* ss; float qscale; int tin;
    __device__ __forceinline__ void operator()(const f32x4 (&acc)[2][2][4][2], const Unit& u, int wr, int wc, int fr, int fq) const {
        if (u.pm >= TILE_X) { const EpiWin W{ws, ss, qscale}; const Unit v{u.pm - TILE_X, u.pn - tin}; W(acc, v, wr, wc, fr, fq); }
        else { const EpiMemKV KV{(bf16_t*)(ws + WS_MEMK), (bf16_t*)(ws + WS_MEMVT), (const float*)(ws + WS_MSS)}; const Unit v{u.pm - TILE_MK, u.pn - TILE_MK}; KV(acc, v, wr, wc, fr, fq); }
    }
};

template <class Epi, class Sched, bool ALIGN_EPI = false, bool SP2 = false, bool FP8 = false, bool ABLK = false>
__device__ __forceinline__ void gemm_phase(PG8_LAS unsigned char* lds, const Gemm g, const Sched& S, const Epi& E) {
    int tid_ = threadIdx.x; asm volatile("" : "+v"(tid_));
    const int tid = tid_, wid = __builtin_amdgcn_readfirstlane(tid >> 6), lane = tid & 63, wr = wid >> 2, wc = wid & 3, fr = lane & 15, fq = lane >> 4;
    const int K = g.K, nt = K / BK;
    unsigned voffA[2], voffB[2];
#pragma unroll
    for (int i = 0; i < 2; ++i) { int R, C; stage_rc(tid * 16 + i * 8192, R, C); const int Rb = Epi::PERM ? ((R & ~31) + perm32(R & 31)) : R;
        voffA[i] = ABLK ? (unsigned)(((((R >> 6) * 4 + (C >> 4)) * 8 + ((R >> 4) & 3)) * 64 + ((C >> 3) & 1) * 32 + (R & 15) * 2) * 8) : (unsigned)(R * K + C) * 2u; voffB[i] = (unsigned)(Rb * K + C) * 2u; }
    const size_t kstep = (size_t)(BK * 2);
    const size_t hstep = (size_t)HALF * K * 2;
    const size_t kstepA = ABLK ? (size_t)32768 : kstep, hstepA = ABLK ? (size_t)2048 : hstep;
    const size_t tstep = 2 * hstep;
    const unsigned ldsw = (unsigned)wid * 1024u;
    const int aoff = lds_byte(wr * 64 + fr, fq * 8), boff = lds_byte(wc * 32 + fr, fq * 8);
#define PG8_SA(b, h) (((b) * 2 + (h)) * HTB)
#define PG8_SB(b, h) ((4 + (b) * 2 + (h)) * HTB)
#define PG8_STAGE(bufoff, gbase, voff) do { _Pragma("unroll") for (int _i = 0; _i < 2; ++_i) \
        __builtin_amdgcn_global_load_lds((const unsigned*)((const char*)(gbase) + (voff)[_i]), (PG8_LAS unsigned*)(lds + (bufoff) + ldsw + _i * 8192), 16, 0, 0); } while (0)
#define PG8_LDA(dst, b, h) do { _Pragma("unroll") for (int m = 0; m < 4; ++m) _Pragma("unroll") for (int k = 0; k < 2; ++k) dst[m][k] = *(const PG8_LAS bf16x8*)(lds + PG8_SA(b, h) + aoff + m * 2048 + k * 1024); } while (0)
#define PG8_LDB(dst, b, h) do { _Pragma("unroll") for (int n = 0; n < 2; ++n) _Pragma("unroll") for (int k = 0; k < 2; ++k) dst[n][k] = *(const PG8_LAS bf16x8*)(lds + PG8_SB(b, h) + boff + n * 2048 + k * 1024); } while (0)
#define PG8_MMA(ai, bj, At, Bt) do { __builtin_amdgcn_s_setprio(1); _Pragma("unroll") for (int m = 0; m < 4; ++m) _Pragma("unroll") for (int n = 0; n < 2; ++n) { \
        if constexpr (FP8) { typedef int v4i_ __attribute__((ext_vector_type(4))); typedef int v8i_ __attribute__((ext_vector_type(8))); \
            const v8i_ b8 = __builtin_shufflevector(__builtin_bit_cast(v4i_, Bt[n][0]), __builtin_bit_cast(v4i_, Bt[n][1]), 0, 1, 2, 3, 4, 5, 6, 7), a8 = __builtin_shufflevector(__builtin_bit_cast(v4i_, At[m][0]), __builtin_bit_cast(v4i_, At[m][1]), 0, 1, 2, 3, 4, 5, 6, 7); \
            asm volatile("v_mfma_scale_f32_16x16x128_f8f6f4 %0, %1, %2, %0, %3, %3 op_sel_hi:[0,0,0]" : "+v"(acc[ai][bj][m][n]) : "v"(b8), "v"(a8), "v"(0x7f7f7f7f)); }   \
        else { _Pragma("unroll") for (int k = 0; k < 2; ++k) acc[ai][bj][m][n] = __builtin_amdgcn_mfma_f32_16x16x32_bf16(Bt[n][k], At[m][k], acc[ai][bj][m][n], 0, 0, 0); } } \
        __builtin_amdgcn_s_setprio(0); } while (0)
#define PG8_WAIT_V(n) asm volatile("s_waitcnt vmcnt(" #n ")" ::: "memory")
#define PG8_WAIT_V8_UNLESS_FIRST(t) asm volatile("s_cmp_eq_u32 %0, 0\n\ts_cbranch_scc1 .Lpg8skip%=\n\ts_waitcnt vmcnt(8)\n.Lpg8skip%=:" :: "s"(t) : "scc", "memory")
#define PG8_WAIT_L(n) asm volatile("s_waitcnt lgkmcnt(" #n ")" ::: "memory")
#define PG8_BAR __builtin_amdgcn_s_barrier()
#define PG8_SCHED __builtin_amdgcn_sched_barrier(0)
    Unit cur, nxt; int ui = 0;
    if (!S.next(0, cur)) return;
    f32x4 acc[2][2][4][2];
#pragma unroll
    for (int a = 0; a < 2; ++a)
#pragma unroll
        for (int b = 0; b < 2; ++b)
#pragma unroll
            for (int m = 0; m < 4; ++m)
#pragma unroll
                for (int n = 0; n < 2; ++n) acc[a][b][m][n] = (f32x4){0.f, 0.f, 0.f, 0.f};
    bf16x8 At[4][2], B0[2][2], B1[2][2];
    const char* cA = (const char*)g.A + (size_t)cur.pm * tstep; const char* cB = (const char*)g.Bt + (size_t)cur.pn * tstep;
    S.a_ready(cur);
    if constexpr (SP2) {
        PG8_STAGE(PG8_SB(0, 0), cB, voffB); PG8_STAGE(PG8_SB(0, 1), cB + hstep, voffB); PG8_STAGE(PG8_SA(0, 0), cA, voffA); PG8_STAGE(PG8_SA(0, 1), cA + hstepA, voffA);
        if (wr == 1) PG8_BAR;
        PG8_WAIT_V(2); PG8_BAR;
        PG8_STAGE(PG8_SB(1, 0), cB + kstep, voffB); PG8_STAGE(PG8_SA(1, 0), cA + kstepA, voffA); PG8_STAGE(PG8_SB(1, 1), cB + hstep + kstep, voffB);
        PG8_WAIT_V(0); PG8_BAR;
    } else {
        PG8_STAGE(PG8_SB(0, 0), cB, voffB); PG8_STAGE(PG8_SA(0, 0), cA, voffA); PG8_STAGE(PG8_SB(0, 1), cB + hstep, voffB); PG8_STAGE(PG8_SA(0, 1), cA + hstepA, voffA);
        if (wr == 1) PG8_BAR;
        PG8_WAIT_V(4); PG8_BAR;
        PG8_STAGE(PG8_SB(1, 0), cB + kstep, voffB); PG8_STAGE(PG8_SA(1, 0), cA + kstepA, voffA); PG8_STAGE(PG8_SB(1, 1), cB + hstep + kstep, voffB);
        PG8_WAIT_V(6); PG8_BAR;
    }
    for (;;) {
        const bool has_next = S.next(ui + 1, nxt);
        const char* nA = has_next ? (const char*)g.A + (size_t)nxt.pm * tstep : cA; const char* nB = has_next ? (const char*)g.Bt + (size_t)nxt.pn * tstep : cB;
        for (int t = 0; t < nt; t += 2) {
            const bool last = (t == nt - 2);
            const char* a1 = cA + (size_t)(t + 1) * kstepA;
            const char* a2 = last ? nA : cA + (size_t)(t + 2) * kstepA; const char* b2 = last ? nB : cB + (size_t)(t + 2) * kstep;
            const char* a3 = a2 + kstepA; const char* b3 = b2 + kstep;
            if (last && has_next) S.a_ready(nxt);
            if constexpr (SP2) {
            PG8_LDB(B0, 0, 0); PG8_LDB(B1, 0, 1); PG8_SCHED; PG8_LDA(At, 0, 0); PG8_STAGE(PG8_SA(1, 1), a1 + hstepA, voffA);
            PG8_WAIT_V8_UNLESS_FIRST(t); PG8_WAIT_L(0); PG8_BAR; PG8_MMA(0, 0, At, B0); PG8_MMA(0, 1, At, B1); PG8_BAR; PG8_SCHED;
            PG8_LDA(At, 0, 1); PG8_STAGE(PG8_SB(0, 0), b2, voffB); PG8_STAGE(PG8_SB(0, 1), b2 + hstep, voffB); PG8_STAGE(PG8_SA(0, 0), a2, voffA);
            PG8_WAIT_V8_UNLESS_FIRST(t); PG8_WAIT_L(0); PG8_BAR; PG8_MMA(1, 0, At, B0); PG8_MMA(1, 1, At, B1); PG8_BAR; PG8_SCHED;
            PG8_LDB(B0, 1, 0); PG8_LDB(B1, 1, 1); PG8_SCHED; PG8_LDA(At, 1, 0); PG8_STAGE(PG8_SA(0, 1), a2 + hstepA, voffA);
            PG8_WAIT_V(8); PG8_WAIT_L(0); PG8_BAR; PG8_MMA(0, 0, At, B0); PG8_MMA(0, 1, At, B1); PG8_BAR; PG8_SCHED;
            PG8_LDA(At, 1, 1); PG8_STAGE(PG8_SB(1, 0), b3, voffB); PG8_STAGE(PG8_SB(1, 1), b3 + hstep, voffB); PG8_STAGE(PG8_SA(1, 0), a3, voffA);
            PG8_WAIT_V(8); PG8_WAIT_L(0); PG8_BAR; PG8_MMA(1, 0, At, B0); PG8_MMA(1, 1, At, B1); PG8_BAR; PG8_SCHED;
            } else {
            PG8_LDB(B0, 0, 0); PG8_SCHED; PG8_LDA(At, 0, 0); PG8_STAGE(PG8_SA(1, 1), a1 + hstepA, voffA);
            PG8_WAIT_L(8); PG8_BAR; PG8_WAIT_L(0); PG8_MMA(0, 0, At, B0); PG8_BAR; PG8_SCHED;
            PG8_LDB(B1, 0, 1); PG8_STAGE(PG8_SB(0, 0), b2, voffB);
            PG8_BAR; PG8_WAIT_L(0); PG8_MMA(0, 1, At, B1); PG8_BAR;
            PG8_LDA(At, 0, 1); PG8_STAGE(PG8_SA(0, 0), a2, voffA);
            PG8_BAR; PG8_WAIT_L(0); PG8_MMA(1, 0, At, B0); PG8_BAR; PG8_SCHED;
            PG8_STAGE(PG8_SB(0, 1), b2 + hstep, voffB);
            PG8_WAIT_V(6); PG8_BAR; PG8_MMA(1, 1, At, B1); PG8_BAR;
            PG8_LDB(B0, 1, 0); PG8_SCHED; PG8_LDA(At, 1, 0); PG8_STAGE(PG8_SA(0, 1), a2 + hstepA, voffA);
            PG8_WAIT_L(8); PG8_BAR; PG8_WAIT_L(0); PG8_MMA(0, 0, At, B0); PG8_BAR; PG8_SCHED;
            PG8_LDB(B1, 1, 1); PG8_STAGE(PG8_SB(1, 0), b3, voffB);
            PG8_BAR; PG8_WAIT_L(0); PG8_MMA(0, 1, At, B1); PG8_BAR;
            PG8_LDA(At, 1, 1); PG8_STAGE(PG8_SA(1, 0), a3, voffA);
            PG8_BAR; PG8_WAIT_L(0); PG8_MMA(1, 0, At, B0); PG8_BAR; PG8_SCHED;
            PG8_STAGE(PG8_SB(1, 1), b3 + hstep, voffB);
            PG8_WAIT_V(6); PG8_BAR; PG8_MMA(1, 1, At, B1); PG8_BAR;
            }
        }
        if constexpr (SP2) PG8_WAIT_V(0);
        if constexpr (FP8) asm volatile("s_nop 15\n\ts_nop 15" ::: "memory");
        if constexpr (ALIGN_EPI) { if (wr == 0) PG8_BAR; }
        if constexpr (!Epi::AFTER_DRAIN) { E(acc, cur, wr, wc, fr, fq); S.done(cur); }
        if (!has_next) break;
#pragma unroll
        for (int a = 0; a < 2; ++a)
#pragma unroll
            for (int b = 0; b < 2; ++b)
#pragma unroll
                for (int m = 0; m < 4; ++m)
#pragma unroll
                    for (int n = 0; n < 2; ++n) acc[a][b][m][n] = (f32x4){0.f, 0.f, 0.f, 0.f};
        cur = nxt; cA = nA; cB = nB; ++ui;
        if constexpr (ALIGN_EPI) { if (wr == 1) PG8_BAR; }
    }
    PG8_WAIT_V(0);
    if constexpr (!ALIGN_EPI) { if (wr == 0) PG8_BAR; }
    PG8_BAR;
    if constexpr (Epi::AFTER_DRAIN) { E.fused(acc, cur, wr, wc, fr, fq, lds, wid, lane); S.done(cur); }
#undef PG8_SA
#undef PG8_SB
#undef PG8_STAGE
#undef PG8_LDA
#undef PG8_LDB
#undef PG8_MMA
#undef PG8_WAIT_V
#undef PG8_WAIT_L
#undef PG8_WAIT_V8_UNLESS_FIRST
#undef PG8_BAR
#undef PG8_SCHED
}
}
#define GAS __attribute__((address_space(1)))
#define LAS __attribute__((address_space(3)))
typedef unsigned short bf16;
typedef unsigned v4u __attribute__((ext_vector_type(4)));
typedef float f32x4 __attribute__((ext_vector_type(4)));
typedef short bf16x8 __attribute__((ext_vector_type(8)));
typedef GAS unsigned gu32;
typedef GAS unsigned long long gu64;
#define RLX_AGENT __ATOMIC_RELAXED, __HIP_MEMORY_SCOPE_AGENT
#define LDS_WAIT() asm volatile("s_waitcnt lgkmcnt(0)" ::: "memory")
#define VM_WAIT() asm volatile("s_waitcnt vmcnt(0)" ::: "memory")
__device__ __forceinline__ unsigned long long rt() { return __builtin_amdgcn_s_memrealtime(); }
__device__ __forceinline__ unsigned f2bf(float f) { unsigned u = __builtin_bit_cast(unsigned, f); return (u + 0x7fffu + ((u >> 16) & 1u)) >> 16; }
__device__ __forceinline__ unsigned pk2(float lo, float hi) { return f2bf(lo) | (f2bf(hi) << 16); }

#define XB_TMO      128
#define XB_XCNT(j)  (256  + 64 * (j))
#define XB_XSUB(j)  (1280 + 64 * (j))
#define XB_XGEN(j)  (2304 + 64 * (j))
#define XB_TOP      3328
#define XB_TOPGEN   3392
#define XCD_BAR_WORDS 3456
#define XB_SPIN_CAP (1u << 18)

__device__ __forceinline__ unsigned xb_ld(unsigned* p)              { return __hip_atomic_load(p, __ATOMIC_RELAXED, __HIP_MEMORY_SCOPE_AGENT); }
__device__ __forceinline__ unsigned xb_add(unsigned* p, unsigned v) { return __hip_atomic_fetch_add(p, v, __ATOMIC_RELAXED, __HIP_MEMORY_SCOPE_AGENT); }
__device__ __forceinline__ unsigned xb_xcc_id() { return (unsigned)__builtin_amdgcn_s_getreg((3 << 11) | 20) & 0xFu; }
#define XB_SPIN(cond, bar) do { unsigned _sp = 0; while (cond) { __builtin_amdgcn_s_sleep(1); \
    if ((++_sp & 255u) == 0u) { if (xb_ld(&(bar)[XB_TMO])) break; if (_sp > XB_SPIN_CAP) { atomicAdd(&(bar)[XB_TMO], 1u); break; } } } } while (0)

struct XcdBarrier {
    unsigned* bar; unsigned x;
    volatile LAS unsigned* st;
};

__device__ __forceinline__ XcdBarrier xcd_barrier_post(unsigned* bar, volatile LAS unsigned* st) {
    XcdBarrier b; b.bar = bar; b.x = xb_xcc_id(); b.st = st;
    if (threadIdx.x == 0) (void)xb_add(&bar[XB_XCNT(b.x)], 1u);
    return b;
}
__device__ __forceinline__ void xcd_barrier_complete(unsigned* bar, unsigned x, unsigned& nloc, unsigned& nx) {
    const unsigned G = gridDim.x * gridDim.y * gridDim.z;
    unsigned sum, cnt, mine, sp = 0u;
    for (;;) {
        sum = 0u; cnt = 0u; mine = 0u;
#pragma unroll
        for (unsigned j = 0; j < 16; ++j) { const unsigned c = xb_ld(&bar[XB_XCNT(j)]); sum += c; cnt += (c > 0u) ? 1u : 0u; mine = (j == x) ? c : mine; }
        if (sum == G) break;
        __builtin_amdgcn_s_sleep(1);
        if ((++sp & 255u) == 0u) { if (xb_ld(&bar[XB_TMO])) break; if (sp > XB_SPIN_CAP) { atomicAdd(&bar[XB_TMO], 1u); break; } }
    }
    nloc = mine > 0u ? mine : 1u; nx = cnt > 0u ? cnt : 1u;
}

__device__ __forceinline__ void xcd_barrier(const XcdBarrier& b) {
    asm volatile("s_waitcnt vmcnt(0)" ::: "memory");
    __syncthreads();
    if (threadIdx.x == 0) {
        unsigned* bar = b.bar;
        __builtin_amdgcn_s_waitcnt(0);
        unsigned nloc = b.st[0], nx = b.st[1];
        if (nloc == 0u) { xcd_barrier_complete(bar, b.x, nloc, nx); b.st[0] = nloc; b.st[1] = nx; }
        const unsigned old = xb_add(&bar[XB_XSUB(b.x)], 1u);
        const unsigned gen = old / nloc;
        if (old + 1u == (gen + 1u) * nloc) {
            __builtin_amdgcn_fence(__ATOMIC_RELEASE, "agent");
            asm volatile("s_waitcnt vmcnt(0)" ::: "memory");
            const unsigned og = xb_add(&bar[XB_TOP], 1u);
            const unsigned tg = og / nx;
            if (og + 1u == (tg + 1u) * nx) xb_add(&bar[XB_TOPGEN], 1u);
            else XB_SPIN(xb_ld(&bar[XB_TOPGEN]) == tg, bar);
            __builtin_amdgcn_fence(__ATOMIC_ACQUIRE, "agent");
            xb_add(&bar[XB_XGEN(b.x)], 1u);
            asm volatile("s_waitcnt vmcnt(0)" ::: "memory");
        } else {
            XB_SPIN(xb_ld(&bar[XB_XGEN(b.x)]) == gen, bar);
            __builtin_amdgcn_fence(__ATOMIC_ACQUIRE, "agent");
            asm volatile("s_waitcnt vmcnt(0)" ::: "memory");
        }
    }
    __syncthreads();
}
struct Frame {
    LAS unsigned char* lds; volatile LAS unsigned* MISC; gu32* ctl;
    int tid, lane, wave, vcu, G;
    unsigned char* ws;
};
__device__ __forceinline__ float wave_sum(float v) {
#pragma unroll
    for (int o = 1; o < 64; o <<= 1) v += __shfl_xor(v, o);
    return v;
}
__device__ __forceinline__ float wave_max(float v) {
#pragma unroll
    for (int o = 1; o < 64; o <<= 1) v = fmaxf(v, __shfl_xor(v, o));
    return v;
}
__device__ __forceinline__ float bf2f_lo(unsigned w) { return __uint_as_float(w << 16); }
__device__ __forceinline__ float bf2f_hi(unsigned w) { return __uint_as_float(w & 0xffff0000u); }
__device__ __forceinline__ float bf2f(bf16 h) { return __uint_as_float((unsigned)h << 16); }

__device__ __forceinline__ void tr_item(const float* W, int Ns, const float* gain, bf16* WTrow, int K, int sc0, int nvalid, int k0, LAS float* scr, int lane) {
    const int col = lane & 31;
    float wv_[32];
#pragma unroll
    for (int i = 0; i < 32; ++i) { const int kk = 2 * i + (lane >> 5); wv_[i] = (col < nvalid) ? W[(size_t)(k0 + kk) * Ns + sc0 + col] : 0.f; }
#pragma unroll
    for (int i = 0; i < 32; ++i) { const int kk = 2 * i + (lane >> 5); float v = wv_[i]; if (gain) v *= gain[k0 + kk]; scr[kk * 33 + col] = v; }
    LDS_WAIT(); asm volatile("" ::: "memory");
    const int c = lane & 7;
#pragma unroll
    for (int j = 0; j < 4; ++j) { const int n = (lane >> 3) + 8 * j; const LAS float* s = scr + (8 * c) * 33 + n;
        v4u o; o.x = pk2(s[0 * 33], s[1 * 33]); o.y = pk2(s[2 * 33], s[3 * 33]); o.z = pk2(s[4 * 33], s[5 * 33]); o.w = pk2(s[6 * 33], s[7 * 33]);
        *(GAS v4u*)(WTrow + (size_t)n * K + 8 * c) = o; }
    LDS_WAIT(); asm volatile("" ::: "memory");
}
__device__ __forceinline__ void tr_item8(const float* W, int Ns, unsigned char* WTrow, int K, int sc0, int k0, LAS float* scr, int lane, const float* gain = nullptr) {
    const int col = lane & 31;
    float wv_[32];
#pragma unroll
    for (int i = 0; i < 32; ++i) { const int kk = 2 * i + (lane >> 5); wv_[i] = W[(size_t)(k0 + kk) * Ns + sc0 + col]; }
#pragma unroll
    for (int i = 0; i < 32; ++i) { const int kk = 2 * i + (lane >> 5); float v = wv_[i] * 64.f; if (gain) v *= gain[k0 + kk]; scr[kk * 33 + col] = v; }
    LDS_WAIT(); asm volatile("" ::: "memory");
    const int n = lane >> 1, hf = lane & 1;
#pragma unroll
    for (int q = 0; q < 2; ++q) { const LAS float* sp = scr + (32 * hf + 16 * q) * 33 + n; v4u o;
#pragma unroll
        for (int d = 0; d < 4; ++d) { unsigned w = 0u; w = __builtin_amdgcn_cvt_pk_fp8_f32(sp[(4 * d) * 33], sp[(4 * d + 1) * 33], w, false); w = __builtin_amdgcn_cvt_pk_fp8_f32(sp[(4 * d + 2) * 33], sp[(4 * d + 3) * 33], w, true); o[d] = w; }
        *(GAS v4u*)(WTrow + (size_t)n * K + 32 * hf + 16 * q) = o; }
    LDS_WAIT(); asm volatile("" ::: "memory");
}
__device__ __forceinline__ void plain_item8(const float* W, int Ns, int K, unsigned char* WT, int r, LAS float* scr, int lane, const float* gain = nullptr) {
    const int nkb = K / 64, group = r / nkb, kb = r % nkb;
    tr_item8(W, Ns, WT + (size_t)(group * 32) * K + kb * 64, K, group * 32, kb * 64, scr, lane, gain);
}
__device__ __forceinline__ int win_src_col(int j, int& nvalid) {
    const int tile = j >> 3, half = (j >> 2) & 1, q4 = j & 3; nvalid = 32;
    if (tile < 2) return (half ? 256 : 0) + 128 * tile + 32 * q4;
    if (tile < 4) return (half ? 1024 : 768) + 128 * (tile - 2) + 32 * q4;
    if (tile == 4) return 512 + 128 * half + 32 * q4;
    if (tile < 7) return 1280 + ((tile - 5) * 4 + q4) * 64 + 32 * half;
    if (tile < 9) return 1792 + ((tile - 7) * 4 + q4) * 64 + 32 * half;
    if (tile < 11) return 2304 + (tile - 9) * 256 + 128 * half + 32 * q4;
    if (tile == 11) return 2816 + q4 * 64 + 32 * half;
    if (q4 == 0) return 3072 + 32 * half;
    if (q4 == 1 && half == 1) { nvalid = 4; return 3136; }
    nvalid = 0; return 0;
}
__device__ __forceinline__ void gu_item(const float* wg, const float* wu, const float* gain, bf16* WT, int r, LAS float* scr, int lane) {
    const int group = r >> 4, kb = r & 15, tile = group >> 3, g8 = group & 7;
    tr_item(g8 < 4 ? wg : wu, FF, gain, WT + (size_t)(group * 32) * D + kb * 64, D, 128 * tile + 32 * (g8 & 3), 32, kb * 64, scr, lane);
}
__device__ __forceinline__ void plain_item(const float* W, int Ns, int K, const float* gain, bf16* WT, int r, LAS float* scr, int lane) {
    const int nkb = K / 64, group = r / nkb, kb = r % nkb;
    tr_item(W, Ns, gain, WT + (size_t)(group * 32) * K + kb * 64, K, group * 32, 32, kb * 64, scr, lane);
}
struct Args { const void* in[25]; float* out; unsigned char* ws; float invf[32]; int ph_lo, ph_hi; };
typedef const __attribute__((address_space(4))) Args* KArgs;
#define INF(A, k) ((const float*)(A)->in[k])
enum { I_X = 0, I_MEM, I_POS, I_FFN1_NORM, I_FFN1_WG, I_FFN1_WU, I_FFN1_WD, I_MIX_NORM, I_W_IN, I_CONF_DW, I_CONF_DW_B, I_CONF_LN_G, I_CONF_LN_B, I_SC_DW, I_W_OUT, I_XA_NORM, I_MEM_NORM, I_XA_WQ, I_XA_WKV, I_XA_WO,
       I_FFN2_NORM, I_FFN2_WG, I_FFN2_WU, I_FFN2_WD, I_FINAL_NORM };
constexpr int IT_GU = 2816, IT_D = 1408, IT_IN = 1664, IT_SQ = 512, IT_KV = 1024, IT_LAYER = 2 * IT_GU + 2 * IT_D + IT_IN + 3 * IT_SQ + IT_KV;
__device__ __forceinline__ void p0_prologue(Frame& F, KArgs A) {
    LAS float* scr = (LAS float*)(F.lds + RING_OFF + F.wave * 16384);
    const int gw = F.vcu * NWAVES + F.wave, NGW = F.G * NWAVES, lane = F.lane;
    unsigned char* ws = F.ws;
    for (int it = gw; it < DEPTH * IT_LAYER; it += NGW) {
        const int l = it / IT_LAYER; int r = it % IT_LAYER;
        unsigned char* wl = ws + WS_W + (size_t)l * W_LAYER;
        if (r < IT_GU) { gu_item(INF(A, I_FFN1_WG) + (size_t)l * D * FF, INF(A, I_FFN1_WU) + (size_t)l * D * FF, INF(A, I_FFN1_NORM) + l * D, (bf16*)(wl + WO_GU1), r, scr, lane); continue; } r -= IT_GU;
        if (r < IT_D) { plain_item8(INF(A, I_FFN1_WD) + (size_t)l * FF * D, D, FF, wl + WO_D1, r, scr, lane); continue; } r -= IT_D;
        if (r < IT_IN) { const int group = r >> 4, kb = r & 15; int nv; const int sc = win_src_col(group, nv);
            tr_item(INF(A, I_W_IN) + (size_t)l * D * NIN, NIN, INF(A, I_MIX_NORM) + l * D, (bf16*)(wl + WO_IN) + (size_t)(group * 32) * D + kb * 64, D, sc, nv, kb * 64, scr, lane); continue; } r -= IT_IN;
        if (r < IT_SQ) { plain_item(INF(A, I_W_OUT) + (size_t)l * D * D, D, D, nullptr, (bf16*)(wl + WO_OUT), r, scr, lane); continue; } r -= IT_SQ;
        if (r < IT_SQ) { plain_item8(INF(A, I_XA_WQ) + (size_t)l * D * D, D, D, wl + WO_Q, r, scr, lane, INF(A, I_XA_NORM) + l * D); continue; } r -= IT_SQ;
        if (r < IT_SQ) { plain_item8(INF(A, I_XA_WO) + (size_t)l * D * D, D, D, wl + WO_O, r, scr, lane); continue; } r -= IT_SQ;
        if (r < IT_KV) { plain_item(INF(A, I_XA_WKV) + (size_t)l * D * 2 * D, 2 * D, D, INF(A, I_MEM_NORM) + l * D, (bf16*)(ws + WS_MK) + (size_t)(1024 + 2048 * l) * D, r, scr, lane); continue; } r -= IT_KV;
        if (r < IT_GU) { gu_item(INF(A, I_FFN2_WG) + (size_t)l * D * FF, INF(A, I_FFN2_WU) + (size_t)l * D * FF, INF(A, I_FFN2_NORM) + l * D, (bf16*)(wl + WO_GU2), r, scr, lane); continue; } r -= IT_GU;
        plain_item8(INF(A, I_FFN2_WD) + (size_t)l * FF * D, D, FF, wl + WO_D2, r, scr, lane);
    }
    for (int m = gw; m < M + 1024; m += NGW) {
        const bool ismem = m >= M; const int row = ismem ? m - M : m;
        const GAS f32x4* xr = (const GAS f32x4*)((ismem ? INF(A, I_MEM) : INF(A, I_X)) + (size_t)row * D) + lane;
        GAS unsigned long long* o8 = (GAS unsigned long long*)((bf16*)(ws + (ismem ? WS_MK : WS_X)) + (size_t)row * D) + lane;
        float s = 0.f;
#pragma unroll
        for (int j = 0; j < 4; ++j) { const f32x4 v = xr[64 * j]; const unsigned a = pk2(v.x, v.y), b = pk2(v.z, v.w); o8[64 * j] = (unsigned long long)a | ((unsigned long long)b << 32);
            s += (bf2f_lo(a) * bf2f_lo(a) + bf2f_hi(a) * bf2f_hi(a)) + (bf2f_lo(b) * bf2f_lo(b) + bf2f_hi(b) * bf2f_hi(b)); }
        s = wave_sum(s);
        if (ismem) { if (lane == 0) ((float*)(ws + WS_MSS))[row] = s; } else if (lane < 16) ((float*)(ws + WS_SS))[(size_t)row * 16 + lane] = lane == 0 ? s : 0.f;
    }
    for (int e = (F.vcu * NWAVES * 64 + F.tid); e < M * 32; e += F.G * NWAVES * 64) {
        const int row = e >> 5, i = e & 31;
        const float ang = __fmul_rn((float)((const int*)A->in[I_POS])[row], A->invf[i]);
        const double x = (double)ang, n = __builtin_rint(x * 0.15915494309189535), r = x - n * 6.283185307179586, r2 = r * r;
        double sp = -1.0 / 25852016738884976640000.0, cp = 1.0 / 620448401733239439360000.0;
        sp = sp * r2 + 1.0 / 51090942171709440000.0;  cp = cp * r2 - 1.0 / 1124000727777607680000.0;
        sp = sp * r2 - 1.0 / 121645100408832000.0;    cp = cp * r2 + 1.0 / 2432902008176640000.0;
        sp = sp * r2 + 1.0 / 355687428096000.0;       cp = cp * r2 - 1.0 / 6402373705728000.0;
        sp = sp * r2 - 1.0 / 1307674368000.0;         cp = cp * r2 + 1.0 / 20922789888000.0;
        sp = sp * r2 + 1.0 / 6227020800.0;            cp = cp * r2 - 1.0 / 87178291200.0;
        sp = sp * r2 - 1.0 / 39916800.0;              cp = cp * r2 + 1.0 / 479001600.0;
        sp = sp * r2 + 1.0 / 362880.0;                cp = cp * r2 - 1.0 / 3628800.0;
        sp = sp * r2 - 1.0 / 5040.0;                  cp = cp * r2 + 1.0 / 40320.0;
        sp = sp * r2 + 1.0 / 120.0;                   cp = cp * r2 - 1.0 / 720.0;
        sp = sp * r2 - 1.0 / 6.0;                     cp = cp * r2 + 1.0 / 24.0;
        sp = sp * r2 + 1.0;                           cp = cp * r2 - 0.5;
        cp = cp * r2 + 1.0;
        ((float*)(ws + WS_COS))[e] = (float)cp; ((float*)(ws + WS_SIN))[e] = (float)(sp * r);
    }
}

__device__ __forceinline__ void conv_a_unit(Frame& F, const bf16* HG, bf16* MIX, const float* dw, const float* dwb, const float* lng, const float* lnb, int unit) {
    const int tid = F.tid, lane = F.lane, wave = F.wave;
    const int row0 = unit * 64, t0 = row0 % SEQ;
    LAS unsigned short* hb = (LAS unsigned short*)(F.lds + RING_OFF); LAS float* yb = (LAS float*)(F.lds + RING_OFF + 49152);
    for (int ch = tid; ch < 94 * 32; ch += NWAVES * 64) { const int rr = ch >> 5, c16 = ch & 31; const int t = t0 - 30 + rr;
        v4u v = (v4u){0u, 0u, 0u, 0u}; if (t >= 0) v = *(const GAS v4u*)(HG + (size_t)(row0 - 30 + rr) * 256 + c16 * 8);
        *(LAS v4u*)(hb + rr * 256 + c16 * 8) = v; }
    __syncthreads();
    { const int c = tid & 255, half = tid >> 8;
      float w[31];
#pragma unroll
      for (int j = 0; j < 31; ++j) w[j] = dw[j * 256 + c];
      const float bias = dwb[c];
      float hv[62];
#pragma unroll
      for (int k = 0; k < 62; ++k) hv[k] = bf2f(hb[(32 * half + k) * 256 + c]);
#pragma unroll
      for (int i = 0; i < 32; ++i) { float y = bias;
#pragma unroll
          for (int j = 0; j < 31; ++j) y += w[j] * hv[i + j];
          yb[(32 * half + i) * 256 + c] = y; } }
    __syncthreads();
    { const f32x4 g = *(const GAS f32x4*)(lng + lane * 4), bb = *(const GAS f32x4*)(lnb + lane * 4);
      for (int tt = wave; tt < 64; tt += NWAVES) { const f32x4 y = *(LAS f32x4*)(yb + tt * 256 + lane * 4);
          const float mean = wave_sum((y.x + y.y) + (y.z + y.w)) * (1.f / 256.f); const f32x4 d = y - mean;
          const float var = wave_sum((d.x * d.x + d.y * d.y) + (d.z * d.z + d.w * d.w)) * (1.f / 256.f); const float rs = 1.0f / sqrtf(var + 1e-5f);
          f32x4 o = d * rs * g + bb;
#pragma unroll
          for (int j = 0; j < 4; ++j) o[j] = o[j] * pg8::sigm(o[j]);
          *(GAS unsigned long long*)(MIX + (size_t)(row0 + tt) * 1024 + lane * 4) = (unsigned long long)pk2(o.x, o.y) | ((unsigned long long)pk2(o.z, o.w) << 32); } }
    __syncthreads();
}
__device__ __forceinline__ void conv_b_all(Frame& F, const bf16* U, const bf16* BG, bf16* MIX, const float* sw) {
    for (int it = F.vcu * NWAVES * 64 + F.tid; it < M * 32; it += F.G * NWAVES * 64) { const int row = it >> 5, c8 = (it & 31) * 8, t = row % SEQ;
        const v4u z = (v4u){0u, 0u, 0u, 0u};
        const v4u u0 = *(const GAS v4u*)(U + (size_t)row * 256 + c8), u1 = t >= 1 ? *(const GAS v4u*)(U + (size_t)(row - 1) * 256 + c8) : z, u2 = t >= 2 ? *(const GAS v4u*)(U + (size_t)(row - 2) * 256 + c8) : z;
        const v4u g = *(const GAS v4u*)(BG + (size_t)row * 256 + c8);
        float o[8];
#pragma unroll
        for (int k = 0; k < 4; ++k) { const int c = c8 + 2 * k;
            o[2 * k]     = bf2f_lo(g[k]) * (sw[c] * bf2f_lo(u2[k]) + sw[256 + c] * bf2f_lo(u1[k]) + sw[512 + c] * bf2f_lo(u0[k]));
            o[2 * k + 1] = bf2f_hi(g[k]) * (sw[c + 1] * bf2f_hi(u2[k]) + sw[256 + c + 1] * bf2f_hi(u1[k]) + sw[512 + c + 1] * bf2f_hi(u0[k])); }
        v4u w; w.x = pk2(o[0], o[1]); w.y = pk2(o[2], o[3]); w.z = pk2(o[4], o[5]); w.w = pk2(o[6], o[7]);
        *(GAS v4u*)(MIX + (size_t)row * 1024 + 256 + c8) = w; }
}
__device__ __forceinline__ unsigned mono32(float f) { const unsigned u = __float_as_uint(f); return (u & 0x80000000u) ? ~u : (u | 0x80000000u); }
template <bool FROM_MASK> __device__ __forceinline__ void dsa_naive_query(Frame& F, const bf16* Q, const bf16* K, const bf16* V, const bf16* QI, const bf16* KI, const float* WI, const unsigned long long* MASK, bf16* MIX, int row) {
    const int tid = F.tid, lane = F.lane, wave = F.wave;
    const int b = row / SEQ, t = row % SEQ, n = t + 1;
    LAS unsigned long long* key64 = (LAS unsigned long long*)(F.lds + RING_OFF);
    LAS float* qi = (LAS float*)(F.lds + RING_OFF + 65536); LAS float* qh = (LAS float*)(F.lds + RING_OFF + 66560); LAS float* pl = (LAS float*)(F.lds + RING_OFF + 68608);
    LAS int* sel = (LAS int*)(F.lds + RING_OFF + 76800); LAS unsigned* cnt = (LAS unsigned*)(F.lds + RING_OFF + 77824);
    if (tid < 256) qi[tid] = bf2f(QI[(size_t)row * 256 + tid]);
    qh[tid] = bf2f(Q[(size_t)row * 512 + tid]);
    if (tid < 64) cnt[tid] = 0u;
    const f32x4 wv = *(const GAS f32x4*)(WI + (size_t)row * 4);
    __syncthreads();
    unsigned em = 0u;
    if constexpr (FROM_MASK) {
#pragma unroll
        for (int j = 0; j < 16; ++j) { const int s = tid + 512 * j;
            if (s < n) { const int kb = s >> 5, ko = s & 31, r = (ko & 3) + 4 * (ko >> 3), hh = (ko >> 2) & 1; const unsigned long long w = MASK[(((size_t)b * 256 + (t >> 5)) * 256 + kb) * 16 + r]; em |= (unsigned)((w >> (hh * 32 + (t & 31))) & 1ull) << j; } }
    } else {
    unsigned long long e[16]; unsigned long long T = 0ull;
#pragma unroll
    for (int j = 0; j < 16; ++j) { const int s = tid + 512 * j; e[j] = 0ull;
        if (s < n) { const GAS v4u* kr = (const GAS v4u*)(KI + (size_t)(b * SEQ + s) * 64); float kf[64];
#pragma unroll
            for (int c = 0; c < 8; ++c) { const v4u v = kr[c];
#pragma unroll
                for (int k = 0; k < 4; ++k) { kf[c * 8 + 2 * k] = bf2f_lo(v[k]); kf[c * 8 + 2 * k + 1] = bf2f_hi(v[k]); } }
            float sc = 0.f;
#pragma unroll
            for (int h = 0; h < 4; ++h) { float d0 = 0.f;
#pragma unroll
                for (int d = 0; d < 64; ++d) d0 += qi[h * 64 + d] * kf[d];
                sc += wv[h] * fmaxf(d0, 0.f); }
            sc = sc * IDX_SCALE + 0.0f;
            e[j] = ((unsigned long long)mono32(sc) << 13) | (unsigned long long)(8191 - s); } }
    if (n > 256) {
        for (int bit = 44; bit >= 0; --bit) { const unsigned long long cand = T | (1ull << bit); unsigned c = 0;
#pragma unroll
            for (int j = 0; j < 16; ++j) c += (e[j] >= cand) ? 1u : 0u;
            c = (unsigned)wave_sum((float)c);
            if (lane == 0) atomicAdd((unsigned*)&cnt[bit], c);
            __syncthreads();
            if (cnt[bit] >= 256u) T = cand; }
    }
    if (T == 0ull) T = 1ull;
#pragma unroll
    for (int j = 0; j < 16; ++j) em |= (e[j] >= T ? 1u : 0u) << j;
    }
    { unsigned c = 0;
      c = (unsigned)__builtin_popcount(em);
      unsigned inc = c;
#pragma unroll
      for (int o = 1; o < 64; o <<= 1) { const unsigned v = __shfl_up(inc, o); if (lane >= o) inc += v; }
      if (lane == 63) cnt[50 + wave] = inc;
      __syncthreads();
      unsigned base = inc - c;
#pragma unroll
      for (int w = 0; w < NWAVES; ++w) if (w < wave) base += cnt[50 + w];
#pragma unroll
      for (int j = 0; j < 16; ++j) if ((em >> j) & 1u) { if (base < 256u) sel[base] = tid + 512 * j; ++base; }
      if (tid == NWAVES * 64 - 1) cnt[48] = base; }
    __syncthreads();
    const int nsel = min((int)cnt[48], 256);
    { const int h = wave; float mx = -INFINITY;
#pragma unroll 1
      for (int kk = 0; kk < 4; ++kk) { const int k = lane + 64 * kk; float d0 = -INFINITY;
          if (k < nsel) { const GAS v4u* kr = (const GAS v4u*)(K + (size_t)(b * SEQ + sel[k]) * 512 + h * 64); d0 = 0.f;
#pragma unroll
              for (int c = 0; c < 8; ++c) { const v4u v = kr[c];
#pragma unroll
                  for (int q = 0; q < 4; ++q) d0 += qh[h * 64 + c * 8 + 2 * q] * bf2f_lo(v[q]) + qh[h * 64 + c * 8 + 2 * q + 1] * bf2f_hi(v[q]); } }
          pl[h * 256 + k] = d0; mx = fmaxf(mx, d0); }
      mx = wave_max(mx); float sum = 0.f;
#pragma unroll 1
      for (int kk = 0; kk < 4; ++kk) { const int k = lane + 64 * kk; const float p = (k < nsel) ? __builtin_amdgcn_exp2f(pl[h * 256 + k] - mx) : 0.f; pl[h * 256 + k] = p; sum += p; }
      sum = wave_sum(sum);
      LDS_WAIT(); asm volatile("" ::: "memory");
      float o = 0.f;
#pragma unroll 8
      for (int k = 0; k < nsel; ++k) o += pl[h * 256 + k] * bf2f(V[(size_t)(b * SEQ + sel[k]) * 512 + h * 64 + lane]);
      MIX[(size_t)row * 1024 + 512 + h * 64 + lane] = (bf16)pk2(o / sum, 0.f); }
    __syncthreads();
}
typedef float f32x16 __attribute__((ext_vector_type(16)));
__device__ __forceinline__ int crow(int r, int hi) { return (r & 3) + 8 * (r >> 2) + 4 * hi; }
constexpr int XA_ROWB = 528;
__device__ __forceinline__ void xattn_stage(Frame& F, const bf16* src  ) {
#pragma unroll 1
    for (int g = 0; g < 2; ++g) { v4u t[8];
#pragma unroll
        for (int i = 0; i < 8; ++i) { const int c = F.tid + 512 * (8 * g + i); t[i] = *(const GAS v4u*)(src + (size_t)(c >> 5) * 1024 + (c & 31) * 8); }
#pragma unroll
        for (int i = 0; i < 8; ++i) { const int c = F.tid + 512 * (8 * g + i); *(LAS v4u*)(F.lds + RING_OFF + (c >> 5) * XA_ROWB + (c & 31) * 16) = t[i]; } }
}
__device__ __forceinline__ void xattn_unit(Frame& F, const bf16* XQ, unsigned char* XO  , const bf16* MEMK, const bf16* MEMVT, int pm, int h) {
    const int lane = F.lane, wave = F.wave, r32 = lane & 31, hi = lane >> 5, b = pm >> 5;
    const int R0 = pm * 256 + wave * 32;
    LAS float* wsf = (LAS float*)(F.lds + RING_OFF + 256 * XA_ROWB) + wave * 64;
    xattn_stage(F, MEMK + (size_t)(b * 256) * 1024 + h * 256);
    bf16x8 qf[16];
#pragma unroll
    for (int kk = 0; kk < 16; ++kk) qf[kk] = *(const GAS bf16x8*)(XQ + (size_t)(R0 + r32) * 1024 + h * 256 + kk * 16 + hi * 8);
    __syncthreads();
    f32x16 st[8];
#pragma unroll
    for (int kb = 0; kb < 8; ++kb) { st[kb] = (f32x16){};
        const LAS unsigned char* kr = F.lds + RING_OFF + (kb * 32 + r32) * XA_ROWB + hi * 16;
#pragma unroll
        for (int kk = 0; kk < 16; ++kk) { const bf16x8 kf = *(const LAS bf16x8*)(kr + kk * 32); st[kb] = __builtin_amdgcn_mfma_f32_32x32x16_bf16(kf, qf[kk], st[kb], 0, 0, 0); if ((kk & 3) == 3) asm volatile("" ::: "memory"); } }
    float mx = -INFINITY;
#pragma unroll
    for (int kb = 0; kb < 8; ++kb)
#pragma unroll
        for (int r = 0; r < 16; ++r) mx = fmaxf(mx, st[kb][r]);
    { const auto rr = __builtin_amdgcn_permlane32_swap(__float_as_uint(mx), __float_as_uint(mx), false, false); mx = fmaxf(__uint_as_float(rr[0]), __uint_as_float(rr[1])); }
    float sum = 0.f; v4u pk[8][2];
#pragma unroll
    for (int kb = 0; kb < 8; ++kb) {
#pragma unroll
        for (int r = 0; r < 16; ++r) { st[kb][r] = __builtin_amdgcn_exp2f(st[kb][r] - mx); sum += st[kb][r]; }
#pragma unroll
        for (int hf = 0; hf < 2; ++hf)
#pragma unroll
            for (int q = 0; q < 4; ++q) pk[kb][hf][q] = pg8::cvt_pk_bf16(st[kb][8 * hf + 2 * q], st[kb][8 * hf + 2 * q + 1]); }
    { const auto rr = __builtin_amdgcn_permlane32_swap(__float_as_uint(sum), __float_as_uint(sum), false, false); sum = __uint_as_float(rr[0]) + __uint_as_float(rr[1]); }
    __syncthreads();
    xattn_stage(F, MEMVT + (size_t)(h * 256) * 1024 + b * 256);
    if (hi == 0) wsf[r32] = sum;
    __syncthreads();
    f32x16 o[8];
#pragma unroll
    for (int db = 0; db < 8; ++db) { o[db] = (f32x16){};
        const LAS unsigned char* vr = F.lds + RING_OFF + (db * 32 + r32) * XA_ROWB + hi * 8;
#pragma unroll
        for (int ks = 0; ks < 16; ++ks) { const pg8::u32x2 lo = *(const LAS pg8::u32x2*)(vr + ks * 32), hh = *(const LAS pg8::u32x2*)(vr + ks * 32 + 16);
            const v4u vv = (v4u){lo.x, lo.y, hh.x, hh.y};
            o[db] = __builtin_amdgcn_mfma_f32_32x32x16_bf16(__builtin_bit_cast(bf16x8, pk[ks >> 1][ks & 1]), __builtin_bit_cast(bf16x8, vv), o[db], 0, 0, 0); if ((ks & 3) == 3) asm volatile("" ::: "memory"); } }
    float rl[16];
#pragma unroll
    for (int r = 0; r < 16; ++r) rl[r] = 1.0f / wsf[crow(r, hi)];
#pragma unroll
    for (int db = 0; db < 8; ++db)
#pragma unroll
        for (int r = 0; r < 16; ++r) XO[(size_t)(R0 + crow(r, hi)) * 1024 + h * 256 + db * 32 + r32] = (unsigned char)__builtin_amdgcn_cvt_pk_fp8_f32(o[db][r] * rl[r], 0.f, 0u, false);
    __syncthreads();
}
__device__ __forceinline__ void final_norm_all(Frame& F, const bf16* X, const float* ss, const float* g, float* out) {
    const int gw = F.vcu * NWAVES + F.wave, NGW = F.G * NWAVES, lane = F.lane;
    f32x4 gg[4];
#pragma unroll
    for (int j = 0; j < 4; ++j) gg[j] = *(const GAS f32x4*)(g + (lane + 64 * j) * 4);
    for (int m0 = gw * 4; m0 < M; m0 += NGW * 4) {
        unsigned long long v[4][4]; float rs[4];
#pragma unroll
        for (int i = 0; i < 4; ++i) { rs[i] = pg8::rstd_of(ss, m0 + i);
#pragma unroll
            for (int j = 0; j < 4; ++j) v[i][j] = ((const GAS unsigned long long*)(X + (size_t)(m0 + i) * D))[lane + 64 * j]; }
#pragma unroll
        for (int i = 0; i < 4; ++i)
#pragma unroll
            for (int j = 0; j < 4; ++j) { const unsigned a = (unsigned)v[i][j], bq = (unsigned)(v[i][j] >> 32);
                *(GAS f32x4*)(out + (size_t)(m0 + i) * D + (lane + 64 * j) * 4) = (f32x4){bf2f_lo(a) * rs[i] * gg[j].x, bf2f_hi(a) * rs[i] * gg[j].y, bf2f_lo(bq) * rs[i] * gg[j].z, bf2f_hi(bq) * rs[i] * gg[j].w}; } }
}

constexpr int IX_HS = 1025;
constexpr int IX_ST = 32 * IX_HS * 4;
constexpr int IX_CAP = 1024;
#ifndef IX_DUP
#define IX_DUP 0
#endif
__device__ __forceinline__ void idx_load_a(bf16x8 (&a)[4], const bf16* kbase, int kb) {
#pragma unroll
    for (int kk = 0; kk < 4; ++kk) a[kk] = *(const GAS bf16x8*)(kbase + (size_t)kb * 2048 + kk * 512);
}
#define IX_RELU(x) __int_as_float(max(__float_as_int(x), 0))
#define IX_MF(ACC, H, KK) ACC = __builtin_amdgcn_mfma_f32_32x32x16_bf16(a[KK], bq[H][KK], ACC, 0, 0, 0)
#define IX_RS0(ACC, W, R) do { _Pragma("unroll") for (int r = (R); r < (R) + 4; ++r) { const float x = ACC[r]; sc[r] = __builtin_fmaf(W, IX_RELU(x), 0.0f); } } while (0)
#define IX_RS(ACC, W, R) do { _Pragma("unroll") for (int r = (R); r < (R) + 4; ++r) { const float x = ACC[r]; sc[r] = __builtin_fmaf(W, IX_RELU(x), sc[r]); } } while (0)
#define IX_PIN(ACC, VACC, R) asm volatile("" : "+v"(ACC), "+v"(VACC), "+v"(sc[R]), "+v"(sc[(R) + 1]), "+v"(sc[(R) + 2]), "+v"(sc[(R) + 3]))
template <bool PREV> __device__ __forceinline__ void idx_half1(float (&sc)[16], f32x16& acc0, f32x16& acc1, f32x16& acc2, f32x16& acc3, const bf16x8 (&a)[4], const bf16x8 (&bq)[4][4], const f32x4 wv) {
    acc0 = (f32x16){};
#pragma unroll
    for (int kk = 0; kk < 4; ++kk) { IX_MF(acc0, 0, kk); if constexpr (PREV) { IX_RS(acc2, wv[2], 4 * kk); IX_PIN(acc0, acc2, 4 * kk); } }
    acc1 = (f32x16){};
#pragma unroll
    for (int kk = 0; kk < 4; ++kk) { IX_MF(acc1, 1, kk); if constexpr (PREV) { IX_RS(acc3, wv[3], 4 * kk); IX_PIN(acc1, acc3, 4 * kk); } }
}
__device__ __forceinline__ void idx_half2(float (&sc)[16], f32x16& acc0, f32x16& acc1, f32x16& acc2, f32x16& acc3, const bf16x8 (&a)[4], const bf16x8 (&bq)[4][4], const f32x4 wv) {
    acc2 = (f32x16){};
#pragma unroll
    for (int kk = 0; kk < 4; ++kk) { IX_MF(acc2, 2, kk); IX_RS0(acc0, wv[0], 4 * kk); IX_PIN(acc2, acc0, 4 * kk); }
    acc3 = (f32x16){};
#pragma unroll
    for (int kk = 0; kk < 4; ++kk) { IX_MF(acc3, 3, kk); IX_RS(acc1, wv[1], 4 * kk); IX_PIN(acc3, acc1, 4 * kk); }
}
__device__ __forceinline__ void idx_tail(float (&sc)[16], const f32x16& acc2, const f32x16& acc3, const f32x4 wv) {
    IX_RS(acc2, wv[2], 0); IX_RS(acc2, wv[2], 4); IX_RS(acc2, wv[2], 8); IX_RS(acc2, wv[2], 12);
    IX_RS(acc3, wv[3], 0); IX_RS(acc3, wv[3], 4); IX_RS(acc3, wv[3], 8); IX_RS(acc3, wv[3], 12);
}
#undef IX_PIN
#undef IX_RELU
#undef IX_MF
#undef IX_RS0
#undef IX_RS
template <bool L2> __device__ __forceinline__ void idx_scan(LAS unsigned* row, bool positive, unsigned need, int lane, unsigned& bin_out, unsigned& need_out) {
    asm volatile("" : "+v"(lane));
    unsigned c[16], sum = 0;
#pragma unroll
    for (int i = 0; i < 16; ++i) { const int p = 16 * lane + i; const int bin = L2 ? (positive ? 1023 - p : p) : (p < 512 ? 511 - p : p); c[i] = row[bin]; row[bin] = 0u; sum += c[i]; }
    unsigned incl = sum;
#pragma unroll
    for (int o = 1; o < 64; o <<= 1) { const unsigned v = __shfl_up(incl, o); if (lane >= o) incl += v; }
    const unsigned long long m = __ballot(incl >= need);
    const int Ls = m ? (int)__builtin_ctzll(m) : 63;
    unsigned cum = incl - sum, fb = 0u, fn = 1u; bool found = false;
#pragma unroll
    for (int i = 0; i < 16; ++i) { const int p = 16 * lane + i; const unsigned bin = (unsigned)(L2 ? (positive ? 1023 - p : p) : (p < 512 ? 511 - p : p));
        if (!found && cum + c[i] >= need) { found = true; fb = bin; fn = need - cum; } cum += c[i]; }
    bin_out = (unsigned)__shfl((int)fb, Ls); need_out = (unsigned)__shfl((int)fn, Ls);
}
template <int NS> __device__ __forceinline__ unsigned idx_select(LAS unsigned* row, unsigned n, unsigned need, int lane) {
    unsigned v[NS], vor = 0u, vand = 0xffffffffu;
#pragma unroll
    for (int s = 0; s < NS; ++s) { const unsigned idx = (unsigned)(s * 64 + lane); const bool ok = idx < n; v[s] = ok ? row[idx] : 0u; vor |= v[s]; vand &= ok ? v[s] : 0xffffffffu; }
#pragma unroll
    for (int o = 1; o < 64; o <<= 1) { vor |= (unsigned)__shfl_xor((int)vor, o); vand &= (unsigned)__shfl_xor((int)vand, o); }
    const unsigned diff = vor ^ vand;
    if (diff == 0u) return vand;
    const int top = 31 - __builtin_clz(diff);
    unsigned T = vand & ~((2u << top) - 1u);
    for (int bit = top; bit >= 0; --bit) { const unsigned cand = T | (1u << bit); unsigned c = 0;
#pragma unroll
        for (int s = 0; s < NS; ++s) c += (unsigned)__builtin_popcountll(__ballot(v[s] >= cand));
        if (c >= need) T = cand; }
    return T;
}
__device__ __forceinline__ unsigned ix_mono(unsigned raw) { return (raw & 0x80000000u) ? ~raw : (raw | 0x80000000u); }
__device__ __forceinline__ float ix_h2f(unsigned h) { return (float)__builtin_bit_cast(_Float16, (unsigned short)h); }
__device__ __forceinline__ unsigned ix_pick(const float (&sc)[16], unsigned r) {
    const unsigned m0 = (unsigned)((int)(r << 31) >> 31), m1 = (unsigned)((int)(r << 30) >> 31), m2 = (unsigned)((int)(r << 29) >> 31), m3 = (unsigned)((int)(r << 28) >> 31); unsigned t[8], u[4], w[2];
#pragma unroll
    for (int i = 0; i < 8; ++i) t[i] = (__float_as_uint(sc[2 * i + 1]) & m0) | (__float_as_uint(sc[2 * i]) & ~m0);
#pragma unroll
    for (int i = 0; i < 4; ++i) u[i] = (t[2 * i + 1] & m1) | (t[2 * i] & ~m1);
#pragma unroll
    for (int i = 0; i < 2; ++i) w[i] = (u[2 * i + 1] & m2) | (u[2 * i] & ~m2);
    return (w[1] & m3) | (w[0] & ~m3);
}
__device__ __forceinline__ void idx_unit(Frame& F, const bf16* QI, const bf16* KI, const float* WI, unsigned* MASK, int b, int j) {
    int lane = F.lane, r32 = lane & 31, hi = lane >> 5; const int wave = F.wave;
#define IX_LAUNDER() asm volatile("" : "+v"(lane), "+v"(r32), "+v"(hi))
    LAS unsigned* hist = (LAS unsigned*)(F.lds + RING_OFF);
    LAS unsigned* st = (LAS unsigned*)(F.lds + RING_OFF + IX_ST);
    const size_t qrow = (size_t)b * SEQ + 32 * j + r32;
    bf16x8 bq[4][4];
#pragma unroll
    for (int h = 0; h < 4; ++h)
#pragma unroll
        for (int kk = 0; kk < 4; ++kk) bq[h][kk] = *(const GAS bf16x8*)(QI + qrow * 256 + h * 64 + kk * 16 + hi * 8);
    f32x4 wv = *(const GAS f32x4*)(WI + qrow * 4); wv = wv * IDX_SCALE;
    const bf16* kbase = KI + (size_t)b * SEQ * 64 + (size_t)(hi * 32 + r32) * 8;
    LAS unsigned* myrow = hist + r32 * IX_HS;
    const unsigned myrow_b = (unsigned)(uintptr_t)myrow;
#define IX_BODY(KBP, ...) do { const int kb = (KBP); if (kb == j) { _Pragma("unroll") for (int r = 0; r < 16; ++r) sc[r] = (crow(r, hi) > r32) ? -INFINITY : sc[r]; } __VA_ARGS__ } while (0)
#define IX_STEP(A, KB, ...) do { idx_half1<true>(sc, acc0, acc1, acc2, acc3, A, bq, wv); IX_BODY(kbp, __VA_ARGS__); idx_half2(sc, acc0, acc1, acc2, acc3, A, bq, wv); idx_load_a(A, kbase, min((KB) + 3 * NWAVES, j)); kbp = (KB); } while (0)
#define IX_PASS(...) do { IX_LAUNDER(); bf16x8 a0[4], a1[4], a2[4]; idx_load_a(a0, kbase, min(wave, j)); idx_load_a(a1, kbase, min(wave + NWAVES, j)); idx_load_a(a2, kbase, min(wave + 2 * NWAVES, j)); \
        if (wave <= j) { float sc[16]; f32x16 acc0, acc1, acc2, acc3; int kbp = wave; \
            idx_half1<false>(sc, acc0, acc1, acc2, acc3, a0, bq, wv); idx_half2(sc, acc0, acc1, acc2, acc3, a0, bq, wv); idx_load_a(a0, kbase, min(wave + 3 * NWAVES, j)); \
            for (int kb_ = wave + NWAVES;;) { \
                if (kb_ > j) break; IX_STEP(a1, kb_, __VA_ARGS__); kb_ += NWAVES; \
                if (kb_ > j) break; IX_STEP(a2, kb_, __VA_ARGS__); kb_ += NWAVES; \
                if (kb_ > j) break; IX_STEP(a0, kb_, __VA_ARGS__); kb_ += NWAVES; } \
            idx_tail(sc, acc2, acc3, wv); IX_BODY(kbp, __VA_ARGS__); } } while (0)
    float ts = -3.402823466e38f, ti = -3.402823466e38f; unsigned mbase = 0u;
    if (j >= 8) for (int ra_ = 0; ra_ < 1 + (IX_DUP & 1); ++ra_) {
        IX_PASS({
            _Pragma("unroll") for (int r = 0; r < 16; r += 2) { unsigned u; asm("v_cvt_pkrtz_f16_f32 %0, %1, %2" : "=v"(u) : "v"(sc[r]), "v"(sc[r + 1]));
                unsigned a0, a1; asm("v_lshl_add_u32 %0, %1, 2, %2" : "=v"(a0) : "v"((u >> 6) & 1023u), "v"(myrow_b)); asm("v_lshl_add_u32 %0, %1, 2, %2" : "=v"(a1) : "v"(u >> 22), "v"(myrow_b));
                __hip_atomic_fetch_add((LAS unsigned*)a0, 1u, __ATOMIC_RELAXED, __HIP_MEMORY_SCOPE_WORKGROUP); __hip_atomic_fetch_add((LAS unsigned*)a1, 1u, __ATOMIC_RELAXED, __HIP_MEMORY_SCOPE_WORKGROUP); } });
        __syncthreads();
#pragma unroll 1
        for (int qq = wave * 4; qq < wave * 4 + 4; ++qq) { unsigned bn, nd; idx_scan<false>(hist + qq * IX_HS, true, 256u, lane, bn, nd);
            if (lane == 0) {
                float tsv, tiv;
                if (bn < 512u) { tiv = ix_h2f(bn << 6); tsv = ix_h2f((bn + 1u) << 6); }
                else { const unsigned mb = bn - 512u; const float mlo = ix_h2f(mb << 6), mhi = ix_h2f((mb + 1u) << 6);
                    tsv = (mlo == 0.f) ? 0.f : __uint_as_float(__float_as_uint(-mlo) - 1u); tiv = __uint_as_float(__float_as_uint(-mhi) - 1u); }
                st[qq] = bn; st[32 + qq] = nd; st[64 + qq] = __float_as_uint(tsv); st[96 + qq] = __float_as_uint(tiv); st[128 + qq] = ix_mono(__float_as_uint(tiv)); st[160 + qq] = 0u; } }
        __syncthreads();
        ts = __uint_as_float(st[64 + r32]); ti = __uint_as_float(st[96 + r32]); mbase = st[128 + r32];
    }
    unsigned short* mrow = (unsigned short*)(MASK + (((size_t)b * 256 + j) * 128) * 64);
    for (int rd_ = 0; rd_ < 1 + ((IX_DUP >> 1) & 1); ++rd_) { if (rd_) { __syncthreads(); if (F.tid < 32) st[160 + F.tid] = 0u; __syncthreads(); }
    IX_PASS({
            unsigned w16 = 0u, c16 = 0u;
            _Pragma("unroll") for (int r = 15; r >= 0; --r) asm("v_cmp_ge_f32_e32 vcc, %2, %3\n\tv_addc_co_u32_e32 %0, vcc, %0, %0, vcc\n\tv_cmp_ge_f32_e32 vcc, %2, %4\n\tv_addc_co_u32_e32 %1, vcc, %1, %1, vcc" : "+v"(w16), "+v"(c16) : "v"(sc[r]), "v"(ts), "v"(ti) : "vcc");
            mrow[(((size_t)(kb >> 1) * 64 + lane) << 1) + (kb & 1)] = (unsigned short)w16;
            const unsigned cm = c16 & ~w16;
            if (cm) { unsigned base = __hip_atomic_fetch_add(st + 160 + r32, (unsigned)__builtin_popcount(cm), __ATOMIC_RELAXED, __HIP_MEMORY_SCOPE_WORKGROUP);
                _Pragma("unroll 1") for (unsigned cmv = cm; cmv; cmv &= cmv - 1u) { const unsigned r = (unsigned)__builtin_ctz(cmv); const unsigned d = ix_mono(ix_pick(sc, r)) - mbase;
                        if (base < (unsigned)IX_CAP) myrow[base] = (min(d, 0x7ffffu) << 13) | (8191u - (32u * (unsigned)kb + (r & 3u) + 8u * (r >> 2) + 4u * (unsigned)hi)); ++base; } } });
    }
    for (int kb = j + 1 + wave; kb <= (j | 7); kb += NWAVES) mrow[(((size_t)(kb >> 1) * 64 + lane) << 1) + (kb & 1)] = (unsigned short)0;
    asm volatile("s_waitcnt vmcnt(0)" ::: "memory");
    __syncthreads();
    if (j >= 8) {
#pragma unroll 1
        for (int qq = wave * 4; qq < wave * 4 + 4; ++qq) { LAS unsigned* row = hist + qq * IX_HS; const unsigned n = min(st[160 + qq], (unsigned)IX_CAP), need = st[32 + qq];
            const int ns = (int)((n + 63u) >> 6); unsigned T = 0u;
            if (ns <= 2) T = idx_select<2>(row, n, need, lane); else if (ns <= 4) T = idx_select<4>(row, n, need, lane); else if (ns <= 8) T = idx_select<8>(row, n, need, lane); else T = idx_select<16>(row, n, need, lane);
            for (int s = 0; s < ns; ++s) { const unsigned idx = (unsigned)(s * 64 + lane);
                if (idx < n) { const unsigned v = row[idx]; row[idx] = 0u;
                    if (v >= T) { const unsigned key = 8191u - (v & 8191u), kbk = key >> 5, ko = key & 31u, rr = (ko & 3u) + 4u * (ko >> 3), hh = (ko >> 2) & 1u;
                        __hip_atomic_fetch_or((unsigned*)mrow + (size_t)(kbk >> 1) * 64 + hh * 32 + qq, 1u << (16u * (kbk & 1u) + rr), __ATOMIC_RELAXED, __HIP_MEMORY_SCOPE_AGENT); } } } }
        __syncthreads();
    }
#undef IX_PASS
#undef IX_STEP
#undef IX_BODY
#undef IX_LAUNDER
}
__device__ __forceinline__ void idx_unit_of(int u, int& b, int& j) { const int slot = u >> 8, v = u & 255, i = v & 63; b = v >> 6; j = slot == 0 ? 255 - i : slot == 1 ? 128 + i : slot == 2 ? 127 - i : i; }

#include <hip/hip_bf16.h>
namespace attn_body {
using bf16=__hip_bfloat16;
using bf16x8=__attribute__((ext_vector_type(8)))short;
using s16x4=__attribute__((ext_vector_type(4)))short;
using f32x16=__attribute__((ext_vector_type(16)))float;
using u32x4=__attribute__((ext_vector_type(4)))unsigned;
constexpr int BATCH=4,NHEAD=8,SEQ=8192,D=64,DM=NHEAD*D,OPITCH=1024;
constexpr int NW=8,QBLK=32,QB=QBLK*NW,KVBLK=64,NQB=SEQ/QB;
constexpr int ATTN_PITCH=DM, ATTN_UNIT_ROWS=QB;
__device__ __forceinline__ int crow(int r,int hi){return (r&3)+8*(r>>2)+4*hi;}
#define SBAR() __builtin_amdgcn_sched_barrier(0)
#define MASK1(p,w,e) ({ unsigned m_; asm("v_bfe_i32 %0, %1, %2, 1":"=v"(m_):"v"(w),"n"(e)); __uint_as_float(__float_as_uint(p)&m_); })

constexpr int NSLOT=3, SLOTB=8192;
constexpr int LDS_K=0, LDS_V=NSLOT*SLOTB, LDS_WS=2*NSLOT*SLOTB, LDS_OST=LDS_WS+NW*64*4, LDS_BYTES=LDS_OST+NW*4096;
constexpr float C2=0.125f*1.4426950408889634f;
__device__ __forceinline__ void glds16(const void*gsrc,unsigned lds_dst){unsigned keep;
  asm volatile("s_mov_b32 %0, m0\n\ts_mov_b32 m0, %2\n\ts_nop 0\n\tglobal_load_lds_dwordx4 %1, off\n\ts_mov_b32 m0, %0":"=&s"(keep):"v"(gsrc),"s"(lds_dst):"memory");}
__device__ __forceinline__ float max3f(float a,float b,float c){float r;asm("v_max3_f32 %0, %1, %2, %3":"=v"(r):"v"(a),"v"(b),"v"(c));return r;}
__device__ __forceinline__ float max2f(float a,float b){float r;asm("v_max_f32_e32 %0, %1, %2":"=v"(r):"v"(a),"v"(b));return r;}
__device__ __forceinline__ float fadd_s(float a,float b){float r;asm("v_add_f32_e32 %0, %1, %2":"=v"(r):"v"(a),"v"(b));return r;}
__device__ __forceinline__ float fsub_s(float a,float b){float r;asm("v_sub_f32_e32 %0, %1, %2":"=v"(r):"v"(a),"v"(b));return r;}
typedef float f32x2_t __attribute__((ext_vector_type(2))); typedef __bf16 bf16x2_t __attribute__((ext_vector_type(2)));
__device__ __forceinline__ unsigned cvtpk_s(float lo,float hi){f32x2_t v={lo,hi};bf16x2_t b=__builtin_convertvector(v,bf16x2_t);return __builtin_bit_cast(unsigned,b);}
#define WAIT_BAR(N) asm volatile("s_waitcnt vmcnt(" #N ") lgkmcnt(0)\n\ts_barrier":::"memory")

__device__ __forceinline__ void qkt(f32x16&p0,f32x16&p1,const char*Kslot,const bf16x8*qr,const f32x16&negm,int r32,int hi){
  const char*kb=Kslot+hi*1024+r32*16;
  #pragma unroll
  for(int d0=0;d0<4;++d0){
    const bf16x8 b0=*reinterpret_cast<const bf16x8*>(kb+d0*2048);
    const bf16x8 b1=*reinterpret_cast<const bf16x8*>(kb+d0*2048+512);
    if(d0==0){p0=__builtin_amdgcn_mfma_f32_32x32x16_bf16(b0,qr[0],negm,0,0,0);p1=__builtin_amdgcn_mfma_f32_32x32x16_bf16(b1,qr[0],negm,0,0,0);}
    else{p0=__builtin_amdgcn_mfma_f32_32x32x16_bf16(b0,qr[d0],p0,0,0,0);p1=__builtin_amdgcn_mfma_f32_32x32x16_bf16(b1,qr[d0],p1,0,0,0);}}
}
typedef __attribute__((address_space(3))) const char* lds_cptr;
typedef short v4i16_t __attribute__((ext_vector_type(4)));
__device__ __forceinline__ void kload8(bf16x8*kf,lds_cptr kp){
  kf[0]=*(const __attribute__((address_space(3))) bf16x8*)(kp);      kf[1]=*(const __attribute__((address_space(3))) bf16x8*)(kp+512);
  kf[2]=*(const __attribute__((address_space(3))) bf16x8*)(kp+2048); kf[3]=*(const __attribute__((address_space(3))) bf16x8*)(kp+2560);
  kf[4]=*(const __attribute__((address_space(3))) bf16x8*)(kp+4096); kf[5]=*(const __attribute__((address_space(3))) bf16x8*)(kp+4608);
  kf[6]=*(const __attribute__((address_space(3))) bf16x8*)(kp+6144); kf[7]=*(const __attribute__((address_space(3))) bf16x8*)(kp+6656);
}
__device__ __forceinline__ void kload2(bf16x8*kf,lds_cptr kp,int j){ kf[2*j]=*(const __attribute__((address_space(3))) bf16x8*)(kp+j*2048); kf[2*j+1]=*(const __attribute__((address_space(3))) bf16x8*)(kp+j*2048+512); }
__device__ __forceinline__ s16x4 vtr(lds_cptr p){ return __builtin_bit_cast(s16x4,__builtin_amdgcn_ds_read_tr16_b64_v4i16((__attribute__((address_space(3))) v4i16_t*)p)); }
__device__ __forceinline__ float rowmax(const f32x16&p0,const f32x16&p1){
  float a=max3f(p0[0],p0[1],p1[0]),b=max3f(p0[2],p0[3],p1[1]);a=max3f(a,p1[2],p1[3]);
  #pragma unroll
  for(int r=4;r<16;r+=4){a=max3f(a,p0[r],p0[r+1]);b=max3f(b,p0[r+2],p0[r+3]);a=max3f(a,p1[r],p1[r+1]);b=max3f(b,p1[r+2],p1[r+3]);}
  const float m=max2f(a,b);
  auto rr=__builtin_amdgcn_permlane32_swap(__float_as_uint(m),__float_as_uint(m),false,false);
  return max2f(__uint_as_float(rr[0]),__uint_as_float(rr[1]));
}
__device__ __forceinline__ void pv(f32x16*o,int vb,bf16x8 pa0,bf16x8 pa1,bf16x8 pa2,bf16x8 pa3){
  #pragma unroll
  for(int d0=0;d0<2;++d0){s16x4 lo[4],hi[4];
    #pragma unroll
    for(int ks=0;ks<4;++ks){
      asm volatile("ds_read_b64_tr_b16 %0,%1 offset:%c2":"=&v"(lo[ks]):"v"(vb),"i"(d0*4096+ks*1024):"memory");
      asm volatile("ds_read_b64_tr_b16 %0,%1 offset:%c2":"=&v"(hi[ks]):"v"(vb),"i"(d0*4096+ks*1024+512):"memory");}
    asm volatile("s_waitcnt lgkmcnt(0)":::"memory");SBAR();
    #define PK(k) (bf16x8){lo[k][0],lo[k][1],lo[k][2],lo[k][3],hi[k][0],hi[k][1],hi[k][2],hi[k][3]}
    o[d0]=__builtin_amdgcn_mfma_f32_32x32x16_bf16(pa0,PK(0),o[d0],0,0,0);
    o[d0]=__builtin_amdgcn_mfma_f32_32x32x16_bf16(pa1,PK(1),o[d0],0,0,0);
    o[d0]=__builtin_amdgcn_mfma_f32_32x32x16_bf16(pa2,PK(2),o[d0],0,0,0);
    o[d0]=__builtin_amdgcn_mfma_f32_32x32x16_bf16(pa3,PK(3),o[d0],0,0,0);
    #undef PK
  }
}

#ifndef ATTN_STORE16
#define ATTN_STORE16(p,v) (*(u32x4*)(p)=(v))
#endif
template<int THRL> __device__ __forceinline__ void attn_unit(int b,int h,int qb,const bf16*Q,const bf16*__restrict__ K,const bf16*__restrict__ V,bf16*O,const unsigned*MASK,char*shm){
  int tid_=threadIdx.x; asm volatile("":"+v"(tid_));
  const int tid=tid_,lane=tid&63,r32=lane&31,hi=lane>>5; const int wid=__builtin_amdgcn_readfirstlane(tid>>6);
  const long rowbase=(long)b*SEQ; const int q0=qb*QB;
  const bf16*Qw=Q+(rowbase+q0+wid*QBLK)*DM+h*D;
  const bf16*Kh=K+rowbase*DM+h*D,*Vh=V+rowbase*DM+h*D;
  const unsigned lds0=(unsigned)(uintptr_t)shm;
  float*wsf=(float*)(shm+LDS_WS)+wid*64;
  const bf16*ksrc=Kh+(long)lane*DM+wid*8;
  const bf16*vsrc=Vh+(long)(16*(wid&3)+(lane>>2))*DM+(wid>>2)*32+(lane&3)*8;
  const unsigned kdst=lds0+LDS_K+wid*1024, vdst=lds0+LDS_V+wid*1024;
  #define DMA_K(t,slot) glds16(ksrc+(long)(t)*KVBLK*DM,(unsigned)__builtin_amdgcn_readfirstlane(kdst+(slot)))
  #define DMA_V(t,slot) glds16(vsrc+(long)(t)*KVBLK*DM,(unsigned)__builtin_amdgcn_readfirstlane(vdst+(slot)))
  const int vb0=(int)(lds0+LDS_V)+((lane>>4)&1)*32+(lane&3)*8+(4*hi+((lane&15)>>2))*64;
  const char*Kbase=shm+LDS_K; bf16x8 kf[8];
  const lds_cptr shm3=(lds_cptr)shm; const lds_cptr kp0=shm3+LDS_K+hi*1024+r32*16; const lds_cptr vp0=shm3+LDS_V+((lane>>4)&1)*32+(lane&3)*8+(4*hi+((lane&15)>>2))*64;
  const int NT=(q0+QB)/KVBLK;
  const unsigned*mwl=MASK+((size_t)(b*256+qb*8+wid)*128)*64+lane;
  unsigned wA,wB;
  #define WLOAD(W,t) asm volatile("global_load_dword %0, %1, off":"=v"(W):"v"(mwl+(size_t)(t)*64):"memory")
  WLOAD(wA,0);WLOAD(wB,1);
  DMA_K(0,0);DMA_V(0,0);DMA_K(1,SLOTB);
  bf16x8 qr[4];
  #pragma unroll
  for(int d0=0;d0<4;++d0)qr[d0]=*reinterpret_cast<const bf16x8*>(&Qw[(long)r32*DM+d0*16+hi*8]);
  float mhat=0.f,l_reg=0.f;f32x16 o[2];o[0]=f32x16{};o[1]=f32x16{};f32x16 negm=f32x16{};asm volatile("":"+v"(negm));
  bool resc=false;
  #define START(P0,P1) do{ const float rm=rowmax(P0,P1); resc=false; \
    { const float dl=rm>-1e30f?rm:0.f; mhat=fadd_s(mhat,dl); \
      _Pragma("unroll") for(int r=0;r<16;++r){P0[r]=fsub_s(P0[r],dl);P1[r]=fsub_s(P1[r],dl);} \
      _Pragma("unroll") for(int r=0;r<16;++r)negm[r]=-mhat; asm volatile("":"+v"(negm)); } \
    _Pragma("unroll") for(int r=0;r<16;++r)P0[r]=__builtin_amdgcn_exp2f(P0[r]); }while(0)
  #define RESC() do{ if(resc){ asm volatile("s_waitcnt lgkmcnt(0)":::"memory"); \
      _Pragma("unroll") for(int d_=0;d_<2;++d_) _Pragma("unroll") for(int r=0;r<16;++r)o[d_][r]*=wsf[crow(r,hi)]; } }while(0)
  f32x16 pA0,pA1,pB0,pB1;
  int sl_prev=0,sl_cur=0,sl_next=SLOTB;
  #define ROT() do{sl_prev=sl_cur;sl_cur=sl_next;sl_next=(sl_next==(NSLOT-1)*SLOTB)?0:sl_next+SLOTB;}while(0)
  DMA_K(2,2*SLOTB);
  WAIT_BAR(3);
  qkt(pA0,pA1,Kbase,qr,negm,r32,hi);asm volatile("s_nop 15\n\ts_nop 7":"+v"(pA0),"+v"(pA1));
  START(pA0,pA1);
  _Pragma("unroll") for(int r=0;r<16;++r)pA1[r]=__builtin_amdgcn_exp2f(pA1[r]);
  _Pragma("unroll") for(int r=0;r<16;++r){pA0[r]=MASK1(pA0[r],wA,r);pA1[r]=MASK1(pA1[r],wA,16+r);}
  WAIT_BAR(0);
  DMA_K(3,0);DMA_V(1,SLOTB);
  ROT();
  kload8(kf,kp0+sl_cur);
  WAIT_BAR(2);
  s16x4 vlo[8],vhi[8]; u32x4 pw0,pw1,pw2,pw3;
  #define PKW(P,B) cvtpk_s(P[B],P[B+1])
  #define PAF(k) __builtin_bit_cast(bf16x8,pw##k)
  #define VFR(i) (bf16x8){vlo[i][0],vlo[i][1],vlo[i][2],vlo[i][3],vhi[i][0],vhi[i][1],vhi[i][2],vhi[i][3]}
  #define PIN(x) asm volatile("":"+v"(x))
  #define MX3(a,b,c) __builtin_fmaxf(__builtin_fmaxf((a),(b)),(c))
  #define GAPA(MF,A0,A1,A2,A3,W0,W1,PW) do{ MF; sacc+=A0; sacc+=A1; sacc+=A2; sacc+=A3; PIN(sacc); W0; W1; PIN(PW); SBAR(); }while(0)
  #define EX(v) __builtin_amdgcn_exp2f(v)
  #define BFE1(m,w,e) asm("v_bfe_i32 %0, %1, %2, 1":"=v"(m):"v"(w),"n"(e))
  #define AND1(x,m) __uint_as_float(__float_as_uint(x)&(m))
  #define GAPB(MF,X,B,W,E) do{ MF; unsigned m0_,m1_,m2_,m3_; BFE1(m0_,W,(E)); BFE1(m1_,W,(E)+1); BFE1(m2_,W,(E)+2); BFE1(m3_,W,(E)+3); SBAR(); const float e0_=EX(X[B]); SBAR(); const float e1_=EX(X[B+1]); SBAR(); const float e2_=EX(X[B+2]); SBAR(); const float e3_=EX(X[B+3]); SBAR(); \
      X[B]=AND1(e0_,m0_); SBAR(); X[B+1]=AND1(e1_,m1_); SBAR(); X[B+2]=AND1(e2_,m2_); SBAR(); X[B+3]=AND1(e3_,m3_); PIN(X); SBAR(); }while(0)
  #define VRD(i) do{ vlo[i]=vtr(vp_+(((i)>>2)*4096+((i)&3)*1024)); vhi[i]=vtr(vp_+(((i)>>2)*4096+((i)&3)*1024+512)); }while(0)
  #define KRD(G,j) do{ if(G){ kload2(kf,kp0+sl_next,j); SBAR(); } }while(0)
  #define STEP(C0,C1,P0,P1,t,GK,GV,GL,WU,WL) do{ SBAR(); if((t)+1<NT){WLOAD(WL,(t)+1);} SBAR(); \
    const lds_cptr vp_=vp0+sl_prev; \
    VRD(0); SBAR(); float sacc=(P0[0]+P0[1]); \
    GAPA(C0=__builtin_amdgcn_mfma_f32_32x32x16_bf16(kf[0],qr[0],negm,0,0,0), P0[2],P0[3],P0[4],P0[5],     pw0[0]=PKW(P0,0), pw0[1]=PKW(P0,2), pw0); \
    VRD(4); SBAR(); GAPA(C1=__builtin_amdgcn_mfma_f32_32x32x16_bf16(kf[1],qr[0],negm,0,0,0), P0[6],P0[7],P0[8],P0[9],     pw0[2]=PKW(P0,4), pw0[3]=PKW(P0,6), pw0); \
    VRD(1); SBAR(); GAPA(C0=__builtin_amdgcn_mfma_f32_32x32x16_bf16(kf[2],qr[1],C0,0,0,0),   P0[10],P0[11],P0[12],P0[13], pw1[0]=PKW(P0,8), pw1[1]=PKW(P0,10), pw1); \
    VRD(5); SBAR(); GAPA(C1=__builtin_amdgcn_mfma_f32_32x32x16_bf16(kf[3],qr[1],C1,0,0,0),   P0[14],P0[15],P1[0],P1[1],   pw1[2]=PKW(P0,12),pw1[3]=PKW(P0,14), pw1); \
    VRD(2); SBAR(); GAPA(C0=__builtin_amdgcn_mfma_f32_32x32x16_bf16(kf[4],qr[2],C0,0,0,0),   P1[2],P1[3],P1[4],P1[5],     pw2[0]=PKW(P1,0), pw2[1]=PKW(P1,2), pw2); \
    VRD(6); SBAR(); GAPA(C1=__builtin_amdgcn_mfma_f32_32x32x16_bf16(kf[5],qr[2],C1,0,0,0),   P1[6],P1[7],P1[8],P1[9],     pw2[2]=PKW(P1,4), pw2[3]=PKW(P1,6), pw2); \
    VRD(3); SBAR(); GAPA(C0=__builtin_amdgcn_mfma_f32_32x32x16_bf16(kf[6],qr[3],C0,0,0,0),   P1[10],P1[11],P1[12],P1[13], pw3[0]=PKW(P1,8), pw3[1]=PKW(P1,10), pw3); \
    VRD(7); SBAR(); GAPA(C1=__builtin_amdgcn_mfma_f32_32x32x16_bf16(kf[7],qr[3],C1,0,0,0),   P1[14],P1[15],0.f,0.f,       pw3[2]=PKW(P1,12),pw3[3]=PKW(P1,14), pw3); \
    l_reg+=sacc; \
    if(GK){DMA_K((t)+3,sl_cur);} if(GV){DMA_V((t)+1,sl_next);} \
    { float a=MX3(C0[0],C0[1],C1[0]),b=MX3(C0[2],C0[3],C1[1]); a=MX3(a,C1[2],C1[3]); \
      _Pragma("unroll") for(int r=4;r<16;r+=4){a=MX3(a,C0[r],C0[r+1]);b=MX3(b,C0[r+2],C0[r+3]);a=MX3(a,C1[r],C1[r+1]);b=MX3(b,C1[r+2],C1[r+3]);} \
      float rm=__builtin_fmaxf(a,b); { auto rr=__builtin_amdgcn_permlane32_swap(__float_as_uint(rm),__float_as_uint(rm),false,false); rm=__builtin_fmaxf(__uint_as_float(rr[0]),__uint_as_float(rr[1])); } \
      resc=false; \
      if(__builtin_expect(__any(rm>(float)THRL),0)){ const float dl=__builtin_fmaxf(rm,0.f); mhat+=dl; \
        _Pragma("unroll") for(int r=0;r<16;++r){C0[r]-=dl;C1[r]-=dl;} \
        _Pragma("unroll") for(int r=0;r<16;++r)negm[r]=-mhat; asm volatile("":"+v"(negm)); \
        const float f=__builtin_amdgcn_exp2f(-dl); l_reg*=f; if(hi==0)wsf[r32]=f; resc=true; } } \
    SBAR(); \
    GAPB(o[0]=__builtin_amdgcn_mfma_f32_32x32x16_bf16(PAF(0),VFR(0),o[0],0,0,0), C0,0,WU,0); \
    GAPB(o[1]=__builtin_amdgcn_mfma_f32_32x32x16_bf16(PAF(0),VFR(4),o[1],0,0,0), C0,4,WU,4); \
    KRD(GL,0); GAPB(o[0]=__builtin_amdgcn_mfma_f32_32x32x16_bf16(PAF(1),VFR(1),o[0],0,0,0), C0,8,WU,8); \
    KRD(GL,1); GAPB(o[1]=__builtin_amdgcn_mfma_f32_32x32x16_bf16(PAF(1),VFR(5),o[1],0,0,0), C0,12,WU,12); \
    KRD(GL,2); GAPB(o[0]=__builtin_amdgcn_mfma_f32_32x32x16_bf16(PAF(2),VFR(2),o[0],0,0,0), C1,0,WU,16); \
    KRD(GL,3); GAPB(o[1]=__builtin_amdgcn_mfma_f32_32x32x16_bf16(PAF(2),VFR(6),o[1],0,0,0), C1,4,WU,20); \
    GAPB(o[0]=__builtin_amdgcn_mfma_f32_32x32x16_bf16(PAF(3),VFR(3),o[0],0,0,0), C1,8,WU,24); \
    GAPB(o[1]=__builtin_amdgcn_mfma_f32_32x32x16_bf16(PAF(3),VFR(7),o[1],0,0,0), C1,12,WU,28); \
    }while(0)
  int t=1;
  for(;t+5<NT;t+=2){
    STEP(pB0,pB1,pA0,pA1,t,true,true,true,wB,wA);     WAIT_BAR(2); RESC(); ROT();
    STEP(pA0,pA1,pB0,pB1,t+1,true,true,true,wA,wB);   WAIT_BAR(2); RESC(); ROT();
  }
  #define ENDW(tt) do{ if((tt)+3<NT){WAIT_BAR(2);} else if((tt)+2<NT){WAIT_BAR(1);} else {WAIT_BAR(0);} }while(0)
  for(;t+1<NT;t+=2){
    STEP(pB0,pB1,pA0,pA1,t,(t+3<NT),(t+1<NT),(t+1<NT),wB,wA);       ENDW(t);   RESC(); ROT();
    STEP(pA0,pA1,pB0,pB1,t+1,(t+4<NT),(t+2<NT),(t+2<NT),wA,wB);     ENDW(t+1); RESC(); ROT();
  }
  STEP(pB0,pB1,pA0,pA1,NT-1,false,false,false,wB,wA); RESC();
  { float sacc=pB0[0]+pB0[1]; _Pragma("unroll") for(int r=2;r<16;++r)sacc+=pB0[r]; _Pragma("unroll") for(int r=0;r<16;++r)sacc+=pB1[r]; l_reg+=sacc;
    pw0=(u32x4){PKW(pB0,0),PKW(pB0,2),PKW(pB0,4),PKW(pB0,6)};pw1=(u32x4){PKW(pB0,8),PKW(pB0,10),PKW(pB0,12),PKW(pB0,14)};pw2=(u32x4){PKW(pB1,0),PKW(pB1,2),PKW(pB1,4),PKW(pB1,6)};pw3=(u32x4){PKW(pB1,8),PKW(pB1,10),PKW(pB1,12),PKW(pB1,14)};
    SBAR(); pv(o,vb0+sl_cur,PAF(0),PAF(1),PAF(2),PAF(3)); }
  #undef PKW
  #undef PAF
  #undef VFR
  #undef PIN
  #undef MX3
  #undef GAPA
  #undef GAPB
  #undef EX
  #undef VRD
  #undef KRD
  #undef STEP
  #undef ENDW
  {auto rr=__builtin_amdgcn_permlane32_swap(__float_as_uint(l_reg),__float_as_uint(l_reg),false,false);l_reg=__uint_as_float(rr[0])+__uint_as_float(rr[1]);}
  if(hi==0)wsf[32+r32]=l_reg;asm volatile("s_waitcnt lgkmcnt(0)":::"memory");
  float rli[16];
  #pragma unroll
  for(int r=0;r<16;++r)rli[r]=__builtin_amdgcn_rcpf(wsf[32+crow(r,hi)]);
  bf16*Ow=O+(rowbase+q0+wid*QBLK)*OPITCH+h*D;
  { bf16*stg=(bf16*)(shm+LDS_OST)+wid*2048;
    #pragma unroll
    for(int r=0;r<16;++r){const int orow=crow(r,hi);
      #pragma unroll
      for(int d0=0;d0<2;++d0)stg[orow*64+d0*32+r32]=__float2bfloat16(o[d0][r]*rli[r]);}
    asm volatile("s_waitcnt lgkmcnt(0)":::"memory");
    #pragma unroll
    for(int i=0;i<4;++i){const int row=i*8+(lane>>3),ch=lane&7; const u32x4 v=*(const u32x4*)(stg+row*64+ch*8); ATTN_STORE16(Ow+(long)row*OPITCH+ch*8,v);} }
  asm volatile("s_waitcnt lgkmcnt(0)\n\ts_barrier":::"memory");
  #undef DMA_K
  #undef DMA_V
  #undef WLOAD
  #undef START
  #undef RESC
  #undef ROT
}
constexpr int ATTN_LDS_BYTES=LDS_BYTES;
struct AttnTensors { const bf16* Q; const bf16* K; const bf16* V; bf16* O; const unsigned* MASK; };
struct AttnUnit { int bh; int qb; };
struct StaticOrder {
  int vcu;
  int grid;
  __device__ __forceinline__ explicit StaticOrder(int grid_,int block):vcu((grid_%8==0)?(block%8)*(grid_/8)+block/8:block),grid(grid_){}
  __device__ __forceinline__ bool next(int i,AttnUnit&u)const{ const int v=vcu+(i>>2)*grid; if(v>=256)return false; const int k=i&3,s=v&7; u.bh=v>>3; u.qb=(k==0)?s:(k==1)?15-s:(k==2)?16+s:31-s; return true; }
  __device__ __forceinline__ void a_ready(const AttnUnit&)const{}
  __device__ __forceinline__ void done(const AttnUnit&)const{}
};
template<class Sched,int THRL=8> __device__ __forceinline__ void attn_phase(char*lds,const AttnTensors&T,const Sched&S){
  AttnUnit u;
  for(int i=0;S.next(i,u);++i){ S.a_ready(u); attn_unit<THRL>(u.bh/NHEAD,u.bh%NHEAD,u.qb,T.Q,T.K,T.V,T.O,T.MASK,lds); S.done(u); }
}
#undef SBAR
#undef WAIT_BAR
}

#ifndef MK_EN
#define MK_EN 0x3ff
#endif
#define EN(n) (((MK_EN) >> (n)) & 1)
#ifndef MK_NAIVE_SELECT
#define MK_NAIVE_SELECT 0
#endif
#ifndef MK_NAIVE_ATTN
#define MK_NAIVE_ATTN 0
#endif
#ifndef MK_DUP
#define MK_DUP 0
#endif
#ifndef MK_REPN
#define MK_REPN 1
#endif
#define REP(n) for (int rep_ = 0; rep_ < 1 + MK_REPN * (((MK_DUP) >> (n)) & 1); ++rep_)
#ifndef MK_ONE_LAUNCH
#define MK_ONE_LAUNCH 1
#endif
__device__ __forceinline__ bool static_unit(int nM, int nN, int G, int c, int i, int& pm, int& pn) {
    const int nwg = nM * nN; const long L = (long)i * G + c; if (L >= nwg) return false;
    int wgid = (int)L; { const int q = nwg / 8, r = nwg % 8, xcd = wgid % 8, off = wgid / 8; wgid = (xcd < r ? xcd * (q + 1) : r * (q + 1) + (xcd - r) * q) + off; }
    const int nig = 8 * nN, gid = wgid / nig, fm = gid * 8, gsz = (nM - fm) < 8 ? (nM - fm) : 8;
    pm = fm + ((wgid % nig) % gsz); pn = (wgid % nig) / gsz; return true;
}
__global__ void __launch_bounds__(NWAVES * 64, 2) mk_fwd(Args args) {
    extern __shared__ __attribute__((aligned(16))) unsigned char lds[];
    Frame F;
    F.lds = (LAS unsigned char*)lds; F.MISC = (volatile LAS unsigned*)(F.lds + MISC_OFF);
    F.tid = threadIdx.x; F.lane = F.tid & 63; F.wave = __builtin_amdgcn_readfirstlane(F.tid >> 6);
    F.G = gridDim.x; { const int bx = blockIdx.x; F.vcu = (F.G % 8 == 0) ? (bx % 8) * (F.G / 8) + bx / 8 : bx; }
    KArgs A = (KArgs)__builtin_amdgcn_kernarg_segment_ptr();
    unsigned char* ws = A->ws; F.ws = ws; F.ctl = (gu32*)(ws + WS_CTL);
#define PHASE_BEGIN() do { int t_ = threadIdx.x; asm volatile("" : "+v"(t_)); F.tid = t_; F.lane = t_ & 63; F.wave = __builtin_amdgcn_readfirstlane(t_ >> 6); \
        A = (KArgs)__builtin_amdgcn_kernarg_segment_ptr(); asm volatile("" : "+s"(A)); ws = A->ws; F.ws = ws; F.ctl = (gu32*)(ws + WS_CTL); } while (0)
    for (int u = F.tid; u < (LDS_BYTES - LDSCTL_OFF) / 4; u += NWAVES * 64) ((LAS unsigned*)(F.lds + LDSCTL_OFF))[u] = 0u;
    __syncthreads();
    const int lo = A->ph_lo, hi = A->ph_hi;
    XcdBarrier bar; bar.bar = (unsigned*)(F.ctl + CW_BAR); bar.x = 0; bar.st = nullptr;
    if (hi - lo > 1) bar = xcd_barrier_post((unsigned*)(F.ctl + CW_BAR), F.MISC + 8);
#define IN(k) (lo <= (k) && (k) < hi)
#define SEAM(k) do { if (IN(k) && IN((k) + 1)) xcd_barrier(bar); } while (0)
#define X ((bf16*)(ws + WS_X))
#define SSV(k) ((float*)(ws + WS_SS + (size_t)((k) & 1) * SS_STAGE))

    if (EN(0) && IN(0)) { PHASE_BEGIN(); REP(0) p0_prologue(F, A); SEAM(0); }
    for (int l = 0; l < DEPTH; ++l) {
        const int pb = 2 + 11 * l;
#define FFN_UP(PH, WGU, SSIN) if (EN(2) && IN(PH)) { PHASE_BEGIN(); unsigned char* wl = ws + WS_W + (size_t)l * W_LAYER; \
            pg8::Gemm g{X, (const bf16*)(wl + (WGU)), M, NGU, D}; pg8::StaticOrder S; S.init(M, NGU, F.G, (int)blockIdx.x); \
            pg8::EpiSwiGLU E{(bf16*)(ws + WS_H), SSV(SSIN)}; \
            REP(2) pg8::gemm_phase<pg8::EpiSwiGLU, pg8::StaticOrder, true, true>(F.lds + RING_OFF, g, S, E); SEAM(PH); }
#define GEMM_RES(PH, A, W, KK, SSOUT, SCALE, F8, WX8, AB) if (EN(3) && IN(PH)) { PHASE_BEGIN(); unsigned char* wl = ws + WS_W + (size_t)l * W_LAYER; \
            pg8::Gemm g{(const bf16*)(A), (const bf16*)(wl + (W)), M, D, (KK)}; pg8::StaticOrder S; S.init(M, D, F.G, (int)blockIdx.x); \
            REP(3) { const pg8::EpiRes<WX8> E{X, SSV(SSOUT), rep_ ? 0.f : (SCALE)}; pg8::gemm_phase<pg8::EpiRes<WX8>, pg8::StaticOrder, true, true, F8, AB>(F.lds + RING_OFF, g, S, E); } SEAM(PH); }
        FFN_UP(pb + 0, WO_GU1, 4 * l)
        GEMM_RES(pb + 1, ws + WS_H, WO_D1, FF / 2, 4 * l + 1, 0.5f / 64.f, true, false, true)
        if (EN(4) && IN(pb + 2)) { PHASE_BEGIN(); unsigned char* wl = ws + WS_W + (size_t)l * W_LAYER;
            pg8::Gemm g{(const bf16*)ws, (const bf16*)ws, M, NINP, D}; const pg8::WinKVOrder S{F.G, (int)blockIdx.x, (int)((WS_W + (size_t)l * W_LAYER + WO_IN) >> 19), l == 0 ? 64 : 0};
            const pg8::EpiWinKV E{ws, SSV(4 * l + 1), QSCALE, (int)((WS_W + (size_t)l * W_LAYER + WO_IN) >> 19)};
            REP(4) pg8::gemm_phase<pg8::EpiWinKV, pg8::WinKVOrder, true, true>(F.lds + RING_OFF, g, S, E); SEAM(pb + 2);
        }
        if (EN(5) && IN(pb + 3)) { PHASE_BEGIN(); REP(5) {
            REP(10) for (int u = F.vcu; u < M / 64; u += F.G) conv_a_unit(F, (const bf16*)(ws + WS_HG), (bf16*)(ws + WS_MIX), INF(A, I_CONF_DW) + l * 31 * 256, INF(A, I_CONF_DW_B) + l * 256, INF(A, I_CONF_LN_G) + l * 256, INF(A, I_CONF_LN_B) + l * 256, u);
            REP(11) conv_b_all(F, (const bf16*)(ws + WS_U), (const bf16*)(ws + WS_BG), (bf16*)(ws + WS_MIX), INF(A, I_SC_DW) + l * 3 * 256);
#if !MK_NAIVE_SELECT
            for (int u = F.tid; u < 32 * IX_HS + 192; u += NWAVES * 64) ((LAS unsigned*)(F.lds + RING_OFF))[u] = 0u;
            __syncthreads();
            for (int u = F.vcu; u < 1024; u += F.G) { int b, j; idx_unit_of(u, b, j); idx_unit(F, (const bf16*)(ws + WS_QI), (const bf16*)(ws + WS_KI), (const float*)(ws + WS_WI), (unsigned*)(ws + (l ? WS_MASK1 : WS_MASK)), b, j); }
#endif
            }
            SEAM(pb + 3);
        }
        if (EN(6) && IN(pb + 4)) { PHASE_BEGIN();
#if MK_NAIVE_SELECT
            for (int q = F.vcu; q < M; q += F.G) dsa_naive_query<false>(F, (const bf16*)(ws + WS_Q), (const bf16*)(ws + WS_K), (const bf16*)(ws + WS_V), (const bf16*)(ws + WS_QI), (const bf16*)(ws + WS_KI), (const float*)(ws + WS_WI), nullptr, (bf16*)(ws + WS_MIX), q);
#elif MK_NAIVE_ATTN
            for (int q = F.vcu; q < M; q += F.G) dsa_naive_query<true>(F, (const bf16*)(ws + WS_Q), (const bf16*)(ws + WS_K), (const bf16*)(ws + WS_V), (const bf16*)(ws + WS_QI), (const bf16*)(ws + WS_KI), (const float*)(ws + WS_WI), (const unsigned long long*)(ws + (l ? WS_MASK1 : WS_MASK)), (bf16*)(ws + WS_MIX), q);
#else
            { const attn_body::AttnTensors AT{(const attn_body::bf16*)(ws + WS_Q), (const attn_body::bf16*)(ws + WS_K), (const attn_body::bf16*)(ws + WS_V), (attn_body::bf16*)(ws + WS_MIX) + 512, (const unsigned*)(ws + (l ? WS_MASK1 : WS_MASK))};
              const attn_body::StaticOrder S((int)F.G, (int)blockIdx.x);
              REP(6) attn_body::attn_phase<attn_body::StaticOrder>((char*)lds + RING_OFF, AT, S); }
#endif
            SEAM(pb + 4);
        }
        GEMM_RES(pb + 5, ws + WS_MIX, WO_OUT, D, 4 * l + 2, 1.0f, false, true, false)
        if (EN(7) && IN(pb + 6)) { PHASE_BEGIN(); unsigned char* wl = ws + WS_W + (size_t)l * W_LAYER;
            pg8::Gemm g{(const bf16*)(ws + WS_X8), (const bf16*)(wl + WO_Q), M, D, D / 2}; pg8::StaticOrder S; S.init(M, D, F.G, (int)blockIdx.x);
            pg8::EpiRowScale E{(bf16*)(ws + WS_XQ), D, SSV(4 * l + 2), XQSCALE / 64.f};
            REP(7) pg8::gemm_phase<pg8::EpiRowScale, pg8::StaticOrder, true, true, true>(F.lds + RING_OFF, g, S, E);
            if (EN(8)) { PHASE_BEGIN(); for (int i = 0;; ++i) { int upm, upn; if (!static_unit(M / 256, D / 256, F.G, (int)blockIdx.x, i, upm, upn)) break; xattn_unit(F, (const bf16*)(ws + WS_XQ), ws + WS_XO8, (const bf16*)(ws + WS_MEMK) + (size_t)l * 1024 * 1024, (const bf16*)(ws + WS_MEMVT) + (size_t)l * 1024 * 1024, upm, upn); } }
            SEAM(pb + 6);
        }
        GEMM_RES(pb + 8, ws + WS_XO8, WO_O, D / 2, 4 * l + 3, 1.0f / 64.f, true, false, false)
        FFN_UP(pb + 9, WO_GU2, 4 * l + 3)
        GEMM_RES(pb + 10, ws + WS_H, WO_D2, FF / 2, 4 * l + 4, 0.5f / 64.f, true, false, true)
    }
    if (EN(9) && IN(NPH - 1)) { PHASE_BEGIN(); final_norm_all(F, X, SSV(4 * DEPTH), INF(A, I_FINAL_NORM), A->out); }
#undef IN
#undef SEAM
#undef X
#undef SSV
}

extern "C" void kernel_launch(void* const* d_in, const int* in_sizes, int n_in, void* d_out, int out_size, void* d_ws, size_t ws_size, hipStream_t stream) {
    static int grid = 0;
    if (grid == 0) {
        if (n_in != 25 || in_sizes[0] != M * D || out_size != M * D || ws_size < WS_END) { fprintf(stderr, "kernel_launch: unexpected shapes (n_in %d, in0 %d, out %d, ws %zu); nothing launched\n", n_in, n_in > 0 ? in_sizes[0] : -1, out_size, ws_size); grid = -1; return; }
        int dev = 0, cus = 0, per_cu = 0;
        if (hipGetDevice(&dev) != hipSuccess || hipDeviceGetAttribute(&cus, hipDeviceAttributeMultiprocessorCount, dev) != hipSuccess) { grid = -1; return; }
        if (hipFuncSetAttribute((const void*)mk_fwd, hipFuncAttributeMaxDynamicSharedMemorySize, LDS_BYTES) != hipSuccess) { fprintf(stderr, "kernel_launch: hipFuncSetAttribute failed\n"); grid = -1; return; }
        if (hipOccupancyMaxActiveBlocksPerMultiprocessor(&per_cu, (const void*)mk_fwd, NWAVES * 64, LDS_BYTES) != hipSuccess || per_cu < 1) { fprintf(stderr, "kernel_launch: occupancy query reports %d\n", per_cu); }
        (void)hipGetLastError();
        grid = cus;
    }
    if (grid < 0) return;
    if (hipMemsetAsync((char*)d_ws + WS_CTL, 0, CTL_ZERO_BYTES, stream) != hipSuccess) return;
    Args a{};
    for (int i = 0; i < 25; ++i) a.in[i] = d_in[i];
    a.out = (float*)d_out; a.ws = (unsigned char*)d_ws;
    for (int i = 0; i < 32; ++i) a.invf[i] = powf(10000.0f, -(float)(2 * i) / 64.0f);
#if MK_ONE_LAUNCH
    a.ph_lo = 0; a.ph_hi = NPH;
    hipLaunchKernelGGL(mk_fwd, dim3(grid), dim3(NWAVES * 64), LDS_BYTES, stream, a);
#else
    for (int p = 0; p < NPH; ++p) { a.ph_lo = p; a.ph_hi = p + 1; hipLaunchKernelGGL(mk_fwd, dim3(grid), dim3(NWAVES * 64), LDS_BYTES, stream, a); }
#endif
}
```

```cpp
#include <hip/hip_runtime.h>
#include <cstdio>
#include <cstdint>
#include <cmath>
constexpr int NWAVES = 8;
constexpr int M = 32768, D = 1024, FF = 2816, SEQ = 8192, NBATCH = 4, DEPTH = 2, NGU = 2 * FF  , NINP = 3328  , NIN = 3140;
constexpr int NPH = 2 + 11 * DEPTH + 1;
constexpr float QSCALE = 0.125f * 1.4426950408889634f;
constexpr float XQSCALE = 0.0625f * 1.4426950408889634f;
constexpr float IDX_SCALE = 0.5f * 0.125f;
constexpr size_t MiB = 1u << 20;
constexpr size_t WS_CTL = 0, CTL_ZERO_BYTES = 1 * MiB;
constexpr size_t WS_SS = 448 * MiB, SS_STAGE = 2 * MiB;
constexpr size_t WS_MSS = 3 * MiB;
constexpr size_t WS_COS = 4 * MiB, WS_SIN = 8 * MiB;
constexpr size_t WS_MK = 12 * MiB;
constexpr size_t WS_MEMK = 22 * MiB, WS_MEMVT = 26 * MiB;
constexpr size_t WS_W = 30 * MiB, W_LAYER = 45 * MiB + MiB / 2;
constexpr size_t WO_GU1 = 0, WO_D1 = 11 * MiB, WO_IN = WO_D1 + 5 * MiB + MiB / 2, WO_OUT = WO_IN + 6 * MiB + MiB / 2, WO_Q = WO_OUT + 2 * MiB, WO_O = WO_Q + 2 * MiB, WO_GU2 = WO_O + 2 * MiB, WO_D2 = WO_GU2 + 11 * MiB;
static_assert(WO_D2 + 5 * MiB + MiB / 2 == W_LAYER, "weight map");
constexpr size_t WS_X = 122 * MiB;
constexpr size_t WS_R = 186 * MiB;
constexpr size_t WS_H = WS_R;
constexpr size_t WS_HG = WS_R, WS_U = WS_R + 16 * MiB, WS_BG = WS_R + 32 * MiB, WS_Q = WS_R + 48 * MiB, WS_K = WS_R + 80 * MiB, WS_V = WS_R + 112 * MiB, WS_QI = WS_R + 144 * MiB,
                 WS_KI = WS_R + 160 * MiB, WS_WI = WS_R + 164 * MiB, WS_MIX = WS_R + 165 * MiB, WS_MASK = WS_R + 229 * MiB, WS_MIXEND = WS_R + 261 * MiB;
constexpr size_t WS_XQ = WS_R;
constexpr size_t WS_X8 = WS_R + 96 * MiB;
constexpr size_t WS_XO8 = WS_R + 64 * MiB;
constexpr size_t WS_MASK1 = 452 * MiB;
constexpr size_t WS_END = 484 * MiB;
static_assert(WS_W + 2 * W_LAYER <= WS_X && WS_X + (size_t)M * D * 2 <= WS_R && WS_H + (size_t)M * FF * 2 <= WS_END && WS_MIXEND <= WS_END, "d_ws map");
constexpr int CW_TMO = 0, CW_BAR = 4096;
constexpr int RING_OFF = 0, RING_BYTES = 131072, LDSCTL_OFF = 143360, MISC_OFF = LDSCTL_OFF + 320, LDS_BYTES = 147456;

namespace pg8 {
#define PG8_LAS __attribute__((address_space(3)))
typedef unsigned short bf16_t;
typedef short bf16x8 __attribute__((ext_vector_type(8)));
typedef float f32x4 __attribute__((ext_vector_type(4)));
typedef unsigned u32x4 __attribute__((ext_vector_type(4)));
constexpr int BM = 256, BK = 64, HALF = 128, HTB = HALF * BK * 2  , STAGE_BYTES = 8 * HTB, NXCD = 8, WGM = 8;

__host__ __device__ __forceinline__ int lds_byte(int r, int c) { const int st = (r >> 4) * 2 + (c >> 5), rr = r & 15, cc = c & 31, ob = rr * 64 + cc * 2; return st * 1024 + (ob ^ (((ob >> 9) & 1) << 5)); }
__host__ __device__ __forceinline__ void stage_rc(int b, int& R, int& C) { const int st = b / 1024, sb = b % 1024, swz = sb ^ (((sb >> 9) & 1) << 5); R = (st >> 1) * 16 + swz / 64; C = (st & 1) * 32 + (swz % 64) / 2; }
__host__ __device__ __forceinline__ int perm32(int rho) { const int n = rho >> 4, i = rho & 15; return 8 * (i >> 2) + 4 * n + (i & 3); }

struct Unit { int pm, pn; };
struct Gemm { const bf16_t* A; const bf16_t* Bt; int M, N, K; };

struct StaticOrder {
    int nM, nN, nwg, G, c;
    __host__ __device__ void init(int M, int N, int G_, int c_) { nM = M / BM; nN = N / BM; nwg = nM * nN; G = G_; c = c_; }
    __host__ __device__ bool next(int i, Unit& u) const {
        const long L = (long)i * G + c; if (L >= nwg) return false;
        int wgid = (int)L; { const int q = nwg / NXCD, r = nwg % NXCD, xcd = wgid % NXCD, off = wgid / NXCD; wgid = (xcd < r ? xcd * (q + 1) : r * (q + 1) + (xcd - r) * q) + off; }
        const int nig = WGM * nN, gid = wgid / nig, fm = gid * WGM, gsz = (nM - fm) < WGM ? (nM - fm) : WGM;
        u.pm = fm + ((wgid % nig) % gsz); u.pn = (wgid % nig) / gsz; return true;
    }
    __device__ __forceinline__ void a_ready(const Unit&) const {}
    __device__ __forceinline__ void done(const Unit&) const {}
};
__device__ __forceinline__ unsigned cvt_pk_bf16(float lo, float hi) { unsigned r; asm volatile("v_cvt_pk_bf16_f32 %0, %1, %2" : "=v"(r) : "v"(lo), "v"(hi)); return r; }
typedef float f32x2 __attribute__((ext_vector_type(2)));
typedef unsigned u32x2 __attribute__((ext_vector_type(2)));
__device__ __forceinline__ float bflo(unsigned w) { return __uint_as_float(w << 16); }
__device__ __forceinline__ float bfhi(unsigned w) { return __uint_as_float(w & 0xffff0000u); }
__device__ __forceinline__ float sigm(float x) { return __builtin_amdgcn_rcpf(1.f + __builtin_amdgcn_exp2f(-1.4426950408889634f * x)); }
__device__ __forceinline__ u32x4 pack8(const f32x4 a, const f32x4 b) { u32x4 w; w.x = cvt_pk_bf16(a[0], a[1]); w.y = cvt_pk_bf16(a[2], a[3]); w.z = cvt_pk_bf16(b[0], b[1]); w.w = cvt_pk_bf16(b[2], b[3]); return w; }
__device__ __forceinline__ float sumsq_of(const float* ss, int row) { const f32x4* p = (const f32x4*)(ss + (size_t)row * 16); const f32x4 a = p[0], b = p[1], c = p[2], d = p[3];
    return (((a[0] + a[1]) + (a[2] + a[3])) + ((b[0] + b[1]) + (b[2] + b[3]))) + (((c[0] + c[1]) + (c[2] + c[3])) + ((d[0] + d[1]) + (d[2] + d[3]))); }
__device__ __forceinline__ float rstd_of(const float* ss, int row) { return __builtin_amdgcn_rsqf(sumsq_of(ss, row) * (1.f / 1024.f) + 1e-6f); }
__device__ __forceinline__ float rstd_of4(const float* ss, int row, int fq) { const f32x4 a = *(const f32x4*)(ss + (size_t)row * 16 + fq * 4); float s = (a[0] + a[1]) + (a[2] + a[3]);
    s += __shfl_xor(s, 16); s += __shfl_xor(s, 32); return __builtin_amdgcn_rsqf(s * (1.f / 1024.f) + 1e-6f); }
__device__ __forceinline__ f32x4 rstd_ld4(const float* ss, int row, int fq) { return *(const f32x4*)(ss + (size_t)row * 16 + fq * 4); }
__device__ __forceinline__ float rstd_fin4(const f32x4 a) { float s = (a[0] + a[1]) + (a[2] + a[3]); s += __shfl_xor(s, 16); s += __shfl_xor(s, 32); return __builtin_amdgcn_rsqf(s * (1.f / 1024.f) + 1e-6f); }
__device__ __forceinline__ float rstd_of1(const float* ss, int row) { return __builtin_amdgcn_rsqf(ss[row] * (1.f / 1024.f) + 1e-6f); }
constexpr int FFH = 2816;

struct EpiSwiGLU {
    static constexpr bool PERM = true, AFTER_DRAIN = false;
    bf16_t* H; const float* ss;
    __device__ __forceinline__ void operator()(const f32x4 (&acc)[2][2][4][2], const Unit& u, int wr, int wc, int fr, int fq) const {
        asm volatile("" : "+v"(fr), "+v"(fq));
        const int row0 = u.pm * BM + wr * 64 + fr;
        unsigned char* const hb = (unsigned char*)H + (size_t)(u.pm * (FFH / 128) + u.pn) * 32768 + (((wr * 4 + wc) * 8) * 64 + (fq >> 1) * 32 + fr * 2 + (fq & 1)) * 8;
        f32x4 pa[2][4];
#pragma unroll
        for (int ai = 0; ai < 2; ++ai)
#pragma unroll
            for (int m = 0; m < 4; ++m) pa[ai][m] = rstd_ld4(ss, row0 + ai * HALF + m * 16, fq);
#pragma unroll
        for (int ai = 0; ai < 2; ++ai)
#pragma unroll
            for (int m = 0; m < 4; ++m) { const float rs = rstd_fin4(pa[ai][m]);
                const float rsl = rs * 1.4426950408889634f, rsu = rs * 0.6931471805599453f;
                f32x4 h0, h1;
#pragma unroll
                for (int n = 0; n < 2; ++n) { const f32x4 G = acc[ai][0][m][n], U = acc[ai][1][m][n]; f32x4 hv;
#pragma unroll
                    for (int q = 0; q < 2; ++q) { const f32x2 g2 = (f32x2){G[2 * q], G[2 * q + 1]} * rsl, u2 = (f32x2){U[2 * q], U[2 * q + 1]} * rsu;
                        f32x2 r2; r2.x = __builtin_amdgcn_rcpf(1.f + __builtin_amdgcn_exp2f(-g2.x)); r2.y = __builtin_amdgcn_rcpf(1.f + __builtin_amdgcn_exp2f(-g2.y));
                        const f32x2 o2 = g2 * u2 * r2; hv[2 * q] = o2.x; hv[2 * q + 1] = o2.y; }
                    if (n == 0) h0 = hv; else h1 = hv; }
                unsigned w0 = 0u, w1 = 0u;
                w0 = __builtin_amdgcn_cvt_pk_fp8_f32(h0[0], h0[1], w0, false); w0 = __builtin_amdgcn_cvt_pk_fp8_f32(h0[2], h0[3], w0, true); w1 = __builtin_amdgcn_cvt_pk_fp8_f32(h1[0], h1[1], w1, false); w1 = __builtin_amdgcn_cvt_pk_fp8_f32(h1[2], h1[3], w1, true);
                *(u32x2*)(hb + (ai * 4 + m) * 512) = (u32x2){w0, w1}; asm volatile("" ::: "memory"); }
    }
};
template <bool WX8> struct EpiRes {
    static constexpr bool PERM = true, AFTER_DRAIN = false;
    bf16_t* X; float* ssn; float scale;
    __device__ __forceinline__ void operator()(const f32x4 (&acc)[2][2][4][2], const Unit& u, int wr, int wc, int fr, int fq) const {
        asm volatile("" : "+v"(fr), "+v"(fq));
        const int row0 = u.pm * BM + wr * 64 + fr, col0 = u.pn * BM + wc * 32 + fq * 8;
        u32x4 xcur[2][2], xnxt[2][2];
#pragma unroll
        for (int h2 = 0; h2 < 2; ++h2)
#pragma unroll
            for (int bj = 0; bj < 2; ++bj) xcur[h2][bj] = *(const u32x4*)(X + (size_t)(row0 + h2 * 16) * 1024 + col0 + bj * HALF);
#pragma unroll
        for (int q = 0; q < 8; ++q) { const int ai = q >> 2, m = q & 3; const int row = row0 + ai * HALF + m * 16; float s = 0.f;
            if ((q & 1) == 0 && q + 2 < 8) {
#pragma unroll
                for (int h2 = 0; h2 < 2; ++h2)
#pragma unroll
                    for (int bj = 0; bj < 2; ++bj) { const int qn = q + 2 + h2; xnxt[h2][bj] = *(const u32x4*)(X + (size_t)(row0 + (qn >> 2) * HALF + (qn & 3) * 16) * 1024 + col0 + bj * HALF); } }
#pragma unroll
                for (int bj = 0; bj < 2; ++bj) { bf16_t* p = X + (size_t)row * 1024 + col0 + bj * HALF; const u32x4 xv = xcur[q & 1][bj];
                    f32x4 a = acc[ai][bj][m][0] * scale, b = acc[ai][bj][m][1] * scale;
                    a[0] += bflo(xv.x); a[1] += bfhi(xv.x); a[2] += bflo(xv.y); a[3] += bfhi(xv.y); b[0] += bflo(xv.z); b[1] += bfhi(xv.z); b[2] += bflo(xv.w); b[3] += bfhi(xv.w);
                    const u32x4 w = pack8(a, b); *(u32x4*)p = w;
                    if constexpr (WX8) { unsigned q0 = 0u, q1 = 0u; q0 = __builtin_amdgcn_cvt_pk_fp8_f32(bflo(w.x), bfhi(w.x), q0, false); q0 = __builtin_amdgcn_cvt_pk_fp8_f32(bflo(w.y), bfhi(w.y), q0, true); q1 = __builtin_amdgcn_cvt_pk_fp8_f32(bflo(w.z), bfhi(w.z), q1, false); q1 = __builtin_amdgcn_cvt_pk_fp8_f32(bflo(w.w), bfhi(w.w), q1, true);
                        *(u32x2*)((unsigned char*)X + (WS_X8 - WS_X) + (size_t)row * 1024 + col0 + bj * HALF) = (u32x2){q0, q1}; }
                    s += (bflo(w.x) * bflo(w.x) + bfhi(w.x) * bfhi(w.x)) + (bflo(w.y) * bflo(w.y) + bfhi(w.y) * bfhi(w.y)) + (bflo(w.z) * bflo(w.z) + bfhi(w.z) * bfhi(w.z)) + (bflo(w.w) * bflo(w.w) + bfhi(w.w) * bfhi(w.w)); }
                s += __shfl_xor(s, 16); s += __shfl_xor(s, 32);
                if (fq == 0) ssn[(size_t)row * 16 + u.pn * 4 + wc] = s;
            if (q & 1) { asm volatile("" ::: "memory");
#pragma unroll
                for (int h2 = 0; h2 < 2; ++h2)
#pragma unroll
                    for (int bj = 0; bj < 2; ++bj) xcur[h2][bj] = xnxt[h2][bj]; } }
    }
};
struct EpiRowScale {
    static constexpr bool PERM = true, AFTER_DRAIN = false;
    bf16_t* O; int ldc; const float* ss; float scale;
    __device__ __forceinline__ void operator()(const f32x4 (&acc)[2][2][4][2], const Unit& u, int wr, int wc, int fr, int fq) const {
        asm volatile("" : "+v"(fr), "+v"(fq));
        const int row0 = u.pm * BM + wr * 64 + fr, col0 = u.pn * BM + wc * 32 + fq * 8;
#pragma unroll
        for (int ai = 0; ai < 2; ++ai)
#pragma unroll
            for (int m = 0; m < 4; ++m) { const int row = row0 + ai * HALF + m * 16; const float rs = rstd_of4(ss, row, fq) * scale;
#pragma unroll
                for (int bj = 0; bj < 2; ++bj) *(u32x4*)(O + (size_t)row * ldc + col0 + bj * HALF) = pack8(acc[ai][bj][m][0] * rs, acc[ai][bj][m][1] * rs); asm volatile("" ::: "memory"); }
    }
};
struct EpiWin {
    static constexpr bool PERM = true, AFTER_DRAIN = false;
    unsigned char* ws; const float* ss; float qscale;
    __device__ __forceinline__ void operator()(const f32x4 (&acc)[2][2][4][2], const Unit& u, int wr, int wc, int fr, int fq) const {
        asm volatile("" : "+v"(fr), "+v"(fq));
        const int row0 = u.pm * BM + wr * 64 + fr, t = u.pn, c8 = wc * 32 + fq * 8;
        bf16_t* const HG = (bf16_t*)(ws + WS_HG); bf16_t* const U = (bf16_t*)(ws + WS_U); bf16_t* const BG = (bf16_t*)(ws + WS_BG); bf16_t* const Q = (bf16_t*)(ws + WS_Q); bf16_t* const K = (bf16_t*)(ws + WS_K);
        bf16_t* const V = (bf16_t*)(ws + WS_V); bf16_t* const QI = (bf16_t*)(ws + WS_QI); bf16_t* const KI = (bf16_t*)(ws + WS_KI); float* const WI = (float*)(ws + WS_WI); const float* const cs = (const float*)(ws + WS_COS); const float* const sn = (const float*)(ws + WS_SIN);
        float rsv[8];
        { f32x4 pa[8];
#pragma unroll
          for (int q = 0; q < 8; ++q) pa[q] = rstd_ld4(ss, row0 + (q >> 2) * HALF + (q & 3) * 16, fq);
#pragma unroll
          for (int q = 0; q < 8; ++q) rsv[q] = rstd_fin4(pa[q]); }
        asm volatile("" ::: "memory");
        if (t < 5 || t == 9 || t == 10) {
#pragma unroll
            for (int q = 0; q < 8; ++q) { const int ai = q >> 2, m = q & 3; const int row = row0 + ai * HALF + m * 16; const float rs = rsv[q];
                const f32x4 a0 = acc[ai][0][m][0] * rs, a1 = acc[ai][0][m][1] * rs, b0 = acc[ai][1][m][0] * rs, b1 = acc[ai][1][m][1] * rs;
                if (t < 2) { f32x4 o0, o1;
#pragma unroll
                    for (int j = 0; j < 4; ++j) { o0[j] = a0[j] * sigm(b0[j]); o1[j] = a1[j] * sigm(b1[j]); }
                    *(u32x4*)(HG + (size_t)row * 256 + t * 128 + c8) = pack8(o0, o1); }
                else if (t < 4) { *(u32x4*)(U + (size_t)row * 256 + (t - 2) * 128 + c8) = pack8(a0 * b0, a1 * b1); }
                else if (t == 4) { *(u32x4*)(BG + (size_t)row * 256 + c8) = pack8(a0, a1); *(u32x4*)(BG + (size_t)row * 256 + 128 + c8) = pack8(b0, b1); }
                else { *(u32x4*)(V + (size_t)row * 512 + (t - 9) * 256 + c8) = pack8(a0, a1); *(u32x4*)(V + (size_t)row * 512 + (t - 9) * 256 + 128 + c8) = pack8(b0, b1); }
                asm volatile("" ::: "memory"); }
        } else {
            f32x4 cc[4], cn[4];
            { const size_t o = (size_t)row0 * 32 + fq * 8; cc[0] = *(const f32x4*)(cs + o); cc[1] = *(const f32x4*)(cs + o + 4); cc[2] = *(const f32x4*)(sn + o); cc[3] = *(const f32x4*)(sn + o + 4); }
#pragma unroll
            for (int q = 0; q < 8; ++q) { const int ai = q >> 2, m = q & 3; const int row = row0 + ai * HALF + m * 16; const float rs = rsv[q];
                if (q + 1 < 8) { const size_t o = (size_t)(row0 + ((q + 1) >> 2) * HALF + ((q + 1) & 3) * 16) * 32 + fq * 8; cn[0] = *(const f32x4*)(cs + o); cn[1] = *(const f32x4*)(cs + o + 4); cn[2] = *(const f32x4*)(sn + o); cn[3] = *(const f32x4*)(sn + o + 4); }
                const f32x4 a0 = acc[ai][0][m][0] * rs, a1 = acc[ai][0][m][1] * rs, b0 = acc[ai][1][m][0] * rs, b1 = acc[ai][1][m][1] * rs;
                const f32x4 c0 = cc[0], c1 = cc[1], s0 = cc[2], s1 = cc[3];
                f32x4 p0 = a0 * c0 - b0 * s0, p1 = a1 * c1 - b1 * s1, r0 = b0 * c0 + a0 * s0, r1 = b1 * c1 + a1 * s1;
                if (t < 7) { bf16_t* d = Q + (size_t)row * 512 + ((t - 5) * 4 + wc) * 64 + fq * 8; *(u32x4*)d = pack8(p0 * qscale, p1 * qscale); *(u32x4*)(d + 32) = pack8(r0 * qscale, r1 * qscale); }
                else if (t < 9) { bf16_t* d = K + (size_t)row * 512 + ((t - 7) * 4 + wc) * 64 + fq * 8; *(u32x4*)d = pack8(p0, p1); *(u32x4*)(d + 32) = pack8(r0, r1); }
                else if (t == 11) { bf16_t* d = QI + (size_t)row * 256 + wc * 64 + fq * 8; *(u32x4*)d = pack8(p0, p1); *(u32x4*)(d + 32) = pack8(r0, r1); }
                else { if (wc == 0) { bf16_t* d = KI + ((((size_t)(row >> 5) * 4 + (fq >> 1)) * 64 + (fq & 1) * 32 + (row & 31)) << 3); *(u32x4*)d = pack8(p0, p1); *(u32x4*)(d + 1024) = pack8(r0, r1); }
                       if (wc == 1 && fq == 0) *(f32x4*)(WI + (size_t)row * 4) = b0; }
                asm volatile("" ::: "memory");
#pragma unroll
                for (int i = 0; i < 4; ++i) cc[i] = cn[i]; }
        }
    }
};
struct EpiMemKV {
    static constexpr bool PERM = true, AFTER_DRAIN = false;
    bf16_t *MEMK, *MEMVT; const float* mss;
    __device__ __forceinline__ void operator()(const f32x4 (&acc)[2][2][4][2], const Unit& u, int wr, int wc, int fr, int fq) const {
        asm volatile("" : "+v"(fr), "+v"(fq));
        const bool isv = u.pm >= 4; const int l = isv ? ((u.pm - 8) >> 3) : ((u.pn - 4) >> 3);
        const int pr = isv ? ((u.pm - 8) & 7) : u.pm, pc = isv ? u.pn : ((u.pn - 4) & 7);
        bf16_t* O = (isv ? MEMVT : MEMK) + (size_t)l * 1024 * 1024;
        const int row0 = pr * BM + wr * 64 + fr, col0 = pc * BM + wc * 32 + fq * 8;
#pragma unroll
        for (int ai = 0; ai < 2; ++ai)
#pragma unroll
            for (int m = 0; m < 4; ++m) { const int row = row0 + ai * HALF + m * 16; const float rsr = isv ? 1.f : rstd_of1(mss, row);
#pragma unroll
                for (int bj = 0; bj < 2; ++bj) { f32x4 a = acc[ai][bj][m][0] * rsr, b = acc[ai][bj][m][1] * rsr;
                    if (isv) {
#pragma unroll
                        for (int j = 0; j < 4; ++j) { a[j] *= rstd_of1(mss, col0 + bj * HALF + j); b[j] *= rstd_of1(mss, col0 + bj * HALF + 4 + j); } }
                    *(u32x4*)(O + (size_t)row * 1024 + col0 + bj * HALF) = pack8(a, b); } asm volatile("" ::: "memory"); }
    }
};
struct MemKVOrder {
    int G, c;
    __device__ __forceinline__ bool next(int i, Unit& u) const {
        const int L = i * G + c; if (L >= 64) return false;
        const int ty = L >> 4, a = (L >> 2) & 3, b = L & 3, l = ty & 1;
        if (ty < 2) { u.pm = a; u.pn = 4 + 8 * l + b; } else { u.pm = 8 + 8 * l + a; u.pn = b; }
        return true;
    }
    __device__ __forceinline__ void a_ready(const Unit&) const {}
    __device__ __forceinline__ void done(const Unit&) const {}
};

constexpr int TILE_X = (int)(WS_X >> 19), TILE_MK = (int)(WS_MK >> 19);
static_assert((WS_X & ((1u << 19) - 1)) == 0 && (WS_MK & ((1u << 19) - 1)) == 0 && ((WS_W + WO_IN) & ((1u << 19) - 1)) == 0 && (W_LAYER & ((1u << 19) - 1)) == 0, "tile-aligned operands");
struct WinKVOrder {
    int G, c, tin, nkv;
    __device__ __forceinline__ bool next(int i, Unit& u) const {
        const int nwin = 128 * 13; const long L0 = (long)i * G + c; if (L0 >= nwin + nkv) return false;
        int L = (int)L0;
        if (L < nwin) { int wgid = L; { const int q = nwin / 8, xcd = wgid % 8, off = wgid / 8; wgid = xcd * q + off; }
            const int nig = 8 * 13, gid = wgid / nig, fm = gid * 8; u.pm = TILE_X + fm + ((wgid % nig) % 8); u.pn = tin + (wgid % nig) / 8; return true; }
        L -= nwin; const int ty = L >> 4, a = (L >> 2) & 3, b = L & 3, l = ty & 1;
        if (ty < 2) { u.pm = TILE_MK + a; u.pn = TILE_MK + 4 + 8 * l + b; } else { u.pm = TILE_MK + 8 + 8 * l + a; u.pn = TILE_MK + b; }
        return true;
    }
    __device__ __forceinline__ void a_ready(const Unit&) const {}
    __device__ __forceinline__ void done(const Unit&) const {}
};
struct EpiWinKV {
    static constexpr bool PERM = true, AFTER_DRAIN = false;
    unsigned char* ws; const float* ss; float qscale; int tin;
    __device__ __forceinline__ void operator()(const f32x4 (&acc)[2][2][4][2], const Unit& u, int wr, int wc, int fr, int fq) const {
        if (u.pm >= TILE_X) { const EpiWin W{ws, ss, qscale}; const Unit v{u.pm - TILE_X, u.pn - tin}; W(acc, v, wr, wc, fr, fq); }
        else { const EpiMemKV KV{(bf16_t*)(ws + WS_MEMK), (bf16_t*)(ws + WS_MEMVT), (const float*)(ws + WS_MSS)}; const Unit v{u.pm - TILE_MK, u.pn - TILE_MK}; KV(acc, v, wr, wc, fr, fq); }
    }
};

template <class Epi, class Sched, bool ALIGN_EPI = false, bool SP2 = false, bool FP8 = false, bool ABLK = false>
__device__ __forceinline__ void gemm_phase(PG8_LAS unsigned char* lds, const Gemm g, const Sched& S, const Epi& E) {
    int tid_ = threadIdx.x; asm volatile("" : "+v"(tid_));
    const int tid = tid_, wid = __builtin_amdgcn_readfirstlane(tid >> 6), lane = tid & 63, wr = wid >> 2, wc = wid & 3, fr = lane & 15, fq = lane >> 4;
    const int K = g.K, nt = K / BK;
    unsigned voffA[2], voffB[2];
#pragma unroll
    for (int i = 0; i < 2; ++i) { int R, C; stage_rc(tid * 16 + i * 8192, R, C); const int Rb = Epi::PERM ? ((R & ~31) + perm32(R & 31)) : R;
        voffA[i] = ABLK ? (unsigned)(((((R >> 6) * 4 + (C >> 4)) * 8 + ((R >> 4) & 3)) * 64 + ((C >> 3) & 1) * 32 + (R & 15) * 2) * 8) : (unsigned)(R * K + C) * 2u; voffB[i] = (unsigned)(Rb * K + C) * 2u; }
    const size_t kstep = (size_t)(BK * 2);
    const size_t hstep = (size_t)HALF * K * 2;
    const size_t kstepA = ABLK ? (size_t)32768 : kstep, hstepA = ABLK ? (size_t)2048 : hstep;
    const size_t tstep = 2 * hstep;
    const unsigned ldsw = (unsigned)wid * 1024u;
    const int aoff = lds_byte(wr * 64 + fr, fq * 8), boff = lds_byte(wc * 32 + fr, fq * 8);
#define PG8_SA(b, h) (((b) * 2 + (h)) * HTB)
#define PG8_SB(b, h) ((4 + (b) * 2 + (h)) * HTB)
#define PG8_STAGE(bufoff, gbase, voff) do { _Pragma("unroll") for (int _i = 0; _i < 2; ++_i) \
        __builtin_amdgcn_global_load_lds((const unsigned*)((const char*)(gbase) + (voff)[_i]), (PG8_LAS unsigned*)(lds + (bufoff) + ldsw + _i * 8192), 16, 0, 0); } while (0)
#define PG8_LDA(dst, b, h) do { _Pragma("unroll") for (int m = 0; m < 4; ++m) _Pragma("unroll") for (int k = 0; k < 2; ++k) dst[m][k] = *(const PG8_LAS bf16x8*)(lds + PG8_SA(b, h) + aoff + m * 2048 + k * 1024); } while (0)
#define PG8_LDB(dst, b, h) do { _Pragma("unroll") for (int n = 0; n < 2; ++n) _Pragma("unroll") for (int k = 0; k < 2; ++k) dst[n][k] = *(const PG8_LAS bf16x8*)(lds + PG8_SB(b, h) + boff + n * 2048 + k * 1024); } while (0)
#define PG8_MMA(ai, bj, At, Bt) do { __builtin_amdgcn_s_setprio(1); _Pragma("unroll") for (int m = 0; m < 4; ++m) _Pragma("unroll") for (int n = 0; n < 2; ++n) { \
        if constexpr (FP8) { typedef int v4i_ __attribute__((ext_vector_type(4))); typedef int v8i_ __attribute__((ext_vector_type(8))); \
            const v8i_ b8 = __builtin_shufflevector(__builtin_bit_cast(v4i_, Bt[n][0]), __builtin_bit_cast(v4i_, Bt[n][1]), 0, 1, 2, 3, 4, 5, 6, 7), a8 = __builtin_shufflevector(__builtin_bit_cast(v4i_, At[m][0]), __builtin_bit_cast(v4i_, At[m][1]), 0, 1, 2, 3, 4, 5, 6, 7); \
            asm volatile("v_mfma_scale_f32_16x16x128_f8f6f4 %0, %1, %2, %0, %3, %3 op_sel_hi:[0,0,0]" : "+v"(acc[ai][bj][m][n]) : "v"(b8), "v"(a8), "v"(0x7f7f7f7f)); }   \
        else { _Pragma("unroll") for (int k = 0; k < 2; ++k) acc[ai][bj][m][n] = __builtin_amdgcn_mfma_f32_16x16x32_bf16(Bt[n][k], At[m][k], acc[ai][bj][m][n], 0, 0, 0); } } \
        __builtin_amdgcn_s_setprio(0); } while (0)
#define PG8_WAIT_V(n) asm volatile("s_waitcnt vmcnt(" #n ")" ::: "memory")
#define PG8_WAIT_V8_UNLESS_FIRST(t) asm volatile("s_cmp_eq_u32 %0, 0\n\ts_cbranch_scc1 .Lpg8skip%=\n\ts_waitcnt vmcnt(8)\n.Lpg8skip%=:" :: "s"(t) : "scc", "memory")
#define PG8_WAIT_L(n) asm volatile("s_waitcnt lgkmcnt(" #n ")" ::: "memory")
#define PG8_BAR __builtin_amdgcn_s_barrier()
#define PG8_SCHED __builtin_amdgcn_sched_barrier(0)
    Unit cur, nxt; int ui = 0;
    if (!S.next(0, cur)) return;
    f32x4 acc[2][2][4][2];
#pragma unroll
    for (int a = 0; a < 2; ++a)
#pragma unroll
        for (int b = 0; b < 2; ++b)
#pragma unroll
            for (int m = 0; m < 4; ++m)
#pragma unroll
                for (int n = 0; n < 2; ++n) acc[a][b][m][n] = (f32x4){0.f, 0.f, 0.f, 0.f};
    bf16x8 At[4][2], B0[2][2], B1[2][2];
    const char* cA = (const char*)g.A + (size_t)cur.pm * tstep; const char* cB = (const char*)g.Bt + (size_t)cur.pn * tstep;
    S.a_ready(cur);
    if constexpr (SP2) {
        PG8_STAGE(PG8_SB(0, 0), cB, voffB); PG8_STAGE(PG8_SB(0, 1), cB + hstep, voffB); PG8_STAGE(PG8_SA(0, 0), cA, voffA); PG8_STAGE(PG8_SA(0, 1), cA + hstepA, voffA);
        if (wr == 1) PG8_BAR;
        PG8_WAIT_V(2); PG8_BAR;
        PG8_STAGE(PG8_SB(1, 0), cB + kstep, voffB); PG8_STAGE(PG8_SA(1, 0), cA + kstepA, voffA); PG8_STAGE(PG8_SB(1, 1), cB + hstep + kstep, voffB);
        PG8_WAIT_V(0); PG8_BAR;
    } else {
        PG8_STAGE(PG8_SB(0, 0), cB, voffB); PG8_STAGE(PG8_SA(0, 0), cA, voffA); PG8_STAGE(PG8_SB(0, 1), cB + hstep, voffB); PG8_STAGE(PG8_SA(0, 1), cA + hstepA, voffA);
        if (wr == 1) PG8_BAR;
        PG8_WAIT_V(4); PG8_BAR;
        PG8_STAGE(PG8_SB(1, 0), cB + kstep, voffB); PG8_STAGE(PG8_SA(1, 0), cA + kstepA, voffA); PG8_STAGE(PG8_SB(1, 1), cB + hstep + kstep, voffB);
        PG8_WAIT_V(6); PG8_BAR;
    }
    for (;;) {
        const bool has_next = S.next(ui + 1, nxt);
        const char* nA = has_next ? (const char*)g.A + (size_t)nxt.pm * tstep : cA; const char* nB = has_next ? (const char*)g.Bt + (size_t)nxt.pn * tstep : cB;
        for (int t = 0; t < nt; t += 2) {
            const bool last = (t == nt - 2);
            const char* a1 = cA + (size_t)(t + 1) * kstepA;
            const char* a2 = last ? nA : cA + (size_t)(t + 2) * kstepA; const char* b2 = last ? nB : cB + (size_t)(t + 2) * kstep;
            const char* a3 = a2 + kstepA; const char* b3 = b2 + kstep;
            if (last && has_next) S.a_ready(nxt);
            if constexpr (SP2) {
            PG8_LDB(B0, 0, 0); PG8_LDB(B1, 0, 1); PG8_SCHED; PG8_LDA(At, 0, 0); PG8_STAGE(PG8_SA(1, 1), a1 + hstepA, voffA);
            PG8_WAIT_V8_UNLESS_FIRST(t); PG8_WAIT_L(0); PG8_BAR; PG8_MMA(0, 0, At, B0); PG8_MMA(0, 1, At, B1); PG8_BAR; PG8_SCHED;
            PG8_LDA(At, 0, 1); PG8_STAGE(PG8_SB(0, 0), b2, voffB); PG8_STAGE(PG8_SB(0, 1), b2 + hstep, voffB); PG8_STAGE(PG8_SA(0, 0), a2, voffA);
            PG8_WAIT_V8_UNLESS_FIRST(t); PG8_WAIT_L(0); PG8_BAR; PG8_MMA(1, 0, At, B0); PG8_MMA(1, 1, At, B1); PG8_BAR; PG8_SCHED;
            PG8_LDB(B0, 1, 0); PG8_LDB(B1, 1, 1); PG8_SCHED; PG8_LDA(At, 1, 0); PG8_STAGE(PG8_SA(0, 1), a2 + hstepA, voffA);
            PG8_WAIT_V(8); PG8_WAIT_L(0); PG8_BAR; PG8_MMA(0, 0, At, B0); PG8_MMA(0, 1, At, B1); PG8_BAR; PG8_SCHED;
            PG8_LDA(At, 1, 1); PG8_STAGE(PG8_SB(1, 0), b3, voffB); PG8_STAGE(PG8_SB(1, 1), b3 + hstep, voffB); PG8_STAGE(PG8_SA(1, 0), a3, voffA);
            PG8_WAIT_V(8); PG8_WAIT_L(0); PG8_BAR; PG8_MMA(1, 0, At, B0); PG8_MMA(1, 1, At, B1); PG8_BAR; PG8_SCHED;
            } else {
            PG8_LDB(B0, 0, 0); PG8_SCHED; PG8_LDA(At, 0, 0); PG8_STAGE(PG8_SA(1, 1), a1 + hstepA, voffA);
            PG8_WAIT_L(8); PG8_BAR; PG8_WAIT_L(0); PG8_MMA(0, 0, At, B0); PG8_BAR; PG8_SCHED;
            PG8_LDB(B1, 0, 1); PG8_STAGE(PG8_SB(0, 0), b2, voffB);
            PG8_BAR; PG8_WAIT_L(0); PG8_MMA(0, 1, At, B1); PG8_BAR;
            PG8_LDA(At, 0, 1); PG8_STAGE(PG8_SA(0, 0), a2, voffA);
            PG8_BAR; PG8_WAIT_L(0); PG8_MMA(1, 0, At, B0); PG8_BAR; PG8_SCHED;
            PG8_STAGE(PG8_SB(0, 1), b2 + hstep, voffB);
            PG8_WAIT_V(6); PG8_BAR; PG8_MMA(1, 1, At, B1); PG8_BAR;
            PG8_LDB(B0, 1, 0); PG8_SCHED; PG8_LDA(At, 1, 0); PG8_STAGE(PG8_SA(0, 1), a2 + hstepA, voffA);
            PG8_WAIT_L(8); PG8_BAR; PG8_WAIT_L(0); PG8_MMA(0, 0, At, B0); PG8_BAR; PG8_SCHED;
            PG8_LDB(B1, 1, 1); PG8_STAGE(PG8_SB(1, 0), b3, voffB);
            PG8_BAR; PG8_WAIT_L(0); PG8_MMA(0, 1, At, B1); PG8_BAR;
            PG8_LDA(At, 1, 1); PG8_STAGE(PG8_SA(1, 0), a3, voffA);
            PG8_BAR; PG8_WAIT_L(0); PG8_MMA(1, 0, At, B0); PG8_BAR; PG8_SCHED;
            PG8_STAGE(PG8_SB(1, 1), b3 + hstep, voffB);
            PG8_WAIT_V(6); PG8_BAR; PG8_MMA(1, 1, At, B1); PG8_BAR;
            }
        }
        if constexpr (SP2) PG8_WAIT_V(0);
        if constexpr (FP8) asm volatile("s_nop 15\n\ts_nop 15" ::: "memory");
        if constexpr (ALIGN_EPI) { if (wr == 0) PG8_BAR; }
        if constexpr (!Epi::AFTER_DRAIN) { E(acc, cur, wr, wc, fr, fq); S.done(cur); }
        if (!has_next) break;
#pragma unroll
        for (int a = 0; a < 2; ++a)
#pragma unroll
            for (int b = 0; b < 2; ++b)
#pragma unroll
                for (int m = 0; m < 4; ++m)
#pragma unroll
                    for (int n = 0; n < 2; ++n) acc[a][b][m][n] = (f32x4){0.f, 0.f, 0.f, 0.f};
        cur = nxt; cA = nA; cB = nB; ++ui;
        if constexpr (ALIGN_EPI) { if (wr == 1) PG8_BAR; }
    }
    PG8_WAIT_V(0);
    if constexpr (!ALIGN_EPI) { if (wr == 0) PG8_BAR; }
    PG8_BAR;
    if constexpr (Epi::AFTER_DRAIN) { E.fused(acc, cur, wr, wc, fr, fq, lds, wid, lane); S.done(cur); }
#undef PG8_SA
#undef PG8_SB
#undef PG8_STAGE
#undef PG8_LDA
#undef PG8_LDB
#undef PG8_MMA
#undef PG8_WAIT_V
#undef PG8_WAIT_L
#undef PG8_WAIT_V8_UNLESS_FIRST
#undef PG8_BAR
#undef PG8_SCHED
}
}
#define GAS __attribute__((address_space(1)))
#define LAS __attribute__((address_space(3)))
typedef unsigned short bf16;
typedef unsigned v4u __attribute__((ext_vector_type(4)));
typedef float f32x4 __attribute__((ext_vector_type(4)));
typedef short bf16x8 __attribute__((ext_vector_type(8)));
typedef GAS unsigned gu32;
typedef GAS unsigned long long gu64;
#define RLX_AGENT __ATOMIC_RELAXED, __HIP_MEMORY_SCOPE_AGENT
#define LDS_WAIT() asm volatile("s_waitcnt lgkmcnt(0)" ::: "memory")
#define VM_WAIT() asm volatile("s_waitcnt vmcnt(0)" ::: "memory")
__device__ __forceinline__ unsigned long long rt() { return __builtin_amdgcn_s_memrealtime(); }
__device__ __forceinline__ unsigned f2bf(float f) { unsigned u = __builtin_bit_cast(unsigned, f); return (u + 0x7fffu + ((u >> 16) & 1u)) >> 16; }
__device__ __forceinline__ unsigned pk2(float lo, float hi) { return f2bf(lo) | (f2bf(hi) << 16); }

#define XB_TMO      128
#define XB_XCNT(j)  (256  + 64 * (j))
#define XB_XSUB(j)  (1280 + 64 * (j))
#define XB_XGEN(j)  (2304 + 64 * (j))
#define XB_TOP      3328
#define XB_TOPGEN   3392
#define XCD_BAR_WORDS 3456
#define XB_SPIN_CAP (1u << 18)

__device__ __forceinline__ unsigned xb_ld(unsigned* p)              { return __hip_atomic_load(p, __ATOMIC_RELAXED, __HIP_MEMORY_SCOPE_AGENT); }
__device__ __forceinline__ unsigned xb_add(unsigned* p, unsigned v) { return __hip_atomic_fetch_add(p, v, __ATOMIC_RELAXED, __HIP_MEMORY_SCOPE_AGENT); }
__device__ __forceinline__ unsigned xb_xcc_id() { return (unsigned)__builtin_amdgcn_s_getreg((3 << 11) | 20) & 0xFu; }
#define XB_SPIN(cond, bar) do { unsigned _sp = 0; while (cond) { __builtin_amdgcn_s_sleep(1); \
    if ((++_sp & 255u) == 0u) { if (xb_ld(&(bar)[XB_TMO])) break; if (_sp > XB_SPIN_CAP) { atomicAdd(&(bar)[XB_TMO], 1u); break; } } } } while (0)

struct XcdBarrier {
    unsigned* bar; unsigned x;
    volatile LAS unsigned* st;
};

__device__ __forceinline__ XcdBarrier xcd_barrier_post(unsigned* bar, volatile LAS unsigned* st) {
    XcdBarrier b; b.bar = bar; b.x = xb_xcc_id(); b.st = st;
    if (threadIdx.x == 0) (void)xb_add(&bar[XB_XCNT(b.x)], 1u);
    return b;
}
__device__ __forceinline__ void xcd_barrier_complete(unsigned* bar, unsigned x, unsigned& nloc, unsigned& nx) {
    const unsigned G = gridDim.x * gridDim.y * gridDim.z;
    unsigned sum, cnt, mine, sp = 0u;
    for (;;) {
        sum = 0u; cnt = 0u; mine = 0u;
#pragma unroll
        for (unsigned j = 0; j < 16; ++j) { const unsigned c = xb_ld(&bar[XB_XCNT(j)]); sum += c; cnt += (c > 0u) ? 1u : 0u; mine = (j == x) ? c : mine; }
        if (sum == G) break;
        __builtin_amdgcn_s_sleep(1);
        if ((++sp & 255u) == 0u) { if (xb_ld(&bar[XB_TMO])) break; if (sp > XB_SPIN_CAP) { atomicAdd(&bar[XB_TMO], 1u); break; } }
    }
    nloc = mine > 0u ? mine : 1u; nx = cnt > 0u ? cnt : 1u;
}

__device__ __forceinline__ void xcd_barrier(const XcdBarrier& b) {
    asm volatile("s_waitcnt vmcnt(0)" ::: "memory");
    __syncthreads();
    if (threadIdx.x == 0) {
        unsigned* bar = b.bar;
        __builtin_amdgcn_s_waitcnt(0);
        unsigned nloc = b.st[0], nx = b.st[1];
        if (nloc == 0u) { xcd_barrier_complete(bar, b.x, nloc, nx); b.st[0] = nloc; b.st[1] = nx; }
        const unsigned old = xb_add(&bar[XB_XSUB(b.x)], 1u);
        const unsigned gen = old / nloc;
        if (old + 1u == (gen + 1u) * nloc) {
            __builtin_amdgcn_fence(__ATOMIC_RELEASE, "agent");
            asm volatile("s_waitcnt vmcnt(0)" ::: "memory");
            const unsigned og = xb_add(&bar[XB_TOP], 1u);
            const unsigned tg = og / nx;
            if (og + 1u == (tg + 1u) * nx) xb_add(&bar[XB_TOPGEN], 1u);
            else XB_SPIN(xb_ld(&bar[XB_TOPGEN]) == tg, bar);
            __builtin_amdgcn_fence(__ATOMIC_ACQUIRE, "agent");
            xb_add(&bar[XB_XGEN(b.x)], 1u);
            asm volatile("s_waitcnt vmcnt(0)" ::: "memory");
        } else {
            XB_SPIN(xb_ld(&bar[XB_XGEN(b.x)]) == gen, bar);
            __builtin_amdgcn_fence(__ATOMIC_ACQUIRE, "agent");
            asm volatile("s_waitcnt vmcnt(0)" ::: "memory");
        }
    }
    __syncthreads();
}
struct Frame {
    LAS unsigned char* lds; volatile LAS unsigned* MISC; gu32* ctl;
    int tid, lane, wave, vcu, G;
    unsigned char* ws;
};
__device__ __forceinline__ float wave_sum(float v) {
#pragma unroll
    for (int o = 1; o < 64; o <<= 1) v += __shfl_xor(v, o);
    return v;
}
__device__ __forceinline__ float wave_max(float v) {
#pragma unroll
    for (int o = 1; o < 64; o <<= 1) v = fmaxf(v, __shfl_xor(v, o));
    return v;
}
__device__ __forceinline__ float bf2f_lo(unsigned w) { return __uint_as_float(w << 16); }
__device__ __forceinline__ float bf2f_hi(unsigned w) { return __uint_as_float(w & 0xffff0000u); }
__device__ __forceinline__ float bf2f(bf16 h) { return __uint_as_float((unsigned)h << 16); }

__device__ __forceinline__ void tr_item(const float* W, int Ns, const float* gain, bf16* WTrow, int K, int sc0, int nvalid, int k0, LAS float* scr, int lane) {
    const int col = lane & 31;
    float wv_[32];
#pragma unroll
    for (int i = 0; i < 32; ++i) { const int kk = 2 * i + (lane >> 5); wv_[i] = (col < nvalid) ? W[(size_t)(k0 + kk) * Ns + sc0 + col] : 0.f; }
#pragma unroll
    for (int i = 0; i < 32; ++i) { const int kk = 2 * i + (lane >> 5); float v = wv_[i]; if (gain) v *= gain[k0 + kk]; scr[kk * 33 + col] = v; }
    LDS_WAIT(); asm volatile("" ::: "memory");
    const int c = lane & 7;
#pragma unroll
    for (int j = 0; j < 4; ++j) { const int n = (lane >> 3) + 8 * j; const LAS float* s = scr + (8 * c) * 33 + n;
        v4u o; o.x = pk2(s[0 * 33], s[1 * 33]); o.y = pk2(s[2 * 33], s[3 * 33]); o.z = pk2(s[4 * 33], s[5 * 33]); o.w = pk2(s[6 * 33], s[7 * 33]);
        *(GAS v4u*)(WTrow + (size_t)n * K + 8 * c) = o; }
    LDS_WAIT(); asm volatile("" ::: "memory");
}
__device__ __forceinline__ void tr_item8(const float* W, int Ns, unsigned char* WTrow, int K, int sc0, int k0, LAS float* scr, int lane, const float* gain = nullptr) {
    const int col = lane & 31;
    float wv_[32];
#pragma unroll
    for (int i = 0; i < 32; ++i) { const int kk = 2 * i + (lane >> 5); wv_[i] = W[(size_t)(k0 + kk) * Ns + sc0 + col]; }
#pragma unroll
    for (int i = 0; i < 32; ++i) { const int kk = 2 * i + (lane >> 5); float v = wv_[i] * 64.f; if (gain) v *= gain[k0 + kk]; scr[kk * 33 + col] = v; }
    LDS_WAIT(); asm volatile("" ::: "memory");
    const int n = lane >> 1, hf = lane & 1;
#pragma unroll
    for (int q = 0; q < 2; ++q) { const LAS float* sp = scr + (32 * hf + 16 * q) * 33 + n; v4u o;
#pragma unroll
        for (int d = 0; d < 4; ++d) { unsigned w = 0u; w = __builtin_amdgcn_cvt_pk_fp8_f32(sp[(4 * d) * 33], sp[(4 * d + 1) * 33], w, false); w = __builtin_amdgcn_cvt_pk_fp8_f32(sp[(4 * d + 2) * 33], sp[(4 * d + 3) * 33], w, true); o[d] = w; }
        *(GAS v4u*)(WTrow + (size_t)n * K + 32 * hf + 16 * q) = o; }
    LDS_WAIT(); asm volatile("" ::: "memory");
}
__device__ __forceinline__ void plain_item8(const float* W, int Ns, int K, unsigned char* WT, int r, LAS float* scr, int lane, const float* gain = nullptr) {
    const int nkb = K / 64, group = r / nkb, kb = r % nkb;
    tr_item8(W, Ns, WT + (size_t)(group * 32) * K + kb * 64, K, group * 32, kb * 64, scr, lane, gain);
}
__device__ __forceinline__ int win_src_col(int j, int& nvalid) {
    const int tile = j >> 3, half = (j >> 2) & 1, q4 = j & 3; nvalid = 32;
    if (tile < 2) return (half ? 256 : 0) + 128 * tile + 32 * q4;
    if (tile < 4) return (half ? 1024 : 768) + 128 * (tile - 2) + 32 * q4;
    if (tile == 4) return 512 + 128 * half + 32 * q4;
    if (tile < 7) return 1280 + ((tile - 5) * 4 + q4) * 64 + 32 * half;
    if (tile < 9) return 1792 + ((tile - 7) * 4 + q4) * 64 + 32 * half;
    if (tile < 11) return 2304 + (tile - 9) * 256 + 128 * half + 32 * q4;
    if (tile == 11) return 2816 + q4 * 64 + 32 * half;
    if (q4 == 0) return 3072 + 32 * half;
    if (q4 == 1 && half == 1) { nvalid = 4; return 3136; }
    nvalid = 0; return 0;
}
__device__ __forceinline__ void gu_item(const float* wg, const float* wu, const float* gain, bf16* WT, int r, LAS float* scr, int lane) {
    const int group = r >> 4, kb = r & 15, tile = group >> 3, g8 = group & 7;
    tr_item(g8 < 4 ? wg : wu, FF, gain, WT + (size_t)(group * 32) * D + kb * 64, D, 128 * tile + 32 * (g8 & 3), 32, kb * 64, scr, lane);
}
__device__ __forceinline__ void plain_item(const float* W, int Ns, int K, const float* gain, bf16* WT, int r, LAS float* scr, int lane) {
    const int nkb = K / 64, group = r / nkb, kb = r % nkb;
    tr_item(W, Ns, gain, WT + (size_t)(group * 32) * K + kb * 64, K, group * 32, 32, kb * 64, scr, lane);
}
struct Args { const void* in[25]; float* out; unsigned char* ws; float invf[32]; int ph_lo, ph_hi; };
typedef const __attribute__((address_space(4))) Args* KArgs;
#define INF(A, k) ((const float*)(A)->in[k])
enum { I_X = 0, I_MEM, I_POS, I_FFN1_NORM, I_FFN1_WG, I_FFN1_WU, I_FFN1_WD, I_MIX_NORM, I_W_IN, I_CONF_DW, I_CONF_DW_B, I_CONF_LN_G, I_CONF_LN_B, I_SC_DW, I_W_OUT, I_XA_NORM, I_MEM_NORM, I_XA_WQ, I_XA_WKV, I_XA_WO,
       I_FFN2_NORM, I_FFN2_WG, I_FFN2_WU, I_FFN2_WD, I_FINAL_NORM };
constexpr int IT_GU = 2816, IT_D = 1408, IT_IN = 1664, IT_SQ = 512, IT_KV = 1024, IT_LAYER = 2 * IT_GU + 2 * IT_D + IT_IN + 3 * IT_SQ + IT_KV;
__device__ __forceinline__ void p0_prologue(Frame& F, KArgs A) {
    LAS float* scr = (LAS float*)(F.lds + RING_OFF + F.wave * 16384);
    const int gw = F.vcu * NWAVES + F.wave, NGW = F.G * NWAVES, lane = F.lane;
    unsigned char* ws = F.ws;
    for (int it = gw; it < DEPTH * IT_LAYER; it += NGW) {
        const int l = it / IT_LAYER; int r = it % IT_LAYER;
        unsigned char* wl = ws + WS_W + (size_t)l * W_LAYER;
        if (r < IT_GU) { gu_item(INF(A, I_FFN1_WG) + (size_t)l * D * FF, INF(A, I_FFN1_WU) + (size_t)l * D * FF, INF(A, I_FFN1_NORM) + l * D, (bf16*)(wl + WO_GU1), r, scr, lane); continue; } r -= IT_GU;
        if (r < IT_D) { plain_item8(INF(A, I_FFN1_WD) + (size_t)l * FF * D, D, FF, wl + WO_D1, r, scr, lane); continue; } r -= IT_D;
        if (r < IT_IN) { const int group = r >> 4, kb = r & 15; int nv; const int sc = win_src_col(group, nv);
            tr_item(INF(A, I_W_IN) + (size_t)l * D * NIN, NIN, INF(A, I_MIX_NORM) + l * D, (bf16*)(wl + WO_IN) + (size_t)(group * 32) * D + kb * 64, D, sc, nv, kb * 64, scr, lane); continue; } r -= IT_IN;
        if (r < IT_SQ) { plain_item(INF(A, I_W_OUT) + (size_t)l * D * D, D, D, nullptr, (bf16*)(wl + WO_OUT), r, scr, lane); continue; } r -= IT_SQ;
        if (r < IT_SQ) { plain_item8(INF(A, I_XA_WQ) + (size_t)l * D * D, D, D, wl + WO_Q, r, scr, lane, INF(A, I_XA_NORM) + l * D); continue; } r -= IT_SQ;
        if (r < IT_SQ) { plain_item8(INF(A, I_XA_WO) + (size_t)l * D * D, D, D, wl + WO_O, r, scr, lane); continue; } r -= IT_SQ;
        if (r < IT_KV) { plain_item(INF(A, I_XA_WKV) + (size_t)l * D * 2 * D, 2 * D, D, INF(A, I_MEM_NORM) + l * D, (bf16*)(ws + WS_MK) + (size_t)(1024 + 2048 * l) * D, r, scr, lane); continue; } r -= IT_KV;
        if (r < IT_GU) { gu_item(INF(A, I_FFN2_WG) + (size_t)l * D * FF, INF(A, I_FFN2_WU) + (size_t)l * D * FF, INF(A, I_FFN2_NORM) + l * D, (bf16*)(wl + WO_GU2), r, scr, lane); continue; } r -= IT_GU;
        plain_item8(INF(A, I_FFN2_WD) + (size_t)l * FF * D, D, FF, wl + WO_D2, r, scr, lane);
    }
    for (int m = gw; m < M + 1024; m += NGW) {
        const bool ismem = m >= M; const int row = ismem ? m - M : m;
        const GAS f32x4* xr = (const GAS f32x4*)((ismem ? INF(A, I_MEM) : INF(A, I_X)) + (size_t)row * D) + lane;
        GAS unsigned long long* o8 = (GAS unsigned long long*)((bf16*)(ws + (ismem ? WS_MK : WS_X)) + (size_t)row * D) + lane;
        float s = 0.f;
#pragma unroll
        for (int j = 0; j < 4; ++j) { const f32x4 v = xr[64 * j]; const unsigned a = pk2(v.x, v.y), b = pk2(v.z, v.w); o8[64 * j] = (unsigned long long)a | ((unsigned long long)b << 32);
            s += (bf2f_lo(a) * bf2f_lo(a) + bf2f_hi(a) * bf2f_hi(a)) + (bf2f_lo(b) * bf2f_lo(b) + bf2f_hi(b) * bf2f_hi(b)); }
        s = wave_sum(s);
        if (ismem) { if (lane == 0) ((float*)(ws + WS_MSS))[row] = s; } else if (lane < 16) ((float*)(ws + WS_SS))[(size_t)row * 16 + lane] = lane == 0 ? s : 0.f;
    }
    for (int e = (F.vcu * NWAVES * 64 + F.tid); e < M * 32; e += F.G * NWAVES * 64) {
        const int row = e >> 5, i = e & 31;
        const float ang = __fmul_rn((float)((const int*)A->in[I_POS])[row], A->invf[i]);
        const double x = (double)ang, n = __builtin_rint(x * 0.15915494309189535), r = x - n * 6.283185307179586, r2 = r * r;
        double sp = -1.0 / 25852016738884976640000.0, cp = 1.0 / 620448401733239439360000.0;
        sp = sp * r2 + 1.0 / 51090942171709440000.0;  cp = cp * r2 - 1.0 / 1124000727777607680000.0;
        sp = sp * r2 - 1.0 / 121645100408832000.0;    cp = cp * r2 + 1.0 / 2432902008176640000.0;
        sp = sp * r2 + 1.0 / 355687428096000.0;       cp = cp * r2 - 1.0 / 6402373705728000.0;
        sp = sp * r2 - 1.0 / 1307674368000.0;         cp = cp * r2 + 1.0 / 20922789888000.0;
        sp = sp * r2 + 1.0 / 6227020800.0;            cp = cp * r2 - 1.0 / 87178291200.0;
        sp = sp * r2 - 1.0 / 39916800.0;              cp = cp * r2 + 1.0 / 479001600.0;
        sp = sp * r2 + 1.0 / 362880.0;                cp = cp * r2 - 1.0 / 3628800.0;
        sp = sp * r2 - 1.0 / 5040.0;                  cp = cp * r2 + 1.0 / 40320.0;
        sp = sp * r2 + 1.0 / 120.0;                   cp = cp * r2 - 1.0 / 720.0;
        sp = sp * r2 - 1.0 / 6.0;                     cp = cp * r2 + 1.0 / 24.0;
        sp = sp * r2 + 1.0;                           cp = cp * r2 - 0.5;
        cp = cp * r2 + 1.0;
        ((float*)(ws + WS_COS))[e] = (float)cp; ((float*)(ws + WS_SIN))[e] = (float)(sp * r);
    }
}

__device__ __forceinline__ void conv_a_unit(Frame& F, const bf16* HG, bf16* MIX, const float* dw, const float* dwb, const float* lng, const float* lnb, int unit) {
    const int tid = F.tid, lane = F.lane, wave = F.wave;
    const int row0 = unit * 64, t0 = row0 % SEQ;
    LAS unsigned short* hb = (LAS unsigned short*)(F.lds + RING_OFF); LAS float* yb = (LAS float*)(F.lds + RING_OFF + 49152);
    for (int ch = tid; ch < 94 * 32; ch += NWAVES * 64) { const int rr = ch >> 5, c16 = ch & 31; const int t = t0 - 30 + rr;
        v4u v = (v4u){0u, 0u, 0u, 0u}; if (t >= 0) v = *(const GAS v4u*)(HG + (size_t)(row0 - 30 + rr) * 256 + c16 * 8);
        *(LAS v4u*)(hb + rr * 256 + c16 * 8) = v; }
    __syncthreads();
    { const int c = tid & 255, half = tid >> 8;
      float w[31];
#pragma unroll
      for (int j = 0; j < 31; ++j) w[j] = dw[j * 256 + c];
      const float bias = dwb[c];
      float hv[62];
#pragma unroll
      for (int k = 0; k < 62; ++k) hv[k] = bf2f(hb[(32 * half + k) * 256 + c]);
#pragma unroll
      for (int i = 0; i < 32; ++i) { float y = bias;
#pragma unroll
          for (int j = 0; j < 31; ++j) y += w[j] * hv[i + j];
          yb[(32 * half + i) * 256 + c] = y; } }
    __syncthreads();
    { const f32x4 g = *(const GAS f32x4*)(lng + lane * 4), bb = *(const GAS f32x4*)(lnb + lane * 4);
      for (int tt = wave; tt < 64; tt += NWAVES) { const f32x4 y = *(LAS f32x4*)(yb + tt * 256 + lane * 4);
          const float mean = wave_sum((y.x + y.y) + (y.z + y.w)) * (1.f / 256.f); const f32x4 d = y - mean;
          const float var = wave_sum((d.x * d.x + d.y * d.y) + (d.z * d.z + d.w * d.w)) * (1.f / 256.f); const float rs = 1.0f / sqrtf(var + 1e-5f);
          f32x4 o = d * rs * g + bb;
#pragma unroll
          for (int j = 0; j < 4; ++j) o[j] = o[j] * pg8::sigm(o[j]);
          *(GAS unsigned long long*)(MIX + (size_t)(row0 + tt) * 1024 + lane * 4) = (unsigned long long)pk2(o.x, o.y) | ((unsigned long long)pk2(o.z, o.w) << 32); } }
    __syncthreads();
}
__device__ __forceinline__ void conv_b_all(Frame& F, const bf16* U, const bf16* BG, bf16* MIX, const float* sw) {
    for (int it = F.vcu * NWAVES * 64 + F.tid; it < M * 32; it += F.G * NWAVES * 64) { const int row = it >> 5, c8 = (it & 31) * 8, t = row % SEQ;
        const v4u z = (v4u){0u, 0u, 0u, 0u};
        const v4u u0 = *(const GAS v4u*)(U + (size_t)row * 256 + c8), u1 = t >= 1 ? *(const GAS v4u*)(U + (size_t)(row - 1) * 256 + c8) : z, u2 = t >= 2 ? *(const GAS v4u*)(U + (size_t)(row - 2) * 256 + c8) : z;
        const v4u g = *(const GAS v4u*)(BG + (size_t)row * 256 + c8);
        float o[8];
#pragma unroll
        for (int k = 0; k < 4; ++k) { const int c = c8 + 2 * k;
            o[2 * k]     = bf2f_lo(g[k]) * (sw[c] * bf2f_lo(u2[k]) + sw[256 + c] * bf2f_lo(u1[k]) + sw[512 + c] * bf2f_lo(u0[k]));
            o[2 * k + 1] = bf2f_hi(g[k]) * (sw[c + 1] * bf2f_hi(u2[k]) + sw[256 + c + 1] * bf2f_hi(u1[k]) + sw[512 + c + 1] * bf2f_hi(u0[k])); }
        v4u w; w.x = pk2(o[0], o[1]); w.y = pk2(o[2], o[3]); w.z = pk2(o[4], o[5]); w.w = pk2(o[6], o[7]);
        *(GAS v4u*)(MIX + (size_t)row * 1024 + 256 + c8) = w; }
}
__device__ __forceinline__ unsigned mono32(float f) { const unsigned u = __float_as_uint(f); return (u & 0x80000000u) ? ~u : (u | 0x80000000u); }
template <bool FROM_MASK> __device__ __forceinline__ void dsa_naive_query(Frame& F, const bf16* Q, const bf16* K, const bf16* V, const bf16* QI, const bf16* KI, const float* WI, const unsigned long long* MASK, bf16* MIX, int row) {
    const int tid = F.tid, lane = F.lane, wave = F.wave;
    const int b = row / SEQ, t = row % SEQ, n = t + 1;
    LAS unsigned long long* key64 = (LAS unsigned long long*)(F.lds + RING_OFF);
    LAS float* qi = (LAS float*)(F.lds + RING_OFF + 65536); LAS float* qh = (LAS float*)(F.lds + RING_OFF + 66560); LAS float* pl = (LAS float*)(F.lds + RING_OFF + 68608);
    LAS int* sel = (LAS int*)(F.lds + RING_OFF + 76800); LAS unsigned* cnt = (LAS unsigned*)(F.lds + RING_OFF + 77824);
    if (tid < 256) qi[tid] = bf2f(QI[(size_t)row * 256 + tid]);
    qh[tid] = bf2f(Q[(size_t)row * 512 + tid]);
    if (tid < 64) cnt[tid] = 0u;
    const f32x4 wv = *(const GAS f32x4*)(WI + (size_t)row * 4);
    __syncthreads();
    unsigned em = 0u;
    if constexpr (FROM_MASK) {
#pragma unroll
        for (int j = 0; j < 16; ++j) { const int s = tid + 512 * j;
            if (s < n) { const int kb = s >> 5, ko = s & 31, r = (ko & 3) + 4 * (ko >> 3), hh = (ko >> 2) & 1; const unsigned long long w = MASK[(((size_t)b * 256 + (t >> 5)) * 256 + kb) * 16 + r]; em |= (unsigned)((w >> (hh * 32 + (t & 31))) & 1ull) << j; } }
    } else {
    unsigned long long e[16]; unsigned long long T = 0ull;
#pragma unroll
    for (int j = 0; j < 16; ++j) { const int s = tid + 512 * j; e[j] = 0ull;
        if (s < n) { const GAS v4u* kr = (const GAS v4u*)(KI + (size_t)(b * SEQ + s) * 64); float kf[64];
#pragma unroll
            for (int c = 0; c < 8; ++c) { const v4u v = kr[c];
#pragma unroll
                for (int k = 0; k < 4; ++k) { kf[c * 8 + 2 * k] = bf2f_lo(v[k]); kf[c * 8 + 2 * k + 1] = bf2f_hi(v[k]); } }
            float sc = 0.f;
#pragma unroll
            for (int h = 0; h < 4; ++h) { float d0 = 0.f;
#pragma unroll
                for (int d = 0; d < 64; ++d) d0 += qi[h * 64 + d] * kf[d];
                sc += wv[h] * fmaxf(d0, 0.f); }
            sc = sc * IDX_SCALE + 0.0f;
            e[j] = ((unsigned long long)mono32(sc) << 13) | (unsigned long long)(8191 - s); } }
    if (n > 256) {
        for (int bit = 44; bit >= 0; --bit) { const unsigned long long cand = T | (1ull << bit); unsigned c = 0;
#pragma unroll
            for (int j = 0; j < 16; ++j) c += (e[j] >= cand) ? 1u : 0u;
            c = (unsigned)wave_sum((float)c);
            if (lane == 0) atomicAdd((unsigned*)&cnt[bit], c);
            __syncthreads();
            if (cnt[bit] >= 256u) T = cand; }
    }
    if (T == 0ull) T = 1ull;
#pragma unroll
    for (int j = 0; j < 16; ++j) em |= (e[j] >= T ? 1u : 0u) << j;
    }
    { unsigned c = 0;
      c = (unsigned)__builtin_popcount(em);
      unsigned inc = c;
#pragma unroll
      for (int o = 1; o < 64; o <<= 1) { const unsigned v = __shfl_up(inc, o); if (lane >= o) inc += v; }
      if (lane == 63) cnt[50 + wave] = inc;
      __syncthreads();
      unsigned base = inc - c;
#pragma unroll
      for (int w = 0; w < NWAVES; ++w) if (w < wave) base += cnt[50 + w];
#pragma unroll
      for (int j = 0; j < 16; ++j) if ((em >> j) & 1u) { if (base < 256u) sel[base] = tid + 512 * j; ++base; }
      if (tid == NWAVES * 64 - 1) cnt[48] = base; }
    __syncthreads();
    const int nsel = min((int)cnt[48], 256);
    { const int h = wave; float mx = -INFINITY;
#pragma unroll 1
      for (int kk = 0; kk < 4; ++kk) { const int k = lane + 64 * kk; float d0 = -INFINITY;
          if (k < nsel) { const GAS v4u* kr = (const GAS v4u*)(K + (size_t)(b * SEQ + sel[k]) * 512 + h * 64); d0 = 0.f;
#pragma unroll
              for (int c = 0; c < 8; ++c) { const v4u v = kr[c];
#pragma unroll
                  for (int q = 0; q < 4; ++q) d0 += qh[h * 64 + c * 8 + 2 * q] * bf2f_lo(v[q]) + qh[h * 64 + c * 8 + 2 * q + 1] * bf2f_hi(v[q]); } }
          pl[h * 256 + k] = d0; mx = fmaxf(mx, d0); }
      mx = wave_max(mx); float sum = 0.f;
#pragma unroll 1
      for (int kk = 0; kk < 4; ++kk) { const int k = lane + 64 * kk; const float p = (k < nsel) ? __builtin_amdgcn_exp2f(pl[h * 256 + k] - mx) : 0.f; pl[h * 256 + k] = p; sum += p; }
      sum = wave_sum(sum);
      LDS_WAIT(); asm volatile("" ::: "memory");
      float o = 0.f;
#pragma unroll 8
      for (int k = 0; k < nsel; ++k) o += pl[h * 256 + k] * bf2f(V[(size_t)(b * SEQ + sel[k]) * 512 + h * 64 + lane]);
      MIX[(size_t)row * 1024 + 512 + h * 64 + lane] = (bf16)pk2(o / sum, 0.f); }
    __syncthreads();
}
typedef float f32x16 __attribute__((ext_vector_type(16)));
__device__ __forceinline__ int crow(int r, int hi) { return (r & 3) + 8 * (r >> 2) + 4 * hi; }
constexpr int XA_ROWB = 528;
__device__ __forceinline__ void xattn_stage(Frame& F, const bf16* src  ) {
#pragma unroll 1
    for (int g = 0; g < 2; ++g) { v4u t[8];
#pragma unroll
        for (int i = 0; i < 8; ++i) { const int c = F.tid + 512 * (8 * g + i); t[i] = *(const GAS v4u*)(src + (size_t)(c >> 5) * 1024 + (c & 31) * 8); }
#pragma unroll
        for (int i = 0; i < 8; ++i) { const int c = F.tid + 512 * (8 * g + i); *(LAS v4u*)(F.lds + RING_OFF + (c >> 5) * XA_ROWB + (c & 31) * 16) = t[i]; } }
}
__device__ __forceinline__ void xattn_unit(Frame& F, const bf16* XQ, unsigned char* XO  , const bf16* MEMK, const bf16* MEMVT, int pm, int h) {
    const int lane = F.lane, wave = F.wave, r32 = lane & 31, hi = lane >> 5, b = pm >> 5;
    const int R0 = pm * 256 + wave * 32;
    LAS float* wsf = (LAS float*)(F.lds + RING_OFF + 256 * XA_ROWB) + wave * 64;
    xattn_stage(F, MEMK + (size_t)(b * 256) * 1024 + h * 256);
    bf16x8 qf[16];
#pragma unroll
    for (int kk = 0; kk < 16; ++kk) qf[kk] = *(const GAS bf16x8*)(XQ + (size_t)(R0 + r32) * 1024 + h * 256 + kk * 16 + hi * 8);
    __syncthreads();
    f32x16 st[8];
#pragma unroll
    for (int kb = 0; kb < 8; ++kb) { st[kb] = (f32x16){};
        const LAS unsigned char* kr = F.lds + RING_OFF + (kb * 32 + r32) * XA_ROWB + hi * 16;
#pragma unroll
        for (int kk = 0; kk < 16; ++kk) { const bf16x8 kf = *(const LAS bf16x8*)(kr + kk * 32); st[kb] = __builtin_amdgcn_mfma_f32_32x32x16_bf16(kf, qf[kk], st[kb], 0, 0, 0); if ((kk & 3) == 3) asm volatile("" ::: "memory"); } }
    float mx = -INFINITY;
#pragma unroll
    for (int kb = 0; kb < 8; ++kb)
#pragma unroll
        for (int r = 0; r < 16; ++r) mx = fmaxf(mx, st[kb][r]);
    { const auto rr = __builtin_amdgcn_permlane32_swap(__float_as_uint(mx), __float_as_uint(mx), false, false); mx = fmaxf(__uint_as_float(rr[0]), __uint_as_float(rr[1])); }
    float sum = 0.f; v4u pk[8][2];
#pragma unroll
    for (int kb = 0; kb < 8; ++kb) {
#pragma unroll
        for (int r = 0; r < 16; ++r) { st[kb][r] = __builtin_amdgcn_exp2f(st[kb][r] - mx); sum += st[kb][r]; }
#pragma unroll
        for (int hf = 0; hf < 2; ++hf)
#pragma unroll
            for (int q = 0; q < 4; ++q) pk[kb][hf][q] = pg8::cvt_pk_bf16(st[kb][8 * hf + 2 * q], st[kb][8 * hf + 2 * q + 1]); }
    { const auto rr = __builtin_amdgcn_permlane32_swap(__float_as_uint(sum), __float_as_uint(sum), false, false); sum = __uint_as_float(rr[0]) + __uint_as_float(rr[1]); }
    __syncthreads();
    xattn_stage(F, MEMVT + (size_t)(h * 256) * 1024 + b * 256);
    if (hi == 0) wsf[r32] = sum;
    __syncthreads();
    f32x16 o[8];
#pragma unroll
    for (int db = 0; db < 8; ++db) { o[db] = (f32x16){};
        const LAS unsigned char* vr = F.lds + RING_OFF + (db * 32 + r32) * XA_ROWB + hi * 8;
#pragma unroll
        for (int ks = 0; ks < 16; ++ks) { const pg8::u32x2 lo = *(const LAS pg8::u32x2*)(vr + ks * 32), hh = *(const LAS pg8::u32x2*)(vr + ks * 32 + 16);
            const v4u vv = (v4u){lo.x, lo.y, hh.x, hh.y};
            o[db] = __builtin_amdgcn_mfma_f32_32x32x16_bf16(__builtin_bit_cast(bf16x8, pk[ks >> 1][ks & 1]), __builtin_bit_cast(bf16x8, vv), o[db], 0, 0, 0); if ((ks & 3) == 3) asm volatile("" ::: "memory"); } }
    float rl[16];
#pragma unroll
    for (int r = 0; r < 16; ++r) rl[r] = 1.0f / wsf[crow(r, hi)];
#pragma unroll
    for (int db = 0; db < 8; ++db)
#pragma unroll
        for (int r = 0; r < 16; ++r) XO[(size_t)(R0 + crow(r, hi)) * 1024 + h * 256 + db * 32 + r32] = (unsigned char)__builtin_amdgcn_cvt_pk_fp8_f32(o[db][r] * rl[r], 0.f, 0u, false);
    __syncthreads();
}
__device__ __forceinline__ void final_norm_all(Frame& F, const bf16* X, const float* ss, const float* g, float* out) {
    const int gw = F.vcu * NWAVES + F.wave, NGW = F.G * NWAVES, lane = F.lane;
    f32x4 gg[4];
#pragma unroll
    for (int j = 0; j < 4; ++j) gg[j] = *(const GAS f32x4*)(g + (lane + 64 * j) * 4);
    for (int m0 = gw * 4; m0 < M; m0 += NGW * 4) {
        unsigned long long v[4][4]; float rs[4];
#pragma unroll
        for (int i = 0; i < 4; ++i) { rs[i] = pg8::rstd_of(ss, m0 + i);
#pragma unroll
            for (int j = 0; j < 4; ++j) v[i][j] = ((const GAS unsigned long long*)(X + (size_t)(m0 + i) * D))[lane + 64 * j]; }
#pragma unroll
        for (int i = 0; i < 4; ++i)
#pragma unroll
            for (int j = 0; j < 4; ++j) { const unsigned a = (unsigned)v[i][j], bq = (unsigned)(v[i][j] >> 32);
                *(GAS f32x4*)(out + (size_t)(m0 + i) * D + (lane + 64 * j) * 4) = (f32x4){bf2f_lo(a) * rs[i] * gg[j].x, bf2f_hi(a) * rs[i] * gg[j].y, bf2f_lo(bq) * rs[i] * gg[j].z, bf2f_hi(bq) * rs[i] * gg[j].w}; } }
}

constexpr int IX_HS = 1025;
constexpr int IX_ST = 32 * IX_HS * 4;
constexpr int IX_CAP = 1024;
#ifndef IX_DUP
#define IX_DUP 0
#endif
__device__ __forceinline__ void idx_load_a(bf16x8 (&a)[4], const bf16* kbase, int kb) {
#pragma unroll
    for (int kk = 0; kk < 4; ++kk) a[kk] = *(const GAS bf16x8*)(kbase + (size_t)kb * 2048 + kk * 512);
}
#define IX_RELU(x) __int_as_float(max(__float_as_int(x), 0))
#define IX_MF(ACC, H, KK) ACC = __builtin_amdgcn_mfma_f32_32x32x16_bf16(a[KK], bq[H][KK], ACC, 0, 0, 0)
#define IX_RS0(ACC, W, R) do { _Pragma("unroll") for (int r = (R); r < (R) + 4; ++r) { const float x = ACC[r]; sc[r] = __builtin_fmaf(W, IX_RELU(x), 0.0f); } } while (0)
#define IX_RS(ACC, W, R) do { _Pragma("unroll") for (int r = (R); r < (R) + 4; ++r) { const float x = ACC[r]; sc[r] = __builtin_fmaf(W, IX_RELU(x), sc[r]); } } while (0)
#define IX_PIN(ACC, VACC, R) asm volatile("" : "+v"(ACC), "+v"(VACC), "+v"(sc[R]), "+v"(sc[(R) + 1]), "+v"(sc[(R) + 2]), "+v"(sc[(R) + 3]))
template <bool PREV> __device__ __forceinline__ void idx_half1(float (&sc)[16], f32x16& acc0, f32x16& acc1, f32x16& acc2, f32x16& acc3, const bf16x8 (&a)[4], const bf16x8 (&bq)[4][4], const f32x4 wv) {
    acc0 = (f32x16){};
#pragma unroll
    for (int kk = 0; kk < 4; ++kk) { IX_MF(acc0, 0, kk); if constexpr (PREV) { IX_RS(acc2, wv[2], 4 * kk); IX_PIN(acc0, acc2, 4 * kk); } }
    acc1 = (f32x16){};
#pragma unroll
    for (int kk = 0; kk < 4; ++kk) { IX_MF(acc1, 1, kk); if constexpr (PREV) { IX_RS(acc3, wv[3], 4 * kk); IX_PIN(acc1, acc3, 4 * kk); } }
}
__device__ __forceinline__ void idx_half2(float (&sc)[16], f32x16& acc0, f32x16& acc1, f32x16& acc2, f32x16& acc3, const bf16x8 (&a)[4], const bf16x8 (&bq)[4][4], const f32x4 wv) {
    acc2 = (f32x16){};
#pragma unroll
    for (int kk = 0; kk < 4; ++kk) { IX_MF(acc2, 2, kk); IX_RS0(acc0, wv[0], 4 * kk); IX_PIN(acc2, acc0, 4 * kk); }
    acc3 = (f32x16){};
#pragma unroll
    for (int kk = 0; kk < 4; ++kk) { IX_MF(acc3, 3, kk); IX_RS(acc1, wv[1], 4 * kk); IX_PIN(acc3, acc1, 4 * kk); }
}
__device__ __forceinline__ void idx_tail(float (&sc)[16], const f32x16& acc2, const f32x16& acc3, const f32x4 wv) {
    IX_RS(acc2, wv[2], 0); IX_RS(acc2, wv[2], 4); IX_RS(acc2, wv[2], 8); IX_RS(acc2, wv[2], 12);
    IX_RS(acc3, wv[3], 0); IX_RS(acc3, wv[3], 4); IX_RS(acc3, wv[3], 8); IX_RS(acc3, wv[3], 12);
}
#undef IX_PIN
#undef IX_RELU
#undef IX_MF
#undef IX_RS0
#undef IX_RS
template <bool L2> __device__ __forceinline__ void idx_scan(LAS unsigned* row, bool positive, unsigned need, int lane, unsigned& bin_out, unsigned& need_out) {
    asm volatile("" : "+v"(lane));
    unsigned c[16], sum = 0;
#pragma unroll
    for (int i = 0; i < 16; ++i) { const int p = 16 * lane + i; const int bin = L2 ? (positive ? 1023 - p : p) : (p < 512 ? 511 - p : p); c[i] = row[bin]; row[bin] = 0u; sum += c[i]; }
    unsigned incl = sum;
#pragma unroll
    for (int o = 1; o < 64; o <<= 1) { const unsigned v = __shfl_up(incl, o); if (lane >= o) incl += v; }
    const unsigned long long m = __ballot(incl >= need);
    const int Ls = m ? (int)__builtin_ctzll(m) : 63;
    unsigned cum = incl - sum, fb = 0u, fn = 1u; bool found = false;
#pragma unroll
    for (int i = 0; i < 16; ++i) { const int p = 16 * lane + i; const unsigned bin = (unsigned)(L2 ? (positive ? 1023 - p : p) : (p < 512 ? 511 - p : p));
        if (!found && cum + c[i] >= need) { found = true; fb = bin; fn = need - cum; } cum += c[i]; }
    bin_out = (unsigned)__shfl((int)fb, Ls); need_out = (unsigned)__shfl((int)fn, Ls);
}
template <int NS> __device__ __forceinline__ unsigned idx_select(LAS unsigned* row, unsigned n, unsigned need, int lane) {
    unsigned v[NS], vor = 0u, vand = 0xffffffffu;
#pragma unroll
    for (int s = 0; s < NS; ++s) { const unsigned idx = (unsigned)(s * 64 + lane); const bool ok = idx < n; v[s] = ok ? row[idx] : 0u; vor |= v[s]; vand &= ok ? v[s] : 0xffffffffu; }
#pragma unroll
    for (int o = 1; o < 64; o <<= 1) { vor |= (unsigned)__shfl_xor((int)vor, o); vand &= (unsigned)__shfl_xor((int)vand, o); }
    const unsigned diff = vor ^ vand;
    if (diff == 0u) return vand;
    const int top = 31 - __builtin_clz(diff);
    unsigned T = vand & ~((2u << top) - 1u);
    for (int bit = top; bit >= 0; --bit) { const unsigned cand = T | (1u << bit); unsigned c = 0;
#pragma unroll
        for (int s = 0; s < NS; ++s) c += (unsigned)__builtin_popcountll(__ballot(v[s] >= cand));
        if (c >= need) T = cand; }
    return T;
}
__device__ __forceinline__ unsigned ix_mono(unsigned raw) { return (raw & 0x80000000u) ? ~raw : (raw | 0x80000000u); }
__device__ __forceinline__ float ix_h2f(unsigned h) { return (float)__builtin_bit_cast(_Float16, (unsigned short)h); }
__device__ __forceinline__ unsigned ix_pick(const float (&sc)[16], unsigned r) {
    const unsigned m0 = (unsigned)((int)(r << 31) >> 31), m1 = (unsigned)((int)(r << 30) >> 31), m2 = (unsigned)((int)(r << 29) >> 31), m3 = (unsigned)((int)(r << 28) >> 31); unsigned t[8], u[4], w[2];
#pragma unroll
    for (int i = 0; i < 8; ++i) t[i] = (__float_as_uint(sc[2 * i + 1]) & m0) | (__float_as_uint(sc[2 * i]) & ~m0);
#pragma unroll
    for (int i = 0; i < 4; ++i) u[i] = (t[2 * i + 1] & m1) | (t[2 * i] & ~m1);
#pragma unroll
    for (int i = 0; i < 2; ++i) w[i] = (u[2 * i + 1] & m2) | (u[2 * i] & ~m2);
    return (w[1] & m3) | (w[0] & ~m3);
}
__device__ __forceinline__ void idx_unit(Frame& F, const bf16* QI, const bf16* KI, const float* WI, unsigned* MASK, int b, int j) {
    int lane = F.lane, r32 = lane & 31, hi = lane >> 5; const int wave = F.wave;
#define IX_LAUNDER() asm volatile("" : "+v"(lane), "+v"(r32), "+v"(hi))
    LAS unsigned* hist = (LAS unsigned*)(F.lds + RING_OFF);
    LAS unsigned* st = (LAS unsigned*)(F.lds + RING_OFF + IX_ST);
    const size_t qrow = (size_t)b * SEQ + 32 * j + r32;
    bf16x8 bq[4][4];
#pragma unroll
    for (int h = 0; h < 4; ++h)
#pragma unroll
        for (int kk = 0; kk < 4; ++kk) bq[h][kk] = *(const GAS bf16x8*)(QI + qrow * 256 + h * 64 + kk * 16 + hi * 8);
    f32x4 wv = *(const GAS f32x4*)(WI + qrow * 4); wv = wv * IDX_SCALE;
    const bf16* kbase = KI + (size_t)b * SEQ * 64 + (size_t)(hi * 32 + r32) * 8;
    LAS unsigned* myrow = hist + r32 * IX_HS;
    const unsigned myrow_b = (unsigned)(uintptr_t)myrow;
#define IX_BODY(KBP, ...) do { const int kb = (KBP); if (kb == j) { _Pragma("unroll") for (int r = 0; r < 16; ++r) sc[r] = (crow(r, hi) > r32) ? -INFINITY : sc[r]; } __VA_ARGS__ } while (0)
#define IX_STEP(A, KB, ...) do { idx_half1<true>(sc, acc0, acc1, acc2, acc3, A, bq, wv); IX_BODY(kbp, __VA_ARGS__); idx_half2(sc, acc0, acc1, acc2, acc3, A, bq, wv); idx_load_a(A, kbase, min((KB) + 3 * NWAVES, j)); kbp = (KB); } while (0)
#define IX_PASS(...) do { IX_LAUNDER(); bf16x8 a0[4], a1[4], a2[4]; idx_load_a(a0, kbase, min(wave, j)); idx_load_a(a1, kbase, min(wave + NWAVES, j)); idx_load_a(a2, kbase, min(wave + 2 * NWAVES, j)); \
        if (wave <= j) { float sc[16]; f32x16 acc0, acc1, acc2, acc3; int kbp = wave; \
            idx_half1<false>(sc, acc0, acc1, acc2, acc3, a0, bq, wv); idx_half2(sc, acc0, acc1, acc2, acc3, a0, bq, wv); idx_load_a(a0, kbase, min(wave + 3 * NWAVES, j)); \
            for (int kb_ = wave + NWAVES;;) { \
                if (kb_ > j) break; IX_STEP(a1, kb_, __VA_ARGS__); kb_ += NWAVES; \
                if (kb_ > j) break; IX_STEP(a2, kb_, __VA_ARGS__); kb_ += NWAVES; \
                if (kb_ > j) break; IX_STEP(a0, kb_, __VA_ARGS__); kb_ += NWAVES; } \
            idx_tail(sc, acc2, acc3, wv); IX_BODY(kbp, __VA_ARGS__); } } while (0)
    float ts = -3.402823466e38f, ti = -3.402823466e38f; unsigned mbase = 0u;
    if (j >= 8) for (int ra_ = 0; ra_ < 1 + (IX_DUP & 1); ++ra_) {
        IX_PASS({
            _Pragma("unroll") for (int r = 0; r < 16; r += 2) { unsigned u; asm("v_cvt_pkrtz_f16_f32 %0, %1, %2" : "=v"(u) : "v"(sc[r]), "v"(sc[r + 1]));
                unsigned a0, a1; asm("v_lshl_add_u32 %0, %1, 2, %2" : "=v"(a0) : "v"((u >> 6) & 1023u), "v"(myrow_b)); asm("v_lshl_add_u32 %0, %1, 2, %2" : "=v"(a1) : "v"(u >> 22), "v"(myrow_b));
                __hip_atomic_fetch_add((LAS unsigned*)a0, 1u, __ATOMIC_RELAXED, __HIP_MEMORY_SCOPE_WORKGROUP); __hip_atomic_fetch_add((LAS unsigned*)a1, 1u, __ATOMIC_RELAXED, __HIP_MEMORY_SCOPE_WORKGROUP); } });
        __syncthreads();
#pragma unroll 1
        for (int qq = wave * 4; qq < wave * 4 + 4; ++qq) { unsigned bn, nd; idx_scan<false>(hist + qq * IX_HS, true, 256u, lane, bn, nd);
            if (lane == 0) {
                float tsv, tiv;
                if (bn < 512u) { tiv = ix_h2f(bn << 6); tsv = ix_h2f((bn + 1u) << 6); }
                else { const unsigned mb = bn - 512u; const float mlo = ix_h2f(mb << 6), mhi = ix_h2f((mb + 1u) << 6);
                    tsv = (mlo == 0.f) ? 0.f : __uint_as_float(__float_as_uint(-mlo) - 1u); tiv = __uint_as_float(__float_as_uint(-mhi) - 1u); }
                st[qq] = bn; st[32 + qq] = nd; st[64 + qq] = __float_as_uint(tsv); st[96 + qq] = __float_as_uint(tiv); st[128 + qq] = ix_mono(__float_as_uint(tiv)); st[160 + qq] = 0u; } }
        __syncthreads();
        ts = __uint_as_float(st[64 + r32]); ti = __uint_as_float(st[96 + r32]); mbase = st[128 + r32];
    }
    unsigned short* mrow = (unsigned short*)(MASK + (((size_t)b * 256 + j) * 128) * 64);
    for (int rd_ = 0; rd_ < 1 + ((IX_DUP >> 1) & 1); ++rd_) { if (rd_) { __syncthreads(); if (F.tid < 32) st[160 + F.tid] = 0u; __syncthreads(); }
    IX_PASS({
            unsigned w16 = 0u, c16 = 0u;
            _Pragma("unroll") for (int r = 15; r >= 0; --r) asm("v_cmp_ge_f32_e32 vcc, %2, %3\n\tv_addc_co_u32_e32 %0, vcc, %0, %0, vcc\n\tv_cmp_ge_f32_e32 vcc, %2, %4\n\tv_addc_co_u32_e32 %1, vcc, %1, %1, vcc" : "+v"(w16), "+v"(c16) : "v"(sc[r]), "v"(ts), "v"(ti) : "vcc");
            mrow[(((size_t)(kb >> 1) * 64 + lane) << 1) + (kb & 1)] = (unsigned short)w16;
            const unsigned cm = c16 & ~w16;
            if (cm) { unsigned base = __hip_atomic_fetch_add(st + 160 + r32, (unsigned)__builtin_popcount(cm), __ATOMIC_RELAXED, __HIP_MEMORY_SCOPE_WORKGROUP);
                _Pragma("unroll 1") for (unsigned cmv = cm; cmv; cmv &= cmv - 1u) { const unsigned r = (unsigned)__builtin_ctz(cmv); const unsigned d = ix_mono(ix_pick(sc, r)) - mbase;
                        if (base < (unsigned)IX_CAP) myrow[base] = (min(d, 0x7ffffu) << 13) | (8191u - (32u * (unsigned)kb + (r & 3u) + 8u * (r >> 2) + 4u * (unsigned)hi)); ++base; } } });
    }
    for (int kb = j + 1 + wave; kb <= (j | 7); kb += NWAVES) mrow[(((size_t)(kb >> 1) * 64 + lane) << 1) + (kb & 1)] = (unsigned short)0;
    asm volatile("s_waitcnt vmcnt(0)" ::: "memory");
    __syncthreads();
    if (j >= 8) {
#pragma unroll 1
        for (int qq = wave * 4; qq < wave * 4 + 4; ++qq) { LAS unsigned* row = hist + qq * IX_HS; const unsigned n = min(st[160 + qq], (unsigned)IX_CAP), need = st[32 + qq];
            const int ns = (int)((n + 63u) >> 6); unsigned T = 0u;
            if (ns <= 2) T = idx_select<2>(row, n, need, lane); else if (ns <= 4) T = idx_select<4>(row, n, need, lane); else if (ns <= 8) T = idx_select<8>(row, n, need, lane); else T = idx_select<16>(row, n, need, lane);
            for (int s = 0; s < ns; ++s) { const unsigned idx = (unsigned)(s * 64 + lane);
                if (idx < n) { const unsigned v = row[idx]; row[idx] = 0u;
                    if (v >= T) { const unsigned key = 8191u - (v & 8191u), kbk = key >> 5, ko = key & 31u, rr = (ko & 3u) + 4u * (ko >> 3), hh = (ko >> 2) & 1u;
                        __hip_atomic_fetch_or((unsigned*)mrow + (size_t)(kbk >> 1) * 64 + hh * 32 + qq, 1u << (16u * (kbk & 1u) + rr), __ATOMIC_RELAXED, __HIP_MEMORY_SCOPE_AGENT); } } } }
        __syncthreads();
    }
#undef IX_PASS
#undef IX_STEP
#undef IX_BODY
#undef IX_LAUNDER
}
__device__ __forceinline__ void idx_unit_of(int u, int& b, int& j) { const int slot = u >> 8, v = u & 255, i = v & 63; b = v >> 6; j = slot == 0 ? 255 - i : slot == 1 ? 128 + i : slot == 2 ? 127 - i : i; }

#include <hip/hip_bf16.h>
namespace attn_body {
using bf16=__hip_bfloat16;
using bf16x8=__attribute__((ext_vector_type(8)))short;
using s16x4=__attribute__((ext_vector_type(4)))short;
using f32x16=__attribute__((ext_vector_type(16)))float;
using u32x4=__attribute__((ext_vector_type(4)))unsigned;
constexpr int BATCH=4,NHEAD=8,SEQ=8192,D=64,DM=NHEAD*D,OPITCH=1024;
constexpr int NW=8,QBLK=32,QB=QBLK*NW,KVBLK=64,NQB=SEQ/QB;
constexpr int ATTN_PITCH=DM, ATTN_UNIT_ROWS=QB;
__device__ __forceinline__ int crow(int r,int hi){return (r&3)+8*(r>>2)+4*hi;}
#define SBAR() __builtin_amdgcn_sched_barrier(0)
#define MASK1(p,w,e) ({ unsigned m_; asm("v_bfe_i32 %0, %1, %2, 1":"=v"(m_):"v"(w),"n"(e)); __uint_as_float(__float_as_uint(p)&m_); })

constexpr int NSLOT=3, SLOTB=8192;
constexpr int LDS_K=0, LDS_V=NSLOT*SLOTB, LDS_WS=2*NSLOT*SLOTB, LDS_OST=LDS_WS+NW*64*4, LDS_BYTES=LDS_OST+NW*4096;
constexpr float C2=0.125f*1.4426950408889634f;
__device__ __forceinline__ void glds16(const void*gsrc,unsigned lds_dst){unsigned keep;
  asm volatile("s_mov_b32 %0, m0\n\ts_mov_b32 m0, %2\n\ts_nop 0\n\tglobal_load_lds_dwordx4 %1, off\n\ts_mov_b32 m0, %0":"=&s"(keep):"v"(gsrc),"s"(lds_dst):"memory");}
__device__ __forceinline__ float max3f(float a,float b,float c){float r;asm("v_max3_f32 %0, %1, %2, %3":"=v"(r):"v"(a),"v"(b),"v"(c));return r;}
__device__ __forceinline__ float max2f(float a,float b){float r;asm("v_max_f32_e32 %0, %1, %2":"=v"(r):"v"(a),"v"(b));return r;}
__device__ __forceinline__ float fadd_s(float a,float b){float r;asm("v_add_f32_e32 %0, %1, %2":"=v"(r):"v"(a),"v"(b));return r;}
__device__ __forceinline__ float fsub_s(float a,float b){float r;asm("v_sub_f32_e32 %0, %1, %2":"=v"(r):"v"(a),"v"(b));return r;}
typedef float f32x2_t __attribute__((ext_vector_type(2))); typedef __bf16 bf16x2_t __attribute__((ext_vector_type(2)));
__device__ __forceinline__ unsigned cvtpk_s(float lo,float hi){f32x2_t v={lo,hi};bf16x2_t b=__builtin_convertvector(v,bf16x2_t);return __builtin_bit_cast(unsigned,b);}
#define WAIT_BAR(N) asm volatile("s_waitcnt vmcnt(" #N ") lgkmcnt(0)\n\ts_barrier":::"memory")

__device__ __forceinline__ void qkt(f32x16&p0,f32x16&p1,const char*Kslot,const bf16x8*qr,const f32x16&negm,int r32,int hi){
  const char*kb=Kslot+hi*1024+r32*16;
  #pragma unroll
  for(int d0=0;d0<4;++d0){
    const bf16x8 b0=*reinterpret_cast<const bf16x8*>(kb+d0*2048);
    const bf16x8 b1=*reinterpret_cast<const bf16x8*>(kb+d0*2048+512);
    if(d0==0){p0=__builtin_amdgcn_mfma_f32_32x32x16_bf16(b0,qr[0],negm,0,0,0);p1=__builtin_amdgcn_mfma_f32_32x32x16_bf16(b1,qr[0],negm,0,0,0);}
    else{p0=__builtin_amdgcn_mfma_f32_32x32x16_bf16(b0,qr[d0],p0,0,0,0);p1=__builtin_amdgcn_mfma_f32_32x32x16_bf16(b1,qr[d0],p1,0,0,0);}}
}
typedef __attribute__((address_space(3))) const char* lds_cptr;
typedef short v4i16_t __attribute__((ext_vector_type(4)));
__device__ __forceinline__ void kload8(bf16x8*kf,lds_cptr kp){
  kf[0]=*(const __attribute__((address_space(3))) bf16x8*)(kp);      kf[1]=*(const __attribute__((address_space(3))) bf16x8*)(kp+512);
  kf[2]=*(const __attribute__((address_space(3))) bf16x8*)(kp+2048); kf[3]=*(const __attribute__((address_space(3))) bf16x8*)(kp+2560);
  kf[4]=*(const __attribute__((address_space(3))) bf16x8*)(kp+4096); kf[5]=*(const __attribute__((address_space(3))) bf16x8*)(kp+4608);
  kf[6]=*(const __attribute__((address_space(3))) bf16x8*)(kp+6144); kf[7]=*(const __attribute__((address_space(3))) bf16x8*)(kp+6656);
}
__device__ __forceinline__ void kload2(bf16x8*kf,lds_cptr kp,int j){ kf[2*j]=*(const __attribute__((address_space(3))) bf16x8*)(kp+j*2048); kf[2*j+1]=*(const __attribute__((address_space(3))) bf16x8*)(kp+j*2048+512); }
__device__ __forceinline__ s16x4 vtr(lds_cptr p){ return __builtin_bit_cast(s16x4,__builtin_amdgcn_ds_read_tr16_b64_v4i16((__attribute__((address_space(3))) v4i16_t*)p)); }
__device__ __forceinline__ float rowmax(const f32x16&p0,const f32x16&p1){
  float a=max3f(p0[0],p0[1],p1[0]),b=max3f(p0[2],p0[3],p1[1]);a=max3f(a,p1[2],p1[3]);
  #pragma unroll
  for(int r=4;r<16;r+=4){a=max3f(a,p0[r],p0[r+1]);b=max3f(b,p0[r+2],p0[r+3]);a=max3f(a,p1[r],p1[r+1]);b=max3f(b,p1[r+2],p1[r+3]);}
  const float m=max2f(a,b);
  auto rr=__builtin_amdgcn_permlane32_swap(__float_as_uint(m),__float_as_uint(m),false,false);
  return max2f(__uint_as_float(rr[0]),__uint_as_float(rr[1]));
}
__device__ __forceinline__ void pv(f32x16*o,int vb,bf16x8 pa0,bf16x8 pa1,bf16x8 pa2,bf16x8 pa3){
  #pragma unroll
  for(int d0=0;d0<2;++d0){s16x4 lo[4],hi[4];
    #pragma unroll
    for(int ks=0;ks<4;++ks){
      asm volatile("ds_read_b64_tr_b16 %0,%1 offset:%c2":"=&v"(lo[ks]):"v"(vb),"i"(d0*4096+ks*1024):"memory");
      asm volatile("ds_read_b64_tr_b16 %0,%1 offset:%c2":"=&v"(hi[ks]):"v"(vb),"i"(d0*4096+ks*1024+512):"memory");}
    asm volatile("s_waitcnt lgkmcnt(0)":::"memory");SBAR();
    #define PK(k) (bf16x8){lo[k][0],lo[k][1],lo[k][2],lo[k][3],hi[k][0],hi[k][1],hi[k][2],hi[k][3]}
    o[d0]=__builtin_amdgcn_mfma_f32_32x32x16_bf16(pa0,PK(0),o[d0],0,0,0);
    o[d0]=__builtin_amdgcn_mfma_f32_32x32x16_bf16(pa1,PK(1),o[d0],0,0,0);
    o[d0]=__builtin_amdgcn_mfma_f32_32x32x16_bf16(pa2,PK(2),o[d0],0,0,0);
    o[d0]=__builtin_amdgcn_mfma_f32_32x32x16_bf16(pa3,PK(3),o[d0],0,0,0);
    #undef PK
  }
}

#ifndef ATTN_STORE16
#define ATTN_STORE16(p,v) (*(u32x4*)(p)=(v))
#endif
template<int THRL> __device__ __forceinline__ void attn_unit(int b,int h,int qb,const bf16*Q,const bf16*__restrict__ K,const bf16*__restrict__ V,bf16*O,const unsigned*MASK,char*shm){
  int tid_=threadIdx.x; asm volatile("":"+v"(tid_));
  const int tid=tid_,lane=tid&63,r32=lane&31,hi=lane>>5; const int wid=__builtin_amdgcn_readfirstlane(tid>>6);
  const long rowbase=(long)b*SEQ; const int q0=qb*QB;
  const bf16*Qw=Q+(rowbase+q0+wid*QBLK)*DM+h*D;
  const bf16*Kh=K+rowbase*DM+h*D,*Vh=V+rowbase*DM+h*D;
  const unsigned lds0=(unsigned)(uintptr_t)shm;
  float*wsf=(float*)(shm+LDS_WS)+wid*64;
  const bf16*ksrc=Kh+(long)lane*DM+wid*8;
  const bf16*vsrc=Vh+(long)(16*(wid&3)+(lane>>2))*DM+(wid>>2)*32+(lane&3)*8;
  const unsigned kdst=lds0+LDS_K+wid*1024, vdst=lds0+LDS_V+wid*1024;
  #define DMA_K(t,slot) glds16(ksrc+(long)(t)*KVBLK*DM,(unsigned)__builtin_amdgcn_readfirstlane(kdst+(slot)))
  #define DMA_V(t,slot) glds16(vsrc+(long)(t)*KVBLK*DM,(unsigned)__builtin_amdgcn_readfirstlane(vdst+(slot)))
  const int vb0=(int)(lds0+LDS_V)+((lane>>4)&1)*32+(lane&3)*8+(4*hi+((lane&15)>>2))*64;
  const char*Kbase=shm+LDS_K; bf16x8 kf[8];
  const lds_cptr shm3=(lds_cptr)shm; const lds_cptr kp0=shm3+LDS_K+hi*1024+r32*16; const lds_cptr vp0=shm3+LDS_V+((lane>>4)&1)*32+(lane&3)*8+(4*hi+((lane&15)>>2))*64;
  const int NT=(q0+QB)/KVBLK;
  const unsigned*mwl=MASK+((size_t)(b*256+qb*8+wid)*128)*64+lane;
  unsigned wA,wB;
  #define WLOAD(W,t) asm volatile("global_load_dword %0, %1, off":"=v"(W):"v"(mwl+(size_t)(t)*64):"memory")
  WLOAD(wA,0);WLOAD(wB,1);
  DMA_K(0,0);DMA_V(0,0);DMA_K(1,SLOTB);
  bf16x8 qr[4];
  #pragma unroll
  for(int d0=0;d0<4;++d0)qr[d0]=*reinterpret_cast<const bf16x8*>(&Qw[(long)r32*DM+d0*16+hi*8]);
  float mhat=0.f,l_reg=0.f;f32x16 o[2];o[0]=f32x16{};o[1]=f32x16{};f32x16 negm=f32x16{};asm volatile("":"+v"(negm));
  bool resc=false;
  #define START(P0,P1) do{ const float rm=rowmax(P0,P1); resc=false; \
    { const float dl=rm>-1e30f?rm:0.f; mhat=fadd_s(mhat,dl); \
      _Pragma("unroll") for(int r=0;r<16;++r){P0[r]=fsub_s(P0[r],dl);P1[r]=fsub_s(P1[r],dl);} \
      _Pragma("unroll") for(int r=0;r<16;++r)negm[r]=-mhat; asm volatile("":"+v"(negm)); } \
    _Pragma("unroll") for(int r=0;r<16;++r)P0[r]=__builtin_amdgcn_exp2f(P0[r]); }while(0)
  #define RESC() do{ if(resc){ asm volatile("s_waitcnt lgkmcnt(0)":::"memory"); \
      _Pragma("unroll") for(int d_=0;d_<2;++d_) _Pragma("unroll") for(int r=0;r<16;++r)o[d_][r]*=wsf[crow(r,hi)]; } }while(0)
  f32x16 pA0,pA1,pB0,pB1;
  int sl_prev=0,sl_cur=0,sl_next=SLOTB;
  #define ROT() do{sl_prev=sl_cur;sl_cur=sl_next;sl_next=(sl_next==(NSLOT-1)*SLOTB)?0:sl_next+SLOTB;}while(0)
  DMA_K(2,2*SLOTB);
  WAIT_BAR(3);
  qkt(pA0,pA1,Kbase,qr,negm,r32,hi);asm volatile("s_nop 15\n\ts_nop 7":"+v"(pA0),"+v"(pA1));
  START(pA0,pA1);
  _Pragma("unroll") for(int r=0;r<16;++r)pA1[r]=__builtin_amdgcn_exp2f(pA1[r]);
  _Pragma("unroll") for(int r=0;r<16;++r){pA0[r]=MASK1(pA0[r],wA,r);pA1[r]=MASK1(pA1[r],wA,16+r);}
  WAIT_BAR(0);
  DMA_K(3,0);DMA_V(1,SLOTB);
  ROT();
  kload8(kf,kp0+sl_cur);
  WAIT_BAR(2);
  s16x4 vlo[8],vhi[8]; u32x4 pw0,pw1,pw2,pw3;
  #define PKW(P,B) cvtpk_s(P[B],P[B+1])
  #define PAF(k) __builtin_bit_cast(bf16x8,pw##k)
  #define VFR(i) (bf16x8){vlo[i][0],vlo[i][1],vlo[i][2],vlo[i][3],vhi[i][0],vhi[i][1],vhi[i][2],vhi[i][3]}
  #define PIN(x) asm volatile("":"+v"(x))
  #define MX3(a,b,c) __builtin_fmaxf(__builtin_fmaxf((a),(b)),(c))
  #define GAPA(MF,A0,A1,A2,A3,W0,W1,PW) do{ MF; sacc+=A0; sacc+=A1; sacc+=A2; sacc+=A3; PIN(sacc); W0; W1; PIN(PW); SBAR(); }while(0)
  #define EX(v) __builtin_amdgcn_exp2f(v)
  #define BFE1(m,w,e) asm("v_bfe_i32 %0, %1, %2, 1":"=v"(m):"v"(w),"n"(e))
  #define AND1(x,m) __uint_as_float(__float_as_uint(x)&(m))
  #define GAPB(MF,X,B,W,E) do{ MF; unsigned m0_,m1_,m2_,m3_; \
      const float e0_=EX(X[B]); SBAR(); BFE1(m0_,W,(E)); SBAR(); const float e1_=EX(X[B+1]); SBAR(); BFE1(m1_,W,(E)+1); SBAR(); X[B]=AND1(e0_,m0_); SBAR(); \
      const float e2_=EX(X[B+2]); SBAR(); BFE1(m2_,W,(E)+2); SBAR(); X[B+1]=AND1(e1_,m1_); SBAR(); const float e3_=EX(X[B+3]); SBAR(); BFE1(m3_,W,(E)+3); SBAR(); X[B+2]=AND1(e2_,m2_); SBAR(); X[B+3]=AND1(e3_,m3_); PIN(X); SBAR(); }while(0)
  #define VRD(i) do{ vlo[i]=vtr(vp_+(((i)>>2)*4096+((i)&3)*1024)); vhi[i]=vtr(vp_+(((i)>>2)*4096+((i)&3)*1024+512)); }while(0)
  #define KRD(G,j) do{ if(G){ kload2(kf,kp0+sl_next,j); SBAR(); } }while(0)
  #define STEP(C0,C1,P0,P1,t,GK,GV,GL,WU,WL) do{ SBAR(); if((t)+1<NT){WLOAD(WL,(t)+1);} SBAR(); \
    const lds_cptr vp_=vp0+sl_prev; \
    VRD(0); SBAR(); float sacc=(P0[0]+P0[1]); \
    GAPA(C0=__builtin_amdgcn_mfma_f32_32x32x16_bf16(kf[0],qr[0],negm,0,0,0), P0[2],P0[3],P0[4],P0[5],     pw0[0]=PKW(P0,0), pw0[1]=PKW(P0,2), pw0); \
    VRD(4); SBAR(); GAPA(C1=__builtin_amdgcn_mfma_f32_32x32x16_bf16(kf[1],qr[0],negm,0,0,0), P0[6],P0[7],P0[8],P0[9],     pw0[2]=PKW(P0,4), pw0[3]=PKW(P0,6), pw0); \
    VRD(1); SBAR(); GAPA(C0=__builtin_amdgcn_mfma_f32_32x32x16_bf16(kf[2],qr[1],C0,0,0,0),   P0[10],P0[11],P0[12],P0[13], pw1[0]=PKW(P0,8), pw1[1]=PKW(P0,10), pw1); \
    VRD(5); SBAR(); GAPA(C1=__builtin_amdgcn_mfma_f32_32x32x16_bf16(kf[3],qr[1],C1,0,0,0),   P0[14],P0[15],P1[0],P1[1],   pw1[2]=PKW(P0,12),pw1[3]=PKW(P0,14), pw1); \
    VRD(2); SBAR(); GAPA(C0=__builtin_amdgcn_mfma_f32_32x32x16_bf16(kf[4],qr[2],C0,0,0,0),   P1[2],P1[3],P1[4],P1[5],     pw2[0]=PKW(P1,0), pw2[1]=PKW(P1,2), pw2); \
    VRD(6); SBAR(); GAPA(C1=__builtin_amdgcn_mfma_f32_32x32x16_bf16(kf[5],qr[2],C1,0,0,0),   P1[6],P1[7],P1[8],P1[9],     pw2[2]=PKW(P1,4), pw2[3]=PKW(P1,6), pw2); \
    VRD(3); SBAR(); GAPA(C0=__builtin_amdgcn_mfma_f32_32x32x16_bf16(kf[6],qr[3],C0,0,0,0),   P1[10],P1[11],P1[12],P1[13], pw3[0]=PKW(P1,8), pw3[1]=PKW(P1,10), pw3); \
    VRD(7); SBAR(); GAPA(C1=__builtin_amdgcn_mfma_f32_32x32x16_bf16(kf[7],qr[3],C1,0,0,0),   P1[14],P1[15],0.f,0.f,       pw3[2]=PKW(P1,12),pw3[3]=PKW(P1,14), pw3); \
    l_reg+=sacc; \
    if(GK){DMA_K((t)+3,sl_cur);} if(GV){DMA_V((t)+1,sl_next);} \
    { float a=MX3(C0[0],C0[1],C1[0]),b=MX3(C0[2],C0[3],C1[1]); a=MX3(a,C1[2],C1[3]); \
      _Pragma("unroll") for(int r=4;r<16;r+=4){a=MX3(a,C0[r],C0[r+1]);b=MX3(b,C0[r+2],C0[r+3]);a=MX3(a,C1[r],C1[r+1]);b=MX3(b,C1[r+2],C1[r+3]);} \
      float rm=__builtin_fmaxf(a,b); { auto rr=__builtin_amdgcn_permlane32_swap(__float_as_uint(rm),__float_as_uint(rm),false,false); rm=__builtin_fmaxf(__uint_as_float(rr[0]),__uint_as_float(rr[1])); } \
      resc=false; \
      if(__builtin_expect(__any(rm>(float)THRL),0)){ const float dl=__builtin_fmaxf(rm,0.f); mhat+=dl; \
        _Pragma("unroll") for(int r=0;r<16;++r){C0[r]-=dl;C1[r]-=dl;} \
        _Pragma("unroll") for(int r=0;r<16;++r)negm[r]=-mhat; asm volatile("":"+v"(negm)); \
        const float f=__builtin_amdgcn_exp2f(-dl); l_reg*=f; if(hi==0)wsf[r32]=f; resc=true; } } \
    SBAR(); \
    GAPB(o[0]=__builtin_amdgcn_mfma_f32_32x32x16_bf16(PAF(0),VFR(0),o[0],0,0,0), C0,0,WU,0); \
    GAPB(o[1]=__builtin_amdgcn_mfma_f32_32x32x16_bf16(PAF(0),VFR(4),o[1],0,0,0), C0,4,WU,4); \
    KRD(GL,0); GAPB(o[0]=__builtin_amdgcn_mfma_f32_32x32x16_bf16(PAF(1),VFR(1),o[0],0,0,0), C0,8,WU,8); \
    KRD(GL,1); GAPB(o[1]=__builtin_amdgcn_mfma_f32_32x32x16_bf16(PAF(1),VFR(5),o[1],0,0,0), C0,12,WU,12); \
    KRD(GL,2); GAPB(o[0]=__builtin_amdgcn_mfma_f32_32x32x16_bf16(PAF(2),VFR(2),o[0],0,0,0), C1,0,WU,16); \
    KRD(GL,3); GAPB(o[1]=__builtin_amdgcn_mfma_f32_32x32x16_bf16(PAF(2),VFR(6),o[1],0,0,0), C1,4,WU,20); \
    GAPB(o[0]=__builtin_amdgcn_mfma_f32_32x32x16_bf16(PAF(3),VFR(3),o[0],0,0,0), C1,8,WU,24); \
    GAPB(o[1]=__builtin_amdgcn_mfma_f32_32x32x16_bf16(PAF(3),VFR(7),o[1],0,0,0), C1,12,WU,28); \
    }while(0)
  int t=1;
  for(;t+5<NT;t+=2){
    STEP(pB0,pB1,pA0,pA1,t,true,true,true,wB,wA);     WAIT_BAR(2); RESC(); ROT();
    STEP(pA0,pA1,pB0,pB1,t+1,true,true,true,wA,wB);   WAIT_BAR(2); RESC(); ROT();
  }
  #define ENDW(tt) do{ if((tt)+3<NT){WAIT_BAR(2);} else if((tt)+2<NT){WAIT_BAR(1);} else {WAIT_BAR(0);} }while(0)
  for(;t+1<NT;t+=2){
    STEP(pB0,pB1,pA0,pA1,t,(t+3<NT),(t+1<NT),(t+1<NT),wB,wA);       ENDW(t);   RESC(); ROT();
    STEP(pA0,pA1,pB0,pB1,t+1,(t+4<NT),(t+2<NT),(t+2<NT),wA,wB);     ENDW(t+1); RESC(); ROT();
  }
  STEP(pB0,pB1,pA0,pA1,NT-1,false,false,false,wB,wA); RESC();
  { float sacc=pB0[0]+pB0[1]; _Pragma("unroll") for(int r=2;r<16;++r)sacc+=pB0[r]; _Pragma("unroll") for(int r=0;r<16;++r)sacc+=pB1[r]; l_reg+=sacc;
    pw0=(u32x4){PKW(pB0,0),PKW(pB0,2),PKW(pB0,4),PKW(pB0,6)};pw1=(u32x4){PKW(pB0,8),PKW(pB0,10),PKW(pB0,12),PKW(pB0,14)};pw2=(u32x4){PKW(pB1,0),PKW(pB1,2),PKW(pB1,4),PKW(pB1,6)};pw3=(u32x4){PKW(pB1,8),PKW(pB1,10),PKW(pB1,12),PKW(pB1,14)};
    SBAR(); pv(o,vb0+sl_cur,PAF(0),PAF(1),PAF(2),PAF(3)); }
  #undef PKW
  #undef PAF
  #undef VFR
  #undef PIN
  #undef MX3
  #undef GAPA
  #undef GAPB
  #undef EX
  #undef VRD
  #undef KRD
  #undef STEP
  #undef ENDW
  {auto rr=__builtin_amdgcn_permlane32_swap(__float_as_uint(l_reg),__float_as_uint(l_reg),false,false);l_reg=__uint_as_float(rr[0])+__uint_as_float(rr[1]);}
  if(hi==0)wsf[32+r32]=l_reg;asm volatile("s_waitcnt lgkmcnt(0)":::"memory");
  float rli[16];
  #pragma unroll
  for(int r=0;r<16;++r)rli[r]=__builtin_amdgcn_rcpf(wsf[32+crow(r,hi)]);
  bf16*Ow=O+(rowbase+q0+wid*QBLK)*OPITCH+h*D;
  { bf16*stg=(bf16*)(shm+LDS_OST)+wid*2048;
    #pragma unroll
    for(int r=0;r<16;++r){const int orow=crow(r,hi);
      #pragma unroll
      for(int d0=0;d0<2;++d0)stg[orow*64+d0*32+r32]=__float2bfloat16(o[d0][r]*rli[r]);}
    asm volatile("s_waitcnt lgkmcnt(0)":::"memory");
    #pragma unroll
    for(int i=0;i<4;++i){const int row=i*8+(lane>>3),ch=lane&7; const u32x4 v=*(const u32x4*)(stg+row*64+ch*8); ATTN_STORE16(Ow+(long)row*OPITCH+ch*8,v);} }
  asm volatile("s_waitcnt lgkmcnt(0)\n\ts_barrier":::"memory");
  #undef DMA_K
  #undef DMA_V
  #undef WLOAD
  #undef START
  #undef RESC
  #undef ROT
}
constexpr int ATTN_LDS_BYTES=LDS_BYTES;
struct AttnTensors { const bf16* Q; const bf16* K; const bf16* V; bf16* O; const unsigned* MASK; };
struct AttnUnit { int bh; int qb; };
struct StaticOrder {
  int vcu;
  int grid;
  __device__ __forceinline__ explicit StaticOrder(int grid_,int block):vcu((grid_%8==0)?(block%8)*(grid_/8)+block/8:block),grid(grid_){}
  __device__ __forceinline__ bool next(int i,AttnUnit&u)const{ const int v=vcu+(i>>2)*grid; if(v>=256)return false; const int k=i&3,s=v&7; u.bh=v>>3; u.qb=(k==0)?s:(k==1)?15-s:(k==2)?16+s:31-s; return true; }
  __device__ __forceinline__ void a_ready(const AttnUnit&)const{}
  __device__ __forceinline__ void done(const AttnUnit&)const{}
};
template<class Sched,int THRL=8> __device__ __forceinline__ void attn_phase(char*lds,const AttnTensors&T,const Sched&S){
  AttnUnit u;
  for(int i=0;S.next(i,u);++i){ S.a_ready(u); attn_unit<THRL>(u.bh/NHEAD,u.bh%NHEAD,u.qb,T.Q,T.K,T.V,T.O,T.MASK,lds); S.done(u); }
}
#undef SBAR
#undef WAIT_BAR
}

#ifndef MK_EN
#define MK_EN 0x3ff
#endif
#define EN(n) (((MK_EN) >> (n)) & 1)
#ifndef MK_NAIVE_SELECT
#define MK_NAIVE_SELECT 0
#endif
#ifndef MK_NAIVE_ATTN
#define MK_NAIVE_ATTN 0
#endif
#ifndef MK_DUP
#define MK_DUP 0
#endif
#ifndef MK_REPN
#define MK_REPN 1
#endif
#define REP(n) for (int rep_ = 0; rep_ < 1 + MK_REPN * (((MK_DUP) >> (n)) & 1); ++rep_)
#ifndef MK_ONE_LAUNCH
#define MK_ONE_LAUNCH 1
#endif
__device__ __forceinline__ bool static_unit(int nM, int nN, int G, int c, int i, int& pm, int& pn) {
    const int nwg = nM * nN; const long L = (long)i * G + c; if (L >= nwg) return false;
    int wgid = (int)L; { const int q = nwg / 8, r = nwg % 8, xcd = wgid % 8, off = wgid / 8; wgid = (xcd < r ? xcd * (q + 1) : r * (q + 1) + (xcd - r) * q) + off; }
    const int nig = 8 * nN, gid = wgid / nig, fm = gid * 8, gsz = (nM - fm) < 8 ? (nM - fm) : 8;
    pm = fm + ((wgid % nig) % gsz); pn = (wgid % nig) / gsz; return true;
}
__global__ void __launch_bounds__(NWAVES * 64, 2) mk_fwd(Args args) {
    extern __shared__ __attribute__((aligned(16))) unsigned char lds[];
    Frame F;
    F.lds = (LAS unsigned char*)lds; F.MISC = (volatile LAS unsigned*)(F.lds + MISC_OFF);
    F.tid = threadIdx.x; F.lane = F.tid & 63; F.wave = __builtin_amdgcn_readfirstlane(F.tid >> 6);
    F.G = gridDim.x; { const int bx = blockIdx.x; F.vcu = (F.G % 8 == 0) ? (bx % 8) * (F.G / 8) + bx / 8 : bx; }
    KArgs A = (KArgs)__builtin_amdgcn_kernarg_segment_ptr();
    unsigned char* ws = A->ws; F.ws = ws; F.ctl = (gu32*)(ws + WS_CTL);
#define PHASE_BEGIN() do { int t_ = threadIdx.x; asm volatile("" : "+v"(t_)); F.tid = t_; F.lane = t_ & 63; F.wave = __builtin_amdgcn_readfirstlane(t_ >> 6); \
        A = (KArgs)__builtin_amdgcn_kernarg_segment_ptr(); asm volatile("" : "+s"(A)); ws = A->ws; F.ws = ws; F.ctl = (gu32*)(ws + WS_CTL); } while (0)
    for (int u = F.tid; u < (LDS_BYTES - LDSCTL_OFF) / 4; u += NWAVES * 64) ((LAS unsigned*)(F.lds + LDSCTL_OFF))[u] = 0u;
    __syncthreads();
    const int lo = A->ph_lo, hi = A->ph_hi;
    XcdBarrier bar; bar.bar = (unsigned*)(F.ctl + CW_BAR); bar.x = 0; bar.st = nullptr;
    if (hi - lo > 1) bar = xcd_barrier_post((unsigned*)(F.ctl + CW_BAR), F.MISC + 8);
#define IN(k) (lo <= (k) && (k) < hi)
#define SEAM(k) do { if (IN(k) && IN((k) + 1)) xcd_barrier(bar); } while (0)
#define X ((bf16*)(ws + WS_X))
#define SSV(k) ((float*)(ws + WS_SS + (size_t)((k) & 1) * SS_STAGE))

    if (EN(0) && IN(0)) { PHASE_BEGIN(); REP(0) p0_prologue(F, A); SEAM(0); }
    for (int l = 0; l < DEPTH; ++l) {
        const int pb = 2 + 11 * l;
#define FFN_UP(PH, WGU, SSIN) if (EN(2) && IN(PH)) { PHASE_BEGIN(); unsigned char* wl = ws + WS_W + (size_t)l * W_LAYER; \
            pg8::Gemm g{X, (const bf16*)(wl + (WGU)), M, NGU, D}; pg8::StaticOrder S; S.init(M, NGU, F.G, (int)blockIdx.x); \
            pg8::EpiSwiGLU E{(bf16*)(ws + WS_H), SSV(SSIN)}; \
            REP(2) pg8::gemm_phase<pg8::EpiSwiGLU, pg8::StaticOrder, true, true>(F.lds + RING_OFF, g, S, E); SEAM(PH); }
#define GEMM_RES(PH, A, W, KK, SSOUT, SCALE, F8, WX8, AB) if (EN(3) && IN(PH)) { PHASE_BEGIN(); unsigned char* wl = ws + WS_W + (size_t)l * W_LAYER; \
            pg8::Gemm g{(const bf16*)(A), (const bf16*)(wl + (W)), M, D, (KK)}; pg8::StaticOrder S; S.init(M, D, F.G, (int)blockIdx.x); \
            REP(3) { const pg8::EpiRes<WX8> E{X, SSV(SSOUT), rep_ ? 0.f : (SCALE)}; pg8::gemm_phase<pg8::EpiRes<WX8>, pg8::StaticOrder, true, true, F8, AB>(F.lds + RING_OFF, g, S, E); } SEAM(PH); }
        FFN_UP(pb + 0, WO_GU1, 4 * l)
        GEMM_RES(pb + 1, ws + WS_H, WO_D1, FF / 2, 4 * l + 1, 0.5f / 64.f, true, false, true)
        if (EN(4) && IN(pb + 2)) { PHASE_BEGIN(); unsigned char* wl = ws + WS_W + (size_t)l * W_LAYER;
            pg8::Gemm g{(const bf16*)ws, (const bf16*)ws, M, NINP, D}; const pg8::WinKVOrder S{F.G, (int)blockIdx.x, (int)((WS_W + (size_t)l * W_LAYER + WO_IN) >> 19), l == 0 ? 64 : 0};
            const pg8::EpiWinKV E{ws, SSV(4 * l + 1), QSCALE, (int)((WS_W + (size_t)l * W_LAYER + WO_IN) >> 19)};
            REP(4) pg8::gemm_phase<pg8::EpiWinKV, pg8::WinKVOrder, true, true>(F.lds + RING_OFF, g, S, E); SEAM(pb + 2);
        }
        if (EN(5) && IN(pb + 3)) { PHASE_BEGIN(); REP(5) {
            REP(10) for (int u = F.vcu; u < M / 64; u += F.G) conv_a_unit(F, (const bf16*)(ws + WS_HG), (bf16*)(ws + WS_MIX), INF(A, I_CONF_DW) + l * 31 * 256, INF(A, I_CONF_DW_B) + l * 256, INF(A, I_CONF_LN_G) + l * 256, INF(A, I_CONF_LN_B) + l * 256, u);
            REP(11) conv_b_all(F, (const bf16*)(ws + WS_U), (const bf16*)(ws + WS_BG), (bf16*)(ws + WS_MIX), INF(A, I_SC_DW) + l * 3 * 256);
#if !MK_NAIVE_SELECT
            for (int u = F.tid; u < 32 * IX_HS + 192; u += NWAVES * 64) ((LAS unsigned*)(F.lds + RING_OFF))[u] = 0u;
            __syncthreads();
            for (int u = F.vcu; u < 1024; u += F.G) { int b, j; idx_unit_of(u, b, j); idx_unit(F, (const bf16*)(ws + WS_QI), (const bf16*)(ws + WS_KI), (const float*)(ws + WS_WI), (unsigned*)(ws + (l ? WS_MASK1 : WS_MASK)), b, j); }
#endif
            }
            SEAM(pb + 3);
        }
        if (EN(6) && IN(pb + 4)) { PHASE_BEGIN();
#if MK_NAIVE_SELECT
            for (int q = F.vcu; q < M; q += F.G) dsa_naive_query<false>(F, (const bf16*)(ws + WS_Q), (const bf16*)(ws + WS_K), (const bf16*)(ws + WS_V), (const bf16*)(ws + WS_QI), (const bf16*)(ws + WS_KI), (const float*)(ws + WS_WI), nullptr, (bf16*)(ws + WS_MIX), q);
#elif MK_NAIVE_ATTN
            for (int q = F.vcu; q < M; q += F.G) dsa_naive_query<true>(F, (const bf16*)(ws + WS_Q), (const bf16*)(ws + WS_K), (const bf16*)(ws + WS_V), (const bf16*)(ws + WS_QI), (const bf16*)(ws + WS_KI), (const float*)(ws + WS_WI), (const unsigned long long*)(ws + (l ? WS_MASK1 : WS_MASK)), (bf16*)(ws + WS_MIX), q);
#else
            { const attn_body::AttnTensors AT{(const attn_body::bf16*)(ws + WS_Q), (const attn_body::bf16*)(ws + WS_K), (const attn_body::bf16*)(ws + WS_V), (attn_body::bf16*)(ws + WS_MIX) + 512, (const unsigned*)(ws + (l ? WS_MASK1 : WS_MASK))};
              const attn_body::StaticOrder S((int)F.G, (int)blockIdx.x);
              REP(6) attn_body::attn_phase<attn_body::StaticOrder>((char*)lds + RING_OFF, AT, S); }
#endif
            SEAM(pb + 4);
        }
        GEMM_RES(pb + 5, ws + WS_MIX, WO_OUT, D, 4 * l + 2, 1.0f, false, true, false)
        if (EN(7) && IN(pb + 6)) { PHASE_BEGIN(); unsigned char* wl = ws + WS_W + (size_t)l * W_LAYER;
            pg8::Gemm g{(const bf16*)(ws + WS_X8), (const bf16*)(wl + WO_Q), M, D, D / 2}; pg8::StaticOrder S; S.init(M, D, F.G, (int)blockIdx.x);
            pg8::EpiRowScale E{(bf16*)(ws + WS_XQ), D, SSV(4 * l + 2), XQSCALE / 64.f};
            REP(7) pg8::gemm_phase<pg8::EpiRowScale, pg8::StaticOrder, true, true, true>(F.lds + RING_OFF, g, S, E);
            if (EN(8)) { PHASE_BEGIN(); for (int i = 0;; ++i) { int upm, upn; if (!static_unit(M / 256, D / 256, F.G, (int)blockIdx.x, i, upm, upn)) break; xattn_unit(F, (const bf16*)(ws + WS_XQ), ws + WS_XO8, (const bf16*)(ws + WS_MEMK) + (size_t)l * 1024 * 1024, (const bf16*)(ws + WS_MEMVT) + (size_t)l * 1024 * 1024, upm, upn); } }
            SEAM(pb + 6);
        }
        GEMM_RES(pb + 8, ws + WS_XO8, WO_O, D / 2, 4 * l + 3, 1.0f / 64.f, true, false, false)
        FFN_UP(pb + 9, WO_GU2, 4 * l + 3)
        GEMM_RES(pb + 10, ws + WS_H, WO_D2, FF / 2, 4 * l + 4, 0.5f / 64.f, true, false, true)
    }
    if (EN(9) && IN(NPH - 1)) { PHASE_BEGIN(); final_norm_all(F, X, SSV(4 * DEPTH), INF(A, I_FINAL_NORM), A->out); }
#undef IN
#undef SEAM
#undef X
#undef SSV
}

extern "C" void kernel_launch(void* const* d_in, const int* in_sizes, int n_in, void* d_out, int out_size, void* d_ws, size_t ws_size, hipStream_t stream) {
    static int grid = 0;
    if (grid == 0) {
        if (n_in != 25 || in_sizes[0] != M * D || out_size != M * D || ws_size < WS_END) { fprintf(stderr, "kernel_launch: unexpected shapes (n_in %d, in0 %d, out %d, ws %zu); nothing launched\n", n_in, n_in > 0 ? in_sizes[0] : -1, out_size, ws_size); grid = -1; return; }
        int dev = 0, cus = 0, per_cu = 0;
        if (hipGetDevice(&dev) != hipSuccess || hipDeviceGetAttribute(&cus, hipDeviceAttributeMultiprocessorCount, dev) != hipSuccess) { grid = -1; return; }
        if (hipFuncSetAttribute((const void*)mk_fwd, hipFuncAttributeMaxDynamicSharedMemorySize, LDS_BYTES) != hipSuccess) { fprintf(stderr, "kernel_launch: hipFuncSetAttribute failed\n"); grid = -1; return; }
        if (hipOccupancyMaxActiveBlocksPerMultiprocessor(&per_cu, (const void*)mk_fwd, NWAVES * 64, LDS_BYTES) != hipSuccess || per_cu < 1) { fprintf(stderr, "kernel_launch: occupancy query reports %d\n", per_cu); }
        (void)hipGetLastError();
        grid = cus;
    }
    if (grid < 0) return;
    if (hipMemsetAsync((char*)d_ws + WS_CTL, 0, CTL_ZERO_BYTES, stream) != hipSuccess) return;
    Args a{};
    for (int i = 0; i < 25; ++i) a.in[i] = d_in[i];
    a.out = (float*)d_out; a.ws = (unsigned char*)d_ws;
    for (int i = 0; i < 32; ++i) a.invf[i] = powf(10000.0f, -(float)(2 * i) / 64.0f);
#if MK_ONE_LAUNCH
    a.ph_lo = 0; a.ph_hi = NPH;
    hipLaunchKernelGGL(mk_fwd, dim3(grid), dim3(NWAVES * 64), LDS_BYTES, stream, a);
#else
    for (int p = 0; p < NPH; ++p) { a.ph_lo = p; a.ph_hi = p + 1; hipLaunchKernelGGL(mk_fwd, dim3(grid), dim3(NWAVES * 64), LDS_BYTES, stream, a); }
#endif
}
```

```cpp
#include <hip/hip_runtime.h>
#include <cstdio>
#include <cstdint>
#include <cmath>
constexpr int NWAVES = 8;
constexpr int M = 32768, D = 1024, FF = 2816, SEQ = 8192, NBATCH = 4, DEPTH = 2, NGU = 2 * FF  , NINP = 3328  , NIN = 3140;
constexpr int GU8_LAYER = 1;
constexpr int NPH = 2 + 11 * DEPTH + 1;
constexpr float QSCALE = 0.125f * 1.4426950408889634f;
constexpr float XQSCALE = 0.0625f * 1.4426950408889634f;
constexpr float IDX_SCALE = 0.5f * 0.125f;
constexpr size_t MiB = 1u << 20;
constexpr size_t WS_CTL = 0, CTL_ZERO_BYTES = 1 * MiB;
constexpr size_t WS_SS = 448 * MiB, SS_STAGE = 2 * MiB;
constexpr size_t WS_MSS = 3 * MiB;
constexpr size_t WS_COS = 4 * MiB, WS_SIN = 8 * MiB;
constexpr size_t WS_MK = 12 * MiB;
constexpr size_t WS_MEMK = 22 * MiB, WS_MEMVT = 26 * MiB;
constexpr size_t WS_W = 30 * MiB, W_LAYER = 45 * MiB + MiB / 2;
constexpr size_t WO_GU1 = 0, WO_D1 = 11 * MiB, WO_IN = WO_D1 + 5 * MiB + MiB / 2, WO_OUT = WO_IN + 6 * MiB + MiB / 2, WO_Q = WO_OUT + 2 * MiB, WO_O = WO_Q + 2 * MiB, WO_GU2 = WO_O + 2 * MiB, WO_D2 = WO_GU2 + 11 * MiB;
static_assert(WO_D2 + 5 * MiB + MiB / 2 == W_LAYER, "weight map");
constexpr size_t WS_X = 122 * MiB;
constexpr size_t WS_R = 186 * MiB;
constexpr size_t WS_H = WS_R;
constexpr size_t WS_HG = WS_R, WS_U = WS_R + 16 * MiB, WS_BG = WS_R + 32 * MiB, WS_Q = WS_R + 48 * MiB, WS_K = WS_R + 80 * MiB, WS_V = WS_R + 112 * MiB, WS_QI = WS_R + 144 * MiB,
                 WS_KI = WS_R + 160 * MiB, WS_WI = WS_R + 164 * MiB, WS_MIX = WS_R + 165 * MiB, WS_MASK = WS_R + 229 * MiB, WS_MIXEND = WS_R + 261 * MiB;
constexpr size_t WS_XQ = WS_R;
constexpr size_t WS_X8 = WS_R + 96 * MiB;
constexpr size_t WS_XO8 = WS_R + 64 * MiB;
constexpr size_t WS_MASK1 = 452 * MiB;
constexpr size_t WS_END = 484 * MiB;
static_assert(WS_W + 2 * W_LAYER <= WS_X && WS_X + (size_t)M * D * 2 <= WS_R && WS_H + (size_t)M * FF * 2 <= WS_END && WS_MIXEND <= WS_END, "d_ws map");
constexpr int CW_TMO = 0, CW_BAR = 4096;
constexpr int RING_OFF = 0, RING_BYTES = 131072, LDSCTL_OFF = 143360, MISC_OFF = LDSCTL_OFF + 320, LDS_BYTES = 147456;

namespace pg8 {
#define PG8_LAS __attribute__((address_space(3)))
typedef unsigned short bf16_t;
typedef short bf16x8 __attribute__((ext_vector_type(8)));
typedef float f32x4 __attribute__((ext_vector_type(4)));
typedef unsigned u32x4 __attribute__((ext_vector_type(4)));
constexpr int BM = 256, BK = 64, HALF = 128, HTB = HALF * BK * 2  , STAGE_BYTES = 8 * HTB, NXCD = 8, WGM = 8;

__host__ __device__ __forceinline__ int lds_byte(int r, int c) { const int st = (r >> 4) * 2 + (c >> 5), rr = r & 15, cc = c & 31, ob = rr * 64 + cc * 2; return st * 1024 + (ob ^ (((ob >> 9) & 1) << 5)); }
__host__ __device__ __forceinline__ void stage_rc(int b, int& R, int& C) { const int st = b / 1024, sb = b % 1024, swz = sb ^ (((sb >> 9) & 1) << 5); R = (st >> 1) * 16 + swz / 64; C = (st & 1) * 32 + (swz % 64) / 2; }
__host__ __device__ __forceinline__ int perm32(int rho) { const int n = rho >> 4, i = rho & 15; return 8 * (i >> 2) + 4 * n + (i & 3); }

struct Unit { int pm, pn; };
struct Gemm { const bf16_t* A; const bf16_t* Bt; int M, N, K; };

struct StaticOrder {
    int nM, nN, nwg, G, c;
    __host__ __device__ void init(int M, int N, int G_, int c_) { nM = M / BM; nN = N / BM; nwg = nM * nN; G = G_; c = c_; }
    __host__ __device__ bool next(int i, Unit& u) const {
        const long L = (long)i * G + c; if (L >= nwg) return false;
        int wgid = (int)L; { const int q = nwg / NXCD, r = nwg % NXCD, xcd = wgid % NXCD, off = wgid / NXCD; wgid = (xcd < r ? xcd * (q + 1) : r * (q + 1) + (xcd - r) * q) + off; }
        const int nig = WGM * nN, gid = wgid / nig, fm = gid * WGM, gsz = (nM - fm) < WGM ? (nM - fm) : WGM;
        u.pm = fm + ((wgid % nig) % gsz); u.pn = (wgid % nig) / gsz; return true;
    }
    __device__ __forceinline__ void a_ready(const Unit&) const {}
    __device__ __forceinline__ void done(const Unit&) const {}
};
__device__ __forceinline__ unsigned cvt_pk_bf16(float lo, float hi) { unsigned r; asm volatile("v_cvt_pk_bf16_f32 %0, %1, %2" : "=v"(r) : "v"(lo), "v"(hi)); return r; }
typedef float f32x2 __attribute__((ext_vector_type(2)));
typedef unsigned u32x2 __attribute__((ext_vector_type(2)));
__device__ __forceinline__ float bflo(unsigned w) { return __uint_as_float(w << 16); }
__device__ __forceinline__ float bfhi(unsigned w) { return __uint_as_float(w & 0xffff0000u); }
__device__ __forceinline__ float sigm(float x) { return __builtin_amdgcn_rcpf(1.f + __builtin_amdgcn_exp2f(-1.4426950408889634f * x)); }
__device__ __forceinline__ u32x4 pack8(const f32x4 a, const f32x4 b) { u32x4 w; w.x = cvt_pk_bf16(a[0], a[1]); w.y = cvt_pk_bf16(a[2], a[3]); w.z = cvt_pk_bf16(b[0], b[1]); w.w = cvt_pk_bf16(b[2], b[3]); return w; }
__device__ __forceinline__ float sumsq_of(const float* ss, int row) { const f32x4* p = (const f32x4*)(ss + (size_t)row * 16); const f32x4 a = p[0], b = p[1], c = p[2], d = p[3];
    return (((a[0] + a[1]) + (a[2] + a[3])) + ((b[0] + b[1]) + (b[2] + b[3]))) + (((c[0] + c[1]) + (c[2] + c[3])) + ((d[0] + d[1]) + (d[2] + d[3]))); }
__device__ __forceinline__ float rstd_of(const float* ss, int row) { return __builtin_amdgcn_rsqf(sumsq_of(ss, row) * (1.f / 1024.f) + 1e-6f); }
__device__ __forceinline__ float rstd_of4(const float* ss, int row, int fq) { const f32x4 a = *(const f32x4*)(ss + (size_t)row * 16 + fq * 4); float s = (a[0] + a[1]) + (a[2] + a[3]);
    s += __shfl_xor(s, 16); s += __shfl_xor(s, 32); return __builtin_amdgcn_rsqf(s * (1.f / 1024.f) + 1e-6f); }
__device__ __forceinline__ f32x4 rstd_ld4(const float* ss, int row, int fq) { return *(const f32x4*)(ss + (size_t)row * 16 + fq * 4); }
__device__ __forceinline__ float rstd_fin4(const f32x4 a) { float s = (a[0] + a[1]) + (a[2] + a[3]); s += __shfl_xor(s, 16); s += __shfl_xor(s, 32); return __builtin_amdgcn_rsqf(s * (1.f / 1024.f) + 1e-6f); }
__device__ __forceinline__ float rstd_of1(const float* ss, int row) { return __builtin_amdgcn_rsqf(ss[row] * (1.f / 1024.f) + 1e-6f); }
constexpr int FFH = 2816;

struct EpiSwiGLU {
    static constexpr bool PERM = true, AFTER_DRAIN = false;
    bf16_t* H; const float* ss; float sc;
    __device__ __forceinline__ void operator()(const f32x4 (&acc)[2][2][4][2], const Unit& u, int wr, int wc, int fr, int fq) const {
        asm volatile("" : "+v"(fr), "+v"(fq));
        const int row0 = u.pm * BM + wr * 64 + fr;
        unsigned char* const hb = (unsigned char*)H + (size_t)(u.pm * (FFH / 128) + u.pn) * 32768 + (((wr * 4 + wc) * 8) * 64 + (fq >> 1) * 32 + fr * 2 + (fq & 1)) * 8;
        f32x4 pa[2][4];
#pragma unroll
        for (int ai = 0; ai < 2; ++ai)
#pragma unroll
            for (int m = 0; m < 4; ++m) pa[ai][m] = rstd_ld4(ss, row0 + ai * HALF + m * 16, fq);
#pragma unroll
        for (int ai = 0; ai < 2; ++ai)
#pragma unroll
            for (int m = 0; m < 4; ++m) { const float rs = rstd_fin4(pa[ai][m]) * sc;
                const float rsl = rs * 1.4426950408889634f, rsu = rs * 0.6931471805599453f;
                f32x4 h0, h1;
#pragma unroll
                for (int n = 0; n < 2; ++n) { const f32x4 G = acc[ai][0][m][n], U = acc[ai][1][m][n]; f32x4 hv;
#pragma unroll
                    for (int q = 0; q < 2; ++q) { const f32x2 g2 = (f32x2){G[2 * q], G[2 * q + 1]} * rsl, u2 = (f32x2){U[2 * q], U[2 * q + 1]} * rsu;
                        f32x2 r2; r2.x = __builtin_amdgcn_rcpf(1.f + __builtin_amdgcn_exp2f(-g2.x)); r2.y = __builtin_amdgcn_rcpf(1.f + __builtin_amdgcn_exp2f(-g2.y));
                        const f32x2 o2 = g2 * u2 * r2; hv[2 * q] = o2.x; hv[2 * q + 1] = o2.y; }
                    if (n == 0) h0 = hv; else h1 = hv; }
                unsigned w0 = 0u, w1 = 0u;
                w0 = __builtin_amdgcn_cvt_pk_fp8_f32(h0[0], h0[1], w0, false); w0 = __builtin_amdgcn_cvt_pk_fp8_f32(h0[2], h0[3], w0, true); w1 = __builtin_amdgcn_cvt_pk_fp8_f32(h1[0], h1[1], w1, false); w1 = __builtin_amdgcn_cvt_pk_fp8_f32(h1[2], h1[3], w1, true);
                *(u32x2*)(hb + (ai * 4 + m) * 512) = (u32x2){w0, w1}; asm volatile("" ::: "memory"); }
    }
};
template <bool WX8> struct EpiRes {
    static constexpr bool PERM = true, AFTER_DRAIN = false;
    bf16_t* X; float* ssn; float scale;
    __device__ __forceinline__ void operator()(const f32x4 (&acc)[2][2][4][2], const Unit& u, int wr, int wc, int fr, int fq) const {
        asm volatile("" : "+v"(fr), "+v"(fq));
        const int row0 = u.pm * BM + wr * 64 + fr, col0 = u.pn * BM + wc * 32 + fq * 8;
        u32x4 xcur[2][2], xnxt[2][2];
#pragma unroll
        for (int h2 = 0; h2 < 2; ++h2)
#pragma unroll
            for (int bj = 0; bj < 2; ++bj) xcur[h2][bj] = *(const u32x4*)(X + (size_t)(row0 + h2 * 16) * 1024 + col0 + bj * HALF);
#pragma unroll
        for (int q = 0; q < 8; ++q) { const int ai = q >> 2, m = q & 3; const int row = row0 + ai * HALF + m * 16; float s = 0.f;
            if ((q & 1) == 0 && q + 2 < 8) {
#pragma unroll
                for (int h2 = 0; h2 < 2; ++h2)
#pragma unroll
                    for (int bj = 0; bj < 2; ++bj) { const int qn = q + 2 + h2; xnxt[h2][bj] = *(const u32x4*)(X + (size_t)(row0 + (qn >> 2) * HALF + (qn & 3) * 16) * 1024 + col0 + bj * HALF); } }
#pragma unroll
                for (int bj = 0; bj < 2; ++bj) { bf16_t* p = X + (size_t)row * 1024 + col0 + bj * HALF; const u32x4 xv = xcur[q & 1][bj];
                    f32x4 a = acc[ai][bj][m][0] * scale, b = acc[ai][bj][m][1] * scale;
                    a[0] += bflo(xv.x); a[1] += bfhi(xv.x); a[2] += bflo(xv.y); a[3] += bfhi(xv.y); b[0] += bflo(xv.z); b[1] += bfhi(xv.z); b[2] += bflo(xv.w); b[3] += bfhi(xv.w);
                    const u32x4 w = pack8(a, b); *(u32x4*)p = w;
                    if constexpr (WX8) { unsigned q0 = 0u, q1 = 0u; q0 = __builtin_amdgcn_cvt_pk_fp8_f32(bflo(w.x), bfhi(w.x), q0, false); q0 = __builtin_amdgcn_cvt_pk_fp8_f32(bflo(w.y), bfhi(w.y), q0, true); q1 = __builtin_amdgcn_cvt_pk_fp8_f32(bflo(w.z), bfhi(w.z), q1, false); q1 = __builtin_amdgcn_cvt_pk_fp8_f32(bflo(w.w), bfhi(w.w), q1, true);
                        *(u32x2*)((unsigned char*)X + (WS_X8 - WS_X) + (size_t)row * 1024 + col0 + bj * HALF) = (u32x2){q0, q1}; }
                    s += (bflo(w.x) * bflo(w.x) + bfhi(w.x) * bfhi(w.x)) + (bflo(w.y) * bflo(w.y) + bfhi(w.y) * bfhi(w.y)) + (bflo(w.z) * bflo(w.z) + bfhi(w.z) * bfhi(w.z)) + (bflo(w.w) * bflo(w.w) + bfhi(w.w) * bfhi(w.w)); }
                s += __shfl_xor(s, 16); s += __shfl_xor(s, 32);
                if (fq == 0) ssn[(size_t)row * 16 + u.pn * 4 + wc] = s;
            if (q & 1) { asm volatile("" ::: "memory");
#pragma unroll
                for (int h2 = 0; h2 < 2; ++h2)
#pragma unroll
                    for (int bj = 0; bj < 2; ++bj) xcur[h2][bj] = xnxt[h2][bj]; } }
    }
};
struct EpiRowScale {
    static constexpr bool PERM = true, AFTER_DRAIN = false;
    bf16_t* O; int ldc; const float* ss; float scale;
    __device__ __forceinline__ void operator()(const f32x4 (&acc)[2][2][4][2], const Unit& u, int wr, int wc, int fr, int fq) const {
        asm volatile("" : "+v"(fr), "+v"(fq));
        const int row0 = u.pm * BM + wr * 64 + fr, col0 = u.pn * BM + wc * 32 + fq * 8;
#pragma unroll
        for (int ai = 0; ai < 2; ++ai)
#pragma unroll
            for (int m = 0; m < 4; ++m) { const int row = row0 + ai * HALF + m * 16; const float rs = rstd_of4(ss, row, fq) * scale;
#pragma unroll
                for (int bj = 0; bj < 2; ++bj) *(u32x4*)(O + (size_t)row * ldc + col0 + bj * HALF) = pack8(acc[ai][bj][m][0] * rs, acc[ai][bj][m][1] * rs); asm volatile("" ::: "memory"); }
    }
};
struct EpiWin {
    static constexpr bool PERM = true, AFTER_DRAIN = false;
    unsigned char* ws; const float* ss; float qscale;
    __device__ __forceinline__ void operator()(const f32x4 (&acc)[2][2][4][2], const Unit& u, int wr, int wc, int fr, int fq) const {
        asm volatile("" : "+v"(fr), "+v"(fq));
        const int row0 = u.pm * BM + wr * 64 + fr, t = u.pn, c8 = wc * 32 + fq * 8;
        bf16_t* const HG = (bf16_t*)(ws + WS_HG); bf16_t* const U = (bf16_t*)(ws + WS_U); bf16_t* const BG = (bf16_t*)(ws + WS_BG); bf16_t* const Q = (bf16_t*)(ws + WS_Q); bf16_t* const K = (bf16_t*)(ws + WS_K);
        bf16_t* const V = (bf16_t*)(ws + WS_V); bf16_t* const QI = (bf16_t*)(ws + WS_QI); bf16_t* const KI = (bf16_t*)(ws + WS_KI); float* const WI = (float*)(ws + WS_WI); const float* const cs = (const float*)(ws + WS_COS); const float* const sn = (const float*)(ws + WS_SIN);
        float rsv[8];
        { f32x4 pa[8];
#pragma unroll
          for (int q = 0; q < 8; ++q) pa[q] = rstd_ld4(ss, row0 + (q >> 2) * HALF + (q & 3) * 16, fq);
#pragma unroll
          for (int q = 0; q < 8; ++q) rsv[q] = rstd_fin4(pa[q]); }
        asm volatile("" ::: "memory");
        if (t < 5 || t == 9 || t == 10) {
#pragma unroll
            for (int q = 0; q < 8; ++q) { const int ai = q >> 2, m = q & 3; const int row = row0 + ai * HALF + m * 16; const float rs = rsv[q];
                const f32x4 a0 = acc[ai][0][m][0] * rs, a1 = acc[ai][0][m][1] * rs, b0 = acc[ai][1][m][0] * rs, b1 = acc[ai][1][m][1] * rs;
                if (t < 2) { f32x4 o0, o1;
#pragma unroll
                    for (int j = 0; j < 4; ++j) { o0[j] = a0[j] * sigm(b0[j]); o1[j] = a1[j] * sigm(b1[j]); }
                    *(u32x4*)(HG + (size_t)row * 256 + t * 128 + c8) = pack8(o0, o1); }
                else if (t < 4) { *(u32x4*)(U + (size_t)row * 256 + (t - 2) * 128 + c8) = pack8(a0 * b0, a1 * b1); }
                else if (t == 4) { *(u32x4*)(BG + (size_t)row * 256 + c8) = pack8(a0, a1); *(u32x4*)(BG + (size_t)row * 256 + 128 + c8) = pack8(b0, b1); }
                else { *(u32x4*)(V + (size_t)row * 512 + (t - 9) * 256 + c8) = pack8(a0, a1); *(u32x4*)(V + (size_t)row * 512 + (t - 9) * 256 + 128 + c8) = pack8(b0, b1); }
                asm volatile("" ::: "memory"); }
        } else {
            f32x4 cc[4], cn[4];
            { const size_t o = (size_t)row0 * 32 + fq * 8; cc[0] = *(const f32x4*)(cs + o); cc[1] = *(const f32x4*)(cs + o + 4); cc[2] = *(const f32x4*)(sn + o); cc[3] = *(const f32x4*)(sn + o + 4); }
#pragma unroll
            for (int q = 0; q < 8; ++q) { const int ai = q >> 2, m = q & 3; const int row = row0 + ai * HALF + m * 16; const float rs = rsv[q];
                if (q + 1 < 8) { const size_t o = (size_t)(row0 + ((q + 1) >> 2) * HALF + ((q + 1) & 3) * 16) * 32 + fq * 8; cn[0] = *(const f32x4*)(cs + o); cn[1] = *(const f32x4*)(cs + o + 4); cn[2] = *(const f32x4*)(sn + o); cn[3] = *(const f32x4*)(sn + o + 4); }
                const f32x4 a0 = acc[ai][0][m][0] * rs, a1 = acc[ai][0][m][1] * rs, b0 = acc[ai][1][m][0] * rs, b1 = acc[ai][1][m][1] * rs;
                const f32x4 c0 = cc[0], c1 = cc[1], s0 = cc[2], s1 = cc[3];
                f32x4 p0 = a0 * c0 - b0 * s0, p1 = a1 * c1 - b1 * s1, r0 = b0 * c0 + a0 * s0, r1 = b1 * c1 + a1 * s1;
                if (t < 7) { bf16_t* d = Q + (size_t)row * 512 + ((t - 5) * 4 + wc) * 64 + fq * 8; *(u32x4*)d = pack8(p0 * qscale, p1 * qscale); *(u32x4*)(d + 32) = pack8(r0 * qscale, r1 * qscale); }
                else if (t < 9) { bf16_t* d = K + (size_t)row * 512 + ((t - 7) * 4 + wc) * 64 + fq * 8; *(u32x4*)d = pack8(p0, p1); *(u32x4*)(d + 32) = pack8(r0, r1); }
                else if (t == 11) { bf16_t* d = QI + (size_t)row * 256 + wc * 64 + fq * 8; *(u32x4*)d = pack8(p0, p1); *(u32x4*)(d + 32) = pack8(r0, r1); }
                else { if (wc == 0) { bf16_t* d = KI + ((((size_t)(row >> 5) * 4 + (fq >> 1)) * 64 + (fq & 1) * 32 + (row & 31)) << 3); *(u32x4*)d = pack8(p0, p1); *(u32x4*)(d + 1024) = pack8(r0, r1); }
                       if (wc == 1 && fq == 0) *(f32x4*)(WI + (size_t)row * 4) = b0; }
                asm volatile("" ::: "memory");
#pragma unroll
                for (int i = 0; i < 4; ++i) cc[i] = cn[i]; }
        }
    }
};
struct EpiMemKV {
    static constexpr bool PERM = true, AFTER_DRAIN = false;
    bf16_t *MEMK, *MEMVT; const float* mss;
    __device__ __forceinline__ void operator()(const f32x4 (&acc)[2][2][4][2], const Unit& u, int wr, int wc, int fr, int fq) const {
        asm volatile("" : "+v"(fr), "+v"(fq));
        const bool isv = u.pm >= 4; const int l = isv ? ((u.pm - 8) >> 3) : ((u.pn - 4) >> 3);
        const int pr = isv ? ((u.pm - 8) & 7) : u.pm, pc = isv ? u.pn : ((u.pn - 4) & 7);
        bf16_t* O = (isv ? MEMVT : MEMK) + (size_t)l * 1024 * 1024;
        const int row0 = pr * BM + wr * 64 + fr, col0 = pc * BM + wc * 32 + fq * 8;
#pragma unroll
        for (int ai = 0; ai < 2; ++ai)
#pragma unroll
            for (int m = 0; m < 4; ++m) { const int row = row0 + ai * HALF + m * 16; const float rsr = isv ? 1.f : rstd_of1(mss, row);
#pragma unroll
                for (int bj = 0; bj < 2; ++bj) { f32x4 a = acc[ai][bj][m][0] * rsr, b = acc[ai][bj][m][1] * rsr;
                    if (isv) {
#pragma unroll
                        for (int j = 0; j < 4; ++j) { a[j] *= rstd_of1(mss, col0 + bj * HALF + j); b[j] *= rstd_of1(mss, col0 + bj * HALF + 4 + j); } }
                    *(u32x4*)(O + (size_t)row * 1024 + col0 + bj * HALF) = pack8(a, b); } asm volatile("" ::: "memory"); }
    }
};
struct MemKVOrder {
    int G, c;
    __device__ __forceinline__ bool next(int i, Unit& u) const {
        const int L = i * G + c; if (L >= 64) return false;
        const int ty = L >> 4, a = (L >> 2) & 3, b = L & 3, l = ty & 1;
        if (ty < 2) { u.pm = a; u.pn = 4 + 8 * l + b; } else { u.pm = 8 + 8 * l + a; u.pn = b; }
        return true;
    }
    __device__ __forceinline__ void a_ready(const Unit&) const {}
    __device__ __forceinline__ void done(const Unit&) const {}
};

constexpr int TILE_X = (int)(WS_X >> 19), TILE_MK = (int)(WS_MK >> 19);
static_assert((WS_X & ((1u << 19) - 1)) == 0 && (WS_MK & ((1u << 19) - 1)) == 0 && ((WS_W + WO_IN) & ((1u << 19) - 1)) == 0 && (W_LAYER & ((1u << 19) - 1)) == 0, "tile-aligned operands");
struct WinKVOrder {
    int G, c, tin, nkv;
    __device__ __forceinline__ bool next(int i, Unit& u) const {
        const int nwin = 128 * 13; const long L0 = (long)i * G + c; if (L0 >= nwin + nkv) return false;
        int L = (int)L0;
        if (L < nwin) { int wgid = L; { const int q = nwin / 8, xcd = wgid % 8, off = wgid / 8; wgid = xcd * q + off; }
            const int nig = 8 * 13, gid = wgid / nig, fm = gid * 8; u.pm = TILE_X + fm + ((wgid % nig) % 8); u.pn = tin + (wgid % nig) / 8; return true; }
        L -= nwin; const int ty = L >> 4, a = (L >> 2) & 3, b = L & 3, l = ty & 1;
        if (ty < 2) { u.pm = TILE_MK + a; u.pn = TILE_MK + 4 + 8 * l + b; } else { u.pm = TILE_MK + 8 + 8 * l + a; u.pn = TILE_MK + b; }
        return true;
    }
    __device__ __forceinline__ void a_ready(const Unit&) const {}
    __device__ __forceinline__ void done(const Unit&) const {}
};
struct EpiWinKV {
    static constexpr bool PERM = true, AFTER_DRAIN = false;
    unsigned char* ws; const float* ss; float qscale; int tin;
    __device__ __forceinline__ void operator()(const f32x4 (&acc)[2][2][4][2], const Unit& u, int wr, int wc, int fr, int fq) const {
        if (u.pm >= TILE_X) { const EpiWin W{ws, ss, qscale}; const Unit v{u.pm - TILE_X, u.pn - tin}; W(acc, v, wr, wc, fr, fq); }
        else { const EpiMemKV KV{(bf16_t*)(ws + WS_MEMK), (bf16_t*)(ws + WS_MEMVT), (const float*)(ws + WS_MSS)}; const Unit v{u.pm - TILE_MK, u.pn - TILE_MK}; KV(acc, v, wr, wc, fr, fq); }
    }
};

template <class Epi, class Sched, bool ALIGN_EPI = false, bool SP2 = false, bool FP8 = false, bool ABLK = false>
__device__ __forceinline__ void gemm_phase(PG8_LAS unsigned char* lds, const Gemm g, const Sched& S, const Epi& E) {
    int tid_ = threadIdx.x; asm volatile("" : "+v"(tid_));
    const int tid = tid_, wid = __builtin_amdgcn_readfirstlane(tid >> 6), lane = tid & 63, wr = wid >> 2, wc = wid & 3, fr = lane & 15, fq = lane >> 4;
    const int K = g.K, nt = K / BK;
    unsigned voffA[2], voffB[2];
#pragma unroll
    for (int i = 0; i < 2; ++i) { int R, C; stage_rc(tid * 16 + i * 8192, R, C); const int Rb = Epi::PERM ? ((R & ~31) + perm32(R & 31)) : R;
        voffA[i] = ABLK ? (unsigned)(((((R >> 6) * 4 + (C >> 4)) * 8 + ((R >> 4) & 3)) * 64 + ((C >> 3) & 1) * 32 + (R & 15) * 2) * 8) : (unsigned)(R * K + C) * 2u; voffB[i] = (unsigned)(Rb * K + C) * 2u; }
    const size_t kstep = (size_t)(BK * 2);
    const size_t hstep = (size_t)HALF * K * 2;
    const size_t kstepA = ABLK ? (size_t)32768 : kstep, hstepA = ABLK ? (size_t)2048 : hstep;
    const size_t tstep = 2 * hstep;
    const unsigned ldsw = (unsigned)wid * 1024u;
    const int aoff = lds_byte(wr * 64 + fr, fq * 8), boff = lds_byte(wc * 32 + fr, fq * 8);
#define PG8_SA(b, h) (((b) * 2 + (h)) * HTB)
#define PG8_SB(b, h) ((4 + (b) * 2 + (h)) * HTB)
#define PG8_STAGE(bufoff, gbase, voff) do { _Pragma("unroll") for (int _i = 0; _i < 2; ++_i) \
        __builtin_amdgcn_global_load_lds((const unsigned*)((const char*)(gbase) + (voff)[_i]), (PG8_LAS unsigned*)(lds + (bufoff) + ldsw + _i * 8192), 16, 0, 0); } while (0)
#define PG8_LDA(dst, b, h) do { _Pragma("unroll") for (int m = 0; m < 4; ++m) _Pragma("unroll") for (int k = 0; k < 2; ++k) dst[m][k] = *(const PG8_LAS bf16x8*)(lds + PG8_SA(b, h) + aoff + m * 2048 + k * 1024); } while (0)
#define PG8_LDB(dst, b, h) do { _Pragma("unroll") for (int n = 0; n < 2; ++n) _Pragma("unroll") for (int k = 0; k < 2; ++k) dst[n][k] = *(const PG8_LAS bf16x8*)(lds + PG8_SB(b, h) + boff + n * 2048 + k * 1024); } while (0)
#define PG8_MMA(ai, bj, At, Bt) do { __builtin_amdgcn_s_setprio(1); _Pragma("unroll") for (int m = 0; m < 4; ++m) _Pragma("unroll") for (int n = 0; n < 2; ++n) { \
        if constexpr (FP8) { typedef int v4i_ __attribute__((ext_vector_type(4))); typedef int v8i_ __attribute__((ext_vector_type(8))); \
            const v8i_ b8 = __builtin_shufflevector(__builtin_bit_cast(v4i_, Bt[n][0]), __builtin_bit_cast(v4i_, Bt[n][1]), 0, 1, 2, 3, 4, 5, 6, 7), a8 = __builtin_shufflevector(__builtin_bit_cast(v4i_, At[m][0]), __builtin_bit_cast(v4i_, At[m][1]), 0, 1, 2, 3, 4, 5, 6, 7); \
            asm volatile("v_mfma_scale_f32_16x16x128_f8f6f4 %0, %1, %2, %0, %3, %3 op_sel_hi:[0,0,0]" : "+v"(acc[ai][bj][m][n]) : "v"(b8), "v"(a8), "v"(0x7f7f7f7f)); }   \
        else { _Pragma("unroll") for (int k = 0; k < 2; ++k) acc[ai][bj][m][n] = __builtin_amdgcn_mfma_f32_16x16x32_bf16(Bt[n][k], At[m][k], acc[ai][bj][m][n], 0, 0, 0); } } \
        __builtin_amdgcn_s_setprio(0); } while (0)
#define PG8_WAIT_V(n) asm volatile("s_waitcnt vmcnt(" #n ")" ::: "memory")
#define PG8_WAIT_V8_UNLESS_FIRST(t) asm volatile("s_cmp_eq_u32 %0, 0\n\ts_cbranch_scc1 .Lpg8skip%=\n\ts_waitcnt vmcnt(8)\n.Lpg8skip%=:" :: "s"(t) : "scc", "memory")
#define PG8_WAIT_L(n) asm volatile("s_waitcnt lgkmcnt(" #n ")" ::: "memory")
#define PG8_BAR __builtin_amdgcn_s_barrier()
#define PG8_SCHED __builtin_amdgcn_sched_barrier(0)
    Unit cur, nxt; int ui = 0;
    if (!S.next(0, cur)) return;
    f32x4 acc[2][2][4][2];
#pragma unroll
    for (int a = 0; a < 2; ++a)
#pragma unroll
        for (int b = 0; b < 2; ++b)
#pragma unroll
            for (int m = 0; m < 4; ++m)
#pragma unroll
                for (int n = 0; n < 2; ++n) acc[a][b][m][n] = (f32x4){0.f, 0.f, 0.f, 0.f};
    bf16x8 At[4][2], B0[2][2], B1[2][2];
    const char* cA = (const char*)g.A + (size_t)cur.pm * tstep; const char* cB = (const char*)g.Bt + (size_t)cur.pn * tstep;
    S.a_ready(cur);
    if constexpr (SP2) {
        PG8_STAGE(PG8_SB(0, 0), cB, voffB); PG8_STAGE(PG8_SB(0, 1), cB + hstep, voffB); PG8_STAGE(PG8_SA(0, 0), cA, voffA); PG8_STAGE(PG8_SA(0, 1), cA + hstepA, voffA);
        if (wr == 1) PG8_BAR;
        PG8_WAIT_V(2); PG8_BAR;
        PG8_STAGE(PG8_SB(1, 0), cB + kstep, voffB); PG8_STAGE(PG8_SA(1, 0), cA + kstepA, voffA); PG8_STAGE(PG8_SB(1, 1), cB + hstep + kstep, voffB);
        PG8_WAIT_V(0); PG8_BAR;
    } else {
        PG8_STAGE(PG8_SB(0, 0), cB, voffB); PG8_STAGE(PG8_SA(0, 0), cA, voffA); PG8_STAGE(PG8_SB(0, 1), cB + hstep, voffB); PG8_STAGE(PG8_SA(0, 1), cA + hstepA, voffA);
        if (wr == 1) PG8_BAR;
        PG8_WAIT_V(4); PG8_BAR;
        PG8_STAGE(PG8_SB(1, 0), cB + kstep, voffB); PG8_STAGE(PG8_SA(1, 0), cA + kstepA, voffA); PG8_STAGE(PG8_SB(1, 1), cB + hstep + kstep, voffB);
        PG8_WAIT_V(6); PG8_BAR;
    }
    for (;;) {
        const bool has_next = S.next(ui + 1, nxt);
        const char* nA = has_next ? (const char*)g.A + (size_t)nxt.pm * tstep : cA; const char* nB = has_next ? (const char*)g.Bt + (size_t)nxt.pn * tstep : cB;
        for (int t = 0; t < nt; t += 2) {
            const bool last = (t == nt - 2);
            const char* a1 = cA + (size_t)(t + 1) * kstepA;
            const char* a2 = last ? nA : cA + (size_t)(t + 2) * kstepA; const char* b2 = last ? nB : cB + (size_t)(t + 2) * kstep;
            const char* a3 = a2 + kstepA; const char* b3 = b2 + kstep;
            if (last && has_next) S.a_ready(nxt);
            if constexpr (SP2) {
            PG8_LDB(B0, 0, 0); PG8_LDB(B1, 0, 1); PG8_SCHED; PG8_LDA(At, 0, 0); PG8_STAGE(PG8_SA(1, 1), a1 + hstepA, voffA);
            PG8_WAIT_V8_UNLESS_FIRST(t); PG8_WAIT_L(0); PG8_BAR; PG8_MMA(0, 0, At, B0); PG8_MMA(0, 1, At, B1); PG8_BAR; PG8_SCHED;
            PG8_LDA(At, 0, 1); PG8_STAGE(PG8_SB(0, 0), b2, voffB); PG8_STAGE(PG8_SB(0, 1), b2 + hstep, voffB); PG8_STAGE(PG8_SA(0, 0), a2, voffA);
            PG8_WAIT_V8_UNLESS_FIRST(t); PG8_WAIT_L(0); PG8_BAR; PG8_MMA(1, 0, At, B0); PG8_MMA(1, 1, At, B1); PG8_BAR; PG8_SCHED;
            PG8_LDB(B0, 1, 0); PG8_LDB(B1, 1, 1); PG8_SCHED; PG8_LDA(At, 1, 0); PG8_STAGE(PG8_SA(0, 1), a2 + hstepA, voffA);
            PG8_WAIT_V(8); PG8_WAIT_L(0); PG8_BAR; PG8_MMA(0, 0, At, B0); PG8_MMA(0, 1, At, B1); PG8_BAR; PG8_SCHED;
            PG8_LDA(At, 1, 1); PG8_STAGE(PG8_SB(1, 0), b3, voffB); PG8_STAGE(PG8_SB(1, 1), b3 + hstep, voffB); PG8_STAGE(PG8_SA(1, 0), a3, voffA);
            PG8_WAIT_V(8); PG8_WAIT_L(0); PG8_BAR; PG8_MMA(1, 0, At, B0); PG8_MMA(1, 1, At, B1); PG8_BAR; PG8_SCHED;
            } else {
            PG8_LDB(B0, 0, 0); PG8_SCHED; PG8_LDA(At, 0, 0); PG8_STAGE(PG8_SA(1, 1), a1 + hstepA, voffA);
            PG8_WAIT_L(8); PG8_BAR; PG8_WAIT_L(0); PG8_MMA(0, 0, At, B0); PG8_BAR; PG8_SCHED;
            PG8_LDB(B1, 0, 1); PG8_STAGE(PG8_SB(0, 0), b2, voffB);
            PG8_BAR; PG8_WAIT_L(0); PG8_MMA(0, 1, At, B1); PG8_BAR;
            PG8_LDA(At, 0, 1); PG8_STAGE(PG8_SA(0, 0), a2, voffA);
            PG8_BAR; PG8_WAIT_L(0); PG8_MMA(1, 0, At, B0); PG8_BAR; PG8_SCHED;
            PG8_STAGE(PG8_SB(0, 1), b2 + hstep, voffB);
            PG8_WAIT_V(6); PG8_BAR; PG8_MMA(1, 1, At, B1); PG8_BAR;
            PG8_LDB(B0, 1, 0); PG8_SCHED; PG8_LDA(At, 1, 0); PG8_STAGE(PG8_SA(0, 1), a2 + hstepA, voffA);
            PG8_WAIT_L(8); PG8_BAR; PG8_WAIT_L(0); PG8_MMA(0, 0, At, B0); PG8_BAR; PG8_SCHED;
            PG8_LDB(B1, 1, 1); PG8_STAGE(PG8_SB(1, 0), b3, voffB);
            PG8_BAR; PG8_WAIT_L(0); PG8_MMA(0, 1, At, B1); PG8_BAR;
            PG8_LDA(At, 1, 1); PG8_STAGE(PG8_SA(1, 0), a3, voffA);
            PG8_BAR; PG8_WAIT_L(0); PG8_MMA(1, 0, At, B0); PG8_BAR; PG8_SCHED;
            PG8_STAGE(PG8_SB(1, 1), b3 + hstep, voffB);
            PG8_WAIT_V(6); PG8_BAR; PG8_MMA(1, 1, At, B1); PG8_BAR;
            }
        }
        if constexpr (SP2) PG8_WAIT_V(0);
        if constexpr (FP8) asm volatile("s_nop 15\n\ts_nop 15" ::: "memory");
        if constexpr (ALIGN_EPI) { if (wr == 0) PG8_BAR; }
        if constexpr (!Epi::AFTER_DRAIN) { E(acc, cur, wr, wc, fr, fq); S.done(cur); }
        if (!has_next) break;
#pragma unroll
        for (int a = 0; a < 2; ++a)
#pragma unroll
            for (int b = 0; b < 2; ++b)
#pragma unroll
                for (int m = 0; m < 4; ++m)
#pragma unroll
                    for (int n = 0; n < 2; ++n) acc[a][b][m][n] = (f32x4){0.f, 0.f, 0.f, 0.f};
        cur = nxt; cA = nA; cB = nB; ++ui;
        if constexpr (ALIGN_EPI) { if (wr == 1) PG8_BAR; }
    }
    PG8_WAIT_V(0);
    if constexpr (!ALIGN_EPI) { if (wr == 0) PG8_BAR; }
    PG8_BAR;
    if constexpr (Epi::AFTER_DRAIN) { E.fused(acc, cur, wr, wc, fr, fq, lds, wid, lane); S.done(cur); }
#undef PG8_SA
#undef PG8_SB
#undef PG8_STAGE
#undef PG8_LDA
#undef PG8_LDB
#undef PG8_MMA
#undef PG8_WAIT_V
#undef PG8_WAIT_L
#undef PG8_WAIT_V8_UNLESS_FIRST
#undef PG8_BAR
#undef PG8_SCHED
}
}
#define GAS __attribute__((address_space(1)))
#define LAS __attribute__((address_space(3)))
typedef unsigned short bf16;
typedef unsigned v4u __attribute__((ext_vector_type(4)));
typedef float f32x4 __attribute__((ext_vector_type(4)));
typedef short bf16x8 __attribute__((ext_vector_type(8)));
typedef GAS unsigned gu32;
typedef GAS unsigned long long gu64;
#define RLX_AGENT __ATOMIC_RELAXED, __HIP_MEMORY_SCOPE_AGENT
#define LDS_WAIT() asm volatile("s_waitcnt lgkmcnt(0)" ::: "memory")
#define VM_WAIT() asm volatile("s_waitcnt vmcnt(0)" ::: "memory")
__device__ __forceinline__ unsigned long long rt() { return __builtin_amdgcn_s_memrealtime(); }
__device__ __forceinline__ unsigned f2bf(float f) { unsigned u = __builtin_bit_cast(unsigned, f); return (u + 0x7fffu + ((u >> 16) & 1u)) >> 16; }
__device__ __forceinline__ unsigned pk2(float lo, float hi) { return f2bf(lo) | (f2bf(hi) << 16); }

#define XB_TMO      128
#define XB_XCNT(j)  (256  + 64 * (j))
#define XB_XSUB(j)  (1280 + 64 * (j))
#define XB_XGEN(j)  (2304 + 64 * (j))
#define XB_TOP      3328
#define XB_TOPGEN   3392
#define XCD_BAR_WORDS 3456
#define XB_SPIN_CAP (1u << 18)

__device__ __forceinline__ unsigned xb_ld(unsigned* p)              { return __hip_atomic_load(p, __ATOMIC_RELAXED, __HIP_MEMORY_SCOPE_AGENT); }
__device__ __forceinline__ unsigned xb_add(unsigned* p, unsigned v) { return __hip_atomic_fetch_add(p, v, __ATOMIC_RELAXED, __HIP_MEMORY_SCOPE_AGENT); }
__device__ __forceinline__ unsigned xb_xcc_id() { return (unsigned)__builtin_amdgcn_s_getreg((3 << 11) | 20) & 0xFu; }
#define XB_SPIN(cond, bar) do { unsigned _sp = 0; while (cond) { __builtin_amdgcn_s_sleep(1); \
    if ((++_sp & 255u) == 0u) { if (xb_ld(&(bar)[XB_TMO])) break; if (_sp > XB_SPIN_CAP) { atomicAdd(&(bar)[XB_TMO], 1u); break; } } } } while (0)

struct XcdBarrier {
    unsigned* bar; unsigned x;
    volatile LAS unsigned* st;
};

__device__ __forceinline__ XcdBarrier xcd_barrier_post(unsigned* bar, volatile LAS unsigned* st) {
    XcdBarrier b; b.bar = bar; b.x = xb_xcc_id(); b.st = st;
    if (threadIdx.x == 0) (void)xb_add(&bar[XB_XCNT(b.x)], 1u);
    return b;
}
__device__ __forceinline__ void xcd_barrier_complete(unsigned* bar, unsigned x, unsigned& nloc, unsigned& nx) {
    const unsigned G = gridDim.x * gridDim.y * gridDim.z;
    unsigned sum, cnt, mine, sp = 0u;
    for (;;) {
        sum = 0u; cnt = 0u; mine = 0u;
#pragma unroll
        for (unsigned j = 0; j < 16; ++j) { const unsigned c = xb_ld(&bar[XB_XCNT(j)]); sum += c; cnt += (c > 0u) ? 1u : 0u; mine = (j == x) ? c : mine; }
        if (sum == G) break;
        __builtin_amdgcn_s_sleep(1);
        if ((++sp & 255u) == 0u) { if (xb_ld(&bar[XB_TMO])) break; if (sp > XB_SPIN_CAP) { atomicAdd(&bar[XB_TMO], 1u); break; } }
    }
    nloc = mine > 0u ? mine : 1u; nx = cnt > 0u ? cnt : 1u;
}

__device__ __forceinline__ void xcd_barrier(const XcdBarrier& b) {
    asm volatile("s_waitcnt vmcnt(0)" ::: "memory");
    __syncthreads();
    if (threadIdx.x == 0) {
        unsigned* bar = b.bar;
        __builtin_amdgcn_s_waitcnt(0);
        unsigned nloc = b.st[0], nx = b.st[1];
        if (nloc == 0u) { xcd_barrier_complete(bar, b.x, nloc, nx); b.st[0] = nloc; b.st[1] = nx; }
        const unsigned old = xb_add(&bar[XB_XSUB(b.x)], 1u);
        const unsigned gen = old / nloc;
        if (old + 1u == (gen + 1u) * nloc) {
            __builtin_amdgcn_fence(__ATOMIC_RELEASE, "agent");
            asm volatile("s_waitcnt vmcnt(0)" ::: "memory");
            const unsigned og = xb_add(&bar[XB_TOP], 1u);
            const unsigned tg = og / nx;
            if (og + 1u == (tg + 1u) * nx) xb_add(&bar[XB_TOPGEN], 1u);
            else XB_SPIN(xb_ld(&bar[XB_TOPGEN]) == tg, bar);
            __builtin_amdgcn_fence(__ATOMIC_ACQUIRE, "agent");
            xb_add(&bar[XB_XGEN(b.x)], 1u);
            asm volatile("s_waitcnt vmcnt(0)" ::: "memory");
        } else {
            XB_SPIN(xb_ld(&bar[XB_XGEN(b.x)]) == gen, bar);
            __builtin_amdgcn_fence(__ATOMIC_ACQUIRE, "agent");
            asm volatile("s_waitcnt vmcnt(0)" ::: "memory");
        }
    }
    __syncthreads();
}
struct Frame {
    LAS unsigned char* lds; volatile LAS unsigned* MISC; gu32* ctl;
    int tid, lane, wave, vcu, G;
    unsigned char* ws;
};
__device__ __forceinline__ float wave_sum(float v) {
#pragma unroll
    for (int o = 1; o < 64; o <<= 1) v += __shfl_xor(v, o);
    return v;
}
__device__ __forceinline__ float wave_max(float v) {
#pragma unroll
    for (int o = 1; o < 64; o <<= 1) v = fmaxf(v, __shfl_xor(v, o));
    return v;
}
__device__ __forceinline__ float bf2f_lo(unsigned w) { return __uint_as_float(w << 16); }
__device__ __forceinline__ float bf2f_hi(unsigned w) { return __uint_as_float(w & 0xffff0000u); }
__device__ __forceinline__ float bf2f(bf16 h) { return __uint_as_float((unsigned)h << 16); }

__device__ __forceinline__ void tr_item(const float* W, int Ns, const float* gain, bf16* WTrow, int K, int sc0, int nvalid, int k0, LAS float* scr, int lane) {
    const int col = lane & 31;
    float wv_[32];
#pragma unroll
    for (int i = 0; i < 32; ++i) { const int kk = 2 * i + (lane >> 5); wv_[i] = (col < nvalid) ? W[(size_t)(k0 + kk) * Ns + sc0 + col] : 0.f; }
#pragma unroll
    for (int i = 0; i < 32; ++i) { const int kk = 2 * i + (lane >> 5); float v = wv_[i]; if (gain) v *= gain[k0 + kk]; scr[kk * 33 + col] = v; }
    LDS_WAIT(); asm volatile("" ::: "memory");
    const int c = lane & 7;
#pragma unroll
    for (int j = 0; j < 4; ++j) { const int n = (lane >> 3) + 8 * j; const LAS float* s = scr + (8 * c) * 33 + n;
        v4u o; o.x = pk2(s[0 * 33], s[1 * 33]); o.y = pk2(s[2 * 33], s[3 * 33]); o.z = pk2(s[4 * 33], s[5 * 33]); o.w = pk2(s[6 * 33], s[7 * 33]);
        *(GAS v4u*)(WTrow + (size_t)n * K + 8 * c) = o; }
    LDS_WAIT(); asm volatile("" ::: "memory");
}
__device__ __forceinline__ void tr_item8(const float* W, int Ns, unsigned char* WTrow, int K, int sc0, int k0, LAS float* scr, int lane, const float* gain = nullptr) {
    const int col = lane & 31;
    float wv_[32];
#pragma unroll
    for (int i = 0; i < 32; ++i) { const int kk = 2 * i + (lane >> 5); wv_[i] = W[(size_t)(k0 + kk) * Ns + sc0 + col]; }
#pragma unroll
    for (int i = 0; i < 32; ++i) { const int kk = 2 * i + (lane >> 5); float v = wv_[i] * 64.f; if (gain) v *= gain[k0 + kk]; scr[kk * 33 + col] = v; }
    LDS_WAIT(); asm volatile("" ::: "memory");
    const int n = lane >> 1, hf = lane & 1;
#pragma unroll
    for (int q = 0; q < 2; ++q) { const LAS float* sp = scr + (32 * hf + 16 * q) * 33 + n; v4u o;
#pragma unroll
        for (int d = 0; d < 4; ++d) { unsigned w = 0u; w = __builtin_amdgcn_cvt_pk_fp8_f32(sp[(4 * d) * 33], sp[(4 * d + 1) * 33], w, false); w = __builtin_amdgcn_cvt_pk_fp8_f32(sp[(4 * d + 2) * 33], sp[(4 * d + 3) * 33], w, true); o[d] = w; }
        *(GAS v4u*)(WTrow + (size_t)n * K + 32 * hf + 16 * q) = o; }
    LDS_WAIT(); asm volatile("" ::: "memory");
}
__device__ __forceinline__ void plain_item8(const float* W, int Ns, int K, unsigned char* WT, int r, LAS float* scr, int lane, const float* gain = nullptr) {
    const int nkb = K / 64, group = r / nkb, kb = r % nkb;
    tr_item8(W, Ns, WT + (size_t)(group * 32) * K + kb * 64, K, group * 32, kb * 64, scr, lane, gain);
}
__device__ __forceinline__ void gu_item8(const float* wg, const float* wu, const float* gain, unsigned char* WT, int r, LAS float* scr, int lane) {
    const int group = r >> 4, kb = r & 15, tile = group >> 3, g8 = group & 7;
    tr_item8(g8 < 4 ? wg : wu, FF, WT + (size_t)(group * 32) * D + kb * 64, D, 128 * tile + 32 * (g8 & 3), kb * 64, scr, lane, gain);
}
__device__ __forceinline__ int win_src_col(int j, int& nvalid) {
    const int tile = j >> 3, half = (j >> 2) & 1, q4 = j & 3; nvalid = 32;
    if (tile < 2) return (half ? 256 : 0) + 128 * tile + 32 * q4;
    if (tile < 4) return (half ? 1024 : 768) + 128 * (tile - 2) + 32 * q4;
    if (tile == 4) return 512 + 128 * half + 32 * q4;
    if (tile < 7) return 1280 + ((tile - 5) * 4 + q4) * 64 + 32 * half;
    if (tile < 9) return 1792 + ((tile - 7) * 4 + q4) * 64 + 32 * half;
    if (tile < 11) return 2304 + (tile - 9) * 256 + 128 * half + 32 * q4;
    if (tile == 11) return 2816 + q4 * 64 + 32 * half;
    if (q4 == 0) return 3072 + 32 * half;
    if (q4 == 1 && half == 1) { nvalid = 4; return 3136; }
    nvalid = 0; return 0;
}
__device__ __forceinline__ void gu_item(const float* wg, const float* wu, const float* gain, bf16* WT, int r, LAS float* scr, int lane) {
    const int group = r >> 4, kb = r & 15, tile = group >> 3, g8 = group & 7;
    tr_item(g8 < 4 ? wg : wu, FF, gain, WT + (size_t)(group * 32) * D + kb * 64, D, 128 * tile + 32 * (g8 & 3), 32, kb * 64, scr, lane);
}
__device__ __forceinline__ void gu_item8(const float* wg, const float* wu, const float* gain, unsigned char* WT, int r, LAS float* scr, int lane);
__device__ __forceinline__ void plain_item(const float* W, int Ns, int K, const float* gain, bf16* WT, int r, LAS float* scr, int lane) {
    const int nkb = K / 64, group = r / nkb, kb = r % nkb;
    tr_item(W, Ns, gain, WT + (size_t)(group * 32) * K + kb * 64, K, group * 32, 32, kb * 64, scr, lane);
}
struct Args { const void* in[25]; float* out; unsigned char* ws; float invf[32]; int ph_lo, ph_hi; };
typedef const __attribute__((address_space(4))) Args* KArgs;
#define INF(A, k) ((const float*)(A)->in[k])
enum { I_X = 0, I_MEM, I_POS, I_FFN1_NORM, I_FFN1_WG, I_FFN1_WU, I_FFN1_WD, I_MIX_NORM, I_W_IN, I_CONF_DW, I_CONF_DW_B, I_CONF_LN_G, I_CONF_LN_B, I_SC_DW, I_W_OUT, I_XA_NORM, I_MEM_NORM, I_XA_WQ, I_XA_WKV, I_XA_WO,
       I_FFN2_NORM, I_FFN2_WG, I_FFN2_WU, I_FFN2_WD, I_FINAL_NORM };
constexpr int IT_GU = 2816, IT_D = 1408, IT_IN = 1664, IT_SQ = 512, IT_KV = 1024, IT_LAYER = 2 * IT_GU + 2 * IT_D + IT_IN + 3 * IT_SQ + IT_KV;
__device__ __forceinline__ void p0_prologue(Frame& F, KArgs A) {
    LAS float* scr = (LAS float*)(F.lds + RING_OFF + F.wave * 16384);
    const int gw = F.vcu * NWAVES + F.wave, NGW = F.G * NWAVES, lane = F.lane;
    unsigned char* ws = F.ws;
    for (int it = gw; it < DEPTH * IT_LAYER; it += NGW) {
        const int l = it / IT_LAYER; int r = it % IT_LAYER;
        unsigned char* wl = ws + WS_W + (size_t)l * W_LAYER;
        if (r < IT_GU) { gu_item(INF(A, I_FFN1_WG) + (size_t)l * D * FF, INF(A, I_FFN1_WU) + (size_t)l * D * FF, INF(A, I_FFN1_NORM) + l * D, (bf16*)(wl + WO_GU1), r, scr, lane); continue; } r -= IT_GU;
        if (r < IT_D) { plain_item8(INF(A, I_FFN1_WD) + (size_t)l * FF * D, D, FF, wl + WO_D1, r, scr, lane); continue; } r -= IT_D;
        if (r < IT_IN) { const int group = r >> 4, kb = r & 15; int nv; const int sc = win_src_col(group, nv);
            tr_item(INF(A, I_W_IN) + (size_t)l * D * NIN, NIN, INF(A, I_MIX_NORM) + l * D, (bf16*)(wl + WO_IN) + (size_t)(group * 32) * D + kb * 64, D, sc, nv, kb * 64, scr, lane); continue; } r -= IT_IN;
        if (r < IT_SQ) { plain_item(INF(A, I_W_OUT) + (size_t)l * D * D, D, D, nullptr, (bf16*)(wl + WO_OUT), r, scr, lane); continue; } r -= IT_SQ;
        if (r < IT_SQ) { plain_item8(INF(A, I_XA_WQ) + (size_t)l * D * D, D, D, wl + WO_Q, r, scr, lane, INF(A, I_XA_NORM) + l * D); continue; } r -= IT_SQ;
        if (r < IT_SQ) { plain_item8(INF(A, I_XA_WO) + (size_t)l * D * D, D, D, wl + WO_O, r, scr, lane); continue; } r -= IT_SQ;
        if (r < IT_KV) { plain_item(INF(A, I_XA_WKV) + (size_t)l * D * 2 * D, 2 * D, D, INF(A, I_MEM_NORM) + l * D, (bf16*)(ws + WS_MK) + (size_t)(1024 + 2048 * l) * D, r, scr, lane); continue; } r -= IT_KV;
        if (r < IT_GU) { if (l == GU8_LAYER) gu_item8(INF(A, I_FFN2_WG) + (size_t)l * D * FF, INF(A, I_FFN2_WU) + (size_t)l * D * FF, INF(A, I_FFN2_NORM) + l * D, wl + WO_GU2, r, scr, lane);
                         else gu_item(INF(A, I_FFN2_WG) + (size_t)l * D * FF, INF(A, I_FFN2_WU) + (size_t)l * D * FF, INF(A, I_FFN2_NORM) + l * D, (bf16*)(wl + WO_GU2), r, scr, lane); continue; } r -= IT_GU;
        plain_item8(INF(A, I_FFN2_WD) + (size_t)l * FF * D, D, FF, wl + WO_D2, r, scr, lane);
    }
    for (int m = gw; m < M + 1024; m += NGW) {
        const bool ismem = m >= M; const int row = ismem ? m - M : m;
        const GAS f32x4* xr = (const GAS f32x4*)((ismem ? INF(A, I_MEM) : INF(A, I_X)) + (size_t)row * D) + lane;
        GAS unsigned long long* o8 = (GAS unsigned long long*)((bf16*)(ws + (ismem ? WS_MK : WS_X)) + (size_t)row * D) + lane;
        float s = 0.f;
#pragma unroll
        for (int j = 0; j < 4; ++j) { const f32x4 v = xr[64 * j]; const unsigned a = pk2(v.x, v.y), b = pk2(v.z, v.w); o8[64 * j] = (unsigned long long)a | ((unsigned long long)b << 32);
            s += (bf2f_lo(a) * bf2f_lo(a) + bf2f_hi(a) * bf2f_hi(a)) + (bf2f_lo(b) * bf2f_lo(b) + bf2f_hi(b) * bf2f_hi(b)); }
        s = wave_sum(s);
        if (ismem) { if (lane == 0) ((float*)(ws + WS_MSS))[row] = s; } else if (lane < 16) ((float*)(ws + WS_SS))[(size_t)row * 16 + lane] = lane == 0 ? s : 0.f;
    }
    for (int e = (F.vcu * NWAVES * 64 + F.tid); e < M * 32; e += F.G * NWAVES * 64) {
        const int row = e >> 5, i = e & 31;
        const float ang = __fmul_rn((float)((const int*)A->in[I_POS])[row], A->invf[i]);
        const double x = (double)ang, n = __builtin_rint(x * 0.15915494309189535), r = x - n * 6.283185307179586, r2 = r * r;
        double sp = -1.0 / 25852016738884976640000.0, cp = 1.0 / 620448401733239439360000.0;
        sp = sp * r2 + 1.0 / 51090942171709440000.0;  cp = cp * r2 - 1.0 / 1124000727777607680000.0;
        sp = sp * r2 - 1.0 / 121645100408832000.0;    cp = cp * r2 + 1.0 / 2432902008176640000.0;
        sp = sp * r2 + 1.0 / 355687428096000.0;       cp = cp * r2 - 1.0 / 6402373705728000.0;
        sp = sp * r2 - 1.0 / 1307674368000.0;         cp = cp * r2 + 1.0 / 20922789888000.0;
        sp = sp * r2 + 1.0 / 6227020800.0;            cp = cp * r2 - 1.0 / 87178291200.0;
        sp = sp * r2 - 1.0 / 39916800.0;              cp = cp * r2 + 1.0 / 479001600.0;
        sp = sp * r2 + 1.0 / 362880.0;                cp = cp * r2 - 1.0 / 3628800.0;
        sp = sp * r2 - 1.0 / 5040.0;                  cp = cp * r2 + 1.0 / 40320.0;
        sp = sp * r2 + 1.0 / 120.0;                   cp = cp * r2 - 1.0 / 720.0;
        sp = sp * r2 - 1.0 / 6.0;                     cp = cp * r2 + 1.0 / 24.0;
        sp = sp * r2 + 1.0;                           cp = cp * r2 - 0.5;
        cp = cp * r2 + 1.0;
        ((float*)(ws + WS_COS))[e] = (float)cp; ((float*)(ws + WS_SIN))[e] = (float)(sp * r);
    }
}

__device__ __forceinline__ void conv_a_unit(Frame& F, const bf16* HG, bf16* MIX, const float* dw, const float* dwb, const float* lng, const float* lnb, int unit) {
    const int tid = F.tid, lane = F.lane, wave = F.wave;
    const int row0 = unit * 64, t0 = row0 % SEQ;
    LAS unsigned short* hb = (LAS unsigned short*)(F.lds + RING_OFF); LAS float* yb = (LAS float*)(F.lds + RING_OFF + 49152);
    for (int ch = tid; ch < 94 * 32; ch += NWAVES * 64) { const int rr = ch >> 5, c16 = ch & 31; const int t = t0 - 30 + rr;
        v4u v = (v4u){0u, 0u, 0u, 0u}; if (t >= 0) v = *(const GAS v4u*)(HG + (size_t)(row0 - 30 + rr) * 256 + c16 * 8);
        *(LAS v4u*)(hb + rr * 256 + c16 * 8) = v; }
    __syncthreads();
    { const int c = tid & 255, half = tid >> 8;
      float w[31];
#pragma unroll
      for (int j = 0; j < 31; ++j) w[j] = dw[j * 256 + c];
      const float bias = dwb[c];
      float hv[62];
#pragma unroll
      for (int k = 0; k < 62; ++k) hv[k] = bf2f(hb[(32 * half + k) * 256 + c]);
#pragma unroll
      for (int i = 0; i < 32; ++i) { float y = bias;
#pragma unroll
          for (int j = 0; j < 31; ++j) y += w[j] * hv[i + j];
          yb[(32 * half + i) * 256 + c] = y; } }
    __syncthreads();
    { const f32x4 g = *(const GAS f32x4*)(lng + lane * 4), bb = *(const GAS f32x4*)(lnb + lane * 4);
      for (int tt = wave; tt < 64; tt += NWAVES) { const f32x4 y = *(LAS f32x4*)(yb + tt * 256 + lane * 4);
          const float mean = wave_sum((y.x + y.y) + (y.z + y.w)) * (1.f / 256.f); const f32x4 d = y - mean;
          const float var = wave_sum((d.x * d.x + d.y * d.y) + (d.z * d.z + d.w * d.w)) * (1.f / 256.f); const float rs = 1.0f / sqrtf(var + 1e-5f);
          f32x4 o = d * rs * g + bb;
#pragma unroll
          for (int j = 0; j < 4; ++j) o[j] = o[j] * pg8::sigm(o[j]);
          *(GAS unsigned long long*)(MIX + (size_t)(row0 + tt) * 1024 + lane * 4) = (unsigned long long)pk2(o.x, o.y) | ((unsigned long long)pk2(o.z, o.w) << 32); } }
    __syncthreads();
}
__device__ __forceinline__ void conv_b_all(Frame& F, const bf16* U, const bf16* BG, bf16* MIX, const float* sw) {
    for (int it = F.vcu * NWAVES * 64 + F.tid; it < M * 32; it += F.G * NWAVES * 64) { const int row = it >> 5, c8 = (it & 31) * 8, t = row % SEQ;
        const v4u z = (v4u){0u, 0u, 0u, 0u};
        const v4u u0 = *(const GAS v4u*)(U + (size_t)row * 256 + c8), u1 = t >= 1 ? *(const GAS v4u*)(U + (size_t)(row - 1) * 256 + c8) : z, u2 = t >= 2 ? *(const GAS v4u*)(U + (size_t)(row - 2) * 256 + c8) : z;
        const v4u g = *(const GAS v4u*)(BG + (size_t)row * 256 + c8);
        float o[8];
#pragma unroll
        for (int k = 0; k < 4; ++k) { const int c = c8 + 2 * k;
            o[2 * k]     = bf2f_lo(g[k]) * (sw[c] * bf2f_lo(u2[k]) + sw[256 + c] * bf2f_lo(u1[k]) + sw[512 + c] * bf2f_lo(u0[k]));
            o[2 * k + 1] = bf2f_hi(g[k]) * (sw[c + 1] * bf2f_hi(u2[k]) + sw[256 + c + 1] * bf2f_hi(u1[k]) + sw[512 + c + 1] * bf2f_hi(u0[k])); }
        v4u w; w.x = pk2(o[0], o[1]); w.y = pk2(o[2], o[3]); w.z = pk2(o[4], o[5]); w.w = pk2(o[6], o[7]);
        *(GAS v4u*)(MIX + (size_t)row * 1024 + 256 + c8) = w; }
}
__device__ __forceinline__ unsigned mono32(float f) { const unsigned u = __float_as_uint(f); return (u & 0x80000000u) ? ~u : (u | 0x80000000u); }
template <bool FROM_MASK> __device__ __forceinline__ void dsa_naive_query(Frame& F, const bf16* Q, const bf16* K, const bf16* V, const bf16* QI, const bf16* KI, const float* WI, const unsigned long long* MASK, bf16* MIX, int row) {
    const int tid = F.tid, lane = F.lane, wave = F.wave;
    const int b = row / SEQ, t = row % SEQ, n = t + 1;
    LAS unsigned long long* key64 = (LAS unsigned long long*)(F.lds + RING_OFF);
    LAS float* qi = (LAS float*)(F.lds + RING_OFF + 65536); LAS float* qh = (LAS float*)(F.lds + RING_OFF + 66560); LAS float* pl = (LAS float*)(F.lds + RING_OFF + 68608);
    LAS int* sel = (LAS int*)(F.lds + RING_OFF + 76800); LAS unsigned* cnt = (LAS unsigned*)(F.lds + RING_OFF + 77824);
    if (tid < 256) qi[tid] = bf2f(QI[(size_t)row * 256 + tid]);
    qh[tid] = bf2f(Q[(size_t)row * 512 + tid]);
    if (tid < 64) cnt[tid] = 0u;
    const f32x4 wv = *(const GAS f32x4*)(WI + (size_t)row * 4);
    __syncthreads();
    unsigned em = 0u;
    if constexpr (FROM_MASK) {
#pragma unroll
        for (int j = 0; j < 16; ++j) { const int s = tid + 512 * j;
            if (s < n) { const int kb = s >> 5, ko = s & 31, r = (ko & 3) + 4 * (ko >> 3), hh = (ko >> 2) & 1; const unsigned long long w = MASK[(((size_t)b * 256 + (t >> 5)) * 256 + kb) * 16 + r]; em |= (unsigned)((w >> (hh * 32 + (t & 31))) & 1ull) << j; } }
    } else {
    unsigned long long e[16]; unsigned long long T = 0ull;
#pragma unroll
    for (int j = 0; j < 16; ++j) { const int s = tid + 512 * j; e[j] = 0ull;
        if (s < n) { const GAS v4u* kr = (const GAS v4u*)(KI + (size_t)(b * SEQ + s) * 64); float kf[64];
#pragma unroll
            for (int c = 0; c < 8; ++c) { const v4u v = kr[c];
#pragma unroll
                for (int k = 0; k < 4; ++k) { kf[c * 8 + 2 * k] = bf2f_lo(v[k]); kf[c * 8 + 2 * k + 1] = bf2f_hi(v[k]); } }
            float sc = 0.f;
#pragma unroll
            for (int h = 0; h < 4; ++h) { float d0 = 0.f;
#pragma unroll
                for (int d = 0; d < 64; ++d) d0 += qi[h * 64 + d] * kf[d];
                sc += wv[h] * fmaxf(d0, 0.f); }
            sc = sc * IDX_SCALE + 0.0f;
            e[j] = ((unsigned long long)mono32(sc) << 13) | (unsigned long long)(8191 - s); } }
    if (n > 256) {
        for (int bit = 44; bit >= 0; --bit) { const unsigned long long cand = T | (1ull << bit); unsigned c = 0;
#pragma unroll
            for (int j = 0; j < 16; ++j) c += (e[j] >= cand) ? 1u : 0u;
            c = (unsigned)wave_sum((float)c);
            if (lane == 0) atomicAdd((unsigned*)&cnt[bit], c);
            __syncthreads();
            if (cnt[bit] >= 256u) T = cand; }
    }
    if (T == 0ull) T = 1ull;
#pragma unroll
    for (int j = 0; j < 16; ++j) em |= (e[j] >= T ? 1u : 0u) << j;
    }
    { unsigned c = 0;
      c = (unsigned)__builtin_popcount(em);
      unsigned inc = c;
#pragma unroll
      for (int o = 1; o < 64; o <<= 1) { const unsigned v = __shfl_up(inc, o); if (lane >= o) inc += v; }
      if (lane == 63) cnt[50 + wave] = inc;
      __syncthreads();
      unsigned base = inc - c;
#pragma unroll
      for (int w = 0; w < NWAVES; ++w) if (w < wave) base += cnt[50 + w];
#pragma unroll
      for (int j = 0; j < 16; ++j) if ((em >> j) & 1u) { if (base < 256u) sel[base] = tid + 512 * j; ++base; }
      if (tid == NWAVES * 64 - 1) cnt[48] = base; }
    __syncthreads();
    const int nsel = min((int)cnt[48], 256);
    { const int h = wave; float mx = -INFINITY;
#pragma unroll 1
      for (int kk = 0; kk < 4; ++kk) { const int k = lane + 64 * kk; float d0 = -INFINITY;
          if (k < nsel) { const GAS v4u* kr = (const GAS v4u*)(K + (size_t)(b * SEQ + sel[k]) * 512 + h * 64); d0 = 0.f;
#pragma unroll
              for (int c = 0; c < 8; ++c) { const v4u v = kr[c];
#pragma unroll
                  for (int q = 0; q < 4; ++q) d0 += qh[h * 64 + c * 8 + 2 * q] * bf2f_lo(v[q]) + qh[h * 64 + c * 8 + 2 * q + 1] * bf2f_hi(v[q]); } }
          pl[h * 256 + k] = d0; mx = fmaxf(mx, d0); }
      mx = wave_max(mx); float sum = 0.f;
#pragma unroll 1
      for (int kk = 0; kk < 4; ++kk) { const int k = lane + 64 * kk; const float p = (k < nsel) ? __builtin_amdgcn_exp2f(pl[h * 256 + k] - mx) : 0.f; pl[h * 256 + k] = p; sum += p; }
      sum = wave_sum(sum);
      LDS_WAIT(); asm volatile("" ::: "memory");
      float o = 0.f;
#pragma unroll 8
      for (int k = 0; k < nsel; ++k) o += pl[h * 256 + k] * bf2f(V[(size_t)(b * SEQ + sel[k]) * 512 + h * 64 + lane]);
      MIX[(size_t)row * 1024 + 512 + h * 64 + lane] = (bf16)pk2(o / sum, 0.f); }
    __syncthreads();
}
typedef float f32x16 __attribute__((ext_vector_type(16)));
__device__ __forceinline__ int crow(int r, int hi) { return (r & 3) + 8 * (r >> 2) + 4 * hi; }
constexpr int XA_ROWB = 528;
__device__ __forceinline__ void xattn_stage(Frame& F, const bf16* src  ) {
#pragma unroll 1
    for (int g = 0; g < 2; ++g) { v4u t[8];
#pragma unroll
        for (int i = 0; i < 8; ++i) { const int c = F.tid + 512 * (8 * g + i); t[i] = *(const GAS v4u*)(src + (size_t)(c >> 5) * 1024 + (c & 31) * 8); }
#pragma unroll
        for (int i = 0; i < 8; ++i) { const int c = F.tid + 512 * (8 * g + i); *(LAS v4u*)(F.lds + RING_OFF + (c >> 5) * XA_ROWB + (c & 31) * 16) = t[i]; } }
}
__device__ __forceinline__ void xattn_unit(Frame& F, const bf16* XQ, unsigned char* XO  , const bf16* MEMK, const bf16* MEMVT, int pm, int h) {
    const int lane = F.lane, wave = F.wave, r32 = lane & 31, hi = lane >> 5, b = pm >> 5;
    const int R0 = pm * 256 + wave * 32;
    LAS float* wsf = (LAS float*)(F.lds + RING_OFF + 256 * XA_ROWB) + wave * 64;
    xattn_stage(F, MEMK + (size_t)(b * 256) * 1024 + h * 256);
    bf16x8 qf[16];
#pragma unroll
    for (int kk = 0; kk < 16; ++kk) qf[kk] = *(const GAS bf16x8*)(XQ + (size_t)(R0 + r32) * 1024 + h * 256 + kk * 16 + hi * 8);
    __syncthreads();
    f32x16 st[8];
#pragma unroll
    for (int kb = 0; kb < 8; ++kb) { st[kb] = (f32x16){};
        const LAS unsigned char* kr = F.lds + RING_OFF + (kb * 32 + r32) * XA_ROWB + hi * 16;
#pragma unroll
        for (int kk = 0; kk < 16; ++kk) { const bf16x8 kf = *(const LAS bf16x8*)(kr + kk * 32); st[kb] = __builtin_amdgcn_mfma_f32_32x32x16_bf16(kf, qf[kk], st[kb], 0, 0, 0); if ((kk & 3) == 3) asm volatile("" ::: "memory"); } }
    float mx = -INFINITY;
#pragma unroll
    for (int kb = 0; kb < 8; ++kb)
#pragma unroll
        for (int r = 0; r < 16; ++r) mx = fmaxf(mx, st[kb][r]);
    { const auto rr = __builtin_amdgcn_permlane32_swap(__float_as_uint(mx), __float_as_uint(mx), false, false); mx = fmaxf(__uint_as_float(rr[0]), __uint_as_float(rr[1])); }
    float sum = 0.f; v4u pk[8][2];
#pragma unroll
    for (int kb = 0; kb < 8; ++kb) {
#pragma unroll
        for (int r = 0; r < 16; ++r) { st[kb][r] = __builtin_amdgcn_exp2f(st[kb][r] - mx); sum += st[kb][r]; }
#pragma unroll
        for (int hf = 0; hf < 2; ++hf)
#pragma unroll
            for (int q = 0; q < 4; ++q) pk[kb][hf][q] = pg8::cvt_pk_bf16(st[kb][8 * hf + 2 * q], st[kb][8 * hf + 2 * q + 1]); }
    { const auto rr = __builtin_amdgcn_permlane32_swap(__float_as_uint(sum), __float_as_uint(sum), false, false); sum = __uint_as_float(rr[0]) + __uint_as_float(rr[1]); }
    __syncthreads();
    xattn_stage(F, MEMVT + (size_t)(h * 256) * 1024 + b * 256);
    if (hi == 0) wsf[r32] = sum;
    __syncthreads();
    f32x16 o[8];
#pragma unroll
    for (int db = 0; db < 8; ++db) { o[db] = (f32x16){};
        const LAS unsigned char* vr = F.lds + RING_OFF + (db * 32 + r32) * XA_ROWB + hi * 8;
#pragma unroll
        for (int ks = 0; ks < 16; ++ks) { const pg8::u32x2 lo = *(const LAS pg8::u32x2*)(vr + ks * 32), hh = *(const LAS pg8::u32x2*)(vr + ks * 32 + 16);
            const v4u vv = (v4u){lo.x, lo.y, hh.x, hh.y};
            o[db] = __builtin_amdgcn_mfma_f32_32x32x16_bf16(__builtin_bit_cast(bf16x8, pk[ks >> 1][ks & 1]), __builtin_bit_cast(bf16x8, vv), o[db], 0, 0, 0); if ((ks & 3) == 3) asm volatile("" ::: "memory"); } }
    float rl[16];
#pragma unroll
    for (int r = 0; r < 16; ++r) rl[r] = 1.0f / wsf[crow(r, hi)];
#pragma unroll
    for (int db = 0; db < 8; ++db)
#pragma unroll
        for (int r = 0; r < 16; ++r) XO[(size_t)(R0 + crow(r, hi)) * 1024 + h * 256 + db * 32 + r32] = (unsigned char)__builtin_amdgcn_cvt_pk_fp8_f32(o[db][r] * rl[r], 0.f, 0u, false);
    __syncthreads();
}
__device__ __forceinline__ void final_norm_all(Frame& F, const bf16* X, const float* ss, const float* g, float* out) {
    const int gw = F.vcu * NWAVES + F.wave, NGW = F.G * NWAVES, lane = F.lane;
    f32x4 gg[4];
#pragma unroll
    for (int j = 0; j < 4; ++j) gg[j] = *(const GAS f32x4*)(g + (lane + 64 * j) * 4);
    for (int m0 = gw * 4; m0 < M; m0 += NGW * 4) {
        unsigned long long v[4][4]; float rs[4];
#pragma unroll
        for (int i = 0; i < 4; ++i) { rs[i] = pg8::rstd_of(ss, m0 + i);
#pragma unroll
            for (int j = 0; j < 4; ++j) v[i][j] = ((const GAS unsigned long long*)(X + (size_t)(m0 + i) * D))[lane + 64 * j]; }
#pragma unroll
        for (int i = 0; i < 4; ++i)
#pragma unroll
            for (int j = 0; j < 4; ++j) { const unsigned a = (unsigned)v[i][j], bq = (unsigned)(v[i][j] >> 32);
                *(GAS f32x4*)(out + (size_t)(m0 + i) * D + (lane + 64 * j) * 4) = (f32x4){bf2f_lo(a) * rs[i] * gg[j].x, bf2f_hi(a) * rs[i] * gg[j].y, bf2f_lo(bq) * rs[i] * gg[j].z, bf2f_hi(bq) * rs[i] * gg[j].w}; } }
}

constexpr int IX_HS = 1025;
constexpr int IX_ST = 32 * IX_HS * 4;
constexpr int IX_CAP = 1024;
#ifndef IX_DUP
#define IX_DUP 0
#endif
__device__ __forceinline__ void idx_load_a(bf16x8 (&a)[4], const bf16* kbase, int kb) {
#pragma unroll
    for (int kk = 0; kk < 4; ++kk) a[kk] = *(const GAS bf16x8*)(kbase + (size_t)kb * 2048 + kk * 512);
}
#define IX_RELU(x) __int_as_float(max(__float_as_int(x), 0))
#define IX_MF(ACC, H, KK) ACC = __builtin_amdgcn_mfma_f32_32x32x16_bf16(a[KK], bq[H][KK], ACC, 0, 0, 0)
#define IX_RS0(ACC, W, R) do { _Pragma("unroll") for (int r = (R); r < (R) + 4; ++r) { const float x = ACC[r]; sc[r] = __builtin_fmaf(W, IX_RELU(x), 0.0f); } } while (0)
#define IX_RS(ACC, W, R) do { _Pragma("unroll") for (int r = (R); r < (R) + 4; ++r) { const float x = ACC[r]; sc[r] = __builtin_fmaf(W, IX_RELU(x), sc[r]); } } while (0)
#define IX_PIN(ACC, VACC, R) asm volatile("" : "+v"(ACC), "+v"(VACC), "+v"(sc[R]), "+v"(sc[(R) + 1]), "+v"(sc[(R) + 2]), "+v"(sc[(R) + 3]))
template <bool PREV> __device__ __forceinline__ void idx_half1(float (&sc)[16], f32x16& acc0, f32x16& acc1, f32x16& acc2, f32x16& acc3, const bf16x8 (&a)[4], const bf16x8 (&bq)[4][4], const f32x4 wv) {
    acc0 = (f32x16){};
#pragma unroll
    for (int kk = 0; kk < 4; ++kk) { IX_MF(acc0, 0, kk); if constexpr (PREV) { IX_RS(acc2, wv[2], 4 * kk); IX_PIN(acc0, acc2, 4 * kk); } }
    acc1 = (f32x16){};
#pragma unroll
    for (int kk = 0; kk < 4; ++kk) { IX_MF(acc1, 1, kk); if constexpr (PREV) { IX_RS(acc3, wv[3], 4 * kk); IX_PIN(acc1, acc3, 4 * kk); } }
}
__device__ __forceinline__ void idx_half2(float (&sc)[16], f32x16& acc0, f32x16& acc1, f32x16& acc2, f32x16& acc3, const bf16x8 (&a)[4], const bf16x8 (&bq)[4][4], const f32x4 wv) {
    acc2 = (f32x16){};
#pragma unroll
    for (int kk = 0; kk < 4; ++kk) { IX_MF(acc2, 2, kk); IX_RS0(acc0, wv[0], 4 * kk); IX_PIN(acc2, acc0, 4 * kk); }
    acc3 = (f32x16){};
#pragma unroll
    for (int kk = 0; kk < 4; ++kk) { IX_MF(acc3, 3, kk); IX_RS(acc1, wv[1], 4 * kk); IX_PIN(acc3, acc1, 4 * kk); }
}
__device__ __forceinline__ void idx_tail(float (&sc)[16], const f32x16& acc2, const f32x16& acc3, const f32x4 wv) {
    IX_RS(acc2, wv[2], 0); IX_RS(acc2, wv[2], 4); IX_RS(acc2, wv[2], 8); IX_RS(acc2, wv[2], 12);
    IX_RS(acc3, wv[3], 0); IX_RS(acc3, wv[3], 4); IX_RS(acc3, wv[3], 8); IX_RS(acc3, wv[3], 12);
}
#undef IX_PIN
#undef IX_RELU
#undef IX_MF
#undef IX_RS0
#undef IX_RS
template <bool L2> __device__ __forceinline__ void idx_scan(LAS unsigned* row, bool positive, unsigned need, int lane, unsigned& bin_out, unsigned& need_out) {
    asm volatile("" : "+v"(lane));
    unsigned c[16], sum = 0;
#pragma unroll
    for (int i = 0; i < 16; ++i) { const int p = 16 * lane + i; const int bin = L2 ? (positive ? 1023 - p : p) : (p < 512 ? 511 - p : p); c[i] = row[bin]; row[bin] = 0u; sum += c[i]; }
    unsigned incl = sum;
#pragma unroll
    for (int o = 1; o < 64; o <<= 1) { const unsigned v = __shfl_up(incl, o); if (lane >= o) incl += v; }
    const unsigned long long m = __ballot(incl >= need);
    const int Ls = m ? (int)__builtin_ctzll(m) : 63;
    unsigned cum = incl - sum, fb = 0u, fn = 1u; bool found = false;
#pragma unroll
    for (int i = 0; i < 16; ++i) { const int p = 16 * lane + i; const unsigned bin = (unsigned)(L2 ? (positive ? 1023 - p : p) : (p < 512 ? 511 - p : p));
        if (!found && cum + c[i] >= need) { found = true; fb = bin; fn = need - cum; } cum += c[i]; }
    bin_out = (unsigned)__shfl((int)fb, Ls); need_out = (unsigned)__shfl((int)fn, Ls);
}
template <int NS> __device__ __forceinline__ unsigned idx_select(LAS unsigned* row, unsigned n, unsigned need, int lane) {
    unsigned v[NS], vor = 0u, vand = 0xffffffffu;
#pragma unroll
    for (int s = 0; s < NS; ++s) { const unsigned idx = (unsigned)(s * 64 + lane); const bool ok = idx < n; v[s] = ok ? row[idx] : 0u; vor |= v[s]; vand &= ok ? v[s] : 0xffffffffu; }
#pragma unroll
    for (int o = 1; o < 64; o <<= 1) { vor |= (unsigned)__shfl_xor((int)vor, o); vand &= (unsigned)__shfl_xor((int)vand, o); }
    const unsigned diff = vor ^ vand;
    if (diff == 0u) return vand;
    const int top = 31 - __builtin_clz(diff);
    unsigned T = vand & ~((2u << top) - 1u);
    for (int bit = top; bit >= 0; --bit) { const unsigned cand = T | (1u << bit); unsigned c = 0;
#pragma unroll
        for (int s = 0; s < NS; ++s) c += (unsigned)__builtin_popcountll(__ballot(v[s] >= cand));
        if (c >= need) T = cand; }
    return T;
}
__device__ __forceinline__ unsigned ix_mono(unsigned raw) { return (raw & 0x80000000u) ? ~raw : (raw | 0x80000000u); }
__device__ __forceinline__ float ix_h2f(unsigned h) { return (float)__builtin_bit_cast(_Float16, (unsigned short)h); }
__device__ __forceinline__ unsigned ix_pick(const float (&sc)[16], unsigned r) {
    const unsigned m0 = (unsigned)((int)(r << 31) >> 31), m1 = (unsigned)((int)(r << 30) >> 31), m2 = (unsigned)((int)(r << 29) >> 31), m3 = (unsigned)((int)(r << 28) >> 31); unsigned t[8], u[4], w[2];
#pragma unroll
    for (int i = 0; i < 8; ++i) t[i] = (__float_as_uint(sc[2 * i + 1]) & m0) | (__float_as_uint(sc[2 * i]) & ~m0);
#pragma unroll
    for (int i = 0; i < 4; ++i) u[i] = (t[2 * i + 1] & m1) | (t[2 * i] & ~m1);
#pragma unroll
    for (int i = 0; i < 2; ++i) w[i] = (u[2 * i + 1] & m2) | (u[2 * i] & ~m2);
    return (w[1] & m3) | (w[0] & ~m3);
}
__device__ __forceinline__ void idx_unit(Frame& F, const bf16* QI, const bf16* KI, const float* WI, unsigned* MASK, int b, int j) {
    int lane = F.lane, r32 = lane & 31, hi = lane >> 5; const int wave = F.wave;
#define IX_LAUNDER() asm volatile("" : "+v"(lane), "+v"(r32), "+v"(hi))
    LAS unsigned* hist = (LAS unsigned*)(F.lds + RING_OFF);
    LAS unsigned* st = (LAS unsigned*)(F.lds + RING_OFF + IX_ST);
    const size_t qrow = (size_t)b * SEQ + 32 * j + r32;
    bf16x8 bq[4][4];
#pragma unroll
    for (int h = 0; h < 4; ++h)
#pragma unroll
        for (int kk = 0; kk < 4; ++kk) bq[h][kk] = *(const GAS bf16x8*)(QI + qrow * 256 + h * 64 + kk * 16 + hi * 8);
    f32x4 wv = *(const GAS f32x4*)(WI + qrow * 4); wv = wv * IDX_SCALE;
    const bf16* kbase = KI + (size_t)b * SEQ * 64 + (size_t)(hi * 32 + r32) * 8;
    LAS unsigned* myrow = hist + r32 * IX_HS;
    const unsigned myrow_b = (unsigned)(uintptr_t)myrow;
#define IX_BODY(KBP, ...) do { const int kb = (KBP); if (kb == j) { _Pragma("unroll") for (int r = 0; r < 16; ++r) sc[r] = (crow(r, hi) > r32) ? -INFINITY : sc[r]; } __VA_ARGS__ } while (0)
#define IX_STEP(A, KB, ...) do { idx_half1<true>(sc, acc0, acc1, acc2, acc3, A, bq, wv); IX_BODY(kbp, __VA_ARGS__); idx_half2(sc, acc0, acc1, acc2, acc3, A, bq, wv); idx_load_a(A, kbase, min((KB) + 3 * NWAVES, j)); kbp = (KB); } while (0)
#define IX_PASS(...) do { IX_LAUNDER(); bf16x8 a0[4], a1[4], a2[4]; idx_load_a(a0, kbase, min(wave, j)); idx_load_a(a1, kbase, min(wave + NWAVES, j)); idx_load_a(a2, kbase, min(wave + 2 * NWAVES, j)); \
        if (wave <= j) { float sc[16]; f32x16 acc0, acc1, acc2, acc3; int kbp = wave; \
            idx_half1<false>(sc, acc0, acc1, acc2, acc3, a0, bq, wv); idx_half2(sc, acc0, acc1, acc2, acc3, a0, bq, wv); idx_load_a(a0, kbase, min(wave + 3 * NWAVES, j)); \
            for (int kb_ = wave + NWAVES;;) { \
                if (kb_ > j) break; IX_STEP(a1, kb_, __VA_ARGS__); kb_ += NWAVES; \
                if (kb_ > j) break; IX_STEP(a2, kb_, __VA_ARGS__); kb_ += NWAVES; \
                if (kb_ > j) break; IX_STEP(a0, kb_, __VA_ARGS__); kb_ += NWAVES; } \
            idx_tail(sc, acc2, acc3, wv); IX_BODY(kbp, __VA_ARGS__); } } while (0)
    float ts = -3.402823466e38f, ti = -3.402823466e38f; unsigned mbase = 0u;
    if (j >= 8) for (int ra_ = 0; ra_ < 1 + (IX_DUP & 1); ++ra_) {
        IX_PASS({
            _Pragma("unroll") for (int r = 0; r < 16; r += 2) { unsigned u; asm("v_cvt_pkrtz_f16_f32 %0, %1, %2" : "=v"(u) : "v"(sc[r]), "v"(sc[r + 1]));
                unsigned a0, a1; asm("v_lshl_add_u32 %0, %1, 2, %2" : "=v"(a0) : "v"((u >> 6) & 1023u), "v"(myrow_b)); asm("v_lshl_add_u32 %0, %1, 2, %2" : "=v"(a1) : "v"(u >> 22), "v"(myrow_b));
                __hip_atomic_fetch_add((LAS unsigned*)a0, 1u, __ATOMIC_RELAXED, __HIP_MEMORY_SCOPE_WORKGROUP); __hip_atomic_fetch_add((LAS unsigned*)a1, 1u, __ATOMIC_RELAXED, __HIP_MEMORY_SCOPE_WORKGROUP); } });
        __syncthreads();
#pragma unroll 1
        for (int qq = wave * 4; qq < wave * 4 + 4; ++qq) { unsigned bn, nd; idx_scan<false>(hist + qq * IX_HS, true, 256u, lane, bn, nd);
            if (lane == 0) {
                float tsv, tiv;
                if (bn < 512u) { tiv = ix_h2f(bn << 6); tsv = ix_h2f((bn + 1u) << 6); }
                else { const unsigned mb = bn - 512u; const float mlo = ix_h2f(mb << 6), mhi = ix_h2f((mb + 1u) << 6);
                    tsv = (mlo == 0.f) ? 0.f : __uint_as_float(__float_as_uint(-mlo) - 1u); tiv = __uint_as_float(__float_as_uint(-mhi) - 1u); }
                st[qq] = bn; st[32 + qq] = nd; st[64 + qq] = __float_as_uint(tsv); st[96 + qq] = __float_as_uint(tiv); st[128 + qq] = ix_mono(__float_as_uint(tiv)); st[160 + qq] = 0u; } }
        __syncthreads();
        ts = __uint_as_float(st[64 + r32]); ti = __uint_as_float(st[96 + r32]); mbase = st[128 + r32];
    }
    unsigned short* mrow = (unsigned short*)(MASK + (((size_t)b * 256 + j) * 128) * 64);
    for (int rd_ = 0; rd_ < 1 + ((IX_DUP >> 1) & 1); ++rd_) { if (rd_) { __syncthreads(); if (F.tid < 32) st[160 + F.tid] = 0u; __syncthreads(); }
    IX_PASS({
            unsigned w16 = 0u, c16 = 0u;
            _Pragma("unroll") for (int r = 15; r >= 0; --r) asm("v_cmp_ge_f32_e32 vcc, %2, %3\n\tv_addc_co_u32_e32 %0, vcc, %0, %0, vcc\n\tv_cmp_ge_f32_e32 vcc, %2, %4\n\tv_addc_co_u32_e32 %1, vcc, %1, %1, vcc" : "+v"(w16), "+v"(c16) : "v"(sc[r]), "v"(ts), "v"(ti) : "vcc");
            mrow[(((size_t)(kb >> 1) * 64 + lane) << 1) + (kb & 1)] = (unsigned short)w16;
            const unsigned cm = c16 & ~w16;
            if (cm) { unsigned base = __hip_atomic_fetch_add(st + 160 + r32, (unsigned)__builtin_popcount(cm), __ATOMIC_RELAXED, __HIP_MEMORY_SCOPE_WORKGROUP);
                _Pragma("unroll 1") for (unsigned cmv = cm; cmv; cmv &= cmv - 1u) { const unsigned r = (unsigned)__builtin_ctz(cmv); const unsigned d = ix_mono(ix_pick(sc, r)) - mbase;
                        if (base < (unsigned)IX_CAP) myrow[base] = (min(d, 0x7ffffu) << 13) | (8191u - (32u * (unsigned)kb + (r & 3u) + 8u * (r >> 2) + 4u * (unsigned)hi)); ++base; } } });
    }
    for (int kb = j + 1 + wave; kb <= (j | 7); kb += NWAVES) mrow[(((size_t)(kb >> 1) * 64 + lane) << 1) + (kb & 1)] = (unsigned short)0;
    asm volatile("s_waitcnt vmcnt(0)" ::: "memory");
    __syncthreads();
    if (j >= 8) {
#pragma unroll 1
        for (int qq = wave * 4; qq < wave * 4 + 4; ++qq) { LAS unsigned* row = hist + qq * IX_HS; const unsigned n = min(st[160 + qq], (unsigned)IX_CAP), need = st[32 + qq];
            const int ns = (int)((n + 63u) >> 6); unsigned T = 0u;
            if (ns <= 2) T = idx_select<2>(row, n, need, lane); else if (ns <= 4) T = idx_select<4>(row, n, need, lane); else if (ns <= 8) T = idx_select<8>(row, n, need, lane); else T = idx_select<16>(row, n, need, lane);
            for (int s = 0; s < ns; ++s) { const unsigned idx = (unsigned)(s * 64 + lane);
                if (idx < n) { const unsigned v = row[idx]; row[idx] = 0u;
                    if (v >= T) { const unsigned key = 8191u - (v & 8191u), kbk = key >> 5, ko = key & 31u, rr = (ko & 3u) + 4u * (ko >> 3), hh = (ko >> 2) & 1u;
                        __hip_atomic_fetch_or((unsigned*)mrow + (size_t)(kbk >> 1) * 64 + hh * 32 + qq, 1u << (16u * (kbk & 1u) + rr), __ATOMIC_RELAXED, __HIP_MEMORY_SCOPE_AGENT); } } } }
        __syncthreads();
    }
#undef IX_PASS
#undef IX_STEP
#undef IX_BODY
#undef IX_LAUNDER
}
__device__ __forceinline__ void idx_unit_of(int u, int& b, int& j) { const int slot = u >> 8, v = u & 255, i = v & 63; b = v >> 6; j = slot == 0 ? 255 - i : slot == 1 ? 128 + i : slot == 2 ? 127 - i : i; }

#include <hip/hip_bf16.h>
namespace attn_body {
using bf16=__hip_bfloat16;
using bf16x8=__attribute__((ext_vector_type(8)))short;
using s16x4=__attribute__((ext_vector_type(4)))short;
using f32x16=__attribute__((ext_vector_type(16)))float;
using u32x4=__attribute__((ext_vector_type(4)))unsigned;
constexpr int BATCH=4,NHEAD=8,SEQ=8192,D=64,DM=NHEAD*D,OPITCH=1024;
constexpr int NW=8,QBLK=32,QB=QBLK*NW,KVBLK=64,NQB=SEQ/QB;
constexpr int ATTN_PITCH=DM, ATTN_UNIT_ROWS=QB;
__device__ __forceinline__ int crow(int r,int hi){return (r&3)+8*(r>>2)+4*hi;}
#define SBAR() __builtin_amdgcn_sched_barrier(0)
#define MASK1(p,w,e) ({ unsigned m_; asm("v_bfe_i32 %0, %1, %2, 1":"=v"(m_):"v"(w),"n"(e)); __uint_as_float(__float_as_uint(p)&m_); })

constexpr int NSLOT=3, SLOTB=8192;
constexpr int LDS_K=0, LDS_V=NSLOT*SLOTB, LDS_WS=2*NSLOT*SLOTB, LDS_OST=LDS_WS+NW*64*4, LDS_BYTES=LDS_OST+NW*4096;
constexpr float C2=0.125f*1.4426950408889634f;
__device__ __forceinline__ void glds16(const void*gsrc,unsigned lds_dst){unsigned keep;
  asm volatile("s_mov_b32 %0, m0\n\ts_mov_b32 m0, %2\n\ts_nop 0\n\tglobal_load_lds_dwordx4 %1, off\n\ts_mov_b32 m0, %0":"=&s"(keep):"v"(gsrc),"s"(lds_dst):"memory");}
__device__ __forceinline__ float max3f(float a,float b,float c){float r;asm("v_max3_f32 %0, %1, %2, %3":"=v"(r):"v"(a),"v"(b),"v"(c));return r;}
__device__ __forceinline__ float max2f(float a,float b){float r;asm("v_max_f32_e32 %0, %1, %2":"=v"(r):"v"(a),"v"(b));return r;}
__device__ __forceinline__ float fadd_s(float a,float b){float r;asm("v_add_f32_e32 %0, %1, %2":"=v"(r):"v"(a),"v"(b));return r;}
__device__ __forceinline__ float fsub_s(float a,float b){float r;asm("v_sub_f32_e32 %0, %1, %2":"=v"(r):"v"(a),"v"(b));return r;}
typedef float f32x2_t __attribute__((ext_vector_type(2))); typedef __bf16 bf16x2_t __attribute__((ext_vector_type(2)));
__device__ __forceinline__ unsigned cvtpk_s(float lo,float hi){f32x2_t v={lo,hi};bf16x2_t b=__builtin_convertvector(v,bf16x2_t);return __builtin_bit_cast(unsigned,b);}
#define WAIT_BAR(N) asm volatile("s_waitcnt vmcnt(" #N ") lgkmcnt(0)\n\ts_barrier":::"memory")

__device__ __forceinline__ void qkt(f32x16&p0,f32x16&p1,const char*Kslot,const bf16x8*qr,const f32x16&negm,int r32,int hi){
  const char*kb=Kslot+hi*1024+r32*16;
  #pragma unroll
  for(int d0=0;d0<4;++d0){
    const bf16x8 b0=*reinterpret_cast<const bf16x8*>(kb+d0*2048);
    const bf16x8 b1=*reinterpret_cast<const bf16x8*>(kb+d0*2048+512);
    if(d0==0){p0=__builtin_amdgcn_mfma_f32_32x32x16_bf16(b0,qr[0],negm,0,0,0);p1=__builtin_amdgcn_mfma_f32_32x32x16_bf16(b1,qr[0],negm,0,0,0);}
    else{p0=__builtin_amdgcn_mfma_f32_32x32x16_bf16(b0,qr[d0],p0,0,0,0);p1=__builtin_amdgcn_mfma_f32_32x32x16_bf16(b1,qr[d0],p1,0,0,0);}}
}
typedef __attribute__((address_space(3))) const char* lds_cptr;
typedef short v4i16_t __attribute__((ext_vector_type(4)));
__device__ __forceinline__ void kload8(bf16x8*kf,lds_cptr kp){
  kf[0]=*(const __attribute__((address_space(3))) bf16x8*)(kp);      kf[1]=*(const __attribute__((address_space(3))) bf16x8*)(kp+512);
  kf[2]=*(const __attribute__((address_space(3))) bf16x8*)(kp+2048); kf[3]=*(const __attribute__((address_space(3))) bf16x8*)(kp+2560);
  kf[4]=*(const __attribute__((address_space(3))) bf16x8*)(kp+4096); kf[5]=*(const __attribute__((address_space(3))) bf16x8*)(kp+4608);
  kf[6]=*(const __attribute__((address_space(3))) bf16x8*)(kp+6144); kf[7]=*(const __attribute__((address_space(3))) bf16x8*)(kp+6656);
}
__device__ __forceinline__ void kload2(bf16x8*kf,lds_cptr kp,int j){ kf[2*j]=*(const __attribute__((address_space(3))) bf16x8*)(kp+j*2048); kf[2*j+1]=*(const __attribute__((address_space(3))) bf16x8*)(kp+j*2048+512); }
__device__ __forceinline__ s16x4 vtr(lds_cptr p){ return __builtin_bit_cast(s16x4,__builtin_amdgcn_ds_read_tr16_b64_v4i16((__attribute__((address_space(3))) v4i16_t*)p)); }
__device__ __forceinline__ float rowmax(const f32x16&p0,const f32x16&p1){
  float a=max3f(p0[0],p0[1],p1[0]),b=max3f(p0[2],p0[3],p1[1]);a=max3f(a,p1[2],p1[3]);
  #pragma unroll
  for(int r=4;r<16;r+=4){a=max3f(a,p0[r],p0[r+1]);b=max3f(b,p0[r+2],p0[r+3]);a=max3f(a,p1[r],p1[r+1]);b=max3f(b,p1[r+2],p1[r+3]);}
  const float m=max2f(a,b);
  auto rr=__builtin_amdgcn_permlane32_swap(__float_as_uint(m),__float_as_uint(m),false,false);
  return max2f(__uint_as_float(rr[0]),__uint_as_float(rr[1]));
}
__device__ __forceinline__ void pv(f32x16*o,int vb,bf16x8 pa0,bf16x8 pa1,bf16x8 pa2,bf16x8 pa3){
  #pragma unroll
  for(int d0=0;d0<2;++d0){s16x4 lo[4],hi[4];
    #pragma unroll
    for(int ks=0;ks<4;++ks){
      asm volatile("ds_read_b64_tr_b16 %0,%1 offset:%c2":"=&v"(lo[ks]):"v"(vb),"i"(d0*4096+ks*1024):"memory");
      asm volatile("ds_read_b64_tr_b16 %0,%1 offset:%c2":"=&v"(hi[ks]):"v"(vb),"i"(d0*4096+ks*1024+512):"memory");}
    asm volatile("s_waitcnt lgkmcnt(0)":::"memory");SBAR();
    #define PK(k) (bf16x8){lo[k][0],lo[k][1],lo[k][2],lo[k][3],hi[k][0],hi[k][1],hi[k][2],hi[k][3]}
    o[d0]=__builtin_amdgcn_mfma_f32_32x32x16_bf16(pa0,PK(0),o[d0],0,0,0);
    o[d0]=__builtin_amdgcn_mfma_f32_32x32x16_bf16(pa1,PK(1),o[d0],0,0,0);
    o[d0]=__builtin_amdgcn_mfma_f32_32x32x16_bf16(pa2,PK(2),o[d0],0,0,0);
    o[d0]=__builtin_amdgcn_mfma_f32_32x32x16_bf16(pa3,PK(3),o[d0],0,0,0);
    #undef PK
  }
}

#ifndef ATTN_STORE16
#define ATTN_STORE16(p,v) (*(u32x4*)(p)=(v))
#endif
template<int THRL> __device__ __forceinline__ void attn_unit(int b,int h,int qb,const bf16*Q,const bf16*__restrict__ K,const bf16*__restrict__ V,bf16*O,const unsigned*MASK,char*shm){
  int tid_=threadIdx.x; asm volatile("":"+v"(tid_));
  const int tid=tid_,lane=tid&63,r32=lane&31,hi=lane>>5; const int wid=__builtin_amdgcn_readfirstlane(tid>>6);
  const long rowbase=(long)b*SEQ; const int q0=qb*QB;
  const bf16*Qw=Q+(rowbase+q0+wid*QBLK)*DM+h*D;
  const bf16*Kh=K+rowbase*DM+h*D,*Vh=V+rowbase*DM+h*D;
  const unsigned lds0=(unsigned)(uintptr_t)shm;
  float*wsf=(float*)(shm+LDS_WS)+wid*64;
  const bf16*ksrc=Kh+(long)lane*DM+wid*8;
  const bf16*vsrc=Vh+(long)(16*(wid&3)+(lane>>2))*DM+(wid>>2)*32+(lane&3)*8;
  const unsigned kdst=lds0+LDS_K+wid*1024, vdst=lds0+LDS_V+wid*1024;
  #define DMA_K(t,slot) glds16(ksrc+(long)(t)*KVBLK*DM,(unsigned)__builtin_amdgcn_readfirstlane(kdst+(slot)))
  #define DMA_V(t,slot) glds16(vsrc+(long)(t)*KVBLK*DM,(unsigned)__builtin_amdgcn_readfirstlane(vdst+(slot)))
  const int vb0=(int)(lds0+LDS_V)+((lane>>4)&1)*32+(lane&3)*8+(4*hi+((lane&15)>>2))*64;
  const char*Kbase=shm+LDS_K; bf16x8 kf[8];
  const lds_cptr shm3=(lds_cptr)shm; const lds_cptr kp0=shm3+LDS_K+hi*1024+r32*16; const lds_cptr vp0=shm3+LDS_V+((lane>>4)&1)*32+(lane&3)*8+(4*hi+((lane&15)>>2))*64;
  const int NT=(q0+QB)/KVBLK;
  const unsigned*mwl=MASK+((size_t)(b*256+qb*8+wid)*128)*64+lane;
  unsigned wA,wB;
  #define WLOAD(W,t) asm volatile("global_load_dword %0, %1, off":"=v"(W):"v"(mwl+(size_t)(t)*64):"memory")
  WLOAD(wA,0);WLOAD(wB,1);
  DMA_K(0,0);DMA_V(0,0);DMA_K(1,SLOTB);
  bf16x8 qr[4];
  #pragma unroll
  for(int d0=0;d0<4;++d0)qr[d0]=*reinterpret_cast<const bf16x8*>(&Qw[(long)r32*DM+d0*16+hi*8]);
  float mhat=0.f,l_reg=0.f;f32x16 o[2];o[0]=f32x16{};o[1]=f32x16{};f32x16 negm=f32x16{};asm volatile("":"+v"(negm));
  bool resc=false;
  #define START(P0,P1) do{ const float rm=rowmax(P0,P1); resc=false; \
    { const float dl=rm>-1e30f?rm:0.f; mhat=fadd_s(mhat,dl); \
      _Pragma("unroll") for(int r=0;r<16;++r){P0[r]=fsub_s(P0[r],dl);P1[r]=fsub_s(P1[r],dl);} \
      _Pragma("unroll") for(int r=0;r<16;++r)negm[r]=-mhat; asm volatile("":"+v"(negm)); } \
    _Pragma("unroll") for(int r=0;r<16;++r)P0[r]=__builtin_amdgcn_exp2f(P0[r]); }while(0)
  #define RESC() do{ if(resc){ asm volatile("s_waitcnt lgkmcnt(0)":::"memory"); \
      _Pragma("unroll") for(int d_=0;d_<2;++d_) _Pragma("unroll") for(int r=0;r<16;++r)o[d_][r]*=wsf[crow(r,hi)]; } }while(0)
  f32x16 pA0,pA1,pB0,pB1;
  int sl_prev=0,sl_cur=0,sl_next=SLOTB;
  #define ROT() do{sl_prev=sl_cur;sl_cur=sl_next;sl_next=(sl_next==(NSLOT-1)*SLOTB)?0:sl_next+SLOTB;}while(0)
  DMA_K(2,2*SLOTB);
  WAIT_BAR(3);
  qkt(pA0,pA1,Kbase,qr,negm,r32,hi);asm volatile("s_nop 15\n\ts_nop 7":"+v"(pA0),"+v"(pA1));
  START(pA0,pA1);
  _Pragma("unroll") for(int r=0;r<16;++r)pA1[r]=__builtin_amdgcn_exp2f(pA1[r]);
  _Pragma("unroll") for(int r=0;r<16;++r){pA0[r]=MASK1(pA0[r],wA,r);pA1[r]=MASK1(pA1[r],wA,16+r);}
  WAIT_BAR(0);
  DMA_K(3,0);DMA_V(1,SLOTB);
  ROT();
  kload8(kf,kp0+sl_cur);
  WAIT_BAR(2);
  s16x4 vlo[8],vhi[8]; u32x4 pw0,pw1,pw2,pw3;
  #define PKW(P,B) cvtpk_s(P[B],P[B+1])
  #define PAF(k) __builtin_bit_cast(bf16x8,pw##k)
  #define VFR(i) (bf16x8){vlo[i][0],vlo[i][1],vlo[i][2],vlo[i][3],vhi[i][0],vhi[i][1],vhi[i][2],vhi[i][3]}
  #define PIN(x) asm volatile("":"+v"(x))
  #define MX3(a,b,c) __builtin_fmaxf(__builtin_fmaxf((a),(b)),(c))
  #define GAPA(MF,A0,A1,A2,A3,W0,W1,PW) do{ MF; sacc+=A0; sacc+=A1; sacc+=A2; sacc+=A3; PIN(sacc); W0; W1; PIN(PW); SBAR(); }while(0)
  #define EX(v) __builtin_amdgcn_exp2f(v)
  #define BFE1(m,w,e) asm("v_bfe_i32 %0, %1, %2, 1":"=v"(m):"v"(w),"n"(e))
  #define AND1(x,m) __uint_as_float(__float_as_uint(x)&(m))
  #define GAPB(MF,X,B,W,E) do{ MF; unsigned m0_,m1_,m2_,m3_; \
      const float e0_=EX(X[B]); SBAR(); BFE1(m0_,W,(E)); SBAR(); const float e1_=EX(X[B+1]); SBAR(); BFE1(m1_,W,(E)+1); SBAR(); X[B]=AND1(e0_,m0_); SBAR(); \
      const float e2_=EX(X[B+2]); SBAR(); BFE1(m2_,W,(E)+2); SBAR(); X[B+1]=AND1(e1_,m1_); SBAR(); const float e3_=EX(X[B+3]); SBAR(); BFE1(m3_,W,(E)+3); SBAR(); X[B+2]=AND1(e2_,m2_); SBAR(); X[B+3]=AND1(e3_,m3_); PIN(X); SBAR(); }while(0)
  #define VRD(i) do{ vlo[i]=vtr(vp_+(((i)>>2)*4096+((i)&3)*1024)); vhi[i]=vtr(vp_+(((i)>>2)*4096+((i)&3)*1024+512)); }while(0)
  #define KRD(G,j) do{ if(G){ kload2(kf,kp0+sl_next,j); SBAR(); } }while(0)
  #define STEP(C0,C1,P0,P1,t,GK,GV,GL,WU,WL) do{ SBAR(); if((t)+1<NT){WLOAD(WL,(t)+1);} SBAR(); \
    const lds_cptr vp_=vp0+sl_prev; \
    VRD(0); SBAR(); float sacc=(P0[0]+P0[1]); \
    GAPA(C0=__builtin_amdgcn_mfma_f32_32x32x16_bf16(kf[0],qr[0],negm,0,0,0), P0[2],P0[3],P0[4],P0[5],     pw0[0]=PKW(P0,0), pw0[1]=PKW(P0,2), pw0); \
    VRD(4); SBAR(); GAPA(C1=__builtin_amdgcn_mfma_f32_32x32x16_bf16(kf[1],qr[0],negm,0,0,0), P0[6],P0[7],P0[8],P0[9],     pw0[2]=PKW(P0,4), pw0[3]=PKW(P0,6), pw0); \
    VRD(1); SBAR(); GAPA(C0=__builtin_amdgcn_mfma_f32_32x32x16_bf16(kf[2],qr[1],C0,0,0,0),   P0[10],P0[11],P0[12],P0[13], pw1[0]=PKW(P0,8), pw1[1]=PKW(P0,10), pw1); \
    VRD(5); SBAR(); GAPA(C1=__builtin_amdgcn_mfma_f32_32x32x16_bf16(kf[3],qr[1],C1,0,0,0),   P0[14],P0[15],P1[0],P1[1],   pw1[2]=PKW(P0,12),pw1[3]=PKW(P0,14), pw1); \
    VRD(2); SBAR(); GAPA(C0=__builtin_amdgcn_mfma_f32_32x32x16_bf16(kf[4],qr[2],C0,0,0,0),   P1[2],P1[3],P1[4],P1[5],     pw2[0]=PKW(P1,0), pw2[1]=PKW(P1,2), pw2); \
    VRD(6); SBAR(); GAPA(C1=__builtin_amdgcn_mfma_f32_32x32x16_bf16(kf[5],qr[2],C1,0,0,0),   P1[6],P1[7],P1[8],P1[9],     pw2[2]=PKW(P1,4), pw2[3]=PKW(P1,6), pw2); \
    VRD(3); SBAR(); GAPA(C0=__builtin_amdgcn_mfma_f32_32x32x16_bf16(kf[6],qr[3],C0,0,0,0),   P1[10],P1[11],P1[12],P1[13], pw3[0]=PKW(P1,8), pw3[1]=PKW(P1,10), pw3); \
    VRD(7); SBAR(); GAPA(C1=__builtin_amdgcn_mfma_f32_32x32x16_bf16(kf[7],qr[3],C1,0,0,0),   P1[14],P1[15],0.f,0.f,       pw3[2]=PKW(P1,12),pw3[3]=PKW(P1,14), pw3); \
    l_reg+=sacc; \
    if(GK){DMA_K((t)+3,sl_cur);} if(GV){DMA_V((t)+1,sl_next);} \
    { float a=MX3(C0[0],C0[1],C1[0]),b=MX3(C0[2],C0[3],C1[1]); a=MX3(a,C1[2],C1[3]); \
      _Pragma("unroll") for(int r=4;r<16;r+=4){a=MX3(a,C0[r],C0[r+1]);b=MX3(b,C0[r+2],C0[r+3]);a=MX3(a,C1[r],C1[r+1]);b=MX3(b,C1[r+2],C1[r+3]);} \
      float rm=__builtin_fmaxf(a,b); { auto rr=__builtin_amdgcn_permlane32_swap(__float_as_uint(rm),__float_as_uint(rm),false,false); rm=__builtin_fmaxf(__uint_as_float(rr[0]),__uint_as_float(rr[1])); } \
      resc=false; \
      if(__builtin_expect(__any(rm>(float)THRL),0)){ const float dl=__builtin_fmaxf(rm,0.f); mhat+=dl; \
        _Pragma("unroll") for(int r=0;r<16;++r){C0[r]-=dl;C1[r]-=dl;} \
        _Pragma("unroll") for(int r=0;r<16;++r)negm[r]=-mhat; asm volatile("":"+v"(negm)); \
        const float f=__builtin_amdgcn_exp2f(-dl); l_reg*=f; if(hi==0)wsf[r32]=f; resc=true; } } \
    SBAR(); \
    GAPB(o[0]=__builtin_amdgcn_mfma_f32_32x32x16_bf16(PAF(0),VFR(0),o[0],0,0,0), C0,0,WU,0); \
    GAPB(o[1]=__builtin_amdgcn_mfma_f32_32x32x16_bf16(PAF(0),VFR(4),o[1],0,0,0), C0,4,WU,4); \
    KRD(GL,0); GAPB(o[0]=__builtin_amdgcn_mfma_f32_32x32x16_bf16(PAF(1),VFR(1),o[0],0,0,0), C0,8,WU,8); \
    KRD(GL,1); GAPB(o[1]=__builtin_amdgcn_mfma_f32_32x32x16_bf16(PAF(1),VFR(5),o[1],0,0,0), C0,12,WU,12); \
    KRD(GL,2); GAPB(o[0]=__builtin_amdgcn_mfma_f32_32x32x16_bf16(PAF(2),VFR(2),o[0],0,0,0), C1,0,WU,16); \
    KRD(GL,3); GAPB(o[1]=__builtin_amdgcn_mfma_f32_32x32x16_bf16(PAF(2),VFR(6),o[1],0,0,0), C1,4,WU,20); \
    GAPB(o[0]=__builtin_amdgcn_mfma_f32_32x32x16_bf16(PAF(3),VFR(3),o[0],0,0,0), C1,8,WU,24); \
    GAPB(o[1]=__builtin_amdgcn_mfma_f32_32x32x16_bf16(PAF(3),VFR(7),o[1],0,0,0), C1,12,WU,28); \
    }while(0)
  int t=1;
  for(;t+5<NT;t+=2){
    STEP(pB0,pB1,pA0,pA1,t,true,true,true,wB,wA);     WAIT_BAR(2); RESC(); ROT();
    STEP(pA0,pA1,pB0,pB1,t+1,true,true,true,wA,wB);   WAIT_BAR(2); RESC(); ROT();
  }
  #define ENDW(tt) do{ if((tt)+3<NT){WAIT_BAR(2);} else if((tt)+2<NT){WAIT_BAR(1);} else {WAIT_BAR(0);} }while(0)
  for(;t+1<NT;t+=2){
    STEP(pB0,pB1,pA0,pA1,t,(t+3<NT),(t+1<NT),(t+1<NT),wB,wA);       ENDW(t);   RESC(); ROT();
    STEP(pA0,pA1,pB0,pB1,t+1,(t+4<NT),(t+2<NT),(t+2<NT),wA,wB);     ENDW(t+1); RESC(); ROT();
  }
  STEP(pB0,pB1,pA0,pA1,NT-1,false,false,false,wB,wA); RESC();
  { float sacc=pB0[0]+pB0[1]; _Pragma("unroll") for(int r=2;r<16;++r)sacc+=pB0[r]; _Pragma("unroll") for(int r=0;r<16;++r)sacc+=pB1[r]; l_reg+=sacc;
    pw0=(u32x4){PKW(pB0,0),PKW(pB0,2),PKW(pB0,4),PKW(pB0,6)};pw1=(u32x4){PKW(pB0,8),PKW(pB0,10),PKW(pB0,12),PKW(pB0,14)};pw2=(u32x4){PKW(pB1,0),PKW(pB1,2),PKW(pB1,4),PKW(pB1,6)};pw3=(u32x4){PKW(pB1,8),PKW(pB1,10),PKW(pB1,12),PKW(pB1,14)};
    SBAR(); pv(o,vb0+sl_cur,PAF(0),PAF(1),PAF(2),PAF(3)); }
  #undef PKW
  #undef PAF
  #undef VFR
  #undef PIN
  #undef MX3
  #undef GAPA
  #undef GAPB
  #undef EX
  #undef VRD
  #undef KRD
  #undef STEP
  #undef ENDW
  {auto rr=__builtin_amdgcn_permlane32_swap(__float_as_uint(l_reg),__float_as_uint(l_reg),false,false);l_reg=__uint_as_float(rr[0])+__uint_as_float(rr[1]);}
  if(hi==0)wsf[32+r32]=l_reg;asm volatile("s_waitcnt lgkmcnt(0)":::"memory");
  float rli[16];
  #pragma unroll
  for(int r=0;r<16;++r)rli[r]=__builtin_amdgcn_rcpf(wsf[32+crow(r,hi)]);
  bf16*Ow=O+(rowbase+q0+wid*QBLK)*OPITCH+h*D;
  { bf16*stg=(bf16*)(shm+LDS_OST)+wid*2048;
    #pragma unroll
    for(int r=0;r<16;++r){const int orow=crow(r,hi);
      #pragma unroll
      for(int d0=0;d0<2;++d0)stg[orow*64+d0*32+r32]=__float2bfloat16(o[d0][r]*rli[r]);}
    asm volatile("s_waitcnt lgkmcnt(0)":::"memory");
    #pragma unroll
    for(int i=0;i<4;++i){const int row=i*8+(lane>>3),ch=lane&7; const u32x4 v=*(const u32x4*)(stg+row*64+ch*8); ATTN_STORE16(Ow+(long)row*OPITCH+ch*8,v);} }
  asm volatile("s_waitcnt lgkmcnt(0)\n\ts_barrier":::"memory");
  #undef DMA_K
  #undef DMA_V
  #undef WLOAD
  #undef START
  #undef RESC
  #undef ROT
}
constexpr int ATTN_LDS_BYTES=LDS_BYTES;
struct AttnTensors { const bf16* Q; const bf16* K; const bf16* V; bf16* O; const unsigned* MASK; };
struct AttnUnit { int bh; int qb; };
struct StaticOrder {
  int vcu;
  int grid;
  __device__ __forceinline__ explicit StaticOrder(int grid_,int block):vcu((grid_%8==0)?(block%8)*(grid_/8)+block/8:block),grid(grid_){}
  __device__ __forceinline__ bool next(int i,AttnUnit&u)const{ const int v=vcu+(i>>2)*grid; if(v>=256)return false; const int k=i&3,s=v&7; u.bh=v>>3; u.qb=(k==0)?s:(k==1)?15-s:(k==2)?16+s:31-s; return true; }
  __device__ __forceinline__ void a_ready(const AttnUnit&)const{}
  __device__ __forceinline__ void done(const AttnUnit&)const{}
};
template<class Sched,int THRL=8> __device__ __forceinline__ void attn_phase(char*lds,const AttnTensors&T,const Sched&S){
  AttnUnit u;
  for(int i=0;S.next(i,u);++i){ S.a_ready(u); attn_unit<THRL>(u.bh/NHEAD,u.bh%NHEAD,u.qb,T.Q,T.K,T.V,T.O,T.MASK,lds); S.done(u); }
}
#undef SBAR
#undef WAIT_BAR
}

#ifndef MK_EN
#define MK_EN 0x3ff
#endif
#define EN(n) (((MK_EN) >> (n)) & 1)
#ifndef MK_NAIVE_SELECT
#define MK_NAIVE_SELECT 0
#endif
#ifndef MK_NAIVE_ATTN
#define MK_NAIVE_ATTN 0
#endif
#ifndef MK_DUP
#define MK_DUP 0
#endif
#ifndef MK_REPN
#define MK_REPN 1
#endif
#define REP(n) for (int rep_ = 0; rep_ < 1 + MK_REPN * (((MK_DUP) >> (n)) & 1); ++rep_)
#ifndef MK_ONE_LAUNCH
#define MK_ONE_LAUNCH 1
#endif
__device__ __forceinline__ bool static_unit(int nM, int nN, int G, int c, int i, int& pm, int& pn) {
    const int nwg = nM * nN; const long L = (long)i * G + c; if (L >= nwg) return false;
    int wgid = (int)L; { const int q = nwg / 8, r = nwg % 8, xcd = wgid % 8, off = wgid / 8; wgid = (xcd < r ? xcd * (q + 1) : r * (q + 1) + (xcd - r) * q) + off; }
    const int nig = 8 * nN, gid = wgid / nig, fm = gid * 8, gsz = (nM - fm) < 8 ? (nM - fm) : 8;
    pm = fm + ((wgid % nig) % gsz); pn = (wgid % nig) / gsz; return true;
}
__global__ void __launch_bounds__(NWAVES * 64, 2) mk_fwd(Args args) {
    extern __shared__ __attribute__((aligned(16))) unsigned char lds[];
    Frame F;
    F.lds = (LAS unsigned char*)lds; F.MISC = (volatile LAS unsigned*)(F.lds + MISC_OFF);
    F.tid = threadIdx.x; F.lane = F.tid & 63; F.wave = __builtin_amdgcn_readfirstlane(F.tid >> 6);
    F.G = gridDim.x; { const int bx = blockIdx.x; F.vcu = (F.G % 8 == 0) ? (bx % 8) * (F.G / 8) + bx / 8 : bx; }
    KArgs A = (KArgs)__builtin_amdgcn_kernarg_segment_ptr();
    unsigned char* ws = A->ws; F.ws = ws; F.ctl = (gu32*)(ws + WS_CTL);
#define PHASE_BEGIN() do { int t_ = threadIdx.x; asm volatile("" : "+v"(t_)); F.tid = t_; F.lane = t_ & 63; F.wave = __builtin_amdgcn_readfirstlane(t_ >> 6); \
        A = (KArgs)__builtin_amdgcn_kernarg_segment_ptr(); asm volatile("" : "+s"(A)); ws = A->ws; F.ws = ws; F.ctl = (gu32*)(ws + WS_CTL); } while (0)
    for (int u = F.tid; u < (LDS_BYTES - LDSCTL_OFF) / 4; u += NWAVES * 64) ((LAS unsigned*)(F.lds + LDSCTL_OFF))[u] = 0u;
    __syncthreads();
    const int lo = A->ph_lo, hi = A->ph_hi;
    XcdBarrier bar; bar.bar = (unsigned*)(F.ctl + CW_BAR); bar.x = 0; bar.st = nullptr;
    if (hi - lo > 1) bar = xcd_barrier_post((unsigned*)(F.ctl + CW_BAR), F.MISC + 8);
#define IN(k) (lo <= (k) && (k) < hi)
#define SEAM(k) do { if (IN(k) && IN((k) + 1)) xcd_barrier(bar); } while (0)
#define X ((bf16*)(ws + WS_X))
#define SSV(k) ((float*)(ws + WS_SS + (size_t)((k) & 1) * SS_STAGE))

    if (EN(0) && IN(0)) { PHASE_BEGIN(); REP(0) p0_prologue(F, A); SEAM(0); }
    for (int l = 0; l < DEPTH; ++l) {
        const int pb = 2 + 11 * l;
#define FFN_UP(PH, WGU, SSIN, F8C) if (EN(2) && IN(PH)) { PHASE_BEGIN(); unsigned char* wl = ws + WS_W + (size_t)l * W_LAYER; \
            pg8::StaticOrder S; S.init(M, NGU, F.G, (int)blockIdx.x); \
            if (F8C) { pg8::Gemm g{(const bf16*)(ws + WS_X8), (const bf16*)(wl + (WGU)), M, NGU, D / 2}; pg8::EpiSwiGLU E{(bf16*)(ws + WS_H), SSV(SSIN), 1.f / 64.f};     \
                REP(2) pg8::gemm_phase<pg8::EpiSwiGLU, pg8::StaticOrder, true, true, true>(F.lds + RING_OFF, g, S, E); } \
            else { pg8::Gemm g{X, (const bf16*)(wl + (WGU)), M, NGU, D}; pg8::EpiSwiGLU E{(bf16*)(ws + WS_H), SSV(SSIN), 1.f}; \
                REP(2) pg8::gemm_phase<pg8::EpiSwiGLU, pg8::StaticOrder, true, true>(F.lds + RING_OFF, g, S, E); } SEAM(PH); }
#define GEMM_RES(PH, A, W, KK, SSOUT, SCALE, F8, WX8, AB) if (EN(3) && IN(PH)) { PHASE_BEGIN(); unsigned char* wl = ws + WS_W + (size_t)l * W_LAYER; \
            pg8::Gemm g{(const bf16*)(A), (const bf16*)(wl + (W)), M, D, (KK)}; pg8::StaticOrder S; S.init(M, D, F.G, (int)blockIdx.x); \
            REP(3) { const pg8::EpiRes<WX8> E{X, SSV(SSOUT), rep_ ? 0.f : (SCALE)}; pg8::gemm_phase<pg8::EpiRes<WX8>, pg8::StaticOrder, true, true, F8, AB>(F.lds + RING_OFF, g, S, E); } SEAM(PH); }
        FFN_UP(pb + 0, WO_GU1, 4 * l, false)
        GEMM_RES(pb + 1, ws + WS_H, WO_D1, FF / 2, 4 * l + 1, 0.5f / 64.f, true, false, true)
        if (EN(4) && IN(pb + 2)) { PHASE_BEGIN(); unsigned char* wl = ws + WS_W + (size_t)l * W_LAYER;
            pg8::Gemm g{(const bf16*)ws, (const bf16*)ws, M, NINP, D}; const pg8::WinKVOrder S{F.G, (int)blockIdx.x, (int)((WS_W + (size_t)l * W_LAYER + WO_IN) >> 19), l == 0 ? 64 : 0};
            const pg8::EpiWinKV E{ws, SSV(4 * l + 1), QSCALE, (int)((WS_W + (size_t)l * W_LAYER + WO_IN) >> 19)};
            REP(4) pg8::gemm_phase<pg8::EpiWinKV, pg8::WinKVOrder, true, true>(F.lds + RING_OFF, g, S, E); SEAM(pb + 2);
        }
        if (EN(5) && IN(pb + 3)) { PHASE_BEGIN(); REP(5) {
            REP(10) for (int u = F.vcu; u < M / 64; u += F.G) conv_a_unit(F, (const bf16*)(ws + WS_HG), (bf16*)(ws + WS_MIX), INF(A, I_CONF_DW) + l * 31 * 256, INF(A, I_CONF_DW_B) + l * 256, INF(A, I_CONF_LN_G) + l * 256, INF(A, I_CONF_LN_B) + l * 256, u);
            REP(11) conv_b_all(F, (const bf16*)(ws + WS_U), (const bf16*)(ws + WS_BG), (bf16*)(ws + WS_MIX), INF(A, I_SC_DW) + l * 3 * 256);
#if !MK_NAIVE_SELECT
            for (int u = F.tid; u < 32 * IX_HS + 192; u += NWAVES * 64) ((LAS unsigned*)(F.lds + RING_OFF))[u] = 0u;
            __syncthreads();
            for (int u = F.vcu; u < 1024; u += F.G) { int b, j; idx_unit_of(u, b, j); idx_unit(F, (const bf16*)(ws + WS_QI), (const bf16*)(ws + WS_KI), (const float*)(ws + WS_WI), (unsigned*)(ws + (l ? WS_MASK1 : WS_MASK)), b, j); }
#endif
            }
            SEAM(pb + 3);
        }
        if (EN(6) && IN(pb + 4)) { PHASE_BEGIN();
#if MK_NAIVE_SELECT
            for (int q = F.vcu; q < M; q += F.G) dsa_naive_query<false>(F, (const bf16*)(ws + WS_Q), (const bf16*)(ws + WS_K), (const bf16*)(ws + WS_V), (const bf16*)(ws + WS_QI), (const bf16*)(ws + WS_KI), (const float*)(ws + WS_WI), nullptr, (bf16*)(ws + WS_MIX), q);
#elif MK_NAIVE_ATTN
            for (int q = F.vcu; q < M; q += F.G) dsa_naive_query<true>(F, (const bf16*)(ws + WS_Q), (const bf16*)(ws + WS_K), (const bf16*)(ws + WS_V), (const bf16*)(ws + WS_QI), (const bf16*)(ws + WS_KI), (const float*)(ws + WS_WI), (const unsigned long long*)(ws + (l ? WS_MASK1 : WS_MASK)), (bf16*)(ws + WS_MIX), q);
#else
            { const attn_body::AttnTensors AT{(const attn_body::bf16*)(ws + WS_Q), (const attn_body::bf16*)(ws + WS_K), (const attn_body::bf16*)(ws + WS_V), (attn_body::bf16*)(ws + WS_MIX) + 512, (const unsigned*)(ws + (l ? WS_MASK1 : WS_MASK))};
              const attn_body::StaticOrder S((int)F.G, (int)blockIdx.x);
              REP(6) attn_body::attn_phase<attn_body::StaticOrder>((char*)lds + RING_OFF, AT, S); }
#endif
            SEAM(pb + 4);
        }
        GEMM_RES(pb + 5, ws + WS_MIX, WO_OUT, D, 4 * l + 2, 1.0f, false, true, false)
        if (EN(7) && IN(pb + 6)) { PHASE_BEGIN(); unsigned char* wl = ws + WS_W + (size_t)l * W_LAYER;
            pg8::Gemm g{(const bf16*)(ws + WS_X8), (const bf16*)(wl + WO_Q), M, D, D / 2}; pg8::StaticOrder S; S.init(M, D, F.G, (int)blockIdx.x);
            pg8::EpiRowScale E{(bf16*)(ws + WS_XQ), D, SSV(4 * l + 2), XQSCALE / 64.f};
            REP(7) pg8::gemm_phase<pg8::EpiRowScale, pg8::StaticOrder, true, true, true>(F.lds + RING_OFF, g, S, E);
            if (EN(8)) { PHASE_BEGIN(); for (int i = 0;; ++i) { int upm, upn; if (!static_unit(M / 256, D / 256, F.G, (int)blockIdx.x, i, upm, upn)) break; xattn_unit(F, (const bf16*)(ws + WS_XQ), ws + WS_XO8, (const bf16*)(ws + WS_MEMK) + (size_t)l * 1024 * 1024, (const bf16*)(ws + WS_MEMVT) + (size_t)l * 1024 * 1024, upm, upn); } }
            SEAM(pb + 6);
        }
        GEMM_RES(pb + 8, ws + WS_XO8, WO_O, D / 2, 4 * l + 3, 1.0f / 64.f, true, true, false)
        FFN_UP(pb + 9, WO_GU2, 4 * l + 3, l == GU8_LAYER)
        GEMM_RES(pb + 10, ws + WS_H, WO_D2, FF / 2, 4 * l + 4, 0.5f / 64.f, true, false, true)
    }
    if (EN(9) && IN(NPH - 1)) { PHASE_BEGIN(); final_norm_all(F, X, SSV(4 * DEPTH), INF(A, I_FINAL_NORM), A->out); }
#undef IN
#undef SEAM
#undef X
#undef SSV
}

extern "C" void kernel_launch(void* const* d_in, const int* in_sizes, int n_in, void* d_out, int out_size, void* d_ws, size_t ws_size, hipStream_t stream) {
    static int grid = 0;
    if (grid == 0) {
        if (n_in != 25 || in_sizes[0] != M * D || out_size != M * D || ws_size < WS_END) { fprintf(stderr, "kernel_launch: unexpected shapes (n_in %d, in0 %d, out %d, ws %zu); nothing launched\n", n_in, n_in > 0 ? in_sizes[0] : -1, out_size, ws_size); grid = -1; return; }
        int dev = 0, cus = 0, per_cu = 0;
        if (hipGetDevice(&dev) != hipSuccess || hipDeviceGetAttribute(&cus, hipDeviceAttributeMultiprocessorCount, dev) != hipSuccess) { grid = -1; return; }
        if (hipFuncSetAttribute((const void*)mk_fwd, hipFuncAttributeMaxDynamicSharedMemorySize, LDS_BYTES) != hipSuccess) { fprintf(stderr, "kernel_launch: hipFuncSetAttribute failed\n"); grid = -1; return; }
        if (hipOccupancyMaxActiveBlocksPerMultiprocessor(&per_cu, (const void*)mk_fwd, NWAVES * 64, LDS_BYTES) != hipSuccess || per_cu < 1) { fprintf(stderr, "kernel_launch: occupancy query reports %d\n", per_cu); }
        (void)hipGetLastError();
        grid = cus;
    }
    if (grid < 0) return;
    if (hipMemsetAsync((char*)d_ws + WS_CTL, 0, CTL_ZERO_BYTES, stream) != hipSuccess) return;
    Args a{};
    for (int i = 0; i < 25; ++i) a.in[i] = d_in[i];
    a.out = (float*)d_out; a.ws = (unsigned char*)d_ws;
    for (int i = 0; i < 32; ++i) a.invf[i] = powf(10000.0f, -(float)(2 * i) / 64.0f);
#if MK_ONE_LAUNCH
    a.ph_lo = 0; a.ph_hi = NPH;
    hipLaunchKernelGGL(mk_fwd, dim3(grid), dim3(NWAVES * 64), LDS_BYTES, stream, a);
#else
    for (int p = 0; p < NPH; ++p) { a.ph_lo = p; a.ph_hi = p + 1; hipLaunchKernelGGL(mk_fwd, dim3(grid), dim3(NWAVES * 64), LDS_BYTES, stream, a); }
#endif
}
```

```cpp
#include <hip/hip_runtime.h>
#include <cstdio>
#include <cstdint>
#include <cmath>
constexpr int NWAVES = 8;
constexpr int M = 32768, D = 1024, FF = 2816, SEQ = 8192, NBATCH = 4, DEPTH = 2, NGU = 2 * FF  , NINP = 3328  , NIN = 3140;
constexpr int GU8_FROM = 0;
constexpr int NPH = 2 + 11 * DEPTH + 1;
constexpr float QSCALE = 0.125f * 1.4426950408889634f;
constexpr float XQSCALE = 0.0625f * 1.4426950408889634f;
constexpr float IDX_SCALE = 0.5f * 0.125f;
constexpr size_t MiB = 1u << 20;
constexpr size_t WS_CTL = 0, CTL_ZERO_BYTES = 1 * MiB;
constexpr size_t WS_SS = 448 * MiB, SS_STAGE = 2 * MiB;
constexpr size_t WS_MSS = 3 * MiB;
constexpr size_t WS_COS = 4 * MiB, WS_SIN = 8 * MiB;
constexpr size_t WS_MK = 12 * MiB;
constexpr size_t WS_MEMK = 22 * MiB, WS_MEMVT = 26 * MiB;
constexpr size_t WS_W = 30 * MiB, W_LAYER = 45 * MiB + MiB / 2;
constexpr size_t WO_GU1 = 0, WO_D1 = 11 * MiB, WO_IN = WO_D1 + 5 * MiB + MiB / 2, WO_OUT = WO_IN + 6 * MiB + MiB / 2, WO_Q = WO_OUT + 2 * MiB, WO_O = WO_Q + 2 * MiB, WO_GU2 = WO_O + 2 * MiB, WO_D2 = WO_GU2 + 11 * MiB;
static_assert(WO_D2 + 5 * MiB + MiB / 2 == W_LAYER, "weight map");
constexpr size_t WS_X = 122 * MiB;
constexpr size_t WS_R = 186 * MiB;
constexpr size_t WS_H = WS_R;
constexpr size_t WS_HG = WS_R, WS_U = WS_R + 16 * MiB, WS_BG = WS_R + 32 * MiB, WS_Q = WS_R + 48 * MiB, WS_K = WS_R + 80 * MiB, WS_V = WS_R + 112 * MiB, WS_QI = WS_R + 144 * MiB,
                 WS_KI = WS_R + 160 * MiB, WS_WI = WS_R + 164 * MiB, WS_MIX = WS_R + 165 * MiB, WS_MASK = WS_R + 229 * MiB, WS_MIXEND = WS_R + 261 * MiB;
constexpr size_t WS_XQ = WS_R;
constexpr size_t WS_X8 = WS_R + 96 * MiB;
constexpr size_t WS_XO8 = WS_R + 64 * MiB;
constexpr size_t WS_MASK1 = 452 * MiB;
constexpr size_t WS_END = 484 * MiB;
static_assert(WS_W + 2 * W_LAYER <= WS_X && WS_X + (size_t)M * D * 2 <= WS_R && WS_H + (size_t)M * FF * 2 <= WS_END && WS_MIXEND <= WS_END, "d_ws map");
constexpr int CW_TMO = 0, CW_BAR = 4096;
constexpr int RING_OFF = 0, RING_BYTES = 131072, LDSCTL_OFF = 143360, MISC_OFF = LDSCTL_OFF + 320, LDS_BYTES = 147456;

namespace pg8 {
#define PG8_LAS __attribute__((address_space(3)))
typedef unsigned short bf16_t;
typedef short bf16x8 __attribute__((ext_vector_type(8)));
typedef float f32x4 __attribute__((ext_vector_type(4)));
typedef unsigned u32x4 __attribute__((ext_vector_type(4)));
constexpr int BM = 256, BK = 64, HALF = 128, HTB = HALF * BK * 2  , STAGE_BYTES = 8 * HTB, NXCD = 8, WGM = 8;

__host__ __device__ __forceinline__ int lds_byte(int r, int c) { const int st = (r >> 4) * 2 + (c >> 5), rr = r & 15, cc = c & 31, ob = rr * 64 + cc * 2; return st * 1024 + (ob ^ (((ob >> 9) & 1) << 5)); }
__host__ __device__ __forceinline__ void stage_rc(int b, int& R, int& C) { const int st = b / 1024, sb = b % 1024, swz = sb ^ (((sb >> 9) & 1) << 5); R = (st >> 1) * 16 + swz / 64; C = (st & 1) * 32 + (swz % 64) / 2; }
__host__ __device__ __forceinline__ int perm32(int rho) { const int n = rho >> 4, i = rho & 15; return 8 * (i >> 2) + 4 * n + (i & 3); }

struct Unit { int pm, pn; };
struct Gemm { const bf16_t* A; const bf16_t* Bt; int M, N, K; };

struct StaticOrder {
    int nM, nN, nwg, G, c;
    __host__ __device__ void init(int M, int N, int G_, int c_) { nM = M / BM; nN = N / BM; nwg = nM * nN; G = G_; c = c_; }
    __host__ __device__ bool next(int i, Unit& u) const {
        const long L = (long)i * G + c; if (L >= nwg) return false;
        int wgid = (int)L; { const int q = nwg / NXCD, r = nwg % NXCD, xcd = wgid % NXCD, off = wgid / NXCD; wgid = (xcd < r ? xcd * (q + 1) : r * (q + 1) + (xcd - r) * q) + off; }
        const int nig = WGM * nN, gid = wgid / nig, fm = gid * WGM, gsz = (nM - fm) < WGM ? (nM - fm) : WGM;
        u.pm = fm + ((wgid % nig) % gsz); u.pn = (wgid % nig) / gsz; return true;
    }
    __device__ __forceinline__ void a_ready(const Unit&) const {}
    __device__ __forceinline__ void done(const Unit&) const {}
};
__device__ __forceinline__ unsigned cvt_pk_bf16(float lo, float hi) { unsigned r; asm volatile("v_cvt_pk_bf16_f32 %0, %1, %2" : "=v"(r) : "v"(lo), "v"(hi)); return r; }
typedef float f32x2 __attribute__((ext_vector_type(2)));
typedef unsigned u32x2 __attribute__((ext_vector_type(2)));
__device__ __forceinline__ float bflo(unsigned w) { return __uint_as_float(w << 16); }
__device__ __forceinline__ float bfhi(unsigned w) { return __uint_as_float(w & 0xffff0000u); }
__device__ __forceinline__ float sigm(float x) { return __builtin_amdgcn_rcpf(1.f + __builtin_amdgcn_exp2f(-1.4426950408889634f * x)); }
__device__ __forceinline__ u32x4 pack8(const f32x4 a, const f32x4 b) { u32x4 w; w.x = cvt_pk_bf16(a[0], a[1]); w.y = cvt_pk_bf16(a[2], a[3]); w.z = cvt_pk_bf16(b[0], b[1]); w.w = cvt_pk_bf16(b[2], b[3]); return w; }
__device__ __forceinline__ float sumsq_of(const float* ss, int row) { const f32x4* p = (const f32x4*)(ss + (size_t)row * 16); const f32x4 a = p[0], b = p[1], c = p[2], d = p[3];
    return (((a[0] + a[1]) + (a[2] + a[3])) + ((b[0] + b[1]) + (b[2] + b[3]))) + (((c[0] + c[1]) + (c[2] + c[3])) + ((d[0] + d[1]) + (d[2] + d[3]))); }
__device__ __forceinline__ float rstd_of(const float* ss, int row) { return __builtin_amdgcn_rsqf(sumsq_of(ss, row) * (1.f / 1024.f) + 1e-6f); }
__device__ __forceinline__ float rstd_of4(const float* ss, int row, int fq) { const f32x4 a = *(const f32x4*)(ss + (size_t)row * 16 + fq * 4); float s = (a[0] + a[1]) + (a[2] + a[3]);
    s += __shfl_xor(s, 16); s += __shfl_xor(s, 32); return __builtin_amdgcn_rsqf(s * (1.f / 1024.f) + 1e-6f); }
__device__ __forceinline__ f32x4 rstd_ld4(const float* ss, int row, int fq) { return *(const f32x4*)(ss + (size_t)row * 16 + fq * 4); }
__device__ __forceinline__ float rstd_fin4(const f32x4 a) { float s = (a[0] + a[1]) + (a[2] + a[3]); s += __shfl_xor(s, 16); s += __shfl_xor(s, 32); return __builtin_amdgcn_rsqf(s * (1.f / 1024.f) + 1e-6f); }
__device__ __forceinline__ float rstd_of1(const float* ss, int row) { return __builtin_amdgcn_rsqf(ss[row] * (1.f / 1024.f) + 1e-6f); }
constexpr int FFH = 2816;

struct EpiSwiGLU {
    static constexpr bool PERM = true, AFTER_DRAIN = false;
    bf16_t* H; const float* ss; float sc;
    __device__ __forceinline__ void operator()(const f32x4 (&acc)[2][2][4][2], const Unit& u, int wr, int wc, int fr, int fq) const {
        asm volatile("" : "+v"(fr), "+v"(fq));
        const int row0 = u.pm * BM + wr * 64 + fr;
        unsigned char* const hb = (unsigned char*)H + (size_t)(u.pm * (FFH / 128) + u.pn) * 32768 + (((wr * 4 + wc) * 8) * 64 + (fq >> 1) * 32 + fr * 2 + (fq & 1)) * 8;
        f32x4 pa[2][4];
#pragma unroll
        for (int ai = 0; ai < 2; ++ai)
#pragma unroll
            for (int m = 0; m < 4; ++m) pa[ai][m] = rstd_ld4(ss, row0 + ai * HALF + m * 16, fq);
#pragma unroll
        for (int ai = 0; ai < 2; ++ai)
#pragma unroll
            for (int m = 0; m < 4; ++m) { const float rs = rstd_fin4(pa[ai][m]) * sc;
                const float rsl = rs * 1.4426950408889634f, rsu = rs * 0.6931471805599453f;
                f32x4 h0, h1;
#pragma unroll
                for (int n = 0; n < 2; ++n) { const f32x4 G = acc[ai][0][m][n], U = acc[ai][1][m][n]; f32x4 hv;
#pragma unroll
                    for (int q = 0; q < 2; ++q) { const f32x2 g2 = (f32x2){G[2 * q], G[2 * q + 1]} * rsl, u2 = (f32x2){U[2 * q], U[2 * q + 1]} * rsu;
                        f32x2 r2; r2.x = __builtin_amdgcn_rcpf(1.f + __builtin_amdgcn_exp2f(-g2.x)); r2.y = __builtin_amdgcn_rcpf(1.f + __builtin_amdgcn_exp2f(-g2.y));
                        const f32x2 o2 = g2 * u2 * r2; hv[2 * q] = o2.x; hv[2 * q + 1] = o2.y; }
                    if (n == 0) h0 = hv; else h1 = hv; }
                unsigned w0 = 0u, w1 = 0u;
                w0 = __builtin_amdgcn_cvt_pk_fp8_f32(h0[0], h0[1], w0, false); w0 = __builtin_amdgcn_cvt_pk_fp8_f32(h0[2], h0[3], w0, true); w1 = __builtin_amdgcn_cvt_pk_fp8_f32(h1[0], h1[1], w1, false); w1 = __builtin_amdgcn_cvt_pk_fp8_f32(h1[2], h1[3], w1, true);
                *(u32x2*)(hb + (ai * 4 + m) * 512) = (u32x2){w0, w1}; asm volatile("" ::: "memory"); }
    }
};
template <bool WX8> struct EpiRes {
    static constexpr bool PERM = true, AFTER_DRAIN = false;
    bf16_t* X; float* ssn; float scale;
    __device__ __forceinline__ void operator()(const f32x4 (&acc)[2][2][4][2], const Unit& u, int wr, int wc, int fr, int fq) const {
        asm volatile("" : "+v"(fr), "+v"(fq));
        const int row0 = u.pm * BM + wr * 64 + fr, col0 = u.pn * BM + wc * 32 + fq * 8;
        u32x4 xcur[2][2], xnxt[2][2];
#pragma unroll
        for (int h2 = 0; h2 < 2; ++h2)
#pragma unroll
            for (int bj = 0; bj < 2; ++bj) xcur[h2][bj] = *(const u32x4*)(X + (size_t)(row0 + h2 * 16) * 1024 + col0 + bj * HALF);
#pragma unroll
        for (int q = 0; q < 8; ++q) { const int ai = q >> 2, m = q & 3; const int row = row0 + ai * HALF + m * 16; float s = 0.f;
            if ((q & 1) == 0 && q + 2 < 8) {
#pragma unroll
                for (int h2 = 0; h2 < 2; ++h2)
#pragma unroll
                    for (int bj = 0; bj < 2; ++bj) { const int qn = q + 2 + h2; xnxt[h2][bj] = *(const u32x4*)(X + (size_t)(row0 + (qn >> 2) * HALF + (qn & 3) * 16) * 1024 + col0 + bj * HALF); } }
#pragma unroll
                for (int bj = 0; bj < 2; ++bj) { bf16_t* p = X + (size_t)row * 1024 + col0 + bj * HALF; const u32x4 xv = xcur[q & 1][bj];
                    f32x4 a = acc[ai][bj][m][0] * scale, b = acc[ai][bj][m][1] * scale;
                    a[0] += bflo(xv.x); a[1] += bfhi(xv.x); a[2] += bflo(xv.y); a[3] += bfhi(xv.y); b[0] += bflo(xv.z); b[1] += bfhi(xv.z); b[2] += bflo(xv.w); b[3] += bfhi(xv.w);
                    const u32x4 w = pack8(a, b); *(u32x4*)p = w;
                    if constexpr (WX8) { unsigned q0 = 0u, q1 = 0u; q0 = __builtin_amdgcn_cvt_pk_fp8_f32(bflo(w.x), bfhi(w.x), q0, false); q0 = __builtin_amdgcn_cvt_pk_fp8_f32(bflo(w.y), bfhi(w.y), q0, true); q1 = __builtin_amdgcn_cvt_pk_fp8_f32(bflo(w.z), bfhi(w.z), q1, false); q1 = __builtin_amdgcn_cvt_pk_fp8_f32(bflo(w.w), bfhi(w.w), q1, true);
                        *(u32x2*)((unsigned char*)X + (WS_X8 - WS_X) + (size_t)row * 1024 + col0 + bj * HALF) = (u32x2){q0, q1}; }
                    s += (bflo(w.x) * bflo(w.x) + bfhi(w.x) * bfhi(w.x)) + (bflo(w.y) * bflo(w.y) + bfhi(w.y) * bfhi(w.y)) + (bflo(w.z) * bflo(w.z) + bfhi(w.z) * bfhi(w.z)) + (bflo(w.w) * bflo(w.w) + bfhi(w.w) * bfhi(w.w)); }
                s += __shfl_xor(s, 16); s += __shfl_xor(s, 32);
                if (fq == 0) ssn[(size_t)row * 16 + u.pn * 4 + wc] = s;
            if (q & 1) { asm volatile("" ::: "memory");
#pragma unroll
                for (int h2 = 0; h2 < 2; ++h2)
#pragma unroll
                    for (int bj = 0; bj < 2; ++bj) xcur[h2][bj] = xnxt[h2][bj]; } }
    }
};
struct EpiRowScale {
    static constexpr bool PERM = true, AFTER_DRAIN = false;
    bf16_t* O; int ldc; const float* ss; float scale;
    __device__ __forceinline__ void operator()(const f32x4 (&acc)[2][2][4][2], const Unit& u, int wr, int wc, int fr, int fq) const {
        asm volatile("" : "+v"(fr), "+v"(fq));
        const int row0 = u.pm * BM + wr * 64 + fr, col0 = u.pn * BM + wc * 32 + fq * 8;
#pragma unroll
        for (int ai = 0; ai < 2; ++ai)
#pragma unroll
            for (int m = 0; m < 4; ++m) { const int row = row0 + ai * HALF + m * 16; const float rs = rstd_of4(ss, row, fq) * scale;
#pragma unroll
                for (int bj = 0; bj < 2; ++bj) *(u32x4*)(O + (size_t)row * ldc + col0 + bj * HALF) = pack8(acc[ai][bj][m][0] * rs, acc[ai][bj][m][1] * rs); asm volatile("" ::: "memory"); }
    }
};
struct EpiWin {
    static constexpr bool PERM = true, AFTER_DRAIN = false;
    unsigned char* ws; const float* ss; float qscale;
    __device__ __forceinline__ void operator()(const f32x4 (&acc)[2][2][4][2], const Unit& u, int wr, int wc, int fr, int fq) const {
        asm volatile("" : "+v"(fr), "+v"(fq));
        const int row0 = u.pm * BM + wr * 64 + fr, t = u.pn, c8 = wc * 32 + fq * 8;
        bf16_t* const HG = (bf16_t*)(ws + WS_HG); bf16_t* const U = (bf16_t*)(ws + WS_U); bf16_t* const BG = (bf16_t*)(ws + WS_BG); bf16_t* const Q = (bf16_t*)(ws + WS_Q); bf16_t* const K = (bf16_t*)(ws + WS_K);
        bf16_t* const V = (bf16_t*)(ws + WS_V); bf16_t* const QI = (bf16_t*)(ws + WS_QI); bf16_t* const KI = (bf16_t*)(ws + WS_KI); float* const WI = (float*)(ws + WS_WI); const float* const cs = (const float*)(ws + WS_COS); const float* const sn = (const float*)(ws + WS_SIN);
        float rsv[8];
        { f32x4 pa[8];
#pragma unroll
          for (int q = 0; q < 8; ++q) pa[q] = rstd_ld4(ss, row0 + (q >> 2) * HALF + (q & 3) * 16, fq);
#pragma unroll
          for (int q = 0; q < 8; ++q) rsv[q] = rstd_fin4(pa[q]); }
        asm volatile("" ::: "memory");
        if (t < 5 || t == 9 || t == 10) {
#pragma unroll
            for (int q = 0; q < 8; ++q) { const int ai = q >> 2, m = q & 3; const int row = row0 + ai * HALF + m * 16; const float rs = rsv[q];
                const f32x4 a0 = acc[ai][0][m][0] * rs, a1 = acc[ai][0][m][1] * rs, b0 = acc[ai][1][m][0] * rs, b1 = acc[ai][1][m][1] * rs;
                if (t < 2) { f32x4 o0, o1;
#pragma unroll
                    for (int j = 0; j < 4; ++j) { o0[j] = a0[j] * sigm(b0[j]); o1[j] = a1[j] * sigm(b1[j]); }
                    *(u32x4*)(HG + (size_t)row * 256 + t * 128 + c8) = pack8(o0, o1); }
                else if (t < 4) { *(u32x4*)(U + (size_t)row * 256 + (t - 2) * 128 + c8) = pack8(a0 * b0, a1 * b1); }
                else if (t == 4) { *(u32x4*)(BG + (size_t)row * 256 + c8) = pack8(a0, a1); *(u32x4*)(BG + (size_t)row * 256 + 128 + c8) = pack8(b0, b1); }
                else { *(u32x4*)(V + (size_t)row * 512 + (t - 9) * 256 + c8) = pack8(a0, a1); *(u32x4*)(V + (size_t)row * 512 + (t - 9) * 256 + 128 + c8) = pack8(b0, b1); }
                asm volatile("" ::: "memory"); }
        } else {
            f32x4 cc[4], cn[4];
            { const size_t o = (size_t)row0 * 32 + fq * 8; cc[0] = *(const f32x4*)(cs + o); cc[1] = *(const f32x4*)(cs + o + 4); cc[2] = *(const f32x4*)(sn + o); cc[3] = *(const f32x4*)(sn + o + 4); }
#pragma unroll
            for (int q = 0; q < 8; ++q) { const int ai = q >> 2, m = q & 3; const int row = row0 + ai * HALF + m * 16; const float rs = rsv[q];
                if (q + 1 < 8) { const size_t o = (size_t)(row0 + ((q + 1) >> 2) * HALF + ((q + 1) & 3) * 16) * 32 + fq * 8; cn[0] = *(const f32x4*)(cs + o); cn[1] = *(const f32x4*)(cs + o + 4); cn[2] = *(const f32x4*)(sn + o); cn[3] = *(const f32x4*)(sn + o + 4); }
                const f32x4 a0 = acc[ai][0][m][0] * rs, a1 = acc[ai][0][m][1] * rs, b0 = acc[ai][1][m][0] * rs, b1 = acc[ai][1][m][1] * rs;
                const f32x4 c0 = cc[0], c1 = cc[1], s0 = cc[2], s1 = cc[3];
                f32x4 p0 = a0 * c0 - b0 * s0, p1 = a1 * c1 - b1 * s1, r0 = b0 * c0 + a0 * s0, r1 = b1 * c1 + a1 * s1;
                if (t < 7) { bf16_t* d = Q + (size_t)row * 512 + ((t - 5) * 4 + wc) * 64 + fq * 8; *(u32x4*)d = pack8(p0 * qscale, p1 * qscale); *(u32x4*)(d + 32) = pack8(r0 * qscale, r1 * qscale); }
                else if (t < 9) { bf16_t* d = K + (size_t)row * 512 + ((t - 7) * 4 + wc) * 64 + fq * 8; *(u32x4*)d = pack8(p0, p1); *(u32x4*)(d + 32) = pack8(r0, r1); }
                else if (t == 11) { bf16_t* d = QI + (size_t)row * 256 + wc * 64 + fq * 8; *(u32x4*)d = pack8(p0, p1); *(u32x4*)(d + 32) = pack8(r0, r1); }
                else { if (wc == 0) { bf16_t* d = KI + ((((size_t)(row >> 5) * 4 + (fq >> 1)) * 64 + (fq & 1) * 32 + (row & 31)) << 3); *(u32x4*)d = pack8(p0, p1); *(u32x4*)(d + 1024) = pack8(r0, r1); }
                       if (wc == 1 && fq == 0) *(f32x4*)(WI + (size_t)row * 4) = b0; }
                asm volatile("" ::: "memory");
#pragma unroll
                for (int i = 0; i < 4; ++i) cc[i] = cn[i]; }
        }
    }
};
struct EpiMemKV {
    static constexpr bool PERM = true, AFTER_DRAIN = false;
    bf16_t *MEMK, *MEMVT; const float* mss;
    __device__ __forceinline__ void operator()(const f32x4 (&acc)[2][2][4][2], const Unit& u, int wr, int wc, int fr, int fq) const {
        asm volatile("" : "+v"(fr), "+v"(fq));
        const bool isv = u.pm >= 4; const int l = isv ? ((u.pm - 8) >> 3) : ((u.pn - 4) >> 3);
        const int pr = isv ? ((u.pm - 8) & 7) : u.pm, pc = isv ? u.pn : ((u.pn - 4) & 7);
        bf16_t* O = (isv ? MEMVT : MEMK) + (size_t)l * 1024 * 1024;
        const int row0 = pr * BM + wr * 64 + fr, col0 = pc * BM + wc * 32 + fq * 8;
#pragma unroll
        for (int ai = 0; ai < 2; ++ai)
#pragma unroll
            for (int m = 0; m < 4; ++m) { const int row = row0 + ai * HALF + m * 16; const float rsr = isv ? 1.f : rstd_of1(mss, row);
#pragma unroll
                for (int bj = 0; bj < 2; ++bj) { f32x4 a = acc[ai][bj][m][0] * rsr, b = acc[ai][bj][m][1] * rsr;
                    if (isv) {
#pragma unroll
                        for (int j = 0; j < 4; ++j) { a[j] *= rstd_of1(mss, col0 + bj * HALF + j); b[j] *= rstd_of1(mss, col0 + bj * HALF + 4 + j); } }
                    *(u32x4*)(O + (size_t)row * 1024 + col0 + bj * HALF) = pack8(a, b); } asm volatile("" ::: "memory"); }
    }
};
struct MemKVOrder {
    int G, c;
    __device__ __forceinline__ bool next(int i, Unit& u) const {
        const int L = i * G + c; if (L >= 64) return false;
        const int ty = L >> 4, a = (L >> 2) & 3, b = L & 3, l = ty & 1;
        if (ty < 2) { u.pm = a; u.pn = 4 + 8 * l + b; } else { u.pm = 8 + 8 * l + a; u.pn = b; }
        return true;
    }
    __device__ __forceinline__ void a_ready(const Unit&) const {}
    __device__ __forceinline__ void done(const Unit&) const {}
};

constexpr int TILE_X = (int)(WS_X >> 19), TILE_MK = (int)(WS_MK >> 19);
static_assert((WS_X & ((1u << 19) - 1)) == 0 && (WS_MK & ((1u << 19) - 1)) == 0 && ((WS_W + WO_IN) & ((1u << 19) - 1)) == 0 && (W_LAYER & ((1u << 19) - 1)) == 0, "tile-aligned operands");
struct WinKVOrder {
    int G, c, tin, nkv;
    __device__ __forceinline__ bool next(int i, Unit& u) const {
        const int nwin = 128 * 13; const long L0 = (long)i * G + c; if (L0 >= nwin + nkv) return false;
        int L = (int)L0;
        if (L < nwin) { int wgid = L; { const int q = nwin / 8, xcd = wgid % 8, off = wgid / 8; wgid = xcd * q + off; }
            const int nig = 8 * 13, gid = wgid / nig, fm = gid * 8; u.pm = TILE_X + fm + ((wgid % nig) % 8); u.pn = tin + (wgid % nig) / 8; return true; }
        L -= nwin; const int ty = L >> 4, a = (L >> 2) & 3, b = L & 3, l = ty & 1;
        if (ty < 2) { u.pm = TILE_MK + a; u.pn = TILE_MK + 4 + 8 * l + b; } else { u.pm = TILE_MK + 8 + 8 * l + a; u.pn = TILE_MK + b; }
        return true;
    }
    __device__ __forceinline__ void a_ready(const Unit&) const {}
    __device__ __forceinline__ void done(const Unit&) const {}
};
struct EpiWinKV {
    static constexpr bool PERM = true, AFTER_DRAIN = false;
    unsigned char* ws; const float* ss; float qscale; int tin;
    __device__ __forceinline__ void operator()(const f32x4 (&acc)[2][2][4][2], const Unit& u, int wr, int wc, int fr, int fq) const {
        if (u.pm >= TILE_X) { const EpiWin W{ws, ss, qscale}; const Unit v{u.pm - TILE_X, u.pn - tin}; W(acc, v, wr, wc, fr, fq); }
        else { const EpiMemKV KV{(bf16_t*)(ws + WS_MEMK), (bf16_t*)(ws + WS_MEMVT), (const float*)(ws + WS_MSS)}; const Unit v{u.pm - TILE_MK, u.pn - TILE_MK}; KV(acc, v, wr, wc, fr, fq); }
    }
};

template <class Epi, class Sched, bool ALIGN_EPI = false, bool SP2 = false, bool FP8 = false, bool ABLK = false>
__device__ __forceinline__ void gemm_phase(PG8_LAS unsigned char* lds, const Gemm g, const Sched& S, const Epi& E) {
    int tid_ = threadIdx.x; asm volatile("" : "+v"(tid_));
    const int tid = tid_, wid = __builtin_amdgcn_readfirstlane(tid >> 6), lane = tid & 63, wr = wid >> 2, wc = wid & 3, fr = lane & 15, fq = lane >> 4;
    const int K = g.K, nt = K / BK;
    unsigned voffA[2], voffB[2];
#pragma unroll
    for (int i = 0; i < 2; ++i) { int R, C; stage_rc(tid * 16 + i * 8192, R, C); const int Rb = Epi::PERM ? ((R & ~31) + perm32(R & 31)) : R;
        voffA[i] = ABLK ? (unsigned)(((((R >> 6) * 4 + (C >> 4)) * 8 + ((R >> 4) & 3)) * 64 + ((C >> 3) & 1) * 32 + (R & 15) * 2) * 8) : (unsigned)(R * K + C) * 2u; voffB[i] = (unsigned)(Rb * K + C) * 2u; }
    const size_t kstep = (size_t)(BK * 2);
    const size_t hstep = (size_t)HALF * K * 2;
    const size_t kstepA = ABLK ? (size_t)32768 : kstep, hstepA = ABLK ? (size_t)2048 : hstep;
    const size_t tstep = 2 * hstep;
    const unsigned ldsw = (unsigned)wid * 1024u;
    const int aoff = lds_byte(wr * 64 + fr, fq * 8), boff = lds_byte(wc * 32 + fr, fq * 8);
#define PG8_SA(b, h) (((b) * 2 + (h)) * HTB)
#define PG8_SB(b, h) ((4 + (b) * 2 + (h)) * HTB)
#define PG8_STAGE(bufoff, gbase, voff) do { _Pragma("unroll") for (int _i = 0; _i < 2; ++_i) \
        __builtin_amdgcn_global_load_lds((const unsigned*)((const char*)(gbase) + (voff)[_i]), (PG8_LAS unsigned*)(lds + (bufoff) + ldsw + _i * 8192), 16, 0, 0); } while (0)
#define PG8_LDA(dst, b, h) do { _Pragma("unroll") for (int m = 0; m < 4; ++m) _Pragma("unroll") for (int k = 0; k < 2; ++k) dst[m][k] = *(const PG8_LAS bf16x8*)(lds + PG8_SA(b, h) + aoff + m * 2048 + k * 1024); } while (0)
#define PG8_LDB(dst, b, h) do { _Pragma("unroll") for (int n = 0; n < 2; ++n) _Pragma("unroll") for (int k = 0; k < 2; ++k) dst[n][k] = *(const PG8_LAS bf16x8*)(lds + PG8_SB(b, h) + boff + n * 2048 + k * 1024); } while (0)
#define PG8_MMA(ai, bj, At, Bt) do { __builtin_amdgcn_s_setprio(1); _Pragma("unroll") for (int m = 0; m < 4; ++m) _Pragma("unroll") for (int n = 0; n < 2; ++n) { \
        if constexpr (FP8) { typedef int v4i_ __attribute__((ext_vector_type(4))); typedef int v8i_ __attribute__((ext_vector_type(8))); \
            const v8i_ b8 = __builtin_shufflevector(__builtin_bit_cast(v4i_, Bt[n][0]), __builtin_bit_cast(v4i_, Bt[n][1]), 0, 1, 2, 3, 4, 5, 6, 7), a8 = __builtin_shufflevector(__builtin_bit_cast(v4i_, At[m][0]), __builtin_bit_cast(v4i_, At[m][1]), 0, 1, 2, 3, 4, 5, 6, 7); \
            asm volatile("v_mfma_scale_f32_16x16x128_f8f6f4 %0, %1, %2, %0, %3, %3 op_sel_hi:[0,0,0]" : "+v"(acc[ai][bj][m][n]) : "v"(b8), "v"(a8), "v"(0x7f7f7f7f)); }   \
        else { _Pragma("unroll") for (int k = 0; k < 2; ++k) acc[ai][bj][m][n] = __builtin_amdgcn_mfma_f32_16x16x32_bf16(Bt[n][k], At[m][k], acc[ai][bj][m][n], 0, 0, 0); } } \
        __builtin_amdgcn_s_setprio(0); } while (0)
#define PG8_WAIT_V(n) asm volatile("s_waitcnt vmcnt(" #n ")" ::: "memory")
#define PG8_WAIT_V8_UNLESS_FIRST(t) asm volatile("s_cmp_eq_u32 %0, 0\n\ts_cbranch_scc1 .Lpg8skip%=\n\ts_waitcnt vmcnt(8)\n.Lpg8skip%=:" :: "s"(t) : "scc", "memory")
#define PG8_WAIT_L(n) asm volatile("s_waitcnt lgkmcnt(" #n ")" ::: "memory")
#define PG8_BAR __builtin_amdgcn_s_barrier()
#define PG8_SCHED __builtin_amdgcn_sched_barrier(0)
    Unit cur, nxt; int ui = 0;
    if (!S.next(0, cur)) return;
    f32x4 acc[2][2][4][2];
#pragma unroll
    for (int a = 0; a < 2; ++a)
#pragma unroll
        for (int b = 0; b < 2; ++b)
#pragma unroll
            for (int m = 0; m < 4; ++m)
#pragma unroll
                for (int n = 0; n < 2; ++n) acc[a][b][m][n] = (f32x4){0.f, 0.f, 0.f, 0.f};
    bf16x8 At[4][2], B0[2][2], B1[2][2];
    const char* cA = (const char*)g.A + (size_t)cur.pm * tstep; const char* cB = (const char*)g.Bt + (size_t)cur.pn * tstep;
    S.a_ready(cur);
    if constexpr (SP2) {
        PG8_STAGE(PG8_SB(0, 0), cB, voffB); PG8_STAGE(PG8_SB(0, 1), cB + hstep, voffB); PG8_STAGE(PG8_SA(0, 0), cA, voffA); PG8_STAGE(PG8_SA(0, 1), cA + hstepA, voffA);
        if (wr == 1) PG8_BAR;
        PG8_WAIT_V(2); PG8_BAR;
        PG8_STAGE(PG8_SB(1, 0), cB + kstep, voffB); PG8_STAGE(PG8_SA(1, 0), cA + kstepA, voffA); PG8_STAGE(PG8_SB(1, 1), cB + hstep + kstep, voffB);
        PG8_WAIT_V(0); PG8_BAR;
    } else {
        PG8_STAGE(PG8_SB(0, 0), cB, voffB); PG8_STAGE(PG8_SA(0, 0), cA, voffA); PG8_STAGE(PG8_SB(0, 1), cB + hstep, voffB); PG8_STAGE(PG8_SA(0, 1), cA + hstepA, voffA);
        if (wr == 1) PG8_BAR;
        PG8_WAIT_V(4); PG8_BAR;
        PG8_STAGE(PG8_SB(1, 0), cB + kstep, voffB); PG8_STAGE(PG8_SA(1, 0), cA + kstepA, voffA); PG8_STAGE(PG8_SB(1, 1), cB + hstep + kstep, voffB);
        PG8_WAIT_V(6); PG8_BAR;
    }
    for (;;) {
        const bool has_next = S.next(ui + 1, nxt);
        const char* nA = has_next ? (const char*)g.A + (size_t)nxt.pm * tstep : cA; const char* nB = has_next ? (const char*)g.Bt + (size_t)nxt.pn * tstep : cB;
        for (int t = 0; t < nt; t += 2) {
            const bool last = (t == nt - 2);
            const char* a1 = cA + (size_t)(t + 1) * kstepA;
            const char* a2 = last ? nA : cA + (size_t)(t + 2) * kstepA; const char* b2 = last ? nB : cB + (size_t)(t + 2) * kstep;
            const char* a3 = a2 + kstepA; const char* b3 = b2 + kstep;
            if (last && has_next) S.a_ready(nxt);
            if constexpr (SP2) {
            PG8_LDB(B0, 0, 0); PG8_LDB(B1, 0, 1); PG8_SCHED; PG8_LDA(At, 0, 0); PG8_STAGE(PG8_SA(1, 1), a1 + hstepA, voffA);
            PG8_WAIT_V8_UNLESS_FIRST(t); PG8_WAIT_L(0); PG8_BAR; PG8_MMA(0, 0, At, B0); PG8_MMA(0, 1, At, B1); PG8_BAR; PG8_SCHED;
            PG8_LDA(At, 0, 1); PG8_STAGE(PG8_SB(0, 0), b2, voffB); PG8_STAGE(PG8_SB(0, 1), b2 + hstep, voffB); PG8_STAGE(PG8_SA(0, 0), a2, voffA);
            PG8_WAIT_V8_UNLESS_FIRST(t); PG8_WAIT_L(0); PG8_BAR; PG8_MMA(1, 0, At, B0); PG8_MMA(1, 1, At, B1); PG8_BAR; PG8_SCHED;
            PG8_LDB(B0, 1, 0); PG8_LDB(B1, 1, 1); PG8_SCHED; PG8_LDA(At, 1, 0); PG8_STAGE(PG8_SA(0, 1), a2 + hstepA, voffA);
            PG8_WAIT_V(8); PG8_WAIT_L(0); PG8_BAR; PG8_MMA(0, 0, At, B0); PG8_MMA(0, 1, At, B1); PG8_BAR; PG8_SCHED;
            PG8_LDA(At, 1, 1); PG8_STAGE(PG8_SB(1, 0), b3, voffB); PG8_STAGE(PG8_SB(1, 1), b3 + hstep, voffB); PG8_STAGE(PG8_SA(1, 0), a3, voffA);
            PG8_WAIT_V(8); PG8_WAIT_L(0); PG8_BAR; PG8_MMA(1, 0, At, B0); PG8_MMA(1, 1, At, B1); PG8_BAR; PG8_SCHED;
            } else {
            PG8_LDB(B0, 0, 0); PG8_SCHED; PG8_LDA(At, 0, 0); PG8_STAGE(PG8_SA(1, 1), a1 + hstepA, voffA);
            PG8_WAIT_L(8); PG8_BAR; PG8_WAIT_L(0); PG8_MMA(0, 0, At, B0); PG8_BAR; PG8_SCHED;
            PG8_LDB(B1, 0, 1); PG8_STAGE(PG8_SB(0, 0), b2, voffB);
            PG8_BAR; PG8_WAIT_L(0); PG8_MMA(0, 1, At, B1); PG8_BAR;
            PG8_LDA(At, 0, 1); PG8_STAGE(PG8_SA(0, 0), a2, voffA);
            PG8_BAR; PG8_WAIT_L(0); PG8_MMA(1, 0, At, B0); PG8_BAR; PG8_SCHED;
            PG8_STAGE(PG8_SB(0, 1), b2 + hstep, voffB);
            PG8_WAIT_V(6); PG8_BAR; PG8_MMA(1, 1, At, B1); PG8_BAR;
            PG8_LDB(B0, 1, 0); PG8_SCHED; PG8_LDA(At, 1, 0); PG8_STAGE(PG8_SA(0, 1), a2 + hstepA, voffA);
            PG8_WAIT_L(8); PG8_BAR; PG8_WAIT_L(0); PG8_MMA(0, 0, At, B0); PG8_BAR; PG8_SCHED;
            PG8_LDB(B1, 1, 1); PG8_STAGE(PG8_SB(1, 0), b3, voffB);
            PG8_BAR; PG8_WAIT_L(0); PG8_MMA(0, 1, At, B1); PG8_BAR;
            PG8_LDA(At, 1, 1); PG8_STAGE(PG8_SA(1, 0), a3, voffA);
            PG8_BAR; PG8_WAIT_L(0); PG8_MMA(1, 0, At, B0); PG8_BAR; PG8_SCHED;
            PG8_STAGE(PG8_SB(1, 1), b3 + hstep, voffB);
            PG8_WAIT_V(6); PG8_BAR; PG8_MMA(1, 1, At, B1); PG8_BAR;
            }
        }
        if constexpr (SP2) PG8_WAIT_V(0);
        if constexpr (FP8) asm volatile("s_nop 15\n\ts_nop 15" ::: "memory");
        if constexpr (ALIGN_EPI) { if (wr == 0) PG8_BAR; }
        if constexpr (!Epi::AFTER_DRAIN) { E(acc, cur, wr, wc, fr, fq); S.done(cur); }
        if (!has_next) break;
#pragma unroll
        for (int a = 0; a < 2; ++a)
#pragma unroll
            for (int b = 0; b < 2; ++b)
#pragma unroll
                for (int m = 0; m < 4; ++m)
#pragma unroll
                    for (int n = 0; n < 2; ++n) acc[a][b][m][n] = (f32x4){0.f, 0.f, 0.f, 0.f};
        cur = nxt; cA = nA; cB = nB; ++ui;
        if constexpr (ALIGN_EPI) { if (wr == 1) PG8_BAR; }
    }
    PG8_WAIT_V(0);
    if constexpr (!ALIGN_EPI) { if (wr == 0) PG8_BAR; }
    PG8_BAR;
    if constexpr (Epi::AFTER_DRAIN) { E.fused(acc, cur, wr, wc, fr, fq, lds, wid, lane); S.done(cur); }
#undef PG8_SA
#undef PG8_SB
#undef PG8_STAGE
#undef PG8_LDA
#undef PG8_LDB
#undef PG8_MMA
#undef PG8_WAIT_V
#undef PG8_WAIT_L
#undef PG8_WAIT_V8_UNLESS_FIRST
#undef PG8_BAR
#undef PG8_SCHED
}
}
#define GAS __attribute__((address_space(1)))
#define LAS __attribute__((address_space(3)))
typedef unsigned short bf16;
typedef unsigned v4u __attribute__((ext_vector_type(4)));
typedef float f32x4 __attribute__((ext_vector_type(4)));
typedef short bf16x8 __attribute__((ext_vector_type(8)));
typedef GAS unsigned gu32;
typedef GAS unsigned long long gu64;
#define RLX_AGENT __ATOMIC_RELAXED, __HIP_MEMORY_SCOPE_AGENT
#define LDS_WAIT() asm volatile("s_waitcnt lgkmcnt(0)" ::: "memory")
#define VM_WAIT() asm volatile("s_waitcnt vmcnt(0)" ::: "memory")
__device__ __forceinline__ unsigned long long rt() { return __builtin_amdgcn_s_memrealtime(); }
__device__ __forceinline__ unsigned f2bf(float f) { unsigned u = __builtin_bit_cast(unsigned, f); return (u + 0x7fffu + ((u >> 16) & 1u)) >> 16; }
__device__ __forceinline__ unsigned pk2(float lo, float hi) { return f2bf(lo) | (f2bf(hi) << 16); }

#define XB_TMO      128
#define XB_XCNT(j)  (256  + 64 * (j))
#define XB_XSUB(j)  (1280 + 64 * (j))
#define XB_XGEN(j)  (2304 + 64 * (j))
#define XB_TOP      3328
#define XB_TOPGEN   3392
#define XCD_BAR_WORDS 3456
#define XB_SPIN_CAP (1u << 18)

__device__ __forceinline__ unsigned xb_ld(unsigned* p)              { return __hip_atomic_load(p, __ATOMIC_RELAXED, __HIP_MEMORY_SCOPE_AGENT); }
__device__ __forceinline__ unsigned xb_add(unsigned* p, unsigned v) { return __hip_atomic_fetch_add(p, v, __ATOMIC_RELAXED, __HIP_MEMORY_SCOPE_AGENT); }
__device__ __forceinline__ unsigned xb_xcc_id() { return (unsigned)__builtin_amdgcn_s_getreg((3 << 11) | 20) & 0xFu; }
#define XB_SPIN(cond, bar) do { unsigned _sp = 0; while (cond) { __builtin_amdgcn_s_sleep(1); \
    if ((++_sp & 255u) == 0u) { if (xb_ld(&(bar)[XB_TMO])) break; if (_sp > XB_SPIN_CAP) { atomicAdd(&(bar)[XB_TMO], 1u); break; } } } } while (0)

struct XcdBarrier {
    unsigned* bar; unsigned x;
    volatile LAS unsigned* st;
};

__device__ __forceinline__ XcdBarrier xcd_barrier_post(unsigned* bar, volatile LAS unsigned* st) {
    XcdBarrier b; b.bar = bar; b.x = xb_xcc_id(); b.st = st;
    if (threadIdx.x == 0) (void)xb_add(&bar[XB_XCNT(b.x)], 1u);
    return b;
}
__device__ __forceinline__ void xcd_barrier_complete(unsigned* bar, unsigned x, unsigned& nloc, unsigned& nx) {
    const unsigned G = gridDim.x * gridDim.y * gridDim.z;
    unsigned sum, cnt, mine, sp = 0u;
    for (;;) {
        sum = 0u; cnt = 0u; mine = 0u;
#pragma unroll
        for (unsigned j = 0; j < 16; ++j) { const unsigned c = xb_ld(&bar[XB_XCNT(j)]); sum += c; cnt += (c > 0u) ? 1u : 0u; mine = (j == x) ? c : mine; }
        if (sum == G) break;
        __builtin_amdgcn_s_sleep(1);
        if ((++sp & 255u) == 0u) { if (xb_ld(&bar[XB_TMO])) break; if (sp > XB_SPIN_CAP) { atomicAdd(&bar[XB_TMO], 1u); break; } }
    }
    nloc = mine > 0u ? mine : 1u; nx = cnt > 0u ? cnt : 1u;
}

__device__ __forceinline__ void xcd_barrier(const XcdBarrier& b) {
    asm volatile("s_waitcnt vmcnt(0)" ::: "memory");
    __syncthreads();
    if (threadIdx.x == 0) {
        unsigned* bar = b.bar;
        __builtin_amdgcn_s_waitcnt(0);
        unsigned nloc = b.st[0], nx = b.st[1];
        if (nloc == 0u) { xcd_barrier_complete(bar, b.x, nloc, nx); b.st[0] = nloc; b.st[1] = nx; }
        const unsigned old = xb_add(&bar[XB_XSUB(b.x)], 1u);
        const unsigned gen = old / nloc;
        if (old + 1u == (gen + 1u) * nloc) {
            __builtin_amdgcn_fence(__ATOMIC_RELEASE, "agent");
            asm volatile("s_waitcnt vmcnt(0)" ::: "memory");
            const unsigned og = xb_add(&bar[XB_TOP], 1u);
            const unsigned tg = og / nx;
            if (og + 1u == (tg + 1u) * nx) xb_add(&bar[XB_TOPGEN], 1u);
            else XB_SPIN(xb_ld(&bar[XB_TOPGEN]) == tg, bar);
            __builtin_amdgcn_fence(__ATOMIC_ACQUIRE, "agent");
            xb_add(&bar[XB_XGEN(b.x)], 1u);
            asm volatile("s_waitcnt vmcnt(0)" ::: "memory");
        } else {
            XB_SPIN(xb_ld(&bar[XB_XGEN(b.x)]) == gen, bar);
            __builtin_amdgcn_fence(__ATOMIC_ACQUIRE, "agent");
            asm volatile("s_waitcnt vmcnt(0)" ::: "memory");
        }
    }
    __syncthreads();
}
struct Frame {
    LAS unsigned char* lds; volatile LAS unsigned* MISC; gu32* ctl;
    int tid, lane, wave, vcu, G;
    unsigned char* ws;
};
__device__ __forceinline__ float wave_sum(float v) {
#pragma unroll
    for (int o = 1; o < 64; o <<= 1) v += __shfl_xor(v, o);
    return v;
}
__device__ __forceinline__ float wave_max(float v) {
#pragma unroll
    for (int o = 1; o < 64; o <<= 1) v = fmaxf(v, __shfl_xor(v, o));
    return v;
}
__device__ __forceinline__ float bf2f_lo(unsigned w) { return __uint_as_float(w << 16); }
__device__ __forceinline__ float bf2f_hi(unsigned w) { return __uint_as_float(w & 0xffff0000u); }
__device__ __forceinline__ float bf2f(bf16 h) { return __uint_as_float((unsigned)h << 16); }

__device__ __forceinline__ void tr_item(const float* W, int Ns, const float* gain, bf16* WTrow, int K, int sc0, int nvalid, int k0, LAS float* scr, int lane) {
    const int col = lane & 31;
    float wv_[32];
#pragma unroll
    for (int i = 0; i < 32; ++i) { const int kk = 2 * i + (lane >> 5); wv_[i] = (col < nvalid) ? W[(size_t)(k0 + kk) * Ns + sc0 + col] : 0.f; }
#pragma unroll
    for (int i = 0; i < 32; ++i) { const int kk = 2 * i + (lane >> 5); float v = wv_[i]; if (gain) v *= gain[k0 + kk]; scr[kk * 33 + col] = v; }
    LDS_WAIT(); asm volatile("" ::: "memory");
    const int c = lane & 7;
#pragma unroll
    for (int j = 0; j < 4; ++j) { const int n = (lane >> 3) + 8 * j; const LAS float* s = scr + (8 * c) * 33 + n;
        v4u o; o.x = pk2(s[0 * 33], s[1 * 33]); o.y = pk2(s[2 * 33], s[3 * 33]); o.z = pk2(s[4 * 33], s[5 * 33]); o.w = pk2(s[6 * 33], s[7 * 33]);
        *(GAS v4u*)(WTrow + (size_t)n * K + 8 * c) = o; }
    LDS_WAIT(); asm volatile("" ::: "memory");
}
__device__ __forceinline__ void tr_item8(const float* W, int Ns, unsigned char* WTrow, int K, int sc0, int k0, LAS float* scr, int lane, const float* gain = nullptr) {
    const int col = lane & 31;
    float wv_[32];
#pragma unroll
    for (int i = 0; i < 32; ++i) { const int kk = 2 * i + (lane >> 5); wv_[i] = W[(size_t)(k0 + kk) * Ns + sc0 + col]; }
#pragma unroll
    for (int i = 0; i < 32; ++i) { const int kk = 2 * i + (lane >> 5); float v = wv_[i] * 64.f; if (gain) v *= gain[k0 + kk]; scr[kk * 33 + col] = v; }
    LDS_WAIT(); asm volatile("" ::: "memory");
    const int n = lane >> 1, hf = lane & 1;
#pragma unroll
    for (int q = 0; q < 2; ++q) { const LAS float* sp = scr + (32 * hf + 16 * q) * 33 + n; v4u o;
#pragma unroll
        for (int d = 0; d < 4; ++d) { unsigned w = 0u; w = __builtin_amdgcn_cvt_pk_fp8_f32(sp[(4 * d) * 33], sp[(4 * d + 1) * 33], w, false); w = __builtin_amdgcn_cvt_pk_fp8_f32(sp[(4 * d + 2) * 33], sp[(4 * d + 3) * 33], w, true); o[d] = w; }
        *(GAS v4u*)(WTrow + (size_t)n * K + 32 * hf + 16 * q) = o; }
    LDS_WAIT(); asm volatile("" ::: "memory");
}
__device__ __forceinline__ void plain_item8(const float* W, int Ns, int K, unsigned char* WT, int r, LAS float* scr, int lane, const float* gain = nullptr) {
    const int nkb = K / 64, group = r / nkb, kb = r % nkb;
    tr_item8(W, Ns, WT + (size_t)(group * 32) * K + kb * 64, K, group * 32, kb * 64, scr, lane, gain);
}
__device__ __forceinline__ void gu_item8(const float* wg, const float* wu, const float* gain, unsigned char* WT, int r, LAS float* scr, int lane) {
    const int group = r >> 4, kb = r & 15, tile = group >> 3, g8 = group & 7;
    tr_item8(g8 < 4 ? wg : wu, FF, WT + (size_t)(group * 32) * D + kb * 64, D, 128 * tile + 32 * (g8 & 3), kb * 64, scr, lane, gain);
}
__device__ __forceinline__ int win_src_col(int j, int& nvalid) {
    const int tile = j >> 3, half = (j >> 2) & 1, q4 = j & 3; nvalid = 32;
    if (tile < 2) return (half ? 256 : 0) + 128 * tile + 32 * q4;
    if (tile < 4) return (half ? 1024 : 768) + 128 * (tile - 2) + 32 * q4;
    if (tile == 4) return 512 + 128 * half + 32 * q4;
    if (tile < 7) return 1280 + ((tile - 5) * 4 + q4) * 64 + 32 * half;
    if (tile < 9) return 1792 + ((tile - 7) * 4 + q4) * 64 + 32 * half;
    if (tile < 11) return 2304 + (tile - 9) * 256 + 128 * half + 32 * q4;
    if (tile == 11) return 2816 + q4 * 64 + 32 * half;
    if (q4 == 0) return 3072 + 32 * half;
    if (q4 == 1 && half == 1) { nvalid = 4; return 3136; }
    nvalid = 0; return 0;
}
__device__ __forceinline__ void gu_item(const float* wg, const float* wu, const float* gain, bf16* WT, int r, LAS float* scr, int lane) {
    const int group = r >> 4, kb = r & 15, tile = group >> 3, g8 = group & 7;
    tr_item(g8 < 4 ? wg : wu, FF, gain, WT + (size_t)(group * 32) * D + kb * 64, D, 128 * tile + 32 * (g8 & 3), 32, kb * 64, scr, lane);
}
__device__ __forceinline__ void gu_item8(const float* wg, const float* wu, const float* gain, unsigned char* WT, int r, LAS float* scr, int lane);
__device__ __forceinline__ void plain_item(const float* W, int Ns, int K, const float* gain, bf16* WT, int r, LAS float* scr, int lane) {
    const int nkb = K / 64, group = r / nkb, kb = r % nkb;
    tr_item(W, Ns, gain, WT + (size_t)(group * 32) * K + kb * 64, K, group * 32, 32, kb * 64, scr, lane);
}
struct Args { const void* in[25]; float* out; unsigned char* ws; float invf[32]; int ph_lo, ph_hi; };
typedef const __attribute__((address_space(4))) Args* KArgs;
#define INF(A, k) ((const float*)(A)->in[k])
enum { I_X = 0, I_MEM, I_POS, I_FFN1_NORM, I_FFN1_WG, I_FFN1_WU, I_FFN1_WD, I_MIX_NORM, I_W_IN, I_CONF_DW, I_CONF_DW_B, I_CONF_LN_G, I_CONF_LN_B, I_SC_DW, I_W_OUT, I_XA_NORM, I_MEM_NORM, I_XA_WQ, I_XA_WKV, I_XA_WO,
       I_FFN2_NORM, I_FFN2_WG, I_FFN2_WU, I_FFN2_WD, I_FINAL_NORM };
constexpr int IT_GU = 2816, IT_D = 1408, IT_IN = 1664, IT_SQ = 512, IT_KV = 1024, IT_LAYER = 2 * IT_GU + 2 * IT_D + IT_IN + 3 * IT_SQ + IT_KV;
__device__ __forceinline__ void p0_prologue(Frame& F, KArgs A) {
    LAS float* scr = (LAS float*)(F.lds + RING_OFF + F.wave * 16384);
    const int gw = F.vcu * NWAVES + F.wave, NGW = F.G * NWAVES, lane = F.lane;
    unsigned char* ws = F.ws;
    for (int it = gw; it < DEPTH * IT_LAYER; it += NGW) {
        const int l = it / IT_LAYER; int r = it % IT_LAYER;
        unsigned char* wl = ws + WS_W + (size_t)l * W_LAYER;
        if (r < IT_GU) { gu_item(INF(A, I_FFN1_WG) + (size_t)l * D * FF, INF(A, I_FFN1_WU) + (size_t)l * D * FF, INF(A, I_FFN1_NORM) + l * D, (bf16*)(wl + WO_GU1), r, scr, lane); continue; } r -= IT_GU;
        if (r < IT_D) { plain_item8(INF(A, I_FFN1_WD) + (size_t)l * FF * D, D, FF, wl + WO_D1, r, scr, lane); continue; } r -= IT_D;
        if (r < IT_IN) { const int group = r >> 4, kb = r & 15; int nv; const int sc = win_src_col(group, nv);
            tr_item(INF(A, I_W_IN) + (size_t)l * D * NIN, NIN, INF(A, I_MIX_NORM) + l * D, (bf16*)(wl + WO_IN) + (size_t)(group * 32) * D + kb * 64, D, sc, nv, kb * 64, scr, lane); continue; } r -= IT_IN;
        if (r < IT_SQ) { plain_item(INF(A, I_W_OUT) + (size_t)l * D * D, D, D, nullptr, (bf16*)(wl + WO_OUT), r, scr, lane); continue; } r -= IT_SQ;
        if (r < IT_SQ) { plain_item8(INF(A, I_XA_WQ) + (size_t)l * D * D, D, D, wl + WO_Q, r, scr, lane, INF(A, I_XA_NORM) + l * D); continue; } r -= IT_SQ;
        if (r < IT_SQ) { plain_item8(INF(A, I_XA_WO) + (size_t)l * D * D, D, D, wl + WO_O, r, scr, lane); continue; } r -= IT_SQ;
        if (r < IT_KV) { plain_item(INF(A, I_XA_WKV) + (size_t)l * D * 2 * D, 2 * D, D, INF(A, I_MEM_NORM) + l * D, (bf16*)(ws + WS_MK) + (size_t)(1024 + 2048 * l) * D, r, scr, lane); continue; } r -= IT_KV;
        if (r < IT_GU) { if (l >= GU8_FROM) gu_item8(INF(A, I_FFN2_WG) + (size_t)l * D * FF, INF(A, I_FFN2_WU) + (size_t)l * D * FF, INF(A, I_FFN2_NORM) + l * D, wl + WO_GU2, r, scr, lane);
                         else gu_item(INF(A, I_FFN2_WG) + (size_t)l * D * FF, INF(A, I_FFN2_WU) + (size_t)l * D * FF, INF(A, I_FFN2_NORM) + l * D, (bf16*)(wl + WO_GU2), r, scr, lane); continue; } r -= IT_GU;
        plain_item8(INF(A, I_FFN2_WD) + (size_t)l * FF * D, D, FF, wl + WO_D2, r, scr, lane);
    }
    for (int m = gw; m < M + 1024; m += NGW) {
        const bool ismem = m >= M; const int row = ismem ? m - M : m;
        const GAS f32x4* xr = (const GAS f32x4*)((ismem ? INF(A, I_MEM) : INF(A, I_X)) + (size_t)row * D) + lane;
        GAS unsigned long long* o8 = (GAS unsigned long long*)((bf16*)(ws + (ismem ? WS_MK : WS_X)) + (size_t)row * D) + lane;
        float s = 0.f;
#pragma unroll
        for (int j = 0; j < 4; ++j) { const f32x4 v = xr[64 * j]; const unsigned a = pk2(v.x, v.y), b = pk2(v.z, v.w); o8[64 * j] = (unsigned long long)a | ((unsigned long long)b << 32);
            s += (bf2f_lo(a) * bf2f_lo(a) + bf2f_hi(a) * bf2f_hi(a)) + (bf2f_lo(b) * bf2f_lo(b) + bf2f_hi(b) * bf2f_hi(b)); }
        s = wave_sum(s);
        if (ismem) { if (lane == 0) ((float*)(ws + WS_MSS))[row] = s; } else if (lane < 16) ((float*)(ws + WS_SS))[(size_t)row * 16 + lane] = lane == 0 ? s : 0.f;
    }
    for (int e = (F.vcu * NWAVES * 64 + F.tid); e < M * 32; e += F.G * NWAVES * 64) {
        const int row = e >> 5, i = e & 31;
        const float ang = __fmul_rn((float)((const int*)A->in[I_POS])[row], A->invf[i]);
        const double x = (double)ang, n = __builtin_rint(x * 0.15915494309189535), r = x - n * 6.283185307179586, r2 = r * r;
        double sp = -1.0 / 25852016738884976640000.0, cp = 1.0 / 620448401733239439360000.0;
        sp = sp * r2 + 1.0 / 51090942171709440000.0;  cp = cp * r2 - 1.0 / 1124000727777607680000.0;
        sp = sp * r2 - 1.0 / 121645100408832000.0;    cp = cp * r2 + 1.0 / 2432902008176640000.0;
        sp = sp * r2 + 1.0 / 355687428096000.0;       cp = cp * r2 - 1.0 / 6402373705728000.0;
        sp = sp * r2 - 1.0 / 1307674368000.0;         cp = cp * r2 + 1.0 / 20922789888000.0;
        sp = sp * r2 + 1.0 / 6227020800.0;            cp = cp * r2 - 1.0 / 87178291200.0;
        sp = sp * r2 - 1.0 / 39916800.0;              cp = cp * r2 + 1.0 / 479001600.0;
        sp = sp * r2 + 1.0 / 362880.0;                cp = cp * r2 - 1.0 / 3628800.0;
        sp = sp * r2 - 1.0 / 5040.0;                  cp = cp * r2 + 1.0 / 40320.0;
        sp = sp * r2 + 1.0 / 120.0;                   cp = cp * r2 - 1.0 / 720.0;
        sp = sp * r2 - 1.0 / 6.0;                     cp = cp * r2 + 1.0 / 24.0;
        sp = sp * r2 + 1.0;                           cp = cp * r2 - 0.5;
        cp = cp * r2 + 1.0;
        ((float*)(ws + WS_COS))[e] = (float)cp; ((float*)(ws + WS_SIN))[e] = (float)(sp * r);
    }
}

__device__ __forceinline__ void conv_a_unit(Frame& F, const bf16* HG, bf16* MIX, const float* dw, const float* dwb, const float* lng, const float* lnb, int unit) {
    const int tid = F.tid, lane = F.lane, wave = F.wave;
    const int row0 = unit * 64, t0 = row0 % SEQ;
    LAS unsigned short* hb = (LAS unsigned short*)(F.lds + RING_OFF); LAS float* yb = (LAS float*)(F.lds + RING_OFF + 49152);
    for (int ch = tid; ch < 94 * 32; ch += NWAVES * 64) { const int rr = ch >> 5, c16 = ch & 31; const int t = t0 - 30 + rr;
        v4u v = (v4u){0u, 0u, 0u, 0u}; if (t >= 0) v = *(const GAS v4u*)(HG + (size_t)(row0 - 30 + rr) * 256 + c16 * 8);
        *(LAS v4u*)(hb + rr * 256 + c16 * 8) = v; }
    __syncthreads();
    { const int c = tid & 255, half = tid >> 8;
      float w[31];
#pragma unroll
      for (int j = 0; j < 31; ++j) w[j] = dw[j * 256 + c];
      const float bias = dwb[c];
      float hv[62];
#pragma unroll
      for (int k = 0; k < 62; ++k) hv[k] = bf2f(hb[(32 * half + k) * 256 + c]);
#pragma unroll
      for (int i = 0; i < 32; ++i) { float y = bias;
#pragma unroll
          for (int j = 0; j < 31; ++j) y += w[j] * hv[i + j];
          yb[(32 * half + i) * 256 + c] = y; } }
    __syncthreads();
    { const f32x4 g = *(const GAS f32x4*)(lng + lane * 4), bb = *(const GAS f32x4*)(lnb + lane * 4);
      for (int tt = wave; tt < 64; tt += NWAVES) { const f32x4 y = *(LAS f32x4*)(yb + tt * 256 + lane * 4);
          const float mean = wave_sum((y.x + y.y) + (y.z + y.w)) * (1.f / 256.f); const f32x4 d = y - mean;
          const float var = wave_sum((d.x * d.x + d.y * d.y) + (d.z * d.z + d.w * d.w)) * (1.f / 256.f); const float rs = 1.0f / sqrtf(var + 1e-5f);
          f32x4 o = d * rs * g + bb;
#pragma unroll
          for (int j = 0; j < 4; ++j) o[j] = o[j] * pg8::sigm(o[j]);
          *(GAS unsigned long long*)(MIX + (size_t)(row0 + tt) * 1024 + lane * 4) = (unsigned long long)pk2(o.x, o.y) | ((unsigned long long)pk2(o.z, o.w) << 32); } }
    __syncthreads();
}
__device__ __forceinline__ void conv_b_all(Frame& F, const bf16* U, const bf16* BG, bf16* MIX, const float* sw) {
    for (int it = F.vcu * NWAVES * 64 + F.tid; it < M * 32; it += F.G * NWAVES * 64) { const int row = it >> 5, c8 = (it & 31) * 8, t = row % SEQ;
        const v4u z = (v4u){0u, 0u, 0u, 0u};
        const v4u u0 = *(const GAS v4u*)(U + (size_t)row * 256 + c8), u1 = t >= 1 ? *(const GAS v4u*)(U + (size_t)(row - 1) * 256 + c8) : z, u2 = t >= 2 ? *(const GAS v4u*)(U + (size_t)(row - 2) * 256 + c8) : z;
        const v4u g = *(const GAS v4u*)(BG + (size_t)row * 256 + c8);
        float o[8];
#pragma unroll
        for (int k = 0; k < 4; ++k) { const int c = c8 + 2 * k;
            o[2 * k]     = bf2f_lo(g[k]) * (sw[c] * bf2f_lo(u2[k]) + sw[256 + c] * bf2f_lo(u1[k]) + sw[512 + c] * bf2f_lo(u0[k]));
            o[2 * k + 1] = bf2f_hi(g[k]) * (sw[c + 1] * bf2f_hi(u2[k]) + sw[256 + c + 1] * bf2f_hi(u1[k]) + sw[512 + c + 1] * bf2f_hi(u0[k])); }
        v4u w; w.x = pk2(o[0], o[1]); w.y = pk2(o[2], o[3]); w.z = pk2(o[4], o[5]); w.w = pk2(o[6], o[7]);
        *(GAS v4u*)(MIX + (size_t)row * 1024 + 256 + c8) = w; }
}
__device__ __forceinline__ unsigned mono32(float f) { const unsigned u = __float_as_uint(f); return (u & 0x80000000u) ? ~u : (u | 0x80000000u); }
template <bool FROM_MASK> __device__ __forceinline__ void dsa_naive_query(Frame& F, const bf16* Q, const bf16* K, const bf16* V, const bf16* QI, const bf16* KI, const float* WI, const unsigned long long* MASK, bf16* MIX, int row) {
    const int tid = F.tid, lane = F.lane, wave = F.wave;
    const int b = row / SEQ, t = row % SEQ, n = t + 1;
    LAS unsigned long long* key64 = (LAS unsigned long long*)(F.lds + RING_OFF);
    LAS float* qi = (LAS float*)(F.lds + RING_OFF + 65536); LAS float* qh = (LAS float*)(F.lds + RING_OFF + 66560); LAS float* pl = (LAS float*)(F.lds + RING_OFF + 68608);
    LAS int* sel = (LAS int*)(F.lds + RING_OFF + 76800); LAS unsigned* cnt = (LAS unsigned*)(F.lds + RING_OFF + 77824);
    if (tid < 256) qi[tid] = bf2f(QI[(size_t)row * 256 + tid]);
    qh[tid] = bf2f(Q[(size_t)row * 512 + tid]);
    if (tid < 64) cnt[tid] = 0u;
    const f32x4 wv = *(const GAS f32x4*)(WI + (size_t)row * 4);
    __syncthreads();
    unsigned em = 0u;
    if constexpr (FROM_MASK) {
#pragma unroll
        for (int j = 0; j < 16; ++j) { const int s = tid + 512 * j;
            if (s < n) { const int kb = s >> 5, ko = s & 31, r = (ko & 3) + 4 * (ko >> 3), hh = (ko >> 2) & 1; const unsigned long long w = MASK[(((size_t)b * 256 + (t >> 5)) * 256 + kb) * 16 + r]; em |= (unsigned)((w >> (hh * 32 + (t & 31))) & 1ull) << j; } }
    } else {
    unsigned long long e[16]; unsigned long long T = 0ull;
#pragma unroll
    for (int j = 0; j < 16; ++j) { const int s = tid + 512 * j; e[j] = 0ull;
        if (s < n) { const GAS v4u* kr = (const GAS v4u*)(KI + (size_t)(b * SEQ + s) * 64); float kf[64];
#pragma unroll
            for (int c = 0; c < 8; ++c) { const v4u v = kr[c];
#pragma unroll
                for (int k = 0; k < 4; ++k) { kf[c * 8 + 2 * k] = bf2f_lo(v[k]); kf[c * 8 + 2 * k + 1] = bf2f_hi(v[k]); } }
            float sc = 0.f;
#pragma unroll
            for (int h = 0; h < 4; ++h) { float d0 = 0.f;
#pragma unroll
                for (int d = 0; d < 64; ++d) d0 += qi[h * 64 + d] * kf[d];
                sc += wv[h] * fmaxf(d0, 0.f); }
            sc = sc * IDX_SCALE + 0.0f;
            e[j] = ((unsigned long long)mono32(sc) << 13) | (unsigned long long)(8191 - s); } }
    if (n > 256) {
        for (int bit = 44; bit >= 0; --bit) { const unsigned long long cand = T | (1ull << bit); unsigned c = 0;
#pragma unroll
            for (int j = 0; j < 16; ++j) c += (e[j] >= cand) ? 1u : 0u;
            c = (unsigned)wave_sum((float)c);
            if (lane == 0) atomicAdd((unsigned*)&cnt[bit], c);
            __syncthreads();
            if (cnt[bit] >= 256u) T = cand; }
    }
    if (T == 0ull) T = 1ull;
#pragma unroll
    for (int j = 0; j < 16; ++j) em |= (e[j] >= T ? 1u : 0u) << j;
    }
    { unsigned c = 0;
      c = (unsigned)__builtin_popcount(em);
      unsigned inc = c;
#pragma unroll
      for (int o = 1; o < 64; o <<= 1) { const unsigned v = __shfl_up(inc, o); if (lane >= o) inc += v; }
      if (lane == 63) cnt[50 + wave] = inc;
      __syncthreads();
      unsigned base = inc - c;
#pragma unroll
      for (int w = 0; w < NWAVES; ++w) if (w < wave) base += cnt[50 + w];
#pragma unroll
      for (int j = 0; j < 16; ++j) if ((em >> j) & 1u) { if (base < 256u) sel[base] = tid + 512 * j; ++base; }
      if (tid == NWAVES * 64 - 1) cnt[48] = base; }
    __syncthreads();
    const int nsel = min((int)cnt[48], 256);
    { const int h = wave; float mx = -INFINITY;
#pragma unroll 1
      for (int kk = 0; kk < 4; ++kk) { const int k = lane + 64 * kk; float d0 = -INFINITY;
          if (k < nsel) { const GAS v4u* kr = (const GAS v4u*)(K + (size_t)(b * SEQ + sel[k]) * 512 + h * 64); d0 = 0.f;
#pragma unroll
              for (int c = 0; c < 8; ++c) { const v4u v = kr[c];
#pragma unroll
                  for (int q = 0; q < 4; ++q) d0 += qh[h * 64 + c * 8 + 2 * q] * bf2f_lo(v[q]) + qh[h * 64 + c * 8 + 2 * q + 1] * bf2f_hi(v[q]); } }
          pl[h * 256 + k] = d0; mx = fmaxf(mx, d0); }
      mx = wave_max(mx); float sum = 0.f;
#pragma unroll 1
      for (int kk = 0; kk < 4; ++kk) { const int k = lane + 64 * kk; const float p = (k < nsel) ? __builtin_amdgcn_exp2f(pl[h * 256 + k] - mx) : 0.f; pl[h * 256 + k] = p; sum += p; }
      sum = wave_sum(sum);
      LDS_WAIT(); asm volatile("" ::: "memory");
      float o = 0.f;
#pragma unroll 8
      for (int k = 0; k < nsel; ++k) o += pl[h * 256 + k] * bf2f(V[(size_t)(b * SEQ + sel[k]) * 512 + h * 64 + lane]);
      MIX[(size_t)row * 1024 + 512 + h * 64 + lane] = (bf16)pk2(o / sum, 0.f); }
    __syncthreads();
}
typedef float f32x16 __attribute__((ext_vector_type(16)));
__device__ __forceinline__ int crow(int r, int hi) { return (r & 3) + 8 * (r >> 2) + 4 * hi; }
constexpr int XA_ROWB = 528;
__device__ __forceinline__ void xattn_stage(Frame& F, const bf16* src  ) {
#pragma unroll 1
    for (int g = 0; g < 2; ++g) { v4u t[8];
#pragma unroll
        for (int i = 0; i < 8; ++i) { const int c = F.tid + 512 * (8 * g + i); t[i] = *(const GAS v4u*)(src + (size_t)(c >> 5) * 1024 + (c & 31) * 8); }
#pragma unroll
        for (int i = 0; i < 8; ++i) { const int c = F.tid + 512 * (8 * g + i); *(LAS v4u*)(F.lds + RING_OFF + (c >> 5) * XA_ROWB + (c & 31) * 16) = t[i]; } }
}
__device__ __forceinline__ void xattn_unit(Frame& F, const bf16* XQ, unsigned char* XO  , const bf16* MEMK, const bf16* MEMVT, int pm, int h) {
    const int lane = F.lane, wave = F.wave, r32 = lane & 31, hi = lane >> 5, b = pm >> 5;
    const int R0 = pm * 256 + wave * 32;
    LAS float* wsf = (LAS float*)(F.lds + RING_OFF + 256 * XA_ROWB) + wave * 64;
    xattn_stage(F, MEMK + (size_t)(b * 256) * 1024 + h * 256);
    bf16x8 qf[16];
#pragma unroll
    for (int kk = 0; kk < 16; ++kk) qf[kk] = *(const GAS bf16x8*)(XQ + (size_t)(R0 + r32) * 1024 + h * 256 + kk * 16 + hi * 8);
    __syncthreads();
    f32x16 st[8];
#pragma unroll
    for (int kb = 0; kb < 8; ++kb) { st[kb] = (f32x16){};
        const LAS unsigned char* kr = F.lds + RING_OFF + (kb * 32 + r32) * XA_ROWB + hi * 16;
#pragma unroll
        for (int kk = 0; kk < 16; ++kk) { const bf16x8 kf = *(const LAS bf16x8*)(kr + kk * 32); st[kb] = __builtin_amdgcn_mfma_f32_32x32x16_bf16(kf, qf[kk], st[kb], 0, 0, 0); if ((kk & 3) == 3) asm volatile("" ::: "memory"); } }
    float mx = -INFINITY;
#pragma unroll
    for (int kb = 0; kb < 8; ++kb)
#pragma unroll
        for (int r = 0; r < 16; ++r) mx = fmaxf(mx, st[kb][r]);
    { const auto rr = __builtin_amdgcn_permlane32_swap(__float_as_uint(mx), __float_as_uint(mx), false, false); mx = fmaxf(__uint_as_float(rr[0]), __uint_as_float(rr[1])); }
    float sum = 0.f; v4u pk[8][2];
#pragma unroll
    for (int kb = 0; kb < 8; ++kb) {
#pragma unroll
        for (int r = 0; r < 16; ++r) { st[kb][r] = __builtin_amdgcn_exp2f(st[kb][r] - mx); sum += st[kb][r]; }
#pragma unroll
        for (int hf = 0; hf < 2; ++hf)
#pragma unroll
            for (int q = 0; q < 4; ++q) pk[kb][hf][q] = pg8::cvt_pk_bf16(st[kb][8 * hf + 2 * q], st[kb][8 * hf + 2 * q + 1]); }
    { const auto rr = __builtin_amdgcn_permlane32_swap(__float_as_uint(sum), __float_as_uint(sum), false, false); sum = __uint_as_float(rr[0]) + __uint_as_float(rr[1]); }
    __syncthreads();
    xattn_stage(F, MEMVT + (size_t)(h * 256) * 1024 + b * 256);
    if (hi == 0) wsf[r32] = sum;
    __syncthreads();
    f32x16 o[8];
#pragma unroll
    for (int db = 0; db < 8; ++db) { o[db] = (f32x16){};
        const LAS unsigned char* vr = F.lds + RING_OFF + (db * 32 + r32) * XA_ROWB + hi * 8;
#pragma unroll
        for (int ks = 0; ks < 16; ++ks) { const pg8::u32x2 lo = *(const LAS pg8::u32x2*)(vr + ks * 32), hh = *(const LAS pg8::u32x2*)(vr + ks * 32 + 16);
            const v4u vv = (v4u){lo.x, lo.y, hh.x, hh.y};
            o[db] = __builtin_amdgcn_mfma_f32_32x32x16_bf16(__builtin_bit_cast(bf16x8, pk[ks >> 1][ks & 1]), __builtin_bit_cast(bf16x8, vv), o[db], 0, 0, 0); if ((ks & 3) == 3) asm volatile("" ::: "memory"); } }
    float rl[16];
#pragma unroll
    for (int r = 0; r < 16; ++r) rl[r] = 1.0f / wsf[crow(r, hi)];
#pragma unroll
    for (int db = 0; db < 8; ++db)
#pragma unroll
        for (int r = 0; r < 16; ++r) XO[(size_t)(R0 + crow(r, hi)) * 1024 + h * 256 + db * 32 + r32] = (unsigned char)__builtin_amdgcn_cvt_pk_fp8_f32(o[db][r] * rl[r], 0.f, 0u, false);
    __syncthreads();
}
__device__ __forceinline__ void final_norm_all(Frame& F, const bf16* X, const float* ss, const float* g, float* out) {
    const int gw = F.vcu * NWAVES + F.wave, NGW = F.G * NWAVES, lane = F.lane;
    f32x4 gg[4];
#pragma unroll
    for (int j = 0; j < 4; ++j) gg[j] = *(const GAS f32x4*)(g + (lane + 64 * j) * 4);
    for (int m0 = gw * 4; m0 < M; m0 += NGW * 4) {
        unsigned long long v[4][4]; float rs[4];
#pragma unroll
        for (int i = 0; i < 4; ++i) { rs[i] = pg8::rstd_of(ss, m0 + i);
#pragma unroll
            for (int j = 0; j < 4; ++j) v[i][j] = ((const GAS unsigned long long*)(X + (size_t)(m0 + i) * D))[lane + 64 * j]; }
#pragma unroll
        for (int i = 0; i < 4; ++i)
#pragma unroll
            for (int j = 0; j < 4; ++j) { const unsigned a = (unsigned)v[i][j], bq = (unsigned)(v[i][j] >> 32);
                *(GAS f32x4*)(out + (size_t)(m0 + i) * D + (lane + 64 * j) * 4) = (f32x4){bf2f_lo(a) * rs[i] * gg[j].x, bf2f_hi(a) * rs[i] * gg[j].y, bf2f_lo(bq) * rs[i] * gg[j].z, bf2f_hi(bq) * rs[i] * gg[j].w}; } }
}

constexpr int IX_HS = 1025;
constexpr int IX_ST = 32 * IX_HS * 4;
constexpr int IX_CAP = 1024;
#ifndef IX_DUP
#define IX_DUP 0
#endif
__device__ __forceinline__ void idx_load_a(bf16x8 (&a)[4], const bf16* kbase, int kb) {
#pragma unroll
    for (int kk = 0; kk < 4; ++kk) a[kk] = *(const GAS bf16x8*)(kbase + (size_t)kb * 2048 + kk * 512);
}
#define IX_RELU(x) __int_as_float(max(__float_as_int(x), 0))
#define IX_MF(ACC, H, KK) ACC = __builtin_amdgcn_mfma_f32_32x32x16_bf16(a[KK], bq[H][KK], ACC, 0, 0, 0)
#define IX_RS0(ACC, W, R) do { _Pragma("unroll") for (int r = (R); r < (R) + 4; ++r) { const float x = ACC[r]; sc[r] = __builtin_fmaf(W, IX_RELU(x), 0.0f); } } while (0)
#define IX_RS(ACC, W, R) do { _Pragma("unroll") for (int r = (R); r < (R) + 4; ++r) { const float x = ACC[r]; sc[r] = __builtin_fmaf(W, IX_RELU(x), sc[r]); } } while (0)
#define IX_PIN(ACC, VACC, R) asm volatile("" : "+v"(ACC), "+v"(VACC), "+v"(sc[R]), "+v"(sc[(R) + 1]), "+v"(sc[(R) + 2]), "+v"(sc[(R) + 3]))
template <bool PREV> __device__ __forceinline__ void idx_half1(float (&sc)[16], f32x16& acc0, f32x16& acc1, f32x16& acc2, f32x16& acc3, const bf16x8 (&a)[4], const bf16x8 (&bq)[4][4], const f32x4 wv) {
    acc0 = (f32x16){};
#pragma unroll
    for (int kk = 0; kk < 4; ++kk) { IX_MF(acc0, 0, kk); if constexpr (PREV) { IX_RS(acc2, wv[2], 4 * kk); IX_PIN(acc0, acc2, 4 * kk); } }
    acc1 = (f32x16){};
#pragma unroll
    for (int kk = 0; kk < 4; ++kk) { IX_MF(acc1, 1, kk); if constexpr (PREV) { IX_RS(acc3, wv[3], 4 * kk); IX_PIN(acc1, acc3, 4 * kk); } }
}
__device__ __forceinline__ void idx_half2(float (&sc)[16], f32x16& acc0, f32x16& acc1, f32x16& acc2, f32x16& acc3, const bf16x8 (&a)[4], const bf16x8 (&bq)[4][4], const f32x4 wv) {
    acc2 = (f32x16){};
#pragma unroll
    for (int kk = 0; kk < 4; ++kk) { IX_MF(acc2, 2, kk); IX_RS0(acc0, wv[0], 4 * kk); IX_PIN(acc2, acc0, 4 * kk); }
    acc3 = (f32x16){};
#pragma unroll
    for (int kk = 0; kk < 4; ++kk) { IX_MF(acc3, 3, kk); IX_RS(acc1, wv[1], 4 * kk); IX_PIN(acc3, acc1, 4 * kk); }
}
__device__ __forceinline__ void idx_tail(float (&sc)[16], const f32x16& acc2, const f32x16& acc3, const f32x4 wv) {
    IX_RS(acc2, wv[2], 0); IX_RS(acc2, wv[2], 4); IX_RS(acc2, wv[2], 8); IX_RS(acc2, wv[2], 12);
    IX_RS(acc3, wv[3], 0); IX_RS(acc3, wv[3], 4); IX_RS(acc3, wv[3], 8); IX_RS(acc3, wv[3], 12);
}
#undef IX_PIN
#undef IX_RELU
#undef IX_MF
#undef IX_RS0
#undef IX_RS
template <bool L2> __device__ __forceinline__ void idx_scan(LAS unsigned* row, bool positive, unsigned need, int lane, unsigned& bin_out, unsigned& need_out) {
    asm volatile("" : "+v"(lane));
    unsigned c[16], sum = 0;
#pragma unroll
    for (int i = 0; i < 16; ++i) { const int p = 16 * lane + i; const int bin = L2 ? (positive ? 1023 - p : p) : (p < 512 ? 511 - p : p); c[i] = row[bin]; row[bin] = 0u; sum += c[i]; }
    unsigned incl = sum;
#pragma unroll
    for (int o = 1; o < 64; o <<= 1) { const unsigned v = __shfl_up(incl, o); if (lane >= o) incl += v; }
    const unsigned long long m = __ballot(incl >= need);
    const int Ls = m ? (int)__builtin_ctzll(m) : 63;
    unsigned cum = incl - sum, fb = 0u, fn = 1u; bool found = false;
#pragma unroll
    for (int i = 0; i < 16; ++i) { const int p = 16 * lane + i; const unsigned bin = (unsigned)(L2 ? (positive ? 1023 - p : p) : (p < 512 ? 511 - p : p));
        if (!found && cum + c[i] >= need) { found = true; fb = bin; fn = need - cum; } cum += c[i]; }
    bin_out = (unsigned)__shfl((int)fb, Ls); need_out = (unsigned)__shfl((int)fn, Ls);
}
template <int NS> __device__ __forceinline__ unsigned idx_select(LAS unsigned* row, unsigned n, unsigned need, int lane) {
    unsigned v[NS], vor = 0u, vand = 0xffffffffu;
#pragma unroll
    for (int s = 0; s < NS; ++s) { const unsigned idx = (unsigned)(s * 64 + lane); const bool ok = idx < n; v[s] = ok ? row[idx] : 0u; vor |= v[s]; vand &= ok ? v[s] : 0xffffffffu; }
#pragma unroll
    for (int o = 1; o < 64; o <<= 1) { vor |= (unsigned)__shfl_xor((int)vor, o); vand &= (unsigned)__shfl_xor((int)vand, o); }
    const unsigned diff = vor ^ vand;
    if (diff == 0u) return vand;
    const int top = 31 - __builtin_clz(diff);
    unsigned T = vand & ~((2u << top) - 1u);
    for (int bit = top; bit >= 0; --bit) { const unsigned cand = T | (1u << bit); unsigned c = 0;
#pragma unroll
        for (int s = 0; s < NS; ++s) c += (unsigned)__builtin_popcountll(__ballot(v[s] >= cand));
        if (c >= need) T = cand; }
    return T;
}
__device__ __forceinline__ unsigned ix_mono(unsigned raw) { return (raw & 0x80000000u) ? ~raw : (raw | 0x80000000u); }
__device__ __forceinline__ float ix_h2f(unsigned h) { return (float)__builtin_bit_cast(_Float16, (unsigned short)h); }
__device__ __forceinline__ unsigned ix_pick(const float (&sc)[16], unsigned r) {
    const unsigned m0 = (unsigned)((int)(r << 31) >> 31), m1 = (unsigned)((int)(r << 30) >> 31), m2 = (unsigned)((int)(r << 29) >> 31), m3 = (unsigned)((int)(r << 28) >> 31); unsigned t[8], u[4], w[2];
#pragma unroll
    for (int i = 0; i < 8; ++i) t[i] = (__float_as_uint(sc[2 * i + 1]) & m0) | (__float_as_uint(sc[2 * i]) & ~m0);
#pragma unroll
    for (int i = 0; i < 4; ++i) u[i] = (t[2 * i + 1] & m1) | (t[2 * i] & ~m1);
#pragma unroll
    for (int i = 0; i < 2; ++i) w[i] = (u[2 * i + 1] & m2) | (u[2 * i] & ~m2);
    return (w[1] & m3) | (w[0] & ~m3);
}
__device__ __forceinline__ void idx_unit(Frame& F, const bf16* QI, const bf16* KI, const float* WI, unsigned* MASK, int b, int j) {
    int lane = F.lane, r32 = lane & 31, hi = lane >> 5; const int wave = F.wave;
#define IX_LAUNDER() asm volatile("" : "+v"(lane), "+v"(r32), "+v"(hi))
    LAS unsigned* hist = (LAS unsigned*)(F.lds + RING_OFF);
    LAS unsigned* st = (LAS unsigned*)(F.lds + RING_OFF + IX_ST);
    const size_t qrow = (size_t)b * SEQ + 32 * j + r32;
    bf16x8 bq[4][4];
#pragma unroll
    for (int h = 0; h < 4; ++h)
#pragma unroll
        for (int kk = 0; kk < 4; ++kk) bq[h][kk] = *(const GAS bf16x8*)(QI + qrow * 256 + h * 64 + kk * 16 + hi * 8);
    f32x4 wv = *(const GAS f32x4*)(WI + qrow * 4); wv = wv * IDX_SCALE;
    const bf16* kbase = KI + (size_t)b * SEQ * 64 + (size_t)(hi * 32 + r32) * 8;
    LAS unsigned* myrow = hist + r32 * IX_HS;
    const unsigned myrow_b = (unsigned)(uintptr_t)myrow;
#define IX_BODY(KBP, ...) do { const int kb = (KBP); if (kb == j) { _Pragma("unroll") for (int r = 0; r < 16; ++r) sc[r] = (crow(r, hi) > r32) ? -INFINITY : sc[r]; } __VA_ARGS__ } while (0)
#define IX_STEP(A, KB, ...) do { idx_half1<true>(sc, acc0, acc1, acc2, acc3, A, bq, wv); IX_BODY(kbp, __VA_ARGS__); idx_half2(sc, acc0, acc1, acc2, acc3, A, bq, wv); idx_load_a(A, kbase, min((KB) + 3 * NWAVES, j)); kbp = (KB); } while (0)
#define IX_PASS(...) do { IX_LAUNDER(); bf16x8 a0[4], a1[4], a2[4]; idx_load_a(a0, kbase, min(wave, j)); idx_load_a(a1, kbase, min(wave + NWAVES, j)); idx_load_a(a2, kbase, min(wave + 2 * NWAVES, j)); \
        if (wave <= j) { float sc[16]; f32x16 acc0, acc1, acc2, acc3; int kbp = wave; \
            idx_half1<false>(sc, acc0, acc1, acc2, acc3, a0, bq, wv); idx_half2(sc, acc0, acc1, acc2, acc3, a0, bq, wv); idx_load_a(a0, kbase, min(wave + 3 * NWAVES, j)); \
            for (int kb_ = wave + NWAVES;;) { \
                if (kb_ > j) break; IX_STEP(a1, kb_, __VA_ARGS__); kb_ += NWAVES; \
                if (kb_ > j) break; IX_STEP(a2, kb_, __VA_ARGS__); kb_ += NWAVES; \
                if (kb_ > j) break; IX_STEP(a0, kb_, __VA_ARGS__); kb_ += NWAVES; } \
            idx_tail(sc, acc2, acc3, wv); IX_BODY(kbp, __VA_ARGS__); } } while (0)
    float ts = -3.402823466e38f, ti = -3.402823466e38f; unsigned mbase = 0u;
    if (j >= 8) for (int ra_ = 0; ra_ < 1 + (IX_DUP & 1); ++ra_) {
        IX_PASS({
            _Pragma("unroll") for (int r = 0; r < 16; r += 2) { unsigned u; asm("v_cvt_pkrtz_f16_f32 %0, %1, %2" : "=v"(u) : "v"(sc[r]), "v"(sc[r + 1]));
                unsigned a0, a1; asm("v_lshl_add_u32 %0, %1, 2, %2" : "=v"(a0) : "v"((u >> 6) & 1023u), "v"(myrow_b)); asm("v_lshl_add_u32 %0, %1, 2, %2" : "=v"(a1) : "v"(u >> 22), "v"(myrow_b));
                __hip_atomic_fetch_add((LAS unsigned*)a0, 1u, __ATOMIC_RELAXED, __HIP_MEMORY_SCOPE_WORKGROUP); __hip_atomic_fetch_add((LAS unsigned*)a1, 1u, __ATOMIC_RELAXED, __HIP_MEMORY_SCOPE_WORKGROUP); } });
        __syncthreads();
#pragma unroll 1
        for (int qq = wave * 4; qq < wave * 4 + 4; ++qq) { unsigned bn, nd; idx_scan<false>(hist + qq * IX_HS, true, 256u, lane, bn, nd);
            if (lane == 0) {
                float tsv, tiv;
                if (bn < 512u) { tiv = ix_h2f(bn << 6); tsv = ix_h2f((bn + 1u) << 6); }
                else { const unsigned mb = bn - 512u; const float mlo = ix_h2f(mb << 6), mhi = ix_h2f((mb + 1u) << 6);
                    tsv = (mlo == 0.f) ? 0.f : __uint_as_float(__float_as_uint(-mlo) - 1u); tiv = __uint_as_float(__float_as_uint(-mhi) - 1u); }
                st[qq] = bn; st[32 + qq] = nd; st[64 + qq] = __float_as_uint(tsv); st[96 + qq] = __float_as_uint(tiv); st[128 + qq] = ix_mono(__float_as_uint(tiv)); st[160 + qq] = 0u; } }
        __syncthreads();
        ts = __uint_as_float(st[64 + r32]); ti = __uint_as_float(st[96 + r32]); mbase = st[128 + r32];
    }
    unsigned short* mrow = (unsigned short*)(MASK + (((size_t)b * 256 + j) * 128) * 64);
    for (int rd_ = 0; rd_ < 1 + ((IX_DUP >> 1) & 1); ++rd_) { if (rd_) { __syncthreads(); if (F.tid < 32) st[160 + F.tid] = 0u; __syncthreads(); }
    IX_PASS({
            unsigned w16 = 0u, c16 = 0u;
            _Pragma("unroll") for (int r = 15; r >= 0; --r) asm("v_cmp_ge_f32_e32 vcc, %2, %3\n\tv_addc_co_u32_e32 %0, vcc, %0, %0, vcc\n\tv_cmp_ge_f32_e32 vcc, %2, %4\n\tv_addc_co_u32_e32 %1, vcc, %1, %1, vcc" : "+v"(w16), "+v"(c16) : "v"(sc[r]), "v"(ts), "v"(ti) : "vcc");
            mrow[(((size_t)(kb >> 1) * 64 + lane) << 1) + (kb & 1)] = (unsigned short)w16;
            const unsigned cm = c16 & ~w16;
            if (cm) { unsigned base = __hip_atomic_fetch_add(st + 160 + r32, (unsigned)__builtin_popcount(cm), __ATOMIC_RELAXED, __HIP_MEMORY_SCOPE_WORKGROUP);
                _Pragma("unroll 1") for (unsigned cmv = cm; cmv; cmv &= cmv - 1u) { const unsigned r = (unsigned)__builtin_ctz(cmv); const unsigned d = ix_mono(ix_pick(sc, r)) - mbase;
                        if (base < (unsigned)IX_CAP) myrow[base] = (min(d, 0x7ffffu) << 13) | (8191u - (32u * (unsigned)kb + (r & 3u) + 8u * (r >> 2) + 4u * (unsigned)hi)); ++base; } } });
    }
    for (int kb = j + 1 + wave; kb <= (j | 7); kb += NWAVES) mrow[(((size_t)(kb >> 1) * 64 + lane) << 1) + (kb & 1)] = (unsigned short)0;
    asm volatile("s_waitcnt vmcnt(0)" ::: "memory");
    __syncthreads();
    if (j >= 8) {
#pragma unroll 1
        for (int qq = wave * 4; qq < wave * 4 + 4; ++qq) { LAS unsigned* row = hist + qq * IX_HS; const unsigned n = min(st[160 + qq], (unsigned)IX_CAP), need = st[32 + qq];
            const int ns = (int)((n + 63u) >> 6); unsigned T = 0u;
            if (ns <= 2) T = idx_select<2>(row, n, need, lane); else if (ns <= 4) T = idx_select<4>(row, n, need, lane); else if (ns <= 8) T = idx_select<8>(row, n, need, lane); else T = idx_select<16>(row, n, need, lane);
            for (int s = 0; s < ns; ++s) { const unsigned idx = (unsigned)(s * 64 + lane);
                if (idx < n) { const unsigned v = row[idx]; row[idx] = 0u;
                    if (v >= T) { const unsigned key = 8191u - (v & 8191u), kbk = key >> 5, ko = key & 31u, rr = (ko & 3u) + 4u * (ko >> 3), hh = (ko >> 2) & 1u;
                        __hip_atomic_fetch_or((unsigned*)mrow + (size_t)(kbk >> 1) * 64 + hh * 32 + qq, 1u << (16u * (kbk & 1u) + rr), __ATOMIC_RELAXED, __HIP_MEMORY_SCOPE_AGENT); } } } }
        __syncthreads();
    }
#undef IX_PASS
#undef IX_STEP
#undef IX_BODY
#undef IX_LAUNDER
}
__device__ __forceinline__ void idx_unit_of(int u, int& b, int& j) { const int slot = u >> 8, v = u & 255, i = v & 63; b = v >> 6; j = slot == 0 ? 255 - i : slot == 1 ? 128 + i : slot == 2 ? 127 - i : i; }

#include <hip/hip_bf16.h>
namespace attn_body {
using bf16=__hip_bfloat16;
using bf16x8=__attribute__((ext_vector_type(8)))short;
using s16x4=__attribute__((ext_vector_type(4)))short;
using f32x16=__attribute__((ext_vector_type(16)))float;
using u32x4=__attribute__((ext_vector_type(4)))unsigned;
constexpr int BATCH=4,NHEAD=8,SEQ=8192,D=64,DM=NHEAD*D,OPITCH=1024;
constexpr int NW=8,QBLK=32,QB=QBLK*NW,KVBLK=64,NQB=SEQ/QB;
constexpr int ATTN_PITCH=DM, ATTN_UNIT_ROWS=QB;
__device__ __forceinline__ int crow(int r,int hi){return (r&3)+8*(r>>2)+4*hi;}
#define SBAR() __builtin_amdgcn_sched_barrier(0)
#define MASK1(p,w,e) ({ unsigned m_; asm("v_bfe_i32 %0, %1, %2, 1":"=v"(m_):"v"(w),"n"(e)); __uint_as_float(__float_as_uint(p)&m_); })

constexpr int NSLOT=3, SLOTB=8192;
constexpr int LDS_K=0, LDS_V=NSLOT*SLOTB, LDS_WS=2*NSLOT*SLOTB, LDS_OST=LDS_WS+NW*64*4, LDS_BYTES=LDS_OST+NW*4096;
constexpr float C2=0.125f*1.4426950408889634f;
__device__ __forceinline__ void glds16(const void*gsrc,unsigned lds_dst){unsigned keep;
  asm volatile("s_mov_b32 %0, m0\n\ts_mov_b32 m0, %2\n\ts_nop 0\n\tglobal_load_lds_dwordx4 %1, off\n\ts_mov_b32 m0, %0":"=&s"(keep):"v"(gsrc),"s"(lds_dst):"memory");}
__device__ __forceinline__ float max3f(float a,float b,float c){float r;asm("v_max3_f32 %0, %1, %2, %3":"=v"(r):"v"(a),"v"(b),"v"(c));return r;}
__device__ __forceinline__ float max2f(float a,float b){float r;asm("v_max_f32_e32 %0, %1, %2":"=v"(r):"v"(a),"v"(b));return r;}
__device__ __forceinline__ float fadd_s(float a,float b){float r;asm("v_add_f32_e32 %0, %1, %2":"=v"(r):"v"(a),"v"(b));return r;}
__device__ __forceinline__ float fsub_s(float a,float b){float r;asm("v_sub_f32_e32 %0, %1, %2":"=v"(r):"v"(a),"v"(b));return r;}
typedef float f32x2_t __attribute__((ext_vector_type(2))); typedef __bf16 bf16x2_t __attribute__((ext_vector_type(2)));
__device__ __forceinline__ unsigned cvtpk_s(float lo,float hi){f32x2_t v={lo,hi};bf16x2_t b=__builtin_convertvector(v,bf16x2_t);return __builtin_bit_cast(unsigned,b);}
#define WAIT_BAR(N) asm volatile("s_waitcnt vmcnt(" #N ") lgkmcnt(0)\n\ts_barrier":::"memory")

__device__ __forceinline__ void qkt(f32x16&p0,f32x16&p1,const char*Kslot,const bf16x8*qr,const f32x16&negm,int r32,int hi){
  const char*kb=Kslot+hi*1024+r32*16;
  #pragma unroll
  for(int d0=0;d0<4;++d0){
    const bf16x8 b0=*reinterpret_cast<const bf16x8*>(kb+d0*2048);
    const bf16x8 b1=*reinterpret_cast<const bf16x8*>(kb+d0*2048+512);
    if(d0==0){p0=__builtin_amdgcn_mfma_f32_32x32x16_bf16(b0,qr[0],negm,0,0,0);p1=__builtin_amdgcn_mfma_f32_32x32x16_bf16(b1,qr[0],negm,0,0,0);}
    else{p0=__builtin_amdgcn_mfma_f32_32x32x16_bf16(b0,qr[d0],p0,0,0,0);p1=__builtin_amdgcn_mfma_f32_32x32x16_bf16(b1,qr[d0],p1,0,0,0);}}
}
typedef __attribute__((address_space(3))) const char* lds_cptr;
typedef short v4i16_t __attribute__((ext_vector_type(4)));
__device__ __forceinline__ void kload8(bf16x8*kf,lds_cptr kp){
  kf[0]=*(const __attribute__((address_space(3))) bf16x8*)(kp);      kf[1]=*(const __attribute__((address_space(3))) bf16x8*)(kp+512);
  kf[2]=*(const __attribute__((address_space(3))) bf16x8*)(kp+2048); kf[3]=*(const __attribute__((address_space(3))) bf16x8*)(kp+2560);
  kf[4]=*(const __attribute__((address_space(3))) bf16x8*)(kp+4096); kf[5]=*(const __attribute__((address_space(3))) bf16x8*)(kp+4608);
  kf[6]=*(const __attribute__((address_space(3))) bf16x8*)(kp+6144); kf[7]=*(const __attribute__((address_space(3))) bf16x8*)(kp+6656);
}
__device__ __forceinline__ void kload2(bf16x8*kf,lds_cptr kp,int j){ kf[2*j]=*(const __attribute__((address_space(3))) bf16x8*)(kp+j*2048); kf[2*j+1]=*(const __attribute__((address_space(3))) bf16x8*)(kp+j*2048+512); }
__device__ __forceinline__ s16x4 vtr(lds_cptr p){ return __builtin_bit_cast(s16x4,__builtin_amdgcn_ds_read_tr16_b64_v4i16((__attribute__((address_space(3))) v4i16_t*)p)); }
__device__ __forceinline__ float rowmax(const f32x16&p0,const f32x16&p1){
  float a=max3f(p0[0],p0[1],p1[0]),b=max3f(p0[2],p0[3],p1[1]);a=max3f(a,p1[2],p1[3]);
  #pragma unroll
  for(int r=4;r<16;r+=4){a=max3f(a,p0[r],p0[r+1]);b=max3f(b,p0[r+2],p0[r+3]);a=max3f(a,p1[r],p1[r+1]);b=max3f(b,p1[r+2],p1[r+3]);}
  const float m=max2f(a,b);
  auto rr=__builtin_amdgcn_permlane32_swap(__float_as_uint(m),__float_as_uint(m),false,false);
  return max2f(__uint_as_float(rr[0]),__uint_as_float(rr[1]));
}
__device__ __forceinline__ void pv(f32x16*o,int vb,bf16x8 pa0,bf16x8 pa1,bf16x8 pa2,bf16x8 pa3){
  #pragma unroll
  for(int d0=0;d0<2;++d0){s16x4 lo[4],hi[4];
    #pragma unroll
    for(int ks=0;ks<4;++ks){
      asm volatile("ds_read_b64_tr_b16 %0,%1 offset:%c2":"=&v"(lo[ks]):"v"(vb),"i"(d0*4096+ks*1024):"memory");
      asm volatile("ds_read_b64_tr_b16 %0,%1 offset:%c2":"=&v"(hi[ks]):"v"(vb),"i"(d0*4096+ks*1024+512):"memory");}
    asm volatile("s_waitcnt lgkmcnt(0)":::"memory");SBAR();
    #define PK(k) (bf16x8){lo[k][0],lo[k][1],lo[k][2],lo[k][3],hi[k][0],hi[k][1],hi[k][2],hi[k][3]}
    o[d0]=__builtin_amdgcn_mfma_f32_32x32x16_bf16(pa0,PK(0),o[d0],0,0,0);
    o[d0]=__builtin_amdgcn_mfma_f32_32x32x16_bf16(pa1,PK(1),o[d0],0,0,0);
    o[d0]=__builtin_amdgcn_mfma_f32_32x32x16_bf16(pa2,PK(2),o[d0],0,0,0);
    o[d0]=__builtin_amdgcn_mfma_f32_32x32x16_bf16(pa3,PK(3),o[d0],0,0,0);
    #undef PK
  }
}

#ifndef ATTN_STORE16
#define ATTN_STORE16(p,v) (*(u32x4*)(p)=(v))
#endif
template<int THRL> __device__ __forceinline__ void attn_unit(int b,int h,int qb,const bf16*Q,const bf16*__restrict__ K,const bf16*__restrict__ V,bf16*O,const unsigned*MASK,char*shm){
  int tid_=threadIdx.x; asm volatile("":"+v"(tid_));
  const int tid=tid_,lane=tid&63,r32=lane&31,hi=lane>>5; const int wid=__builtin_amdgcn_readfirstlane(tid>>6);
  const long rowbase=(long)b*SEQ; const int q0=qb*QB;
  const bf16*Qw=Q+(rowbase+q0+wid*QBLK)*DM+h*D;
  const bf16*Kh=K+rowbase*DM+h*D,*Vh=V+rowbase*DM+h*D;
  const unsigned lds0=(unsigned)(uintptr_t)shm;
  float*wsf=(float*)(shm+LDS_WS)+wid*64;
  const bf16*ksrc=Kh+(long)lane*DM+wid*8;
  const bf16*vsrc=Vh+(long)(16*(wid&3)+(lane>>2))*DM+(wid>>2)*32+(lane&3)*8;
  const unsigned kdst=lds0+LDS_K+wid*1024, vdst=lds0+LDS_V+wid*1024;
  #define DMA_K(t,slot) glds16(ksrc+(long)(t)*KVBLK*DM,(unsigned)__builtin_amdgcn_readfirstlane(kdst+(slot)))
  #define DMA_V(t,slot) glds16(vsrc+(long)(t)*KVBLK*DM,(unsigned)__builtin_amdgcn_readfirstlane(vdst+(slot)))
  const int vb0=(int)(lds0+LDS_V)+((lane>>4)&1)*32+(lane&3)*8+(4*hi+((lane&15)>>2))*64;
  const char*Kbase=shm+LDS_K; bf16x8 kf[8];
  const lds_cptr shm3=(lds_cptr)shm; const lds_cptr kp0=shm3+LDS_K+hi*1024+r32*16; const lds_cptr vp0=shm3+LDS_V+((lane>>4)&1)*32+(lane&3)*8+(4*hi+((lane&15)>>2))*64;
  const int NT=(q0+QB)/KVBLK;
  const unsigned*mwl=MASK+((size_t)(b*256+qb*8+wid)*128)*64+lane;
  unsigned wA,wB;
  #define WLOAD(W,t) asm volatile("global_load_dword %0, %1, off":"=v"(W):"v"(mwl+(size_t)(t)*64):"memory")
  WLOAD(wA,0);WLOAD(wB,1);
  DMA_K(0,0);DMA_V(0,0);DMA_K(1,SLOTB);
  bf16x8 qr[4];
  #pragma unroll
  for(int d0=0;d0<4;++d0)qr[d0]=*reinterpret_cast<const bf16x8*>(&Qw[(long)r32*DM+d0*16+hi*8]);
  float mhat=0.f,l_reg=0.f;f32x16 o[2];o[0]=f32x16{};o[1]=f32x16{};f32x16 negm=f32x16{};asm volatile("":"+v"(negm));
  bool resc=false;
  #define START(P0,P1) do{ const float rm=rowmax(P0,P1); resc=false; \
    { const float dl=rm>-1e30f?rm:0.f; mhat=fadd_s(mhat,dl); \
      _Pragma("unroll") for(int r=0;r<16;++r){P0[r]=fsub_s(P0[r],dl);P1[r]=fsub_s(P1[r],dl);} \
      _Pragma("unroll") for(int r=0;r<16;++r)negm[r]=-mhat; asm volatile("":"+v"(negm)); } \
    _Pragma("unroll") for(int r=0;r<16;++r)P0[r]=__builtin_amdgcn_exp2f(P0[r]); }while(0)
  #define RESC() do{ if(resc){ asm volatile("s_waitcnt lgkmcnt(0)":::"memory"); \
      _Pragma("unroll") for(int d_=0;d_<2;++d_) _Pragma("unroll") for(int r=0;r<16;++r)o[d_][r]*=wsf[crow(r,hi)]; } }while(0)
  f32x16 pA0,pA1,pB0,pB1;
  int sl_prev=0,sl_cur=0,sl_next=SLOTB;
  #define ROT() do{sl_prev=sl_cur;sl_cur=sl_next;sl_next=(sl_next==(NSLOT-1)*SLOTB)?0:sl_next+SLOTB;}while(0)
  DMA_K(2,2*SLOTB);
  WAIT_BAR(3);
  qkt(pA0,pA1,Kbase,qr,negm,r32,hi);asm volatile("s_nop 15\n\ts_nop 7":"+v"(pA0),"+v"(pA1));
  START(pA0,pA1);
  _Pragma("unroll") for(int r=0;r<16;++r)pA1[r]=__builtin_amdgcn_exp2f(pA1[r]);
  _Pragma("unroll") for(int r=0;r<16;++r){pA0[r]=MASK1(pA0[r],wA,r);pA1[r]=MASK1(pA1[r],wA,16+r);}
  WAIT_BAR(0);
  DMA_K(3,0);DMA_V(1,SLOTB);
  ROT();
  kload8(kf,kp0+sl_cur);
  WAIT_BAR(2);
  s16x4 vlo[8],vhi[8]; u32x4 pw0,pw1,pw2,pw3;
  #define PKW(P,B) cvtpk_s(P[B],P[B+1])
  #define PAF(k) __builtin_bit_cast(bf16x8,pw##k)
  #define VFR(i) (bf16x8){vlo[i][0],vlo[i][1],vlo[i][2],vlo[i][3],vhi[i][0],vhi[i][1],vhi[i][2],vhi[i][3]}
  #define PIN(x) asm volatile("":"+v"(x))
  #define MX3(a,b,c) __builtin_fmaxf(__builtin_fmaxf((a),(b)),(c))
  #define GAPA(MF,A0,A1,A2,A3,W0,W1,PW) do{ MF; sacc+=A0; sacc+=A1; sacc+=A2; sacc+=A3; PIN(sacc); W0; W1; PIN(PW); SBAR(); }while(0)
  #define EX(v) __builtin_amdgcn_exp2f(v)
  #define BFE1(m,w,e) asm("v_bfe_i32 %0, %1, %2, 1":"=v"(m):"v"(w),"n"(e))
  #define AND1(x,m) __uint_as_float(__float_as_uint(x)&(m))
  #define GAPB(MF,X,B,W,E) do{ MF; unsigned m0_,m1_,m2_,m3_; \
      const float e0_=EX(X[B]); SBAR(); BFE1(m0_,W,(E)); SBAR(); const float e1_=EX(X[B+1]); SBAR(); BFE1(m1_,W,(E)+1); SBAR(); X[B]=AND1(e0_,m0_); SBAR(); \
      const float e2_=EX(X[B+2]); SBAR(); BFE1(m2_,W,(E)+2); SBAR(); X[B+1]=AND1(e1_,m1_); SBAR(); const float e3_=EX(X[B+3]); SBAR(); BFE1(m3_,W,(E)+3); SBAR(); X[B+2]=AND1(e2_,m2_); SBAR(); X[B+3]=AND1(e3_,m3_); PIN(X); SBAR(); }while(0)
  #define VRD(i) do{ vlo[i]=vtr(vp_+(((i)>>2)*4096+((i)&3)*1024)); vhi[i]=vtr(vp_+(((i)>>2)*4096+((i)&3)*1024+512)); }while(0)
  #define KRD(G,j) do{ if(G){ kload2(kf,kp0+sl_next,j); SBAR(); } }while(0)
  #define STEP(C0,C1,P0,P1,t,GK,GV,GL,WU,WL) do{ SBAR(); if((t)+1<NT){WLOAD(WL,(t)+1);} SBAR(); \
    const lds_cptr vp_=vp0+sl_prev; \
    VRD(0); SBAR(); float sacc=(P0[0]+P0[1]); \
    GAPA(C0=__builtin_amdgcn_mfma_f32_32x32x16_bf16(kf[0],qr[0],negm,0,0,0), P0[2],P0[3],P0[4],P0[5],     pw0[0]=PKW(P0,0), pw0[1]=PKW(P0,2), pw0); \
    VRD(4); SBAR(); GAPA(C1=__builtin_amdgcn_mfma_f32_32x32x16_bf16(kf[1],qr[0],negm,0,0,0), P0[6],P0[7],P0[8],P0[9],     pw0[2]=PKW(P0,4), pw0[3]=PKW(P0,6), pw0); \
    VRD(1); SBAR(); GAPA(C0=__builtin_amdgcn_mfma_f32_32x32x16_bf16(kf[2],qr[1],C0,0,0,0),   P0[10],P0[11],P0[12],P0[13], pw1[0]=PKW(P0,8), pw1[1]=PKW(P0,10), pw1); \
    VRD(5); SBAR(); GAPA(C1=__builtin_amdgcn_mfma_f32_32x32x16_bf16(kf[3],qr[1],C1,0,0,0),   P0[14],P0[15],P1[0],P1[1],   pw1[2]=PKW(P0,12),pw1[3]=PKW(P0,14), pw1); \
    VRD(2); SBAR(); GAPA(C0=__builtin_amdgcn_mfma_f32_32x32x16_bf16(kf[4],qr[2],C0,0,0,0),   P1[2],P1[3],P1[4],P1[5],     pw2[0]=PKW(P1,0), pw2[1]=PKW(P1,2), pw2); \
    VRD(6); SBAR(); GAPA(C1=__builtin_amdgcn_mfma_f32_32x32x16_bf16(kf[5],qr[2],C1,0,0,0),   P1[6],P1[7],P1[8],P1[9],     pw2[2]=PKW(P1,4), pw2[3]=PKW(P1,6), pw2); \
    VRD(3); SBAR(); GAPA(C0=__builtin_amdgcn_mfma_f32_32x32x16_bf16(kf[6],qr[3],C0,0,0,0),   P1[10],P1[11],P1[12],P1[13], pw3[0]=PKW(P1,8), pw3[1]=PKW(P1,10), pw3); \
    VRD(7); SBAR(); GAPA(C1=__builtin_amdgcn_mfma_f32_32x32x16_bf16(kf[7],qr[3],C1,0,0,0),   P1[14],P1[15],0.f,0.f,       pw3[2]=PKW(P1,12),pw3[3]=PKW(P1,14), pw3); \
    l_reg+=sacc; \
    if(GK){DMA_K((t)+3,sl_cur);} if(GV){DMA_V((t)+1,sl_next);} \
    { float a=MX3(C0[0],C0[1],C1[0]),b=MX3(C0[2],C0[3],C1[1]); a=MX3(a,C1[2],C1[3]); \
      _Pragma("unroll") for(int r=4;r<16;r+=4){a=MX3(a,C0[r],C0[r+1]);b=MX3(b,C0[r+2],C0[r+3]);a=MX3(a,C1[r],C1[r+1]);b=MX3(b,C1[r+2],C1[r+3]);} \
      float rm=__builtin_fmaxf(a,b); { auto rr=__builtin_amdgcn_permlane32_swap(__float_as_uint(rm),__float_as_uint(rm),false,false); rm=__builtin_fmaxf(__uint_as_float(rr[0]),__uint_as_float(rr[1])); } \
      resc=false; \
      if(__builtin_expect(__any(rm>(float)THRL),0)){ const float dl=__builtin_fmaxf(rm,0.f); mhat+=dl; \
        _Pragma("unroll") for(int r=0;r<16;++r){C0[r]-=dl;C1[r]-=dl;} \
        _Pragma("unroll") for(int r=0;r<16;++r)negm[r]=-mhat; asm volatile("":"+v"(negm)); \
        const float f=__builtin_amdgcn_exp2f(-dl); l_reg*=f; if(hi==0)wsf[r32]=f; resc=true; } } \
    SBAR(); \
    GAPB(o[0]=__builtin_amdgcn_mfma_f32_32x32x16_bf16(PAF(0),VFR(0),o[0],0,0,0), C0,0,WU,0); \
    GAPB(o[1]=__builtin_amdgcn_mfma_f32_32x32x16_bf16(PAF(0),VFR(4),o[1],0,0,0), C0,4,WU,4); \
    KRD(GL,0); GAPB(o[0]=__builtin_amdgcn_mfma_f32_32x32x16_bf16(PAF(1),VFR(1),o[0],0,0,0), C0,8,WU,8); \
    KRD(GL,1); GAPB(o[1]=__builtin_amdgcn_mfma_f32_32x32x16_bf16(PAF(1),VFR(5),o[1],0,0,0), C0,12,WU,12); \
    KRD(GL,2); GAPB(o[0]=__builtin_amdgcn_mfma_f32_32x32x16_bf16(PAF(2),VFR(2),o[0],0,0,0), C1,0,WU,16); \
    KRD(GL,3); GAPB(o[1]=__builtin_amdgcn_mfma_f32_32x32x16_bf16(PAF(2),VFR(6),o[1],0,0,0), C1,4,WU,20); \
    GAPB(o[0]=__builtin_amdgcn_mfma_f32_32x32x16_bf16(PAF(3),VFR(3),o[0],0,0,0), C1,8,WU,24); \
    GAPB(o[1]=__builtin_amdgcn_mfma_f32_32x32x16_bf16(PAF(3),VFR(7),o[1],0,0,0), C1,12,WU,28); \
    }while(0)
  int t=1;
  for(;t+5<NT;t+=2){
    STEP(pB0,pB1,pA0,pA1,t,true,true,true,wB,wA);     WAIT_BAR(2); RESC(); ROT();
    STEP(pA0,pA1,pB0,pB1,t+1,true,true,true,wA,wB);   WAIT_BAR(2); RESC(); ROT();
  }
  #define ENDW(tt) do{ if((tt)+3<NT){WAIT_BAR(2);} else if((tt)+2<NT){WAIT_BAR(1);} else {WAIT_BAR(0);} }while(0)
  for(;t+1<NT;t+=2){
    STEP(pB0,pB1,pA0,pA1,t,(t+3<NT),(t+1<NT),(t+1<NT),wB,wA);       ENDW(t);   RESC(); ROT();
    STEP(pA0,pA1,pB0,pB1,t+1,(t+4<NT),(t+2<NT),(t+2<NT),wA,wB);     ENDW(t+1); RESC(); ROT();
  }
  STEP(pB0,pB1,pA0,pA1,NT-1,false,false,false,wB,wA); RESC();
  { float sacc=pB0[0]+pB0[1]; _Pragma("unroll") for(int r=2;r<16;++r)sacc+=pB0[r]; _Pragma("unroll") for(int r=0;r<16;++r)sacc+=pB1[r]; l_reg+=sacc;
    pw0=(u32x4){PKW(pB0,0),PKW(pB0,2),PKW(pB0,4),PKW(pB0,6)};pw1=(u32x4){PKW(pB0,8),PKW(pB0,10),PKW(pB0,12),PKW(pB0,14)};pw2=(u32x4){PKW(pB1,0),PKW(pB1,2),PKW(pB1,4),PKW(pB1,6)};pw3=(u32x4){PKW(pB1,8),PKW(pB1,10),PKW(pB1,12),PKW(pB1,14)};
    SBAR(); pv(o,vb0+sl_cur,PAF(0),PAF(1),PAF(2),PAF(3)); }
  #undef PKW
  #undef PAF
  #undef VFR
  #undef PIN
  #undef MX3
  #undef GAPA
  #undef GAPB
  #undef EX
  #undef VRD
  #undef KRD
  #undef STEP
  #undef ENDW
  {auto rr=__builtin_amdgcn_permlane32_swap(__float_as_uint(l_reg),__float_as_uint(l_reg),false,false);l_reg=__uint_as_float(rr[0])+__uint_as_float(rr[1]);}
  if(hi==0)wsf[32+r32]=l_reg;asm volatile("s_waitcnt lgkmcnt(0)":::"memory");
  float rli[16];
  #pragma unroll
  for(int r=0;r<16;++r)rli[r]=__builtin_amdgcn_rcpf(wsf[32+crow(r,hi)]);
  bf16*Ow=O+(rowbase+q0+wid*QBLK)*OPITCH+h*D;
  { bf16*stg=(bf16*)(shm+LDS_OST)+wid*2048;
    #pragma unroll
    for(int r=0;r<16;++r){const int orow=crow(r,hi);
      #pragma unroll
      for(int d0=0;d0<2;++d0)stg[orow*64+d0*32+r32]=__float2bfloat16(o[d0][r]*rli[r]);}
    asm volatile("s_waitcnt lgkmcnt(0)":::"memory");
    #pragma unroll
    for(int i=0;i<4;++i){const int row=i*8+(lane>>3),ch=lane&7; const u32x4 v=*(const u32x4*)(stg+row*64+ch*8); ATTN_STORE16(Ow+(long)row*OPITCH+ch*8,v);} }
  asm volatile("s_waitcnt lgkmcnt(0)\n\ts_barrier":::"memory");
  #undef DMA_K
  #undef DMA_V
  #undef WLOAD
  #undef START
  #undef RESC
  #undef ROT
}
constexpr int ATTN_LDS_BYTES=LDS_BYTES;
struct AttnTensors { const bf16* Q; const bf16* K; const bf16* V; bf16* O; const unsigned* MASK; };
struct AttnUnit { int bh; int qb; };
struct StaticOrder {
  int vcu;
  int grid;
  __device__ __forceinline__ explicit StaticOrder(int grid_,int block):vcu((grid_%8==0)?(block%8)*(grid_/8)+block/8:block),grid(grid_){}
  __device__ __forceinline__ bool next(int i,AttnUnit&u)const{ const int v=vcu+(i>>2)*grid; if(v>=256)return false; const int k=i&3,s=v&7; u.bh=v>>3; u.qb=(k==0)?s:(k==1)?15-s:(k==2)?16+s:31-s; return true; }
  __device__ __forceinline__ void a_ready(const AttnUnit&)const{}
  __device__ __forceinline__ void done(const AttnUnit&)const{}
};
template<class Sched,int THRL=8> __device__ __forceinline__ void attn_phase(char*lds,const AttnTensors&T,const Sched&S){
  AttnUnit u;
  for(int i=0;S.next(i,u);++i){ S.a_ready(u); attn_unit<THRL>(u.bh/NHEAD,u.bh%NHEAD,u.qb,T.Q,T.K,T.V,T.O,T.MASK,lds); S.done(u); }
}
#undef SBAR
#undef WAIT_BAR
}

#ifndef MK_EN
#define MK_EN 0x3ff
#endif
#define EN(n) (((MK_EN) >> (n)) & 1)
#ifndef MK_NAIVE_SELECT
#define MK_NAIVE_SELECT 0
#endif
#ifndef MK_NAIVE_ATTN
#define MK_NAIVE_ATTN 0
#endif
#ifndef MK_DUP
#define MK_DUP 0
#endif
#ifndef MK_REPN
#define MK_REPN 1
#endif
#define REP(n) for (int rep_ = 0; rep_ < 1 + MK_REPN * (((MK_DUP) >> (n)) & 1); ++rep_)
#ifndef MK_ONE_LAUNCH
#define MK_ONE_LAUNCH 1
#endif
__device__ __forceinline__ bool static_unit(int nM, int nN, int G, int c, int i, int& pm, int& pn) {
    const int nwg = nM * nN; const long L = (long)i * G + c; if (L >= nwg) return false;
    int wgid = (int)L; { const int q = nwg / 8, r = nwg % 8, xcd = wgid % 8, off = wgid / 8; wgid = (xcd < r ? xcd * (q + 1) : r * (q + 1) + (xcd - r) * q) + off; }
    const int nig = 8 * nN, gid = wgid / nig, fm = gid * 8, gsz = (nM - fm) < 8 ? (nM - fm) : 8;
    pm = fm + ((wgid % nig) % gsz); pn = (wgid % nig) / gsz; return true;
}
__global__ void __launch_bounds__(NWAVES * 64, 2) mk_fwd(Args args) {
    extern __shared__ __attribute__((aligned(16))) unsigned char lds[];
    Frame F;
    F.lds = (LAS unsigned char*)lds; F.MISC = (volatile LAS unsigned*)(F.lds + MISC_OFF);
    F.tid = threadIdx.x; F.lane = F.tid & 63; F.wave = __builtin_amdgcn_readfirstlane(F.tid >> 6);
    F.G = gridDim.x; { const int bx = blockIdx.x; F.vcu = (F.G % 8 == 0) ? (bx % 8) * (F.G / 8) + bx / 8 : bx; }
    KArgs A = (KArgs)__builtin_amdgcn_kernarg_segment_ptr();
    unsigned char* ws = A->ws; F.ws = ws; F.ctl = (gu32*)(ws + WS_CTL);
#define PHASE_BEGIN() do { int t_ = threadIdx.x; asm volatile("" : "+v"(t_)); F.tid = t_; F.lane = t_ & 63; F.wave = __builtin_amdgcn_readfirstlane(t_ >> 6); \
        A = (KArgs)__builtin_amdgcn_kernarg_segment_ptr(); asm volatile("" : "+s"(A)); ws = A->ws; F.ws = ws; F.ctl = (gu32*)(ws + WS_CTL); } while (0)
    for (int u = F.tid; u < (LDS_BYTES - LDSCTL_OFF) / 4; u += NWAVES * 64) ((LAS unsigned*)(F.lds + LDSCTL_OFF))[u] = 0u;
    __syncthreads();
    const int lo = A->ph_lo, hi = A->ph_hi;
    XcdBarrier bar; bar.bar = (unsigned*)(F.ctl + CW_BAR); bar.x = 0; bar.st = nullptr;
    if (hi - lo > 1) bar = xcd_barrier_post((unsigned*)(F.ctl + CW_BAR), F.MISC + 8);
#define IN(k) (lo <= (k) && (k) < hi)
#define SEAM(k) do { if (IN(k) && IN((k) + 1)) xcd_barrier(bar); } while (0)
#define X ((bf16*)(ws + WS_X))
#define SSV(k) ((float*)(ws + WS_SS + (size_t)((k) & 1) * SS_STAGE))

    if (EN(0) && IN(0)) { PHASE_BEGIN(); REP(0) p0_prologue(F, A); SEAM(0); }
    for (int l = 0; l < DEPTH; ++l) {
        const int pb = 2 + 11 * l;
#define FFN_UP(PH, WGU, SSIN, F8C) if (EN(2) && IN(PH)) { PHASE_BEGIN(); unsigned char* wl = ws + WS_W + (size_t)l * W_LAYER; \
            pg8::StaticOrder S; S.init(M, NGU, F.G, (int)blockIdx.x); \
            if (F8C) { pg8::Gemm g{(const bf16*)(ws + WS_X8), (const bf16*)(wl + (WGU)), M, NGU, D / 2}; pg8::EpiSwiGLU E{(bf16*)(ws + WS_H), SSV(SSIN), 1.f / 64.f};     \
                REP(2) pg8::gemm_phase<pg8::EpiSwiGLU, pg8::StaticOrder, true, true, true>(F.lds + RING_OFF, g, S, E); } \
            else { pg8::Gemm g{X, (const bf16*)(wl + (WGU)), M, NGU, D}; pg8::EpiSwiGLU E{(bf16*)(ws + WS_H), SSV(SSIN), 1.f}; \
                REP(2) pg8::gemm_phase<pg8::EpiSwiGLU, pg8::StaticOrder, true, true>(F.lds + RING_OFF, g, S, E); } SEAM(PH); }
#define GEMM_RES(PH, A, W, KK, SSOUT, SCALE, F8, WX8, AB) if (EN(3) && IN(PH)) { PHASE_BEGIN(); unsigned char* wl = ws + WS_W + (size_t)l * W_LAYER; \
            pg8::Gemm g{(const bf16*)(A), (const bf16*)(wl + (W)), M, D, (KK)}; pg8::StaticOrder S; S.init(M, D, F.G, (int)blockIdx.x); \
            REP(3) { const pg8::EpiRes<WX8> E{X, SSV(SSOUT), rep_ ? 0.f : (SCALE)}; pg8::gemm_phase<pg8::EpiRes<WX8>, pg8::StaticOrder, true, true, F8, AB>(F.lds + RING_OFF, g, S, E); } SEAM(PH); }
        FFN_UP(pb + 0, WO_GU1, 4 * l, false)
        GEMM_RES(pb + 1, ws + WS_H, WO_D1, FF / 2, 4 * l + 1, 0.5f / 64.f, true, false, true)
        if (EN(4) && IN(pb + 2)) { PHASE_BEGIN(); unsigned char* wl = ws + WS_W + (size_t)l * W_LAYER;
            pg8::Gemm g{(const bf16*)ws, (const bf16*)ws, M, NINP, D}; const pg8::WinKVOrder S{F.G, (int)blockIdx.x, (int)((WS_W + (size_t)l * W_LAYER + WO_IN) >> 19), l == 0 ? 64 : 0};
            const pg8::EpiWinKV E{ws, SSV(4 * l + 1), QSCALE, (int)((WS_W + (size_t)l * W_LAYER + WO_IN) >> 19)};
            REP(4) pg8::gemm_phase<pg8::EpiWinKV, pg8::WinKVOrder, true, true>(F.lds + RING_OFF, g, S, E); SEAM(pb + 2);
        }
        if (EN(5) && IN(pb + 3)) { PHASE_BEGIN(); REP(5) {
            REP(10) for (int u = F.vcu; u < M / 64; u += F.G) conv_a_unit(F, (const bf16*)(ws + WS_HG), (bf16*)(ws + WS_MIX), INF(A, I_CONF_DW) + l * 31 * 256, INF(A, I_CONF_DW_B) + l * 256, INF(A, I_CONF_LN_G) + l * 256, INF(A, I_CONF_LN_B) + l * 256, u);
            REP(11) conv_b_all(F, (const bf16*)(ws + WS_U), (const bf16*)(ws + WS_BG), (bf16*)(ws + WS_MIX), INF(A, I_SC_DW) + l * 3 * 256);
#if !MK_NAIVE_SELECT
            for (int u = F.tid; u < 32 * IX_HS + 192; u += NWAVES * 64) ((LAS unsigned*)(F.lds + RING_OFF))[u] = 0u;
            __syncthreads();
            for (int u = F.vcu; u < 1024; u += F.G) { int b, j; idx_unit_of(u, b, j); idx_unit(F, (const bf16*)(ws + WS_QI), (const bf16*)(ws + WS_KI), (const float*)(ws + WS_WI), (unsigned*)(ws + (l ? WS_MASK1 : WS_MASK)), b, j); }
#endif
            }
            SEAM(pb + 3);
        }
        if (EN(6) && IN(pb + 4)) { PHASE_BEGIN();
#if MK_NAIVE_SELECT
            for (int q = F.vcu; q < M; q += F.G) dsa_naive_query<false>(F, (const bf16*)(ws + WS_Q), (const bf16*)(ws + WS_K), (const bf16*)(ws + WS_V), (const bf16*)(ws + WS_QI), (const bf16*)(ws + WS_KI), (const float*)(ws + WS_WI), nullptr, (bf16*)(ws + WS_MIX), q);
#elif MK_NAIVE_ATTN
            for (int q = F.vcu; q < M; q += F.G) dsa_naive_query<true>(F, (const bf16*)(ws + WS_Q), (const bf16*)(ws + WS_K), (const bf16*)(ws + WS_V), (const bf16*)(ws + WS_QI), (const bf16*)(ws + WS_KI), (const float*)(ws + WS_WI), (const unsigned long long*)(ws + (l ? WS_MASK1 : WS_MASK)), (bf16*)(ws + WS_MIX), q);
#else
            { const attn_body::AttnTensors AT{(const attn_body::bf16*)(ws + WS_Q), (const attn_body::bf16*)(ws + WS_K), (const attn_body::bf16*)(ws + WS_V), (attn_body::bf16*)(ws + WS_MIX) + 512, (const unsigned*)(ws + (l ? WS_MASK1 : WS_MASK))};
              const attn_body::StaticOrder S((int)F.G, (int)blockIdx.x);
              REP(6) attn_body::attn_phase<attn_body::StaticOrder>((char*)lds + RING_OFF, AT, S); }
#endif
            SEAM(pb + 4);
        }
        GEMM_RES(pb + 5, ws + WS_MIX, WO_OUT, D, 4 * l + 2, 1.0f, false, true, false)
        if (EN(7) && IN(pb + 6)) { PHASE_BEGIN(); unsigned char* wl = ws + WS_W + (size_t)l * W_LAYER;
            pg8::Gemm g{(const bf16*)(ws + WS_X8), (const bf16*)(wl + WO_Q), M, D, D / 2}; pg8::StaticOrder S; S.init(M, D, F.G, (int)blockIdx.x);
            pg8::EpiRowScale E{(bf16*)(ws + WS_XQ), D, SSV(4 * l + 2), XQSCALE / 64.f};
            REP(7) pg8::gemm_phase<pg8::EpiRowScale, pg8::StaticOrder, true, true, true>(F.lds + RING_OFF, g, S, E);
            if (EN(8)) { PHASE_BEGIN(); for (int i = 0;; ++i) { int upm, upn; if (!static_unit(M / 256, D / 256, F.G, (int)blockIdx.x, i, upm, upn)) break; xattn_unit(F, (const bf16*)(ws + WS_XQ), ws + WS_XO8, (const bf16*)(ws + WS_MEMK) + (size_t)l * 1024 * 1024, (const bf16*)(ws + WS_MEMVT) + (size_t)l * 1024 * 1024, upm, upn); } }
            SEAM(pb + 6);
        }
        GEMM_RES(pb + 8, ws + WS_XO8, WO_O, D / 2, 4 * l + 3, 1.0f / 64.f, true, true, false)
        FFN_UP(pb + 9, WO_GU2, 4 * l + 3, l >= GU8_FROM)
        GEMM_RES(pb + 10, ws + WS_H, WO_D2, FF / 2, 4 * l + 4, 0.5f / 64.f, true, false, true)
    }
    if (EN(9) && IN(NPH - 1)) { PHASE_BEGIN(); final_norm_all(F, X, SSV(4 * DEPTH), INF(A, I_FINAL_NORM), A->out); }
#undef IN
#undef SEAM
#undef X
#undef SSV
}

extern "C" void kernel_launch(void* const* d_in, const int* in_sizes, int n_in, void* d_out, int out_size, void* d_ws, size_t ws_size, hipStream_t stream) {
    static int grid = 0;
    if (grid == 0) {
        if (n_in != 25 || in_sizes[0] != M * D || out_size != M * D || ws_size < WS_END) { fprintf(stderr, "kernel_launch: unexpected shapes (n_in %d, in0 %d, out %d, ws %zu); nothing launched\n", n_in, n_in > 0 ? in_sizes[0] : -1, out_size, ws_size); grid = -1; return; }
        int dev = 0, cus = 0, per_cu = 0;
        if (hipGetDevice(&dev) != hipSuccess || hipDeviceGetAttribute(&cus, hipDeviceAttributeMultiprocessorCount, dev) != hipSuccess) { grid = -1; return; }
        if (hipFuncSetAttribute((const void*)mk_fwd, hipFuncAttributeMaxDynamicSharedMemorySize, LDS_BYTES) != hipSuccess) { fprintf(stderr, "kernel_launch: hipFuncSetAttribute failed\n"); grid = -1; return; }
        if (hipOccupancyMaxActiveBlocksPerMultiprocessor(&per_cu, (const void*)mk_fwd, NWAVES * 64, LDS_BYTES) != hipSuccess || per_cu < 1) { fprintf(stderr, "kernel_launch: occupancy query reports %d\n", per_cu); }
        (void)hipGetLastError();
        grid = cus;
    }
    if (grid < 0) return;
    if (hipMemsetAsync((char*)d_ws + WS_CTL, 0, CTL_ZERO_BYTES, stream) != hipSuccess) return;
    Args a{};
    for (int i = 0; i < 25; ++i) a.in[i] = d_in[i];
    a.out = (float*)d_out; a.ws = (unsigned char*)d_ws;
    for (int i = 0; i < 32; ++i) a.invf[i] = powf(10000.0f, -(float)(2 * i) / 64.0f);
#if MK_ONE_LAUNCH
    a.ph_lo = 0; a.ph_hi = NPH;
    hipLaunchKernelGGL(mk_fwd, dim3(grid), dim3(NWAVES * 64), LDS_BYTES, stream, a);
#else
    for (int p = 0; p < NPH; ++p) { a.ph_lo = p; a.ph_hi = p + 1; hipLaunchKernelGGL(mk_fwd, dim3(grid), dim3(NWAVES * 64), LDS_BYTES, stream, a); }
#endif
}
```
